# Optimizing an MI355X kernel written in HIP

```python
import math
import jax, jax.numpy as jnp
from jax import lax
import numpy as np

D_MODEL = 1024
BATCH = 32
SEQ = 256
DEPTH = 2
DEC_BATCH = 8
DEC_SEQ = 1024
PAST_LEN = 256

GRID_W = 64
HEAD_DIM = 64
BLOCK = 128
ROPE_BASE = 10000.0
EPS = 1e-6
WIN_HEADS = 8
WIN_KV_HEADS = 2
WIN_GROUP = WIN_HEADS // WIN_KV_HEADS
WINDOW = 128
WIN_Q_W = WIN_HEADS * HEAD_DIM
WIN_KV_W = WIN_KV_HEADS * HEAD_DIM
ATTN_SCALE = HEAD_DIM ** -0.5
RET_HEADS = 4
RET_CHUNK = 128
RET_W = RET_HEADS * HEAD_DIM
RET_K_SCALE = HEAD_DIM ** -0.5
MLA_HEADS = 4
MLA_NOPE = 64
MLA_ROPE = 32
MLA_V = 64
MLA_KV_RANK = 128
MLA_QK = MLA_NOPE + MLA_ROPE
MLA_Q_W = MLA_HEADS * MLA_QK
MLA_SCALE = MLA_QK ** -0.5
D_IN = WIN_Q_W + 2 * WIN_KV_W + 4 * RET_W + MLA_Q_W + MLA_KV_RANK + MLA_ROPE
MIX_W = WIN_Q_W + RET_W + MLA_HEADS * MLA_V
D_FF = 4 * D_MODEL
N_MOD = 6

kernel_name = 'hybrid_prefix_diffusion_step'


def rms_norm(x, gain):
    xf = x.astype(jnp.float32)
    y = xf * lax.rsqrt(jnp.mean(xf * xf, axis=-1, keepdims=True) + EPS)
    return (y * gain.astype(jnp.float32)).astype(x.dtype)


def head_layer_norm(x, gain):
    mu = jnp.mean(x, axis=-1, keepdims=True)
    var = jnp.mean(jnp.square(x - mu), axis=-1, keepdims=True)
    y = ((x - mu) * lax.rsqrt(var + EPS)).reshape(x.shape[:-2] + (-1,))
    return y * gain.astype(jnp.float32)


def axial_angles(n_tokens, dim):
    rows = n_tokens // GRID_W
    t = jnp.arange(rows * GRID_W)
    row = (t // GRID_W).astype(jnp.float32)
    col = (t % GRID_W).astype(jnp.float32)
    n_freq = dim // 4
    inv_freq = ROPE_BASE ** (-jnp.arange(n_freq, dtype=jnp.float32) / n_freq)
    return row[:, None] * inv_freq, col[:, None] * inv_freq


def rotate(x, ang):
    x1, x2 = jnp.split(x, 2, axis=-1)
    c, s = jnp.cos(ang), jnp.sin(ang)
    return jnp.concatenate([x1 * c - x2 * s, x1 * s + x2 * c], axis=-1)


def axial_rope(x, ang_row, ang_col):
    xr, xc = jnp.split(x.astype(jnp.float32), 2, axis=-1)
    out = jnp.concatenate([rotate(xr, ang_row[:, None, :]), rotate(xc, ang_col[:, None, :])], axis=-1)
    return out.astype(x.dtype)


def sink_softmax(s, sink):
    m = jnp.maximum(jnp.max(s, axis=-1, keepdims=True), sink)
    p = jnp.exp(s - m)
    return p / (jnp.sum(p, axis=-1, keepdims=True) + jnp.exp(sink - m))


def window_attn_context(q, k, v, sink):
    b, l = q.shape[:2]
    qg = q.reshape(b, l, WIN_KV_HEADS, WIN_GROUP, HEAD_DIM)
    s = jnp.einsum('bqkgd,bskd->bkgqs', qg, k).astype(jnp.float32) * ATTN_SCALE
    p = sink_softmax(s, sink.astype(jnp.float32).reshape(1, WIN_KV_HEADS, WIN_GROUP, 1, 1))
    o = jnp.einsum('bkgqs,bskd->bqkgd', p.astype(v.dtype), v)
    return o.reshape(b, l, WIN_Q_W)


def window_attn_latent(q, k, v, k_ctx, v_ctx, sink):
    b, t = q.shape[:2]
    nb = t // BLOCK
    qb = q.reshape(b, nb, BLOCK, WIN_KV_HEADS, WIN_GROUP, HEAD_DIM)

    def neighbours(a):
        ap = jnp.pad(a, ((0, 0), (BLOCK, BLOCK), (0, 0), (0, 0))).reshape(b, nb + 2, BLOCK, WIN_KV_HEADS, HEAD_DIM)
        return jnp.concatenate([ap[:, :-2], ap[:, 1:-1], ap[:, 2:]], axis=2)

    kn, vn = neighbours(k), neighbours(v)
    qpos = jnp.arange(nb)[:, None] * BLOCK + jnp.arange(BLOCK)[None, :]
    kpos = jnp.arange(nb)[:, None] * BLOCK - BLOCK + jnp.arange(3 * BLOCK)[None, :]
    kp = kpos[:, None, :]
    valid = (jnp.abs(kp - qpos[:, :, None]) <= WINDOW) & (kp >= 0) & (kp < t)
    s_loc = jnp.einsum('bnqkgd,bnskd->bnkgqs', qb, kn).astype(jnp.float32) * ATTN_SCALE
    s_loc = jnp.where(valid[None, :, None, None], s_loc, -jnp.inf)
    s_ctx = jnp.einsum('bnqkgd,bskd->bnkgqs', qb, k_ctx).astype(jnp.float32) * ATTN_SCALE
    p = sink_softmax(jnp.concatenate([s_loc, s_ctx], axis=-1),
                     sink.astype(jnp.float32).reshape(1, 1, WIN_KV_HEADS, WIN_GROUP, 1, 1))
    p_loc = p[..., :3 * BLOCK].astype(v.dtype)
    p_ctx = p[..., 3 * BLOCK:].astype(v.dtype)
    o = (jnp.einsum('bnkgqs,bnskd->bnqkgd', p_loc, vn)
         + jnp.einsum('bnkgqs,bskd->bnqkgd', p_ctx, v_ctx))
    return o.reshape(b, t, WIN_Q_W)


def retention_scan(q, k, v, log_gamma, s0):
    b, t, h, d = q.shape
    nc = t // RET_CHUNK
    idx = jnp.arange(RET_CHUNK, dtype=jnp.float32)
    rel = idx[:, None] - idx[None, :]
    lower = rel >= 0
    intra = jnp.where(lower[None], jnp.exp(jnp.where(lower, rel, 0.0)[None] * log_gamma[:, None, None]), 0.0)
    q_dec = jnp.exp((idx[:, None] + 1.0) * log_gamma[None, :])
    k_dec = jnp.exp((RET_CHUNK - 1.0 - idx[:, None]) * log_gamma[None, :])
    c_dec = jnp.exp(RET_CHUNK * log_gamma)

    def chunks(a):
        return a.reshape(b, nc, RET_CHUNK, h, d).transpose(1, 0, 2, 3, 4)

    def step(state, inp):
        qc, kc, vc = inp
        scores = jnp.einsum('bihd,bjhd->bhij', qc, kc) * intra
        o = (jnp.einsum('bhij,bjhe->bihe', scores, vc)
             + jnp.einsum('bihd,bhde->bihe', qc * q_dec[:, :, None], state))
        state = c_dec[:, None, None] * state + jnp.einsum('bjhd,bjhe->bhde', kc * k_dec[:, :, None], vc)
        return state, o

    s_fin, o = lax.scan(step, s0, (chunks(q), chunks(k), chunks(v)))
    return o.transpose(1, 0, 2, 3, 4).reshape(b, t, h, d), s_fin


def bidir_retention(q, k, v, g, decay_logit, gn_gain, s0):
    dt = q.dtype
    qf = q.astype(jnp.float32)
    kf = k.astype(jnp.float32) * RET_K_SCALE
    vf = v.astype(jnp.float32)
    log_gamma = jax.nn.log_sigmoid(decay_logit.astype(jnp.float32))
    s0 = s0.astype(jnp.float32)
    o_f, s_f = retention_scan(qf, kf, vf, log_gamma[0], s0[:, 0])
    o_b, s_b = retention_scan(jnp.flip(qf, 1), jnp.flip(kf, 1), jnp.flip(vf, 1), log_gamma[1], s0[:, 1])
    o = o_f + jnp.flip(o_b, 1)
    y = head_layer_norm(o, gn_gain) * jax.nn.silu(g.astype(jnp.float32))
    return y.astype(dt), jnp.stack([s_f, s_b], axis=1)


def mla_expand(ckv_n, w_kv_b):
    kv = (ckv_n @ w_kv_b).reshape(ckv_n.shape[:2] + (MLA_HEADS, MLA_NOPE + MLA_V))
    return kv[..., :MLA_NOPE], kv[..., MLA_NOPE:]


def mla_attend(q_nope, q_rope, k_nope, k_rope, v):
    s = (jnp.einsum('bqhd,bshd->bhqs', q_nope, k_nope)
         + jnp.einsum('bqhr,bsr->bhqs', q_rope, k_rope)).astype(jnp.float32) * MLA_SCALE
    p = jax.nn.softmax(s, axis=-1).astype(v.dtype)
    return jnp.einsum('bhqs,bshd->bqhd', p, v)


def mla_latent(q_nope, q_rope, k_nope, k_rope, v):
    b, t = q_nope.shape[:2]
    nb = t // BLOCK

    def blocks(a):
        return a.reshape((b, nb, BLOCK) + a.shape[2:]).swapaxes(0, 1)

    o = lax.map(lambda qs: mla_attend(qs[0], qs[1], k_nope, k_rope, v), (blocks(q_nope), blocks(q_rope)))
    return o.swapaxes(0, 1).reshape(b, t, MLA_HEADS * MLA_V)


def in_split_points():
    sizes = (WIN_Q_W, WIN_KV_W, WIN_KV_W, RET_W, RET_W, RET_W, RET_W, MLA_Q_W, MLA_KV_RANK, MLA_ROPE)
    points, acc = [], 0
    for s in sizes[:-1]:
        acc += s
        points.append(acc)
    return points


def trunk_layer(x, mod, lp, ctx=None):
    norm1, norm2, w_in, sink, decay, gn, kvn, w_kv_b, w_out, w_up, w_down = lp
    b, n, _ = x.shape
    shift1, scale1, gate1, shift2, scale2, gate2 = [mod[:, i][:, None, :] for i in range(N_MOD)]
    h = rms_norm(x, norm1) * (1.0 + scale1) + shift1
    proj = h @ w_in
    qa, ka, va, qb, kb, vb, gb, qc, ckv, krope = jnp.split(proj, in_split_points(), axis=-1)
    qa = qa.reshape(b, n, WIN_HEADS, HEAD_DIM)
    ka = ka.reshape(b, n, WIN_KV_HEADS, HEAD_DIM)
    va = va.reshape(b, n, WIN_KV_HEADS, HEAD_DIM)
    qb = qb.reshape(b, n, RET_HEADS, HEAD_DIM)
    kb = kb.reshape(b, n, RET_HEADS, HEAD_DIM)
    vb = vb.reshape(b, n, RET_HEADS, HEAD_DIM)
    qc = qc.reshape(b, n, MLA_HEADS, MLA_QK)
    q_nope, q_rope = qc[..., :MLA_NOPE], qc[..., MLA_NOPE:]
    ckv_n = rms_norm(ckv, kvn)
    k_nope, v_c = mla_expand(ckv_n, w_kv_b)
    if ctx is None:
        out_a = window_attn_context(qa, ka, va, sink)
        s_zero = jnp.zeros((b, 2, RET_HEADS, HEAD_DIM, HEAD_DIM), jnp.float32)
        out_b, s_ret = bidir_retention(qb, kb, vb, gb, decay, gn, s_zero)
        out_c = mla_attend(q_nope, q_rope, k_nope, krope, v_c).reshape(b, n, MLA_HEADS * MLA_V)
        new = (ka, va, ckv_n, krope, s_ret.astype(x.dtype))
    else:
        c_k, c_v, c_ckv, c_krope, c_state = ctx
        ar, ac = axial_angles(n, HEAD_DIM)
        out_a = window_attn_latent(axial_rope(qa, ar, ac), axial_rope(ka, ar, ac), va, c_k, c_v, sink)
        out_b, _ = bidir_retention(qb, kb, vb, gb, decay, gn, c_state)
        mr, mc = axial_angles(n, MLA_ROPE)
        q_rope = axial_rope(q_rope, mr, mc)
        krope = axial_rope(krope[:, :, None, :], mr, mc)[:, :, 0, :]
        ck_nope, cv_c = mla_expand(c_ckv, w_kv_b)
        out_c = mla_latent(q_nope, q_rope,
                           jnp.concatenate([k_nope, ck_nope], axis=1),
                           jnp.concatenate([krope, c_krope], axis=1),
                           jnp.concatenate([v_c, cv_c], axis=1))
        new = None
    mix = jnp.concatenate([out_a, out_b, out_c], axis=-1) @ w_out
    x = x + gate1 * mix
    h2 = rms_norm(x, norm2) * (1.0 + scale2) + shift2
    x = x + gate2 * (jnp.square(jax.nn.relu(h2 @ w_up)) @ w_down)
    return x, new


def setup_inputs(seed: int = 0) -> dict:
    key = jax.random.key(seed)
    ks = jax.random.split(key, 26)

    def nrm(k, shape, s=1.0):
        return jax.random.normal(k, shape, jnp.float32) * s

    base = 1.0 - 2.0 ** (-5.0 - jnp.arange(RET_HEADS, dtype=jnp.float32))
    decay_logit = jnp.log(base) - jnp.log1p(-base)
    return {
        'x_prompt': nrm(ks[0], (BATCH, SEQ, D_MODEL)),
        'x_sample': nrm(ks[1], (DEC_BATCH, DEC_SEQ, D_MODEL)),
        'cache_win_k': nrm(ks[2], (DEC_BATCH, DEPTH, PAST_LEN, WIN_KV_HEADS, HEAD_DIM)),
        'cache_win_v': nrm(ks[3], (DEC_BATCH, DEPTH, PAST_LEN, WIN_KV_HEADS, HEAD_DIM)),
        'cache_mla_ckv': nrm(ks[4], (DEC_BATCH, DEPTH, PAST_LEN, MLA_KV_RANK)),
        'cache_mla_krope': nrm(ks[5], (DEC_BATCH, DEPTH, PAST_LEN, MLA_ROPE)),
        'state_ret': nrm(ks[6], (DEC_BATCH, DEPTH, 2, RET_HEADS, HEAD_DIM, HEAD_DIM), 0.5),
        'c': nrm(ks[7], (DEC_BATCH, D_MODEL)),
        'c_ctx': nrm(ks[8], (D_MODEL,)),
        'w_mod': nrm(ks[9], (DEPTH, D_MODEL, N_MOD * D_MODEL), 0.5 * D_MODEL ** -0.5),
        'b_mod': nrm(ks[10], (DEPTH, N_MOD * D_MODEL), 0.02),
        'norm1': 1.0 + nrm(ks[11], (DEPTH, D_MODEL), 0.02),
        'norm2': 1.0 + nrm(ks[12], (DEPTH, D_MODEL), 0.02),
        'w_in': nrm(ks[13], (DEPTH, D_MODEL, D_IN), D_MODEL ** -0.5),
        'win_sink': nrm(ks[14], (DEPTH, WIN_HEADS), 0.5),
        'ret_decay': decay_logit[None, None, :] + nrm(ks[15], (DEPTH, 2, RET_HEADS), 0.1),
        'ret_gn': 1.0 + nrm(ks[16], (DEPTH, RET_W), 0.02),
        'mla_kv_norm': 1.0 + nrm(ks[17], (DEPTH, MLA_KV_RANK), 0.02),
        'w_kv_b': nrm(ks[18], (DEPTH, MLA_KV_RANK, MLA_HEADS * (MLA_NOPE + MLA_V)), MLA_KV_RANK ** -0.5),
        'w_out': nrm(ks[19], (DEPTH, MIX_W, D_MODEL), MIX_W ** -0.5),
        'w_up': nrm(ks[20], (DEPTH, D_MODEL, D_FF), D_MODEL ** -0.5),
        'w_down': nrm(ks[21], (DEPTH, D_FF, D_MODEL), D_FF ** -0.5),
        'final_norm': 1.0 + nrm(ks[22], (D_MODEL,), 0.02),
    }


def reference(x_prompt, x_sample, cache_win_k, cache_win_v, cache_mla_ckv, cache_mla_krope, state_ret,
              c, c_ctx, w_mod, b_mod, norm1, norm2, w_in, win_sink, ret_decay, ret_gn, mla_kv_norm,
              w_kv_b, w_out, w_up, w_down, final_norm):
    silu_ctx = jax.nn.silu(c_ctx)[None, :]
    silu_lat = jax.nn.silu(c)
    xp, xs = x_prompt, x_sample
    new_k, new_v, new_ckv, new_kr, new_s = [], [], [], [], []
    for l in range(DEPTH):
        lp = (norm1[l], norm2[l], w_in[l], win_sink[l], ret_decay[l], ret_gn[l], mla_kv_norm[l],
              w_kv_b[l], w_out[l], w_up[l], w_down[l])
        mod_ctx = (silu_ctx @ w_mod[l] + b_mod[l]).reshape(1, N_MOD, D_MODEL)
        mod_lat = (silu_lat @ w_mod[l] + b_mod[l]).reshape(-1, N_MOD, D_MODEL)
        xp, (k_l, v_l, ckv_l, kr_l, s_l) = trunk_layer(xp, mod_ctx, lp)
        ctx_l = (cache_win_k[:, l], cache_win_v[:, l], cache_mla_ckv[:, l], cache_mla_krope[:, l], state_ret[:, l])
        xs, _ = trunk_layer(xs, mod_lat, lp, ctx_l)
        new_k.append(k_l)
        new_v.append(v_l)
        new_ckv.append(ckv_l)
        new_kr.append(kr_l)
        new_s.append(s_l)
    y_prompt = rms_norm(xp, final_norm)
    y_sample = rms_norm(xs, final_norm)
    return (y_prompt, y_sample, jnp.stack(new_k, axis=1), jnp.stack(new_v, axis=1),
            jnp.stack(new_ckv, axis=1), jnp.stack(new_kr, axis=1), jnp.stack(new_s, axis=1))
```

```cpp
#include <hip/hip_runtime.h>
#include <hip/hip_cooperative_groups.h>
#include <cstdio>
#include <cstdint>
namespace cg = cooperative_groups;

__device__ __forceinline__ int lane_id() { return (int)__builtin_amdgcn_mbcnt_hi(~0u, __builtin_amdgcn_mbcnt_lo(~0u, 0u)); }

namespace pg8 {
#define PG8_LAS __attribute__((address_space(3)))
typedef unsigned short bf16_t;
typedef short bf16x8 __attribute__((ext_vector_type(8)));
typedef float f32x4 __attribute__((ext_vector_type(4)));
typedef unsigned u32x4 __attribute__((ext_vector_type(4)));
constexpr int BM = 256, BK = 64, HALF = 128, HTB = HALF * BK * 2  , STAGE_BYTES = 8 * HTB, NXCD = 8, WGM = 8;

__host__ __device__ __forceinline__ int lds_byte(int r, int c) { const int st = (r >> 4) * 2 + (c >> 5), rr = r & 15, cc = c & 31, ob = rr * 64 + cc * 2; return st * 1024 + (ob ^ (((ob >> 9) & 1) << 5)); }
__host__ __device__ __forceinline__ void stage_rc(int b, int& R, int& C) { const int st = b / 1024, sb = b % 1024, swz = sb ^ (((sb >> 9) & 1) << 5); R = (st >> 1) * 16 + swz / 64; C = (st & 1) * 32 + (swz % 64) / 2; }
__host__ __device__ __forceinline__ int perm32(int rho) { const int n = rho >> 4, i = rho & 15; return 8 * (i >> 2) + 4 * n + (i & 3); }

struct Unit { int pm, pn; };
struct Gemm { const bf16_t* A; const bf16_t* Bt; int M, N, K; };

struct StaticOrder {
    int nM, nN, nwg, G, c;
    __host__ __device__ void init(int M, int N, int G_, int c_) { nM = M / BM; nN = N / BM; nwg = nM * nN; G = G_; c = c_; }
    __host__ __device__ bool next(int i, Unit& u) const {
        const long L = (long)i * G + c; if (L >= nwg) return false;
        int wgid = (int)L; { const int q = nwg / NXCD, r = nwg % NXCD, xcd = wgid % NXCD, off = wgid / NXCD; wgid = (xcd < r ? xcd * (q + 1) : r * (q + 1) + (xcd - r) * q) + off; }
        const int nig = WGM * nN, gid = wgid / nig, fm = gid * WGM, gsz = (nM - fm) < WGM ? (nM - fm) : WGM;
        u.pm = fm + ((wgid % nig) % gsz); u.pn = (wgid % nig) / gsz; return true;
    }
    __device__ __forceinline__ void a_ready(const Unit&) const {}
    __device__ __forceinline__ void done(const Unit&) const {}
};
template <class Epi, class Sched, bool ALIGN_EPI = false, bool SP2 = false>
__device__ __forceinline__ void gemm_phase(PG8_LAS unsigned char* lds, const Gemm g, const Sched& S, const Epi& E, const int wvp) {
    const int wid = wvp, lane = lane_id(), tid = wid * 64 + lane, wr = wid >> 2, wc = wid & 3, fr = lane & 15, fq = lane >> 4;
    const int K = g.K, nt = K / BK;
    unsigned voffA[2], voffB[2];
#pragma unroll
    for (int i = 0; i < 2; ++i) { int R, C; stage_rc(tid * 16 + i * 8192, R, C); const int Rb = Epi::PERM ? ((R & ~31) + perm32(R & 31)) : R;
        voffA[i] = (unsigned)(R * K + C) * 2u; voffB[i] = (unsigned)(Rb * K + C) * 2u; }
    const size_t kstep = (size_t)(BK * 2);
    const size_t hstep = (size_t)HALF * K * 2;
    const size_t tstep = 2 * hstep;
    const unsigned ldsw = (unsigned)wid * 1024u;
    const int aoff = lds_byte(wr * 64 + fr, fq * 8), boff = lds_byte(wc * 32 + fr, fq * 8);
#define PG8_SA(b, h) (((b) * 2 + (h)) * HTB)
#define PG8_SB(b, h) ((4 + (b) * 2 + (h)) * HTB)
#define PG8_STAGE(bufoff, gbase, voff) do { _Pragma("unroll") for (int _i = 0; _i < 2; ++_i) \
        __builtin_amdgcn_global_load_lds((const unsigned*)((const char*)(gbase) + (voff)[_i]), (PG8_LAS unsigned*)(lds + (bufoff) + ldsw + _i * 8192), 16, 0, 0); } while (0)
#define PG8_LDA(dst, b, h) do { _Pragma("unroll") for (int m = 0; m < 4; ++m) _Pragma("unroll") for (int k = 0; k < 2; ++k) dst[m][k] = *(const PG8_LAS bf16x8*)(lds + PG8_SA(b, h) + aoff + m * 2048 + k * 1024); } while (0)
#define PG8_LDB(dst, b, h) do { _Pragma("unroll") for (int n = 0; n < 2; ++n) _Pragma("unroll") for (int k = 0; k < 2; ++k) dst[n][k] = *(const PG8_LAS bf16x8*)(lds + PG8_SB(b, h) + boff + n * 2048 + k * 1024); } while (0)
#define PG8_MMA(ai, bj, At, Bt) do { __builtin_amdgcn_s_setprio(1); _Pragma("unroll") for (int m = 0; m < 4; ++m) _Pragma("unroll") for (int n = 0; n < 2; ++n) _Pragma("unroll") for (int k = 0; k < 2; ++k) \
        acc[ai][bj][m][n] = __builtin_amdgcn_mfma_f32_16x16x32_bf16(Bt[n][k], At[m][k], acc[ai][bj][m][n], 0, 0, 0); __builtin_amdgcn_s_setprio(0); } while (0)
#define PG8_WAIT_V(n) asm volatile("s_waitcnt vmcnt(" #n ")" ::: "memory")
#define PG8_WAIT_L(n) asm volatile("s_waitcnt lgkmcnt(" #n ")" ::: "memory")
#define PG8_BAR __builtin_amdgcn_s_barrier()
#define PG8_SCHED __builtin_amdgcn_sched_barrier(0)
    Unit cur, nxt; int ui = 0;
    if (!S.next(0, cur)) return;
    f32x4 acc[2][2][4][2];
#pragma unroll
    for (int a = 0; a < 2; ++a)
#pragma unroll
        for (int b = 0; b < 2; ++b)
#pragma unroll
            for (int m = 0; m < 4; ++m)
#pragma unroll
                for (int n = 0; n < 2; ++n) acc[a][b][m][n] = (f32x4){0.f, 0.f, 0.f, 0.f};
    bf16x8 At[4][2], B0[2][2], B1[2][2];
    const char* cA = (const char*)g.A + (size_t)cur.pm * tstep; const char* cB = (const char*)g.Bt + (size_t)cur.pn * tstep;
    S.a_ready(cur);
    if constexpr (SP2) {
        PG8_STAGE(PG8_SB(0, 0), cB, voffB); PG8_STAGE(PG8_SB(0, 1), cB + hstep, voffB); PG8_STAGE(PG8_SA(0, 0), cA, voffA); PG8_STAGE(PG8_SA(0, 1), cA + hstep, voffA);
        if (wr == 1) PG8_BAR;
        PG8_WAIT_V(2); PG8_BAR;
        PG8_STAGE(PG8_SB(1, 0), cB + kstep, voffB); PG8_STAGE(PG8_SA(1, 0), cA + kstep, voffA); PG8_STAGE(PG8_SB(1, 1), cB + hstep + kstep, voffB);
        PG8_WAIT_V(6); PG8_BAR;
    } else {
        PG8_STAGE(PG8_SB(0, 0), cB, voffB); PG8_STAGE(PG8_SA(0, 0), cA, voffA); PG8_STAGE(PG8_SB(0, 1), cB + hstep, voffB); PG8_STAGE(PG8_SA(0, 1), cA + hstep, voffA);
        if (wr == 1) PG8_BAR;
        PG8_WAIT_V(4); PG8_BAR;
        PG8_STAGE(PG8_SB(1, 0), cB + kstep, voffB); PG8_STAGE(PG8_SA(1, 0), cA + kstep, voffA); PG8_STAGE(PG8_SB(1, 1), cB + hstep + kstep, voffB);
        PG8_WAIT_V(6); PG8_BAR;
    }
    for (;;) {
        const bool has_next = S.next(ui + 1, nxt);
        const char* nA = has_next ? (const char*)g.A + (size_t)nxt.pm * tstep : cA; const char* nB = has_next ? (const char*)g.Bt + (size_t)nxt.pn * tstep : cB;
        for (int t = 0; t < nt; t += 2) {
            const bool last = (t == nt - 2);
            const char* a1 = cA + (size_t)(t + 1) * kstep;
            const char* a2 = last ? nA : cA + (size_t)(t + 2) * kstep; const char* b2 = last ? nB : cB + (size_t)(t + 2) * kstep;
            const char* a3 = a2 + kstep; const char* b3 = b2 + kstep;
            if (last && has_next) S.a_ready(nxt);
            if constexpr (SP2) {
            PG8_LDB(B0, 0, 0); PG8_LDB(B1, 0, 1); PG8_SCHED; PG8_LDA(At, 0, 0); PG8_STAGE(PG8_SA(1, 1), a1 + hstep, voffA);
            PG8_WAIT_V(8); PG8_WAIT_L(0); PG8_BAR; PG8_MMA(0, 0, At, B0); PG8_MMA(0, 1, At, B1); PG8_BAR; PG8_SCHED;
            PG8_LDA(At, 0, 1); PG8_STAGE(PG8_SB(0, 0), b2, voffB); PG8_STAGE(PG8_SB(0, 1), b2 + hstep, voffB); PG8_STAGE(PG8_SA(0, 0), a2, voffA);
            PG8_WAIT_V(8); PG8_WAIT_L(0); PG8_BAR; PG8_MMA(1, 0, At, B0); PG8_MMA(1, 1, At, B1); PG8_BAR; PG8_SCHED;
            PG8_LDB(B0, 1, 0); PG8_LDB(B1, 1, 1); PG8_SCHED; PG8_LDA(At, 1, 0); PG8_STAGE(PG8_SA(0, 1), a2 + hstep, voffA);
            PG8_WAIT_V(8); PG8_WAIT_L(0); PG8_BAR; PG8_MMA(0, 0, At, B0); PG8_MMA(0, 1, At, B1); PG8_BAR; PG8_SCHED;
            PG8_LDA(At, 1, 1); PG8_STAGE(PG8_SB(1, 0), b3, voffB); PG8_STAGE(PG8_SB(1, 1), b3 + hstep, voffB); PG8_STAGE(PG8_SA(1, 0), a3, voffA);
            PG8_WAIT_V(8); PG8_WAIT_L(0); PG8_BAR; PG8_MMA(1, 0, At, B0); PG8_MMA(1, 1, At, B1); PG8_BAR; PG8_SCHED;
            } else {
            PG8_LDB(B0, 0, 0); PG8_SCHED; PG8_LDA(At, 0, 0); PG8_STAGE(PG8_SA(1, 1), a1 + hstep, voffA);
            PG8_WAIT_L(8); PG8_BAR; PG8_WAIT_L(0); PG8_MMA(0, 0, At, B0); PG8_BAR; PG8_SCHED;
            PG8_LDB(B1, 0, 1); PG8_STAGE(PG8_SB(0, 0), b2, voffB);
            PG8_BAR; PG8_WAIT_L(0); PG8_MMA(0, 1, At, B1); PG8_BAR;
            PG8_LDA(At, 0, 1); PG8_STAGE(PG8_SA(0, 0), a2, voffA);
            PG8_BAR; PG8_WAIT_L(0); PG8_MMA(1, 0, At, B0); PG8_BAR; PG8_SCHED;
            PG8_STAGE(PG8_SB(0, 1), b2 + hstep, voffB);
            PG8_WAIT_V(6); PG8_BAR; PG8_MMA(1, 1, At, B1); PG8_BAR;
            PG8_LDB(B0, 1, 0); PG8_SCHED; PG8_LDA(At, 1, 0); PG8_STAGE(PG8_SA(0, 1), a2 + hstep, voffA);
            PG8_WAIT_L(8); PG8_BAR; PG8_WAIT_L(0); PG8_MMA(0, 0, At, B0); PG8_BAR; PG8_SCHED;
            PG8_LDB(B1, 1, 1); PG8_STAGE(PG8_SB(1, 0), b3, voffB);
            PG8_BAR; PG8_WAIT_L(0); PG8_MMA(0, 1, At, B1); PG8_BAR;
            PG8_LDA(At, 1, 1); PG8_STAGE(PG8_SA(1, 0), a3, voffA);
            PG8_BAR; PG8_WAIT_L(0); PG8_MMA(1, 0, At, B0); PG8_BAR; PG8_SCHED;
            PG8_STAGE(PG8_SB(1, 1), b3 + hstep, voffB);
            PG8_WAIT_V(6); PG8_BAR; PG8_MMA(1, 1, At, B1); PG8_BAR;
            }
        }
        if constexpr (ALIGN_EPI) { if (wr == 0) PG8_BAR; }
        if constexpr (!Epi::AFTER_DRAIN) { E(acc, cur, wr, wc, fr, fq); S.done(cur); }
        if (!has_next) break;
#pragma unroll
        for (int a = 0; a < 2; ++a)
#pragma unroll
            for (int b = 0; b < 2; ++b)
#pragma unroll
                for (int m = 0; m < 4; ++m)
#pragma unroll
                    for (int n = 0; n < 2; ++n) acc[a][b][m][n] = (f32x4){0.f, 0.f, 0.f, 0.f};
        cur = nxt; cA = nA; cB = nB; ++ui;
        if constexpr (ALIGN_EPI) { if (wr == 1) PG8_BAR; }
    }
    PG8_WAIT_V(0);
    if constexpr (!ALIGN_EPI) { if (wr == 0) PG8_BAR; }
    PG8_BAR;
    if constexpr (Epi::AFTER_DRAIN) { E.fused(acc, cur, wr, wc, fr, fq, lds, wid, lane); S.done(cur); }
#undef PG8_SA
#undef PG8_SB
#undef PG8_STAGE
#undef PG8_LDA
#undef PG8_LDB
#undef PG8_MMA
#undef PG8_WAIT_V
#undef PG8_WAIT_L
#undef PG8_BAR
#undef PG8_SCHED
}
}


typedef unsigned short bf16_t;
typedef short bf16x8 __attribute__((ext_vector_type(8)));
typedef float f32x16 __attribute__((ext_vector_type(16)));
typedef pg8::f32x4 f32x4;
using pg8::Unit;

constexpr int NTHR = 512, NWV = 8;
constexpr int NTOK = 16384, NCTX = 8192, DM = 1024, DIN = 2336, DINP = 2560, DFF = 4096;
constexpr int LDS_RED = 131072;
constexpr int LDS_ROPEW = 131072 + 4096, LDS_ROPEM = LDS_ROPEW + 64 * 32 * 4;
constexpr int LDS_BYTES = LDS_ROPEM + 64 * 16 * 4;
constexpr float LOG2E = 1.4426950408889634f;
constexpr float L2_10000 = 13.287712379549449f;

#define AL256(x) (((x) + 255) & ~(size_t)255)
constexpr size_t OFF_mod = 0;
constexpr size_t OFF_ropeW = OFF_mod + AL256((size_t)2 * 9 * 6144 * 4);
constexpr size_t OFF_ropeM = OFF_ropeW + AL256((size_t)64 * 32 * 4);
constexpr size_t OFF_ctl = OFF_ropeM + AL256((size_t)64 * 16 * 4);
constexpr size_t OFF_rssA = OFF_ctl + AL256((size_t)256 * 4);
constexpr size_t OFF_rssB = OFF_rssA + AL256((size_t)NTOK * 16 * 4);
constexpr size_t OFF_sWin = OFF_rssB + AL256((size_t)NTOK * 16 * 4);
constexpr size_t OFF_sWup = OFF_sWin + AL256((size_t)2 * 9 * DINP * 4);
constexpr size_t OFF_WinT = OFF_sWup + AL256((size_t)2 * 9 * DFF * 4);
constexpr size_t OFF_WoutT = OFF_WinT + AL256((size_t)2 * DINP * DM * 2);
constexpr size_t OFF_WupT = OFF_WoutT + AL256((size_t)2 * DM * DM * 2);
constexpr size_t OFF_WdownT = OFF_WupT + AL256((size_t)2 * DFF * DM * 2);
constexpr size_t OFF_WkvbT = OFF_WdownT + AL256((size_t)2 * DM * DFF * 2);
constexpr size_t OFF_hbuf = OFF_WkvbT + AL256((size_t)2 * 512 * 128 * 2);
constexpr size_t OFF_Kwin_l = OFF_hbuf + AL256((size_t)NTOK * DM * 2);
constexpr size_t OFF_Vtwin_l = OFF_Kwin_l + AL256((size_t)2 * 8 * 1280 * 128 * 2);
constexpr size_t OFF_S0t = OFF_Vtwin_l + AL256((size_t)2 * 8 * 2 * 64 * 1280 * 2);
constexpr size_t OFF_ckvn = OFF_S0t + AL256((size_t)2 * 8 * 2 * 4 * 4096 * 2);
constexpr size_t OFF_Kmla_l = OFF_ckvn + AL256((size_t)2 * 18432 * 128 * 2);
constexpr size_t OFF_Vtmla_l = OFF_Kmla_l + AL256((size_t)2 * 8 * 4 * 1280 * 96 * 2);
constexpr size_t OFF_ubuf = OFF_Vtmla_l + AL256((size_t)2 * 8 * 4 * 64 * 1280 * 2);
constexpr size_t WS_END = OFF_ubuf + AL256((size_t)NTOK * DFF * 2);
constexpr size_t OFF_mix = OFF_ubuf + (size_t)96 * 1024 * 1024;
constexpr size_t OFF_Qwin = OFF_ubuf;
constexpr size_t OFF_Kwin_c = OFF_Qwin + AL256((size_t)NTOK * 512 * 2);
constexpr size_t OFF_Vtwin_c = OFF_Kwin_c + AL256((size_t)NCTX * 128 * 2);
constexpr size_t OFF_Qret = OFF_Vtwin_c + AL256((size_t)32 * 2 * 64 * 256 * 2);
constexpr size_t OFF_Kret = OFF_Qret + AL256((size_t)NTOK * 256 * 2);
constexpr size_t OFF_Gret = OFF_Kret + AL256((size_t)NTOK * 256 * 2);
constexpr size_t OFF_Vtret_c = OFF_Gret + AL256((size_t)NTOK * 256 * 2);
constexpr size_t OFF_Vtret_l = OFF_Vtret_c + AL256((size_t)32 * 4 * 64 * 256 * 2);
constexpr size_t OFF_Qmla = OFF_Vtret_l + AL256((size_t)8 * 4 * 64 * 1024 * 2);
constexpr size_t OFF_Kmla_c = OFF_Qmla + AL256((size_t)NTOK * 384 * 2);
constexpr size_t OFF_Vtmla_c = OFF_Kmla_c + AL256((size_t)32 * 4 * 256 * 96 * 2);
static_assert(OFF_Vtmla_c + (size_t)32 * 4 * 64 * 256 * 2 <= OFF_mix && OFF_mix + (size_t)NTOK * DM * 2 <= WS_END, "attention temporaries + mix must fit in the ubuf region");
static_assert(WS_END <= (size_t)256 * 1024 * 1024, "workspace must fit 256 MiB");

struct P {
  const float *x_prompt, *x_sample, *cache_win_k, *cache_win_v, *cache_mla_ckv, *cache_mla_krope, *state_ret,
      *c, *c_ctx, *w_mod, *b_mod, *norm1, *norm2, *w_in, *win_sink, *ret_decay, *ret_gn, *mla_kv_norm,
      *w_kv_b, *w_out, *w_up, *w_down, *final_norm;
  float* out;
  unsigned char* ws;
#define WSBUF(ty, name) __device__ __forceinline__ ty* name() const { return (ty*)(ws + OFF_##name); }
  WSBUF(unsigned, ctl) WSBUF(float, mod) WSBUF(float, ropeW) WSBUF(float, ropeM) WSBUF(float, rssA) WSBUF(float, rssB) WSBUF(float, sWin) WSBUF(float, sWup) WSBUF(bf16_t, WinT) WSBUF(bf16_t, WoutT) WSBUF(bf16_t, WupT) WSBUF(bf16_t, WdownT) WSBUF(bf16_t, WkvbT)
  WSBUF(bf16_t, hbuf) WSBUF(bf16_t, mix) WSBUF(bf16_t, Qwin) WSBUF(bf16_t, Kwin_c) WSBUF(bf16_t, Vtwin_c) WSBUF(bf16_t, Kwin_l)
  WSBUF(bf16_t, Vtwin_l) WSBUF(bf16_t, Qret) WSBUF(bf16_t, Kret) WSBUF(bf16_t, Gret) WSBUF(bf16_t, Vtret_c) WSBUF(bf16_t, Vtret_l)
  WSBUF(bf16_t, S0t) WSBUF(bf16_t, Qmla) WSBUF(bf16_t, ckvn) WSBUF(bf16_t, Kmla_c) WSBUF(bf16_t, Vtmla_c) WSBUF(bf16_t, Kmla_l)
  WSBUF(bf16_t, Vtmla_l) WSBUF(bf16_t, ubuf)
  __device__ __forceinline__ float* xw() const { return out; }
};

typedef float f32x2_t __attribute__((ext_vector_type(2)));
typedef __bf16 bf16x2_t __attribute__((ext_vector_type(2)));
__device__ __forceinline__ unsigned pk2(float lo, float hi) {
  const f32x2_t v = {lo, hi};
  const bf16x2_t b = __builtin_convertvector(v, bf16x2_t);
  return __builtin_bit_cast(unsigned, b);
}
__device__ __forceinline__ bf16_t f2bf(float f) { return (bf16_t)(pk2(f, 0.f) & 0xffffu); }
__device__ __forceinline__ float bf2f(bf16_t b) { return __uint_as_float(((unsigned)b) << 16); }
__device__ __forceinline__ float shx(float v, int mask, int ln) { return __int_as_float(__builtin_amdgcn_ds_bpermute((ln ^ mask) << 2, __float_as_int(v))); }
__device__ __forceinline__ float wave_sum(float v, int ln) {
#pragma unroll
  for (int o = 1; o < 64; o <<= 1) v += shx(v, o, ln);
  return v;
}
typedef const __attribute__((address_space(4))) unsigned char* kargp_t;
__device__ __forceinline__ P load_params(kargp_t kp) {
  asm volatile("" : "+s"(kp));
  P p;
  __builtin_memcpy(&p, kp, sizeof(P));
  return p;
}
__device__ __forceinline__ int my_tid(int wv) { int w = wv; asm volatile("" : "+s"(w)); int t = w * 64 + lane_id(); asm volatile("" : "+v"(t)); return t; }
__device__ __forceinline__ int my_bid() { int b = blockIdx.x; asm volatile("" : "+s"(b)); return b; }
__device__ __forceinline__ float fexp2(float x) { return __builtin_amdgcn_exp2f(x); }
__device__ __forceinline__ int mod_row(int m) { return m < NCTX ? 0 : 1 + ((m - NCTX) >> 10); }

__device__ __forceinline__ void st_rm_bf16(bf16_t* rp, int h, const f32x16& o) {
#pragma unroll
  for (int g = 0; g < 4; ++g) {
    uint2 u;
    u.x = pk2(o[4 * g], o[4 * g + 1]);
    u.y = pk2(o[4 * g + 2], o[4 * g + 3]);
    *(uint2*)(rp + 8 * g + 4 * h) = u;
  }
}
__device__ __forceinline__ void st_tr_bf16(bf16_t* bp, int stride, int h, const f32x16& o) {
#pragma unroll
  for (int i = 0; i < 16; ++i) bp[(size_t)((i & 3) + 8 * (i >> 2) + 4 * h) * stride] = f2bf(o[i]);
}

__device__ __forceinline__ void st8_bf16(bf16_t* rp, int fq, const f32x4& a, const f32x4& b) {
  *(uint2*)(rp + 4 * fq) = make_uint2(pk2(a[0], a[1]), pk2(a[2], a[3]));
  *(uint2*)(rp + 16 + 4 * fq) = make_uint2(pk2(b[0], b[1]), pk2(b[2], b[3]));
}
__device__ __forceinline__ void st8_f32(float* rp, int fq, const f32x4& a, const f32x4& b) {
  *(f32x4*)(rp + 4 * fq) = a;
  *(f32x4*)(rp + 16 + 4 * fq) = b;
}
__device__ __forceinline__ void st8_tr(bf16_t* bp, int stride, int fq, const f32x4& a, const f32x4& b) {
#pragma unroll
  for (int j = 0; j < 4; ++j) {
    bp[(size_t)(4 * fq + j) * stride] = f2bf(a[j]);
    bp[(size_t)(16 + 4 * fq + j) * stride] = f2bf(b[j]);
  }
}
__device__ __forceinline__ void rope8_win(f32x4& a, f32x4& b, int fq, const float* tab) {
  const f32x4 cs = *(const f32x4*)(tab + 4 * fq), sn = *(const f32x4*)(tab + 16 + 4 * fq);
  const f32x4 x = a, y = b;
  a = x * cs - y * sn;
  b = x * sn + y * cs;
}
__device__ __forceinline__ void rope8_mla(f32x4& a, f32x4& b, int fq, int ln, const float* tabr, const float* tabc) {
  const int fo = 4 * (fq & 1);
  {
    const f32x4 cs = *(const f32x4*)(tabr + fo), sn = *(const f32x4*)(tabr + 8 + fo);
#pragma unroll
    for (int j = 0; j < 4; ++j) { const float pa = shx(a[j], 32, ln); a[j] = fq < 2 ? a[j] * cs[j] - pa * sn[j] : pa * sn[j] + a[j] * cs[j]; }
  }
  asm volatile("" ::: "memory");
  {
    const f32x4 cs = *(const f32x4*)(tabc + fo), sn = *(const f32x4*)(tabc + 8 + fo);
#pragma unroll
    for (int j = 0; j < 4; ++j) { const float pb = shx(b[j], 32, ln); b[j] = fq < 2 ? b[j] * cs[j] - pb * sn[j] : pb * sn[j] + b[j] * cs[j]; }
  }
}

__device__ __forceinline__ float row_rstd(const float* rss, int m) {
  const f32x4 a = *(const f32x4*)(rss + (size_t)m * 16), b = *(const f32x4*)(rss + (size_t)m * 16 + 4);
  const f32x4 c = *(const f32x4*)(rss + (size_t)m * 16 + 8), d = *(const f32x4*)(rss + (size_t)m * 16 + 12);
  const f32x4 s = (a + b) + (c + d);
  return rsqrtf(((s[0] + s[1]) + (s[2] + s[3])) * (1.f / 1024.f) + 1e-6f);
}

typedef f32x4 acc_t[2][2][4][2];
template <int V> struct IC { static constexpr int value = V; };
extern __shared__ __attribute__((aligned(16))) unsigned char smem[];
struct EpiIn8 {
  static constexpr bool PERM = false, AFTER_DRAIN = false;
  P p0; int l; kargp_t kp;
  __device__ __forceinline__ void operator()(const acc_t& acc, const Unit& u, int wr, int wc, int fr_in, int fq_in) const {
    int fr = fr_in; asm volatile("" : "+v"(fr));
    int fq = fq_in; asm volatile("" : "+v"(fq));
    const int ln = fq * 16 + fr; (void)ln;
    P p = p0; asm volatile("" : "+s"(p.ws), "+s"(p.out));
    const bool lat = u.pm >= 32;
    const int rbase = u.pm * 256 + wr * 64 + fr;
#define ROWS_BEGIN _Pragma("unroll") for (int ai = 0; ai < 2; ++ai) _Pragma("unroll") for (int mm = 0; mm < 4; ++mm) { \
      int m = rbase + ai * 128 + mm * 16; asm volatile("" : "+v"(m)); int b, s; \
      if (!lat) { b = m >> 8; s = m & 255; } else { b = (m - NCTX) >> 10; s = (m - NCTX) & 1023; } \
      const float rsd = rsdv[ai][mm]; \
      f32x4 v0 = acc[ai][bj][mm][0] * rsd + sw0, v1 = acc[ai][bj][mm][1] * rsd + sw1; (void)b; (void)s;
#define ROWS_END }
    float rsdv[2][4];
    {
      const float* rss = p.rssA();
#pragma unroll
      for (int ai = 0; ai < 2; ++ai)
#pragma unroll
        for (int mm = 0; mm < 4; ++mm) rsdv[ai][mm] = row_rstd(rss, rbase + ai * 128 + mm * 16);
    }
    auto do_half = [&](auto BJ) {
      constexpr int bj = decltype(BJ)::value;
      const int nb = u.pn * 256 + bj * 128 + wc * 32;
      if (nb >= DIN) return;
      const float* swp = p.sWin() + ((size_t)(l * 9 + (lat ? 1 + ((u.pm - 32) >> 2) : 0))) * DINP + nb;
      const f32x4 sw0 = *(const f32x4*)(swp + 4 * fq), sw1 = *(const f32x4*)(swp + 16 + 4 * fq);
      if (nb < 512) {
        ROWS_BEGIN
          if (lat) rope8_win(v0, v1, fq, (const float*)(smem + LDS_ROPEW) + ((nb & 32) ? (s & 63) : (s >> 6)) * 32);
          st8_bf16(p.Qwin() + (size_t)m * 512 + nb, fq, v0, v1);
        ROWS_END
      } else if (nb < 640) {
        const int c = nb - 512;
        ROWS_BEGIN
          if (!lat) {
            st8_f32(p.out + 16777216 + ((size_t)((b * 2 + l) * 256 + s)) * 128 + c, fq, v0, v1);
            st8_bf16(p.Kwin_c() + (size_t)m * 128 + c, fq, v0, v1);
          } else {
            rope8_win(v0, v1, fq, (const float*)(smem + LDS_ROPEW) + ((nb & 32) ? (s & 63) : (s >> 6)) * 32);
            st8_bf16(p.Kwin_l() + ((size_t)((l * 8 + b) * 1280 + s)) * 128 + c, fq, v0, v1);
          }
        ROWS_END
      } else if (nb < 768) {
        const int c = nb - 640, kv = c >> 6, d0 = c & 63;
        ROWS_BEGIN
          if (!lat) {
            st8_f32(p.out + 18874368 + ((size_t)((b * 2 + l) * 256 + s)) * 128 + c, fq, v0, v1);
            st8_tr(p.Vtwin_c() + ((size_t)((b * 2 + kv) * 64 + d0)) * 256 + s, 256, fq, v0, v1);
          } else {
            st8_tr(p.Vtwin_l() + ((size_t)(((l * 8 + b) * 2 + kv) * 64 + d0)) * 1280 + s, 1280, fq, v0, v1);
          }
        ROWS_END
      } else if (nb < 1024) {
        ROWS_BEGIN
          st8_bf16(p.Qret() + (size_t)m * 256 + (nb - 768), fq, v0, v1);
        ROWS_END
      } else if (nb < 1280) {
        ROWS_BEGIN
          st8_bf16(p.Kret() + (size_t)m * 256 + (nb - 1024), fq, v0, v1);
        ROWS_END
      } else if (nb < 1536) {
        const int c = nb - 1280, hh = c >> 6, d0 = c & 63;
        ROWS_BEGIN
          if (!lat) st8_tr(p.Vtret_c() + ((size_t)((b * 4 + hh) * 64 + d0)) * 256 + s, 256, fq, v0, v1);
          else st8_tr(p.Vtret_l() + ((size_t)((b * 4 + hh) * 64 + d0)) * 1024 + s, 1024, fq, v0, v1);
        ROWS_END
      } else if (nb < 1792) {
        ROWS_BEGIN
          st8_bf16(p.Gret() + (size_t)m * 256 + (nb - 1536), fq, v0, v1);
        ROWS_END
      } else if (nb < 2176) {
        const int c = nb - 1792;
        const bool rp = lat && (c % 96) == 64;
        ROWS_BEGIN
          if (rp) rope8_mla(v0, v1, fq, ln, (const float*)(smem + LDS_ROPEM) + (s >> 6) * 16, (const float*)(smem + LDS_ROPEM) + (s & 63) * 16);
          st8_bf16(p.Qmla() + (size_t)m * 384 + c, fq, v0, v1);
        ROWS_END
      } else if (nb < 2304) {
        const int c = nb - 2176;
        float* red = (float*)(smem + LDS_RED);
        kargp_t k2 = kp; asm volatile("" : "+s"(k2));
        const float* g = ((const __attribute__((address_space(4))) P*)k2)->mla_kv_norm + l * 128 + c;
        const f32x4 g0 = *(const f32x4*)(g + 4 * fq), g1 = *(const f32x4*)(g + 16 + 4 * fq);
#pragma unroll
        for (int ai = 0; ai < 2; ++ai)
#pragma unroll
          for (int mm = 0; mm < 4; ++mm) {
            const float rsd0 = rsdv[ai][mm];
            const f32x4 a = acc[ai][bj][mm][0] * rsd0 + sw0, b4 = acc[ai][bj][mm][1] * rsd0 + sw1;
            float ss = a[0] * a[0] + a[1] * a[1] + a[2] * a[2] + a[3] * a[3] + b4[0] * b4[0] + b4[1] * b4[1] + b4[2] * b4[2] + b4[3] * b4[3];
            ss += shx(ss, 16, ln);
            ss += shx(ss, 32, ln);
            if (fq == 0) red[wc * 256 + ai * 128 + wr * 64 + mm * 16 + fr] = ss;
          }
        asm volatile("s_waitcnt lgkmcnt(0)" ::: "memory");
        __builtin_amdgcn_s_barrier();
        ROWS_BEGIN
          const int rt = ai * 128 + wr * 64 + mm * 16 + fr;
          const float rsv = rsqrtf((red[rt] + red[256 + rt] + red[512 + rt] + red[768 + rt]) * (1.f / 128.f) + 1e-6f);
          v0 = v0 * rsv * g0;
          v1 = v1 * rsv * g1;
          st8_bf16(p.ckvn() + ((size_t)l * 18432 + m) * 128 + c, fq, v0, v1);
          if (!lat) st8_f32(p.out + 20971520 + ((size_t)((b * 2 + l) * 256 + s)) * 128 + c, fq, v0, v1);
        ROWS_END
        asm volatile("s_waitcnt vmcnt(0) lgkmcnt(0)" ::: "memory");
        __builtin_amdgcn_s_barrier();
        if (wr == 0 && wc == 0 && ln == 0) {
          __builtin_amdgcn_fence(__ATOMIC_RELEASE, "agent");
          asm volatile("s_waitcnt vmcnt(0)" ::: "memory");
          __hip_atomic_fetch_add(p.ctl() + 64 * l, 1u, __ATOMIC_RELAXED, __HIP_MEMORY_SCOPE_AGENT);
        }
      } else {
        ROWS_BEGIN
          if (!lat) {
            st8_f32(p.out + 23068672 + ((size_t)((b * 2 + l) * 256 + s)) * 32, fq, v0, v1);
#pragma unroll
            for (int hh = 0; hh < 4; ++hh) st8_bf16(p.Kmla_c() + ((size_t)((b * 4 + hh) * 256 + s)) * 96 + 64, fq, v0, v1);
          } else {
            rope8_mla(v0, v1, fq, ln, (const float*)(smem + LDS_ROPEM) + (s >> 6) * 16, (const float*)(smem + LDS_ROPEM) + (s & 63) * 16);
#pragma unroll
            for (int hh = 0; hh < 4; ++hh) st8_bf16(p.Kmla_l() + ((size_t)(((l * 8 + b) * 4 + hh) * 1280 + s)) * 96 + 64, fq, v0, v1);
          }
        ROWS_END
      }
    };
    do_half(IC<0>{});
    do_half(IC<1>{});
#undef ROWS_BEGIN
#undef ROWS_END
  }
};

struct EpiOut8 {
  static constexpr bool PERM = true, AFTER_DRAIN = false;
  P p0; int l;
  __device__ __forceinline__ void operator()(const acc_t& acc, const Unit& u, int wr, int wc, int fr_in, int fq_in) const {
    int fr = fr_in; asm volatile("" : "+v"(fr));
    int fq = fq_in; asm volatile("" : "+v"(fq));
    const int ln = fq * 16 + fr; (void)ln;
    P p = p0; asm volatile("" : "+s"(p.ws), "+s"(p.out));
    const int rbase = u.pm * 256 + wr * 64 + fr;
    const int cb = u.pn * 256 + wc * 32 + 8 * fq;
    const float* md = p.mod() + ((size_t)(l * 9 + mod_row(u.pm * 256))) * 6144;
    const float* gate = md + 2 * 1024; const float* sc2 = md + 4 * 1024; const float* g2 = p.norm2 + l * DM;
#pragma unroll
    for (int ap = 0; ap < 4; ++ap) {
      constexpr int dummy = 0; (void)dummy;
      const int ai = ap >> 1, m2 = (ap & 1) * 2;
      int mb = rbase + ai * 128 + m2 * 16; asm volatile("" : "+v"(mb));
      f32x4 xv[2][2][2];
#pragma unroll
      for (int mq = 0; mq < 2; ++mq) {
        const int mm = m2 + mq;
        const int m = mb + mq * 16;
        if (l == 0) {
          const float* xr = m < NCTX ? p.x_prompt + (size_t)m * DM : p.x_sample + (size_t)(m - NCTX) * DM;
#pragma unroll
          for (int bj = 0; bj < 2; ++bj)
#pragma unroll
            for (int n = 0; n < 2; ++n) xv[mq][bj][n] = *(const f32x4*)(xr + cb + bj * 128 + n * 4);
        } else {
          const bf16_t* hr = p.hbuf() + (size_t)m * DM;
#pragma unroll
          for (int bj = 0; bj < 2; ++bj)
#pragma unroll
            for (int n = 0; n < 2; ++n) {
              const int c = cb + bj * 128 + n * 4;
              const uint2 hq = *(const uint2*)(hr + c);
              const f32x4 q1 = *(const f32x4*)(p.norm1 + DM + c) * (*(const f32x4*)(md + 1 * 1024 + c) + 1.f);
              f32x4 xm;
              xm[0] = __uint_as_float(hq.x << 16) * __builtin_amdgcn_rcpf(q1[0]); xm[1] = __uint_as_float(hq.x & 0xffff0000u) * __builtin_amdgcn_rcpf(q1[1]);
              xm[2] = __uint_as_float(hq.y << 16) * __builtin_amdgcn_rcpf(q1[2]); xm[3] = __uint_as_float(hq.y & 0xffff0000u) * __builtin_amdgcn_rcpf(q1[3]);
              xv[mq][bj][n] = xm;
            }
        }
      }
#pragma unroll
      for (int mq = 0; mq < 2; ++mq) {
        const int mm = m2 + mq;
        const int m = mb + mq * 16;
        bf16_t* ho = p.hbuf() + (size_t)m * DM;
        float ss = 0.f;
#pragma unroll
        for (int bj = 0; bj < 2; ++bj)
#pragma unroll
          for (int n = 0; n < 2; ++n) {
            const int c = cb + bj * 128 + n * 4;
            const f32x4 xn = xv[mq][bj][n] + *(const f32x4*)(gate + c) * acc[ai][bj][mm][n];
            const f32x4 hv = xn * (*(const f32x4*)(g2 + c) * (*(const f32x4*)(sc2 + c) + 1.f));
            *(uint2*)(ho + c) = make_uint2(pk2(hv[0], hv[1]), pk2(hv[2], hv[3]));
            ss += (xn[0] * xn[0] + xn[1] * xn[1]) + (xn[2] * xn[2] + xn[3] * xn[3]);
          }
        ss += shx(ss, 16, ln);
        ss += shx(ss, 32, ln);
        if (fq == 0) p.rssB()[(size_t)m * 16 + u.pn * 4 + wc] = ss;
      }
      asm volatile("" ::: "memory");
    }
  }
};
struct EpiUp8 {
  static constexpr bool PERM = true, AFTER_DRAIN = false;
  P p0; int l;
  __device__ __forceinline__ void operator()(const acc_t& acc, const Unit& u, int wr, int wc, int fr_in, int fq_in) const {
    int fr = fr_in; asm volatile("" : "+v"(fr));
    int fq = fq_in; asm volatile("" : "+v"(fq));
    const int ln = fq * 16 + fr; (void)ln;
    P p = p0; asm volatile("" : "+s"(p.ws), "+s"(p.out));
    const int rbase = u.pm * 256 + wr * 64 + fr;
    const int cb = u.pn * 256 + wc * 32 + 8 * fq;
    const float* swp = p.sWup() + ((size_t)(l * 9 + mod_row(u.pm * 256))) * DFF;
    float rsdv[2][4];
#pragma unroll
    for (int ai = 0; ai < 2; ++ai)
#pragma unroll
      for (int mm = 0; mm < 4; ++mm) rsdv[ai][mm] = row_rstd(p.rssB(), rbase + ai * 128 + mm * 16);
    f32x4 swv[2][2];
#pragma unroll
    for (int bj = 0; bj < 2; ++bj)
#pragma unroll
      for (int n = 0; n < 2; ++n) swv[bj][n] = *(const f32x4*)(swp + cb + bj * 128 + n * 4);
#pragma unroll
    for (int ai = 0; ai < 2; ++ai)
#pragma unroll
      for (int mm = 0; mm < 4; ++mm) {
        int m = rbase + ai * 128 + mm * 16; asm volatile("" : "+v"(m));
        bf16_t* uo = p.ubuf() + (size_t)m * DFF;
        const float rsd = rsdv[ai][mm];
#pragma unroll
        for (int bj = 0; bj < 2; ++bj) {
          f32x4 t0 = acc[ai][bj][mm][0] * rsd + swv[bj][0], t1 = acc[ai][bj][mm][1] * rsd + swv[bj][1];
#pragma unroll
          for (int j = 0; j < 4; ++j) { const float a = fmaxf(t0[j], 0.f), b = fmaxf(t1[j], 0.f); t0[j] = a * a; t1[j] = b * b; }
          *(uint4*)(uo + cb + bj * 128) = make_uint4(pk2(t0[0], t0[1]), pk2(t0[2], t0[3]), pk2(t1[0], t1[1]), pk2(t1[2], t1[3]));
        }
      }
  }
};
struct EpiDown8 {
  static constexpr bool PERM = true, AFTER_DRAIN = false;
  P p0; int l;
  __device__ __forceinline__ void operator()(const acc_t& acc, const Unit& u, int wr, int wc, int fr_in, int fq_in) const {
    int fr = fr_in; asm volatile("" : "+v"(fr));
    int fq = fq_in; asm volatile("" : "+v"(fq));
    const int ln = fq * 16 + fr; (void)ln;
    P p = p0; asm volatile("" : "+s"(p.ws), "+s"(p.out));
    const int rbase = u.pm * 256 + wr * 64 + fr;
    const int cb = u.pn * 256 + wc * 32 + 8 * fq;
    const int r = mod_row(u.pm * 256);
    const float* md = p.mod() + ((size_t)(l * 9 + r)) * 6144;
    const float* gate = md + 5 * 1024; const float* sc2 = md + 4 * 1024; const float* g2 = p.norm2 + l * DM;
    const float* sc1 = p.mod() + ((size_t)(9 + r)) * 6144 + 1 * 1024;
    const float* g1 = p.norm1 + DM;
    f32x4 riv[2][2];
#pragma unroll
    for (int bj = 0; bj < 2; ++bj)
#pragma unroll
      for (int n = 0; n < 2; ++n) {
        const int c = cb + bj * 128 + n * 4;
        const f32x4 q2 = *(const f32x4*)(g2 + c) * (*(const f32x4*)(sc2 + c) + 1.f);
#pragma unroll
        for (int j = 0; j < 4; ++j) riv[bj][n][j] = __builtin_amdgcn_rcpf(q2[j]);
      }
#pragma unroll
    for (int ap = 0; ap < 4; ++ap) {
      const int ai = ap >> 1, m2 = (ap & 1) * 2;
      int mb = rbase + ai * 128 + m2 * 16; asm volatile("" : "+v"(mb));
      uint2 hvv[2][2][2];
#pragma unroll
      for (int mq = 0; mq < 2; ++mq) {
        const bf16_t* hr = p.hbuf() + (size_t)(mb + mq * 16) * DM;
#pragma unroll
        for (int bj = 0; bj < 2; ++bj)
#pragma unroll
          for (int n = 0; n < 2; ++n) hvv[mq][bj][n] = *(const uint2*)(hr + cb + bj * 128 + n * 4);
      }
#pragma unroll
      for (int mq = 0; mq < 2; ++mq) {
        const int mm = m2 + mq;
        const int m = mb + mq * 16;
        float* xo = p.xw() + (size_t)m * DM;
        bf16_t* ho = p.hbuf() + (size_t)m * DM;
        float ss = 0.f;
#pragma unroll
        for (int bj = 0; bj < 2; ++bj)
#pragma unroll
          for (int n = 0; n < 2; ++n) {
            const int c = cb + bj * 128 + n * 4;
            const uint2 hq = hvv[mq][bj][n];
            f32x4 xm;
            xm[0] = __uint_as_float(hq.x << 16); xm[1] = __uint_as_float(hq.x & 0xffff0000u);
            xm[2] = __uint_as_float(hq.y << 16); xm[3] = __uint_as_float(hq.y & 0xffff0000u);
            const f32x4 xn = xm * riv[bj][n] + *(const f32x4*)(gate + c) * acc[ai][bj][mm][n];
            if (l != 0) *(f32x4*)(xo + c) = xn;
            if (l == 0) {
              const f32x4 hv = xn * (*(const f32x4*)(g1 + c) * (*(const f32x4*)(sc1 + c) + 1.f));
              *(uint2*)(ho + c) = make_uint2(pk2(hv[0], hv[1]), pk2(hv[2], hv[3]));
              ss += (xn[0] * xn[0] + xn[1] * xn[1]) + (xn[2] * xn[2] + xn[3] * xn[3]);
            }
          }
        if (l == 0) {
          ss += shx(ss, 16, ln);
          ss += shx(ss, 32, ln);
          if (fq == 0) p.rssA()[(size_t)m * 16 + u.pn * 4 + wc] = ss;
        }
      }
      asm volatile("" ::: "memory");
    }
  }
};

struct EpiKvb {
  P p; int l;
  __device__ __forceinline__ void operator()(int m, int nb, int h, const f32x16& v) const {
    const int hh = nb >> 7, j0 = nb & 127;
    bf16_t* Kb; bf16_t* Vb; int S, key;
    if (m < NCTX) {
      const int b = m >> 8; key = m & 255; S = 256;
      Kb = p.Kmla_c() + ((size_t)((b * 4 + hh) * 256)) * 96;
      Vb = p.Vtmla_c() + ((size_t)((b * 4 + hh) * 64)) * 256;
    } else {
      int b;
      if (m < NTOK) { b = (m - NCTX) >> 10; key = (m - NCTX) & 1023; }
      else { b = (m - NTOK) >> 8; key = 1024 + ((m - NTOK) & 255); }
      S = 1280;
      Kb = p.Kmla_l() + ((size_t)(((l * 8 + b) * 4 + hh) * 1280)) * 96;
      Vb = p.Vtmla_l() + ((size_t)(((l * 8 + b) * 4 + hh) * 64)) * 1280;
    }
    if (j0 < 64) st_rm_bf16(Kb + (size_t)key * 96 + j0, h, v);
    else st_tr_bf16(Vb + (size_t)(j0 - 64) * S + key, S, h, v);
  }
};

template <class Epi>
__device__ __forceinline__ void gemm_small(const bf16_t* __restrict__ A, int lda, const bf16_t* __restrict__ W, int ldw,
                                           int M, int N, int K, unsigned char* smem, const Epi& epi, const int wv, unsigned* ready, unsigned* ticket) {
  constexpr int TA = 256 * 72, TW = 128 * 72;
  bf16_t* sb = (bf16_t*)smem;
  const int tid = my_tid(wv), bid = my_bid(), lane = tid & 63, wave = tid >> 6;
  const int wm = wave >> 1, wn = wave & 1, r = lane & 31, h = lane >> 5;
  const int MT = M >> 8, NT = N >> 7, ntiles = MT * NT, nk = K >> 6;
  const int lc = tid & 7, lr = tid >> 3;
  (void)bid;
  if (tid == 0) {
    unsigned polls = 0;
    while (__hip_atomic_load(ready, __ATOMIC_RELAXED, __HIP_MEMORY_SCOPE_AGENT) < 64u && ++polls < (1u << 22)) __builtin_amdgcn_s_sleep(8);
    __builtin_amdgcn_fence(__ATOMIC_ACQUIRE, "agent");
    asm volatile("s_waitcnt vmcnt(0)" ::: "memory");
  }
  __syncthreads();
  volatile int* tks = (volatile int*)(smem + LDS_RED + 2048);
  for (;;) {
    __syncthreads();
    if (tid == 0) *tks = (int)__hip_atomic_fetch_add(ticket, 1u, __ATOMIC_RELAXED, __HIP_MEMORY_SCOPE_AGENT);
    __syncthreads();
    const int tile = *tks;
    if (tile >= ntiles) break;
    const int m0 = (tile % MT) << 8, n0 = (tile / MT) << 7;
    f32x16 acc[2][2];
#pragma unroll
    for (int a = 0; a < 2; ++a)
#pragma unroll
      for (int b = 0; b < 2; ++b)
#pragma unroll
        for (int i = 0; i < 16; ++i) acc[a][b][i] = 0.f;
    uint4 ra[4], rw[2];
    const bf16_t* Ap = A + (size_t)(m0 + lr) * lda + lc * 8;
    const bf16_t* Wp = W + (size_t)(n0 + lr) * ldw + lc * 8;
    auto gload = [&](int kt) {
#pragma unroll
      for (int i = 0; i < 4; ++i) ra[i] = *(const uint4*)(Ap + (size_t)(64 * i) * lda + kt * 64);
#pragma unroll
      for (int i = 0; i < 2; ++i) rw[i] = *(const uint4*)(Wp + (size_t)(64 * i) * ldw + kt * 64);
    };
    auto swrite = [&](int bsel) {
      bf16_t* sA = sb + bsel * (TA + TW); bf16_t* sW = sA + TA;
#pragma unroll
      for (int i = 0; i < 4; ++i) *(uint4*)(sA + (lr + 64 * i) * 72 + lc * 8) = ra[i];
#pragma unroll
      for (int i = 0; i < 2; ++i) *(uint4*)(sW + (lr + 64 * i) * 72 + lc * 8) = rw[i];
    };
    __syncthreads();
    gload(0); swrite(0);
    __syncthreads();
    for (int kt = 0; kt < nk; ++kt) {
      if (kt + 1 < nk) gload(kt + 1);
      const bf16_t* sA = sb + (kt & 1) * (TA + TW); const bf16_t* sW = sA + TA;
#pragma unroll
      for (int ks = 0; ks < 4; ++ks) {
        bf16x8 wf[2], af[2];
#pragma unroll
        for (int i = 0; i < 2; ++i) {
          wf[i] = *(const bf16x8*)(sW + (wn * 64 + i * 32 + r) * 72 + ks * 16 + h * 8);
          af[i] = *(const bf16x8*)(sA + (wm * 64 + i * 32 + r) * 72 + ks * 16 + h * 8);
        }
#pragma unroll
        for (int a = 0; a < 2; ++a)
#pragma unroll
          for (int b = 0; b < 2; ++b) acc[a][b] = __builtin_amdgcn_mfma_f32_32x32x16_bf16(wf[a], af[b], acc[a][b], 0, 0, 0);
      }
      if (kt + 1 < nk) swrite((kt + 1) & 1);
      __syncthreads();
    }
#pragma unroll
    for (int a = 0; a < 2; ++a)
#pragma unroll
      for (int b = 0; b < 2; ++b) epi(m0 + wm * 64 + b * 32 + r, n0 + wn * 64 + a * 32, h, acc[a][b]);
  }
}

struct AttnItem {
  const bf16_t* Q; int qs;
  const bf16_t* K; int ks;
  const bf16_t* Vt; int vs;
  int t0, t1, t2, t3;
  int qpos0, T;
  float scale, sink_l2; int has_sink;
  float lgf, lgb;
  const bf16_t *S0f, *S0b;
  const bf16_t* G; const float* gn;
  bf16_t* out;
  float* sout;
};

template <int DQK, int MODE>
__device__ __forceinline__ void attn_item(const AttnItem& it, unsigned char* smem, const int wv) {
  constexpr int KSTR = DQK + 8, NKS = DQK / 16, VSTR = 68, KCH = DQK / 8;
  bf16_t* Ks = (bf16_t*)smem;
  bf16_t* Vs = Ks + 64 * KSTR;
  const int tid = my_tid(wv), lane = tid & 63, wave = tid >> 6, r = lane & 31, h = lane >> 5;
  const int qrow = wave * 32 + r;
  bf16x8 qf[NKS];
  if constexpr (MODE == 3) {
    const int dq = (wave & 1) * 32 + r;
#pragma unroll
    for (int ks = 0; ks < NKS; ++ks) {
      const int e = dq - (ks * 16 + h * 8);
      uint4 v;
      v.x = e == 0 ? 0x3F80u : (e == 1 ? 0x3F800000u : 0u);
      v.y = e == 2 ? 0x3F80u : (e == 3 ? 0x3F800000u : 0u);
      v.z = e == 4 ? 0x3F80u : (e == 5 ? 0x3F800000u : 0u);
      v.w = e == 6 ? 0x3F80u : (e == 7 ? 0x3F800000u : 0u);
      qf[ks] = __builtin_bit_cast(bf16x8, v);
    }
  } else {
#pragma unroll
    for (int ks = 0; ks < NKS; ++ks) qf[ks] = *(const bf16x8*)(it.Q + (size_t)qrow * it.qs + ks * 16 + h * 8);
  }
  f32x16 o0, o1;
#pragma unroll
  for (int i = 0; i < 16; ++i) { o0[i] = 0.f; o1[i] = 0.f; }
  float mrun = it.has_sink ? it.sink_l2 : -1e30f, lrun = 0.f;
  const int qp = it.qpos0 + qrow;
  const int n1 = it.t1 - it.t0, ntl = n1 + (it.t3 - it.t2);
  constexpr int BUFE = 64 * KSTR + 64 * VSTR;
  const int krow0 = tid / KCH, kch0 = tid % KCH, krow1 = (tid + NTHR) / KCH, kch1 = (tid + NTHR) % KCH;
  const bool k2 = (KCH == 12) && (tid + NTHR < 64 * KCH);
  const int vrow = tid >> 3, vch = tid & 7;
  uint4 rk0, rk1, rv;
  auto tile_of = [&](int ti) { return ti < n1 ? it.t0 + ti : it.t2 + (ti - n1); };
  auto gload = [&](int t) {
    const bool stt = (MODE == 2) && (t >= 16);
    if (!stt) {
      const int key0 = t * 64;
      rk0 = *(const uint4*)(it.K + (size_t)(key0 + krow0) * it.ks + kch0 * 8);
      if (k2) rk1 = *(const uint4*)(it.K + (size_t)(key0 + krow1) * it.ks + kch1 * 8);
      rv = *(const uint4*)(it.Vt + (size_t)vrow * it.vs + key0 + vch * 8);
    } else {
      const bf16_t* S = (t == 16) ? it.S0f : it.S0b;
      const int e = krow0 - kch0 * 8;
      rk0.x = e == 0 ? 0x3F80u : (e == 1 ? 0x3F800000u : 0u);
      rk0.y = e == 2 ? 0x3F80u : (e == 3 ? 0x3F800000u : 0u);
      rk0.z = e == 4 ? 0x3F80u : (e == 5 ? 0x3F800000u : 0u);
      rk0.w = e == 6 ? 0x3F80u : (e == 7 ? 0x3F800000u : 0u);
      rv = *(const uint4*)(S + (size_t)vrow * 64 + vch * 8);
    }
  };
  auto swrite = [&](int bsel) {
    bf16_t* Kb = Ks + bsel * BUFE; bf16_t* Vb = Kb + 64 * KSTR;
    *(uint4*)(Kb + krow0 * KSTR + kch0 * 8) = rk0;
    if (k2) *(uint4*)(Kb + krow1 * KSTR + kch1 * 8) = rk1;
    uint2* d = (uint2*)(Vb + vrow * VSTR + vch * 8);
    d[0] = make_uint2(rv.x, rv.y); d[1] = make_uint2(rv.z, rv.w);
  };
  __syncthreads();
  gload(tile_of(0)); swrite(0);
  __syncthreads();
  for (int ti = 0; ti < ntl; ++ti) {
    const int t = tile_of(ti);
    const bool st_tile = (MODE == 2) && (t >= 16);
    const int key0 = t * 64;
    const bool more = ti + 1 < ntl;
    if (more) gload(tile_of(ti + 1));
    const bf16_t* Kc = Ks + (ti & 1) * BUFE; const bf16_t* Vc = Kc + 64 * KSTR;
    bool skip = (MODE == 3) && (wave >= 4);
    if (MODE == 1 && t < 16) {
      const int qlo = it.qpos0 + wave * 32;
      skip = (key0 > qlo + 31 + 128 || key0 + 63 < qlo - 128);
    }
    if (!skip) {
    f32x16 s0, s1;
#pragma unroll
    for (int i = 0; i < 16; ++i) { s0[i] = 0.f; s1[i] = 0.f; }
#pragma unroll
    for (int ks = 0; ks < NKS; ++ks) {
      const bf16x8 k0 = *(const bf16x8*)(Kc + r * KSTR + ks * 16 + h * 8);
      const bf16x8 k1 = *(const bf16x8*)(Kc + (32 + r) * KSTR + ks * 16 + h * 8);
      s0 = __builtin_amdgcn_mfma_f32_32x32x16_bf16(k0, qf[ks], s0, 0, 0, 0);
      s1 = __builtin_amdgcn_mfma_f32_32x32x16_bf16(k1, qf[ks], s1, 0, 0, 0);
    }
    if constexpr (MODE == 3) {
      if (wave < 2) {
        const float base = (float)(it.T - 1 - key0 - 4 * h) * it.lgf - 3.f;
#pragma unroll
        for (int i = 0; i < 16; ++i) {
          s0[i] *= fexp2(fmaf(-(float)((i & 3) + 8 * (i >> 2)), it.lgf, base));
          s1[i] *= fexp2(fmaf(-(float)(32 + (i & 3) + 8 * (i >> 2)), it.lgf, base));
        }
      } else {
        const float base = (float)(key0 + 4 * h) * it.lgb - 3.f;
#pragma unroll
        for (int i = 0; i < 16; ++i) {
          s0[i] *= fexp2(fmaf((float)((i & 3) + 8 * (i >> 2)), it.lgb, base));
          s1[i] *= fexp2(fmaf((float)(32 + (i & 3) + 8 * (i >> 2)), it.lgb, base));
        }
      }
    } else if constexpr (MODE == 2) {
      if (!st_tile) {
        const int qlo = it.qpos0 + wave * 32;
        if (key0 + 63 < qlo) {
          const float base = (float)(qp - key0 - 4 * h) * it.lgf - 3.f;
#pragma unroll
          for (int i = 0; i < 16; ++i) {
            s0[i] *= fexp2(fmaf(-(float)((i & 3) + 8 * (i >> 2)), it.lgf, base));
            s1[i] *= fexp2(fmaf(-(float)(32 + (i & 3) + 8 * (i >> 2)), it.lgf, base));
          }
        } else if (key0 > qlo + 31) {
          const float base = (float)(key0 + 4 * h - qp) * it.lgb - 3.f;
#pragma unroll
          for (int i = 0; i < 16; ++i) {
            s0[i] *= fexp2(fmaf((float)((i & 3) + 8 * (i >> 2)), it.lgb, base));
            s1[i] *= fexp2(fmaf((float)(32 + (i & 3) + 8 * (i >> 2)), it.lgb, base));
          }
        } else {
#pragma unroll
        for (int i = 0; i < 16; ++i) {
          const int key = key0 + (i & 3) + 8 * (i >> 2) + 4 * h;
          const int e0 = qp - key, e1 = e0 - 32;
          float d0 = fexp2((float)(e0 < 0 ? -e0 : e0) * (e0 > 0 ? it.lgf : it.lgb));
          float d1 = fexp2((float)(e1 < 0 ? -e1 : e1) * (e1 > 0 ? it.lgf : it.lgb));
          d0 = e0 == 0 ? 2.f : d0;
          d1 = e1 == 0 ? 2.f : d1;
          s0[i] *= it.scale * d0;
          s1[i] *= it.scale * d1;
        }
        }
      } else {
        const float dec = (t == 16) ? fexp2((float)(qp + 1) * it.lgf) : fexp2((float)(it.T - qp) * it.lgb);
#pragma unroll
        for (int i = 0; i < 16; ++i) { s0[i] *= dec; s1[i] *= dec; }
      }
    } else {
      float mx = -INFINITY;
      const int qlo1 = it.qpos0 + wave * 32;
      const bool need_mask = (MODE == 1) && (t < 16) && !(key0 >= qlo1 + 31 - 128 && key0 + 63 <= qlo1 + 128);
#pragma unroll
      for (int i = 0; i < 16; ++i) {
        float a = s0[i] * it.scale, b = s1[i] * it.scale;
        if (MODE == 1 && need_mask) {
          const int key = key0 + (i & 3) + 8 * (i >> 2) + 4 * h;
          const int e0 = key - qp, e1 = e0 + 32;
          if (e0 > 128 || e0 < -128) a = -INFINITY;
          if (e1 > 128 || e1 < -128) b = -INFINITY;
        }
        s0[i] = a; s1[i] = b;
        mx = fmaxf(mx, fmaxf(a, b));
      }
      mx = fmaxf(mx, shx(mx, 32, lane));
      const float mnew = fmaxf(mrun, mx);
      const float alpha = fexp2(mrun - mnew);
      float sum = 0.f;
#pragma unroll
      for (int i = 0; i < 16; ++i) {
        s0[i] = fexp2(s0[i] - mnew);
        s1[i] = fexp2(s1[i] - mnew);
        sum += s0[i] + s1[i];
      }
      lrun = lrun * alpha + sum;
      mrun = mnew;
#pragma unroll
      for (int i = 0; i < 16; ++i) { o0[i] *= alpha; o1[i] *= alpha; }
    }
#pragma unroll
    for (int kt = 0; kt < 2; ++kt) {
#pragma unroll
      for (int sbk = 0; sbk < 2; ++sbk) {
        uint4 pw;
        if (kt == 0) {
          pw.x = pk2(s0[8 * sbk + 0], s0[8 * sbk + 1]); pw.y = pk2(s0[8 * sbk + 2], s0[8 * sbk + 3]);
          pw.z = pk2(s0[8 * sbk + 4], s0[8 * sbk + 5]); pw.w = pk2(s0[8 * sbk + 6], s0[8 * sbk + 7]);
        } else {
          pw.x = pk2(s1[8 * sbk + 0], s1[8 * sbk + 1]); pw.y = pk2(s1[8 * sbk + 2], s1[8 * sbk + 3]);
          pw.z = pk2(s1[8 * sbk + 4], s1[8 * sbk + 5]); pw.w = pk2(s1[8 * sbk + 6], s1[8 * sbk + 7]);
        }
        const bf16x8 pf = __builtin_bit_cast(bf16x8, pw);
        const int koff = kt * 32 + sbk * 16 + 4 * h;
        const uint2 a0 = *(const uint2*)(Vc + r * VSTR + koff), a1 = *(const uint2*)(Vc + r * VSTR + koff + 8);
        const uint2 b0 = *(const uint2*)(Vc + (32 + r) * VSTR + koff), b1 = *(const uint2*)(Vc + (32 + r) * VSTR + koff + 8);
        const bf16x8 v0 = __builtin_bit_cast(bf16x8, make_uint4(a0.x, a0.y, a1.x, a1.y));
        const bf16x8 v1 = __builtin_bit_cast(bf16x8, make_uint4(b0.x, b0.y, b1.x, b1.y));
        o0 = __builtin_amdgcn_mfma_f32_32x32x16_bf16(v0, pf, o0, 0, 0, 0);
        o1 = __builtin_amdgcn_mfma_f32_32x32x16_bf16(v1, pf, o1, 0, 0, 0);
      }
    }
    }
    if (more) swrite((ti + 1) & 1);
    __syncthreads();
  }
  if constexpr (MODE == 3) {
    if (wave < 4) {
      float* rowp = it.sout + (size_t)(wave >> 1) * 16384 + (size_t)((wave & 1) * 32 + r) * 64;
#pragma unroll
      for (int g = 0; g < 4; ++g) {
        *(float4*)(rowp + 8 * g + 4 * h) = make_float4(o0[4 * g], o0[4 * g + 1], o0[4 * g + 2], o0[4 * g + 3]);
        *(float4*)(rowp + 32 + 8 * g + 4 * h) = make_float4(o1[4 * g], o1[4 * g + 1], o1[4 * g + 2], o1[4 * g + 3]);
      }
    }
    return;
  }
  bf16_t* orow = it.out + (size_t)qrow * DM;
  if constexpr (MODE == 2) {
    float sm = 0.f;
#pragma unroll
    for (int i = 0; i < 16; ++i) sm += o0[i] + o1[i];
    sm += shx(sm, 32, lane);
    const float mu = sm * (1.f / 64.f);
    float vr = 0.f;
#pragma unroll
    for (int i = 0; i < 16; ++i) { o0[i] -= mu; o1[i] -= mu; vr += o0[i] * o0[i] + o1[i] * o1[i]; }
    vr += shx(vr, 32, lane);
    const float rstd = rsqrtf(vr * (1.f / 64.f) + 1e-6f);
    const bf16_t* grow = it.G + (size_t)qrow * 256;
#pragma unroll
    for (int g = 0; g < 4; ++g) {
      const int d = 8 * g + 4 * h;
      const uint2 ga = *(const uint2*)(grow + d), gb = *(const uint2*)(grow + 32 + d);
      const float gav[4] = {__uint_as_float(ga.x << 16), __uint_as_float(ga.x & 0xffff0000u), __uint_as_float(ga.y << 16), __uint_as_float(ga.y & 0xffff0000u)};
      const float gbv[4] = {__uint_as_float(gb.x << 16), __uint_as_float(gb.x & 0xffff0000u), __uint_as_float(gb.y << 16), __uint_as_float(gb.y & 0xffff0000u)};
#pragma unroll
      for (int j = 0; j < 4; ++j) {
        const float x0 = gav[j], x1 = gbv[j];
        o0[4 * g + j] = o0[4 * g + j] * rstd * it.gn[d + j] * (x0 / (1.f + __expf(-x0)));
        o1[4 * g + j] = o1[4 * g + j] * rstd * it.gn[32 + d + j] * (x1 / (1.f + __expf(-x1)));
      }
    }
  } else {
    float lt = lrun + shx(lrun, 32, lane);
    if (it.has_sink) lt += fexp2(it.sink_l2 - mrun);
    const float inv = 1.f / lt;
#pragma unroll
    for (int i = 0; i < 16; ++i) { o0[i] *= inv; o1[i] *= inv; }
  }
  st_rm_bf16(orow, h, o0);
  st_rm_bf16(orow + 32, h, o1);
}

__device__ __forceinline__ float log2_sigmoid(float x) { return -log1pf(expf(-x)) * LOG2E; }

__device__ __forceinline__ void state_item(const P& p, int l, int idx, unsigned char* smem, const int wv) {
  const int b = idx >> 3, hh = (idx >> 1) & 3, dir = idx & 1;
  float* Ksm = (float*)smem;
  float* Vsm = Ksm + 4096;
  const int tid = my_tid(wv);
  const float lg = log2_sigmoid(p.ret_decay[(l * 2 + dir) * 4 + hh]);
  float acc[8];
#pragma unroll
  for (int i = 0; i < 8; ++i) acc[i] = 0.f;
  const int d = tid >> 3, e0 = (tid & 7) * 8;
  for (int c = 0; c < 4; ++c) {
    __syncthreads();
    for (int i = tid; i < 4096; i += NTHR) {
      const int j = i >> 6, dd = i & 63, tok = c * 64 + j;
      const float dec = dir == 0 ? fexp2((float)(255 - tok) * lg) : fexp2((float)tok * lg);
      Ksm[j * 64 + dd] = bf2f(p.Kret()[(size_t)(b * 256 + tok) * 256 + hh * 64 + dd]) * 0.125f * dec;
      const int e = i >> 6, jj = i & 63;
      Vsm[e * 65 + jj] = bf2f(p.Vtret_c()[((size_t)((b * 4 + hh) * 64 + e)) * 256 + c * 64 + jj]);
    }
    __syncthreads();
    for (int j = 0; j < 64; ++j) {
      const float kd = Ksm[j * 64 + d];
#pragma unroll
      for (int i = 0; i < 8; ++i) acc[i] += kd * Vsm[(e0 + i) * 65 + j];
    }
  }
  float* op = p.out + 23592960 + ((size_t)((((b * 2 + l) * 2 + dir) * 4 + hh) * 64 + d)) * 64 + e0;
  *(float4*)(op) = make_float4(acc[0], acc[1], acc[2], acc[3]);
  *(float4*)(op + 4) = make_float4(acc[4], acc[5], acc[6], acc[7]);
}

__device__ __forceinline__ void attn_phase(const P& p, int l, unsigned char* smem, const int wv) {
  constexpr int NA = 128, NB = 128, NC = 256, ND = 256, NE = 128, NF = 128, NG = 128;
  constexpr int TOT = NA + NB + NC + ND + NE + NF + NG;
  unsigned* ticket = p.ctl() + 32 + 64 * l;
  volatile int* tks = (volatile int*)(smem + LDS_RED + 2048);
  const int tid0 = my_tid(wv);
  for (;;) {
    __syncthreads();
    if (tid0 == 0) *tks = (int)__hip_atomic_fetch_add(ticket, 1u, __ATOMIC_RELAXED, __HIP_MEMORY_SCOPE_AGENT);
    __syncthreads();
    const int item = *tks;
    if (item >= TOT) break;
    int idx = item;
    AttnItem it;
    it.t2 = 0; it.t3 = 0; it.qpos0 = 0; it.T = 0; it.sink_l2 = 0.f; it.has_sink = 0; it.lgf = 0.f; it.lgb = 0.f;
    it.S0f = nullptr; it.S0b = nullptr; it.G = nullptr; it.gn = nullptr; it.sout = nullptr;
    if (idx < NA) {
      const int b = idx >> 4, hh = (idx >> 2) & 3, qb = idx & 3, row0 = NCTX + b * 1024 + qb * 256;
      it.Q = p.Qmla() + (size_t)row0 * 384 + hh * 96; it.qs = 384;
      it.K = p.Kmla_l() + ((size_t)(((l * 8 + b) * 4 + hh) * 1280)) * 96; it.ks = 96;
      it.Vt = p.Vtmla_l() + ((size_t)(((l * 8 + b) * 4 + hh) * 64)) * 1280; it.vs = 1280;
      it.t0 = 0; it.t1 = 20;
      it.scale = 0.10206207261596575f * LOG2E;
      it.out = p.mix() + (size_t)row0 * DM + 768 + hh * 64;
      attn_item<96, 0>(it, smem, wv);
      continue;
    }
    idx -= NA;
    if (idx < NB) {
      const int b = idx >> 4, hh = (idx >> 2) & 3, qb = idx & 3, row0 = NCTX + b * 1024 + qb * 256;
      it.Q = p.Qret() + (size_t)row0 * 256 + hh * 64; it.qs = 256;
      it.K = p.Kret() + (size_t)(NCTX + b * 1024) * 256 + hh * 64; it.ks = 256;
      it.Vt = p.Vtret_l() + ((size_t)((b * 4 + hh) * 64)) * 1024; it.vs = 1024;
      it.t0 = 0; it.t1 = 16; it.t2 = 16; it.t3 = 18;
      it.qpos0 = qb * 256; it.T = 1024; it.scale = 0.125f;
      it.lgf = log2_sigmoid(p.ret_decay[(l * 2 + 0) * 4 + hh]);
      it.lgb = log2_sigmoid(p.ret_decay[(l * 2 + 1) * 4 + hh]);
      it.S0f = p.S0t() + ((size_t)((((l * 8 + b) * 2 + 0) * 4 + hh))) * 4096;
      it.S0b = p.S0t() + ((size_t)((((l * 8 + b) * 2 + 1) * 4 + hh))) * 4096;
      it.G = p.Gret() + (size_t)row0 * 256 + hh * 64; it.gn = p.ret_gn + l * 256 + hh * 64;
      it.out = p.mix() + (size_t)row0 * DM + 512 + hh * 64;
      attn_item<64, 2>(it, smem, wv);
      continue;
    }
    idx -= NB;
    if (idx < NC) {
      const int b = idx >> 5, head = (idx >> 2) & 7, qb = idx & 3, kv = head >> 2, row0 = NCTX + b * 1024 + qb * 256;
      it.Q = p.Qwin() + (size_t)row0 * 512 + head * 64; it.qs = 512;
      it.K = p.Kwin_l() + ((size_t)((l * 8 + b) * 1280)) * 128 + kv * 64; it.ks = 128;
      it.Vt = p.Vtwin_l() + ((size_t)(((l * 8 + b) * 2 + kv) * 64)) * 1280; it.vs = 1280;
      it.t0 = max(0, qb * 4 - 2); it.t1 = min(16, qb * 4 + 6); it.t2 = 16; it.t3 = 20;
      it.qpos0 = qb * 256;
      it.scale = 0.125f * LOG2E; it.sink_l2 = p.win_sink[l * 8 + head] * LOG2E; it.has_sink = 1;
      it.out = p.mix() + (size_t)row0 * DM + head * 64;
      attn_item<64, 1>(it, smem, wv);
      continue;
    }
    idx -= NC;
    if (idx < ND) {
      const int b = idx >> 3, head = idx & 7, kv = head >> 2, row0 = b * 256;
      it.Q = p.Qwin() + (size_t)row0 * 512 + head * 64; it.qs = 512;
      it.K = p.Kwin_c() + (size_t)(b * 256) * 128 + kv * 64; it.ks = 128;
      it.Vt = p.Vtwin_c() + ((size_t)((b * 2 + kv) * 64)) * 256; it.vs = 256;
      it.t0 = 0; it.t1 = 4;
      it.scale = 0.125f * LOG2E; it.sink_l2 = p.win_sink[l * 8 + head] * LOG2E; it.has_sink = 1;
      it.out = p.mix() + (size_t)row0 * DM + head * 64;
      attn_item<64, 0>(it, smem, wv);
      continue;
    }
    idx -= ND;
    if (idx < NE) {
      const int b = idx >> 2, hh = idx & 3, row0 = b * 256;
      it.Q = p.Qmla() + (size_t)row0 * 384 + hh * 96; it.qs = 384;
      it.K = p.Kmla_c() + ((size_t)((b * 4 + hh) * 256)) * 96; it.ks = 96;
      it.Vt = p.Vtmla_c() + ((size_t)((b * 4 + hh) * 64)) * 256; it.vs = 256;
      it.t0 = 0; it.t1 = 4;
      it.scale = 0.10206207261596575f * LOG2E;
      it.out = p.mix() + (size_t)row0 * DM + 768 + hh * 64;
      attn_item<96, 0>(it, smem, wv);
      continue;
    }
    idx -= NE;
    if (idx < NF) {
      const int b = idx >> 2, hh = idx & 3, row0 = b * 256;
      it.Q = p.Qret() + (size_t)row0 * 256 + hh * 64; it.qs = 256;
      it.K = p.Kret() + (size_t)(b * 256) * 256 + hh * 64; it.ks = 256;
      it.Vt = p.Vtret_c() + ((size_t)((b * 4 + hh) * 64)) * 256; it.vs = 256;
      it.t0 = 0; it.t1 = 4;
      it.qpos0 = 0; it.T = 256; it.scale = 0.125f;
      it.lgf = log2_sigmoid(p.ret_decay[(l * 2 + 0) * 4 + hh]);
      it.lgb = log2_sigmoid(p.ret_decay[(l * 2 + 1) * 4 + hh]);
      it.G = p.Gret() + (size_t)row0 * 256 + hh * 64; it.gn = p.ret_gn + l * 256 + hh * 64;
      it.out = p.mix() + (size_t)row0 * DM + 512 + hh * 64;
      attn_item<64, 2>(it, smem, wv);
      continue;
    }
    idx -= NF;
    {
      const int b = idx >> 2, hh = idx & 3;
      it.Q = nullptr; it.qs = 0;
      it.K = p.Kret() + (size_t)(b * 256) * 256 + hh * 64; it.ks = 256;
      it.Vt = p.Vtret_c() + ((size_t)((b * 4 + hh) * 64)) * 256; it.vs = 256;
      it.t0 = 0; it.t1 = 4;
      it.T = 256; it.scale = 0.125f;
      it.lgf = log2_sigmoid(p.ret_decay[(l * 2 + 0) * 4 + hh]);
      it.lgb = log2_sigmoid(p.ret_decay[(l * 2 + 1) * 4 + hh]);
      it.out = nullptr;
      it.sout = p.out + 23592960 + ((size_t)((b * 2 + l) * 2 * 4 + hh)) * 4096;
      attn_item<64, 3>(it, smem, wv);
    }
  }
}

__device__ __forceinline__ void norm0_phase(const P& p, unsigned char* smem, const int wv) {
  const int tid = my_tid(wv), lane = tid & 63, gw = my_bid() * NWV + (tid >> 6), ngw = gridDim.x * NWV;
  const float* gain = p.norm1;
  for (int m0 = gw; m0 < NTOK; m0 += 2 * ngw) {
    float4 v[2][4];
    float ss[2] = {0.f, 0.f};
#pragma unroll
    for (int q = 0; q < 2; ++q) {
      const int m = m0 + q * ngw;
      const float* xr = m < NCTX ? p.x_prompt + (size_t)m * DM : p.x_sample + (size_t)(m - NCTX) * DM;
#pragma unroll
      for (int j = 0; j < 4; ++j) v[q][j] = ((const float4*)xr)[lane + 64 * j];
    }
#pragma unroll
    for (int q = 0; q < 2; ++q) {
#pragma unroll
      for (int j = 0; j < 4; ++j) ss[q] += v[q][j].x * v[q][j].x + v[q][j].y * v[q][j].y + v[q][j].z * v[q][j].z + v[q][j].w * v[q][j].w;
      ss[q] = wave_sum(ss[q], lane);
    }
#pragma unroll
    for (int q = 0; q < 2; ++q) {
      const int m = m0 + q * ngw;
      const float* scale = p.mod() + ((size_t)mod_row(m)) * 6144 + 1 * 1024;
#pragma unroll
      for (int j = 0; j < 4; ++j) {
        const int c = (lane + 64 * j) * 4;
        const float4 g = *(const float4*)(gain + c), sc = *(const float4*)(scale + c);
        uint2 u;
        u.x = pk2(v[q][j].x * g.x * (1.f + sc.x), v[q][j].y * g.y * (1.f + sc.y));
        u.y = pk2(v[q][j].z * g.z * (1.f + sc.z), v[q][j].w * g.w * (1.f + sc.w));
        *(uint2*)(p.hbuf() + (size_t)m * DM + c) = u;
      }
      if (lane < 16) p.rssA()[(size_t)m * 16 + lane] = lane == 0 ? ss[q] : 0.f;
    }
  }
  float* sc = (float*)smem;
  float* red = sc + 9216;
  constexpr int G_IN = DIN / 32, G_UP = DFF / 32, NIT = 2 * G_IN + 2 * G_UP;
  for (int item = my_bid(); item < NIT; item += gridDim.x) {
    int l, grp; const float* W; int N; float* outp; int ldo; int which;
    if (item < 2 * G_IN) { l = item / G_IN; grp = item % G_IN; W = p.w_in + (size_t)l * DM * DIN; N = DIN; outp = p.sWin() + (size_t)l * 9 * DINP; ldo = DINP; which = 0; }
    else { const int i2 = item - 2 * G_IN; l = i2 / G_UP; grp = i2 % G_UP; W = p.w_up + (size_t)l * DM * DFF; N = DFF; outp = p.sWup() + (size_t)l * 9 * DFF; ldo = DFF; which = 3; }
    __syncthreads();
    for (int i = tid; i < 9216; i += NTHR) sc[i] = p.mod()[((size_t)(l * 9 + (i >> 10))) * 6144 + which * 1024 + (i & 1023)];
    __syncthreads();
    const int n0 = grp * 32, j = tid & 31, kq = tid >> 5;
    float acc[9];
#pragma unroll
    for (int r = 0; r < 9; ++r) acc[r] = 0.f;
    const float* w = W + (size_t)(kq * 64) * N + n0 + j;
    const float* s = sc + kq * 64;
#pragma unroll 8
    for (int kk = 0; kk < 64; ++kk) {
      const float wv2 = w[(size_t)kk * N];
#pragma unroll
      for (int r = 0; r < 9; ++r) acc[r] += s[r * 1024 + kk] * wv2;
    }
#pragma unroll
    for (int r = 0; r < 9; ++r) red[(kq * 9 + r) * 32 + j] = acc[r];
    __syncthreads();
    for (int oo = tid; oo < 288; oo += NTHR) {
      const int r = oo >> 5, jj = oo & 31;
      float sum = 0.f;
#pragma unroll
      for (int q = 0; q < 16; ++q) sum += red[(q * 9 + r) * 32 + jj];
      outp[(size_t)r * ldo + n0 + jj] = sum;
    }
  }
}
__device__ __forceinline__ void final_norm_phase(const P& p, const int wv) {
  const int tid = my_tid(wv), lane = tid & 63, gw = my_bid() * NWV + (tid >> 6), ngw = gridDim.x * NWV;
  for (int m = gw; m < NTOK; m += ngw) {
    const float* xr = p.xw() + (size_t)m * DM;
    float4 v[4];
    float ss = 0.f;
#pragma unroll
    for (int j = 0; j < 4; ++j) {
      v[j] = ((const float4*)xr)[lane + 64 * j];
      ss += v[j].x * v[j].x + v[j].y * v[j].y + v[j].z * v[j].z + v[j].w * v[j].w;
    }
    ss = wave_sum(ss, lane);
    const float rstd = rsqrtf(ss * (1.f / 1024.f) + 1e-6f);
#pragma unroll
    for (int j = 0; j < 4; ++j) {
      const int c = (lane + 64 * j) * 4;
      const float4 g = *(const float4*)(p.final_norm + c);
      *(float4*)(p.out + (size_t)m * DM + c) = make_float4(v[j].x * rstd * g.x, v[j].y * rstd * g.y, v[j].z * rstd * g.z, v[j].w * rstd * g.w);
    }
  }
}

__device__ __forceinline__ void transpose_tile(const float* __restrict__ W, int K, int N, bf16_t* __restrict__ WT, int item, float* tile, const int tid) {
  const int ntn = (N + 63) >> 6, kt = item / ntn, nt = item % ntn, k0 = kt * 64, n0 = nt * 64;
  const int j = tid & 63, i0 = tid >> 6;
#pragma unroll 4
  for (int itr = 0; itr < 8; ++itr) {
    const int i = i0 + 8 * itr, n = n0 + j;
    tile[i * 65 + j] = n < N ? W[(size_t)(k0 + i) * N + n] : 0.f;
  }
  __syncthreads();
#pragma unroll 4
  for (int itr = 0; itr < 8; ++itr) {
    const int jj = i0 + 8 * itr, n = n0 + jj;
    if (n < N) WT[(size_t)n * K + k0 + j] = f2bf(tile[j * 65 + jj]);
  }
  __syncthreads();
}

__device__ __forceinline__ void prep_phase(const P& p, unsigned char* smem, const int wv) {
  const int tid = my_tid(wv);
  {
    float* sc = (float*)smem;
    float* red = sc + 9216;
    for (int i = tid; i < 9216; i += NTHR) {
      const int r = i >> 10, k = i & 1023;
      const float x = r == 0 ? p.c_ctx[k] : p.c[(r - 1) * 1024 + k];
      sc[i] = x / (1.f + expf(-x));
    }
    __syncthreads();
    for (int item = blockIdx.x; item < 384; item += gridDim.x) {
      const int l = item / 192, n0 = (item % 192) * 32, j = tid & 31, kq = tid >> 5;
      float acc[9];
#pragma unroll
      for (int r = 0; r < 9; ++r) acc[r] = 0.f;
      const float* w = p.w_mod + ((size_t)l * 1024 + kq * 64) * 6144 + n0 + j;
      const float* s = sc + kq * 64;
#pragma unroll 8
      for (int kk = 0; kk < 64; ++kk) {
        const float wv = w[(size_t)kk * 6144];
#pragma unroll
        for (int r = 0; r < 9; ++r) acc[r] += s[r * 1024 + kk] * wv;
      }
#pragma unroll
      for (int r = 0; r < 9; ++r) red[(kq * 9 + r) * 32 + j] = acc[r];
      __syncthreads();
      for (int oo = tid; oo < 288; oo += NTHR) {
        const int r = oo >> 5, jj = oo & 31;
        float sum = 0.f;
#pragma unroll
        for (int q = 0; q < 16; ++q) sum += red[(q * 9 + r) * 32 + jj];
        p.mod()[((size_t)(l * 9 + r)) * 6144 + n0 + jj] = sum + p.b_mod[l * 6144 + n0 + jj];
      }
      __syncthreads();
    }
  }
  __syncthreads();
  {
    float* tile = (float*)smem;
    constexpr int I_IN = 16 * 37, I_OUT = 16 * 16, I_UP = 16 * 64, I_DN = 64 * 16, I_KV = 2 * 8;
    constexpr int PER = I_IN + I_OUT + I_UP + I_DN + I_KV;
    for (int item = blockIdx.x; item < 2 * PER; item += gridDim.x) {
      const int l = item / PER;
      int r = item % PER;
      if (r < I_IN) { transpose_tile(p.w_in + (size_t)l * DM * DIN, DM, DIN, p.WinT() + (size_t)l * DINP * DM, r, tile, tid); continue; }
      r -= I_IN;
      if (r < I_OUT) { transpose_tile(p.w_out + (size_t)l * DM * DM, DM, DM, p.WoutT() + (size_t)l * DM * DM, r, tile, tid); continue; }
      r -= I_OUT;
      if (r < I_UP) { transpose_tile(p.w_up + (size_t)l * DM * DFF, DM, DFF, p.WupT() + (size_t)l * DFF * DM, r, tile, tid); continue; }
      r -= I_UP;
      if (r < I_DN) { transpose_tile(p.w_down + (size_t)l * DFF * DM, DFF, DM, p.WdownT() + (size_t)l * DM * DFF, r, tile, tid); continue; }
      r -= I_DN;
      transpose_tile(p.w_kv_b + (size_t)l * 128 * 512, 128, 512, p.WkvbT() + (size_t)l * 512 * 128, r, tile, tid);
    }
  }
  const int gt = blockIdx.x * NTHR + tid, gs = gridDim.x * NTHR;
  if (gt < 256) p.ctl()[gt] = 0u;
  for (int i = gt; i < 64 * 16; i += gs) {
    const int pos = i >> 4, f = i & 15;
    const float ang = (float)pos * exp2f(-(float)f * (L2_10000 / 16.f));
    p.ropeW()[pos * 32 + f] = __cosf(ang);
    p.ropeW()[pos * 32 + 16 + f] = __sinf(ang);
  }
  for (int i = gt; i < 64 * 8; i += gs) {
    const int pos = i >> 3, f = i & 7;
    const float ang = (float)pos * exp2f(-(float)f * (L2_10000 / 8.f));
    p.ropeM()[pos * 16 + f] = __cosf(ang);
    p.ropeM()[pos * 16 + 8 + f] = __sinf(ang);
  }
  for (int i = gt; i < 2 * (DINP - DIN) * DM / 8; i += gs) {
    const int l = i / ((DINP - DIN) * DM / 8), o = i % ((DINP - DIN) * DM / 8);
    *(uint4*)(p.WinT() + ((size_t)l * DINP + DIN) * DM + (size_t)o * 8) = make_uint4(0, 0, 0, 0);
  }
  for (int i = gt; i < 524288; i += gs) {
    const int d = i & 63, kv = (i >> 6) & 1, s = (i >> 7) & 255, l = (i >> 15) & 1, b = i >> 16;
    p.Kwin_l()[((size_t)((l * 8 + b) * 1280 + 1024 + s)) * 128 + kv * 64 + d] = f2bf(p.cache_win_k[i]);
    p.Vtwin_l()[((size_t)(((l * 8 + b) * 2 + kv) * 64 + d)) * 1280 + 1024 + s] = f2bf(p.cache_win_v[i]);
  }
  for (int i = gt; i < 524288; i += gs) {
    const int j = i & 127, s = (i >> 7) & 255, l = (i >> 15) & 1, b = i >> 16;
    p.ckvn()[((size_t)l * 18432 + 16384 + b * 256 + s) * 128 + j] = f2bf(p.cache_mla_ckv[i]);
  }
  for (int i = gt; i < 131072; i += gs) {
    const int j = i & 31, s = (i >> 5) & 255, l = (i >> 13) & 1, b = i >> 14;
    const bf16_t v = f2bf(p.cache_mla_krope[i]);
#pragma unroll
    for (int hh = 0; hh < 4; ++hh) p.Kmla_l()[((size_t)(((l * 8 + b) * 4 + hh) * 1280 + 1024 + s)) * 96 + 64 + j] = v;
  }
  for (int i = gt; i < 524288; i += gs) {
    const int e = i & 63, d = (i >> 6) & 63, hh = (i >> 12) & 3, dir = (i >> 14) & 1, l = (i >> 15) & 1, b = i >> 16;
    p.S0t()[((size_t)((((l * 8 + b) * 2 + dir) * 4 + hh) * 64 + e)) * 64 + d] = f2bf(p.state_ret[i]);
  }
}

struct RotOrder : pg8::StaticOrder {
  int rot;
  __device__ __forceinline__ bool next(int i, Unit& u) const {
    if (!pg8::StaticOrder::next(i, u)) return false;
    u.pn += rot; if (u.pn >= nN) u.pn -= nN;
    return true;
  }
};
template <class Epi>
__device__ __forceinline__ void big_gemm(unsigned char* smem, const bf16_t* A, const bf16_t* Bt, int N, int K, const Epi& E, const int wv, int rot = 0) {
  pg8::Gemm g{A, Bt, NTOK, N, K};
  RotOrder S;
  S.init(NTOK, N, (int)gridDim.x, my_bid());
  S.rot = rot;
  pg8::gemm_phase<Epi, RotOrder, true, true>((PG8_LAS unsigned char*)smem, g, S, E, wv);
}

#define GSYNC() grid.sync()
__global__ void __launch_bounds__(NTHR, 2) hybrid_fwd(P p_arg) {
  cg::grid_group grid = cg::this_grid();
  const kargp_t kp = (kargp_t)__builtin_amdgcn_kernarg_segment_ptr();
  const int wv = __builtin_amdgcn_readfirstlane((int)threadIdx.x >> 6);
  { const P p = load_params(kp); prep_phase(p, smem, wv); }
  GSYNC();
  { const P p = load_params(kp); norm0_phase(p, smem, wv); }
  GSYNC();
#pragma unroll
  for (int l = 0; l < 2; ++l) {
    { const P pc = load_params(kp); const int t0 = my_tid(wv);
      for (int i = t0; i < 64 * 32; i += NTHR) ((float*)(smem + LDS_ROPEW))[i] = pc.ropeW()[i];
      for (int i = t0; i < 64 * 16; i += NTHR) ((float*)(smem + LDS_ROPEM))[i] = pc.ropeM()[i];
      __syncthreads(); }
    { const P p = load_params(kp);
      big_gemm(smem, p.hbuf(), p.WinT() + (size_t)l * DINP * DM, DINP, DM, EpiIn8{p, l, kp}, wv, 8); }
    { const P p = load_params(kp); gemm_small(p.ckvn() + (size_t)l * 18432 * 128, 128, p.WkvbT() + (size_t)l * 512 * 128, 128, 18432, 512, 128, smem, EpiKvb{p, l}, wv, p.ctl() + 64 * l, p.ctl() + 128 + 64 * l); }
    GSYNC();
    { const P p = load_params(kp); attn_phase(p, l, smem, wv); }
    GSYNC();
    { const P p = load_params(kp); big_gemm(smem, p.mix(), p.WoutT() + (size_t)l * DM * DM, DM, DM, EpiOut8{p, l}, wv); }
    GSYNC();
    { const P p = load_params(kp); big_gemm(smem, p.hbuf(), p.WupT() + (size_t)l * DFF * DM, DFF, DM, EpiUp8{p, l}, wv); }
    GSYNC();
    { const P p = load_params(kp); big_gemm(smem, p.ubuf(), p.WdownT() + (size_t)l * DM * DFF, DM, DFF, EpiDown8{p, l}, wv); }
    GSYNC();
  }
  { const P p = load_params(kp); final_norm_phase(p, wv); }
}

extern "C" void kernel_launch(void* const* d_in, const int* in_sizes, int n_in, void* d_out, int out_size, void* d_ws, size_t ws_size,
                              hipStream_t stream) {
  static int grid_blocks = 0;
  if (grid_blocks == 0) {
    int dev = 0, cus = 0, per_cu = 0;
    (void)hipGetDevice(&dev);
    (void)hipDeviceGetAttribute(&cus, hipDeviceAttributeMultiprocessorCount, dev);
    (void)hipFuncSetAttribute((const void*)hybrid_fwd, hipFuncAttributeMaxDynamicSharedMemorySize, LDS_BYTES);
    (void)hipOccupancyMaxActiveBlocksPerMultiprocessor(&per_cu, (const void*)hybrid_fwd, NTHR, LDS_BYTES);
    if (per_cu < 1) { fprintf(stderr, "occupancy query returned %d\n", per_cu); per_cu = 1; }
    per_cu = 1;
    grid_blocks = cus * per_cu;
  }
  P p{};
  const float* const* in = (const float* const*)d_in;
  p.x_prompt = in[0]; p.x_sample = in[1]; p.cache_win_k = in[2]; p.cache_win_v = in[3]; p.cache_mla_ckv = in[4];
  p.cache_mla_krope = in[5]; p.state_ret = in[6]; p.c = in[7]; p.c_ctx = in[8]; p.w_mod = in[9]; p.b_mod = in[10];
  p.norm1 = in[11]; p.norm2 = in[12]; p.w_in = in[13]; p.win_sink = in[14]; p.ret_decay = in[15]; p.ret_gn = in[16];
  p.mla_kv_norm = in[17]; p.w_kv_b = in[18]; p.w_out = in[19]; p.w_up = in[20]; p.w_down = in[21]; p.final_norm = in[22];
  p.out = (float*)d_out;
  p.ws = (unsigned char*)d_ws;
  if (WS_END > ws_size) { fprintf(stderr, "kernel_launch: workspace too small: need %zu, have %zu\n", (size_t)WS_END, ws_size); return; }
  void* args[] = {&p};
  hipError_t e = hipLaunchCooperativeKernel((const void*)hybrid_fwd, dim3(grid_blocks), dim3(NTHR), args, LDS_BYTES, stream);
  if (e != hipSuccess) fprintf(stderr, "cooperative launch failed: %s (grid %d)\n", hipGetErrorString(e), grid_blocks);
}
```

```cpp
#include <hip/hip_runtime.h>
#include <hip/hip_cooperative_groups.h>
#include <cstdio>
#include <cstdint>
namespace cg = cooperative_groups;

__device__ __forceinline__ int lane_id() { return (int)__builtin_amdgcn_mbcnt_hi(~0u, __builtin_amdgcn_mbcnt_lo(~0u, 0u)); }

namespace pg8 {
#define PG8_LAS __attribute__((address_space(3)))
typedef unsigned short bf16_t;
typedef short bf16x8 __attribute__((ext_vector_type(8)));
typedef float f32x4 __attribute__((ext_vector_type(4)));
typedef unsigned u32x4 __attribute__((ext_vector_type(4)));
constexpr int BM = 256, BK = 64, HALF = 128, HTB = HALF * BK * 2  , STAGE_BYTES = 8 * HTB, NXCD = 8, WGM = 8;

__host__ __device__ __forceinline__ int lds_byte(int r, int c) { const int st = (r >> 4) * 2 + (c >> 5), rr = r & 15, cc = c & 31, ob = rr * 64 + cc * 2; return st * 1024 + (ob ^ (((ob >> 9) & 1) << 5)); }
__host__ __device__ __forceinline__ void stage_rc(int b, int& R, int& C) { const int st = b / 1024, sb = b % 1024, swz = sb ^ (((sb >> 9) & 1) << 5); R = (st >> 1) * 16 + swz / 64; C = (st & 1) * 32 + (swz % 64) / 2; }
__host__ __device__ __forceinline__ int perm32(int rho) { const int n = rho >> 4, i = rho & 15; return 8 * (i >> 2) + 4 * n + (i & 3); }

struct Unit { int pm, pn; };
struct Gemm { const bf16_t* A; const bf16_t* Bt; int M, N, K; };

struct StaticOrder {
    int nM, nN, nwg, G, c;
    __host__ __device__ void init(int M, int N, int G_, int c_) { nM = M / BM; nN = N / BM; nwg = nM * nN; G = G_; c = c_; }
    __host__ __device__ bool next(int i, Unit& u) const {
        const long L = (long)i * G + c; if (L >= nwg) return false;
        int wgid = (int)L; { const int q = nwg / NXCD, r = nwg % NXCD, xcd = wgid % NXCD, off = wgid / NXCD; wgid = (xcd < r ? xcd * (q + 1) : r * (q + 1) + (xcd - r) * q) + off; }
        const int nig = WGM * nN, gid = wgid / nig, fm = gid * WGM, gsz = (nM - fm) < WGM ? (nM - fm) : WGM;
        u.pm = fm + ((wgid % nig) % gsz); u.pn = (wgid % nig) / gsz; return true;
    }
    __device__ __forceinline__ void a_ready(const Unit&) const {}
    __device__ __forceinline__ void done(const Unit&) const {}
};
template <class Epi, class Sched, bool ALIGN_EPI = false, bool SP2 = false>
__device__ __forceinline__ void gemm_phase(PG8_LAS unsigned char* lds, const Gemm g, const Sched& S, const Epi& E, const int wvp) {
    const int wid = wvp, lane = lane_id(), tid = wid * 64 + lane, wr = wid >> 2, wc = wid & 3, fr = lane & 15, fq = lane >> 4;
    const int K = g.K, nt = K / BK;
    unsigned voffA[2], voffB[2];
#pragma unroll
    for (int i = 0; i < 2; ++i) { int R, C; stage_rc(tid * 16 + i * 8192, R, C); const int Rb = Epi::PERM ? ((R & ~31) + perm32(R & 31)) : R;
        voffA[i] = (unsigned)(R * K + C) * 2u; voffB[i] = (unsigned)(Rb * K + C) * 2u; }
    const size_t kstep = (size_t)(BK * 2);
    const size_t hstep = (size_t)HALF * K * 2;
    const size_t tstep = 2 * hstep;
    const unsigned ldsw = (unsigned)wid * 1024u;
    const int aoff = lds_byte(wr * 64 + fr, fq * 8), boff = lds_byte(wc * 32 + fr, fq * 8);
#define PG8_SA(b, h) (((b) * 2 + (h)) * HTB)
#define PG8_SB(b, h) ((4 + (b) * 2 + (h)) * HTB)
#define PG8_STAGE(bufoff, gbase, voff) do { _Pragma("unroll") for (int _i = 0; _i < 2; ++_i) \
        __builtin_amdgcn_global_load_lds((const unsigned*)((const char*)(gbase) + (voff)[_i]), (PG8_LAS unsigned*)(lds + (bufoff) + ldsw + _i * 8192), 16, 0, 0); } while (0)
#define PG8_LDA(dst, b, h) do { _Pragma("unroll") for (int m = 0; m < 4; ++m) _Pragma("unroll") for (int k = 0; k < 2; ++k) dst[m][k] = *(const PG8_LAS bf16x8*)(lds + PG8_SA(b, h) + aoff + m * 2048 + k * 1024); } while (0)
#define PG8_LDB(dst, b, h) do { _Pragma("unroll") for (int n = 0; n < 2; ++n) _Pragma("unroll") for (int k = 0; k < 2; ++k) dst[n][k] = *(const PG8_LAS bf16x8*)(lds + PG8_SB(b, h) + boff + n * 2048 + k * 1024); } while (0)
#define PG8_MMA(ai, bj, At, Bt) do { __builtin_amdgcn_s_setprio(1); _Pragma("unroll") for (int m = 0; m < 4; ++m) _Pragma("unroll") for (int n = 0; n < 2; ++n) _Pragma("unroll") for (int k = 0; k < 2; ++k) \
        acc[ai][bj][m][n] = __builtin_amdgcn_mfma_f32_16x16x32_bf16(Bt[n][k], At[m][k], acc[ai][bj][m][n], 0, 0, 0); __builtin_amdgcn_s_setprio(0); } while (0)
#define PG8_WAIT_V(n) asm volatile("s_waitcnt vmcnt(" #n ")" ::: "memory")
#define PG8_WAIT_L(n) asm volatile("s_waitcnt lgkmcnt(" #n ")" ::: "memory")
#define PG8_BAR __builtin_amdgcn_s_barrier()
#define PG8_SCHED __builtin_amdgcn_sched_barrier(0)
    Unit cur, nxt; int ui = 0;
    if (!S.next(0, cur)) return;
    f32x4 acc[2][2][4][2];
#pragma unroll
    for (int a = 0; a < 2; ++a)
#pragma unroll
        for (int b = 0; b < 2; ++b)
#pragma unroll
            for (int m = 0; m < 4; ++m)
#pragma unroll
                for (int n = 0; n < 2; ++n) acc[a][b][m][n] = (f32x4){0.f, 0.f, 0.f, 0.f};
    bf16x8 At[4][2], B0[2][2], B1[2][2];
    const char* cA = (const char*)g.A + (size_t)cur.pm * tstep; const char* cB = (const char*)g.Bt + (size_t)cur.pn * tstep;
    S.a_ready(cur);
    if constexpr (SP2) {
        PG8_STAGE(PG8_SB(0, 0), cB, voffB); PG8_STAGE(PG8_SB(0, 1), cB + hstep, voffB); PG8_STAGE(PG8_SA(0, 0), cA, voffA); PG8_STAGE(PG8_SA(0, 1), cA + hstep, voffA);
        if (wr == 1) PG8_BAR;
        PG8_WAIT_V(2); PG8_BAR;
        PG8_STAGE(PG8_SB(1, 0), cB + kstep, voffB); PG8_STAGE(PG8_SA(1, 0), cA + kstep, voffA); PG8_STAGE(PG8_SB(1, 1), cB + hstep + kstep, voffB);
        PG8_WAIT_V(6); PG8_BAR;
    } else {
        PG8_STAGE(PG8_SB(0, 0), cB, voffB); PG8_STAGE(PG8_SA(0, 0), cA, voffA); PG8_STAGE(PG8_SB(0, 1), cB + hstep, voffB); PG8_STAGE(PG8_SA(0, 1), cA + hstep, voffA);
        if (wr == 1) PG8_BAR;
        PG8_WAIT_V(4); PG8_BAR;
        PG8_STAGE(PG8_SB(1, 0), cB + kstep, voffB); PG8_STAGE(PG8_SA(1, 0), cA + kstep, voffA); PG8_STAGE(PG8_SB(1, 1), cB + hstep + kstep, voffB);
        PG8_WAIT_V(6); PG8_BAR;
    }
    for (;;) {
        const bool has_next = S.next(ui + 1, nxt);
        const char* nA = has_next ? (const char*)g.A + (size_t)nxt.pm * tstep : cA; const char* nB = has_next ? (const char*)g.Bt + (size_t)nxt.pn * tstep : cB;
        for (int t = 0; t < nt; t += 2) {
            const bool last = (t == nt - 2);
            const char* a1 = cA + (size_t)(t + 1) * kstep;
            const char* a2 = last ? nA : cA + (size_t)(t + 2) * kstep; const char* b2 = last ? nB : cB + (size_t)(t + 2) * kstep;
            const char* a3 = a2 + kstep; const char* b3 = b2 + kstep;
            if (last && has_next) S.a_ready(nxt);
            if constexpr (SP2) {
            PG8_LDB(B0, 0, 0); PG8_LDB(B1, 0, 1); PG8_SCHED; PG8_LDA(At, 0, 0); PG8_STAGE(PG8_SA(1, 1), a1 + hstep, voffA);
            PG8_WAIT_V(8); PG8_WAIT_L(0); PG8_BAR; PG8_MMA(0, 0, At, B0); PG8_MMA(0, 1, At, B1); PG8_BAR; PG8_SCHED;
            PG8_LDA(At, 0, 1); PG8_STAGE(PG8_SB(0, 0), b2, voffB); PG8_STAGE(PG8_SB(0, 1), b2 + hstep, voffB); PG8_STAGE(PG8_SA(0, 0), a2, voffA);
            PG8_WAIT_V(8); PG8_WAIT_L(0); PG8_BAR; PG8_MMA(1, 0, At, B0); PG8_MMA(1, 1, At, B1); PG8_BAR; PG8_SCHED;
            PG8_LDB(B0, 1, 0); PG8_LDB(B1, 1, 1); PG8_SCHED; PG8_LDA(At, 1, 0); PG8_STAGE(PG8_SA(0, 1), a2 + hstep, voffA);
            PG8_WAIT_V(8); PG8_WAIT_L(0); PG8_BAR; PG8_MMA(0, 0, At, B0); PG8_MMA(0, 1, At, B1); PG8_BAR; PG8_SCHED;
            PG8_LDA(At, 1, 1); PG8_STAGE(PG8_SB(1, 0), b3, voffB); PG8_STAGE(PG8_SB(1, 1), b3 + hstep, voffB); PG8_STAGE(PG8_SA(1, 0), a3, voffA);
            PG8_WAIT_V(8); PG8_WAIT_L(0); PG8_BAR; PG8_MMA(1, 0, At, B0); PG8_MMA(1, 1, At, B1); PG8_BAR; PG8_SCHED;
            } else {
            PG8_LDB(B0, 0, 0); PG8_SCHED; PG8_LDA(At, 0, 0); PG8_STAGE(PG8_SA(1, 1), a1 + hstep, voffA);
            PG8_WAIT_L(8); PG8_BAR; PG8_WAIT_L(0); PG8_MMA(0, 0, At, B0); PG8_BAR; PG8_SCHED;
            PG8_LDB(B1, 0, 1); PG8_STAGE(PG8_SB(0, 0), b2, voffB);
            PG8_BAR; PG8_WAIT_L(0); PG8_MMA(0, 1, At, B1); PG8_BAR;
            PG8_LDA(At, 0, 1); PG8_STAGE(PG8_SA(0, 0), a2, voffA);
            PG8_BAR; PG8_WAIT_L(0); PG8_MMA(1, 0, At, B0); PG8_BAR; PG8_SCHED;
            PG8_STAGE(PG8_SB(0, 1), b2 + hstep, voffB);
            PG8_WAIT_V(6); PG8_BAR; PG8_MMA(1, 1, At, B1); PG8_BAR;
            PG8_LDB(B0, 1, 0); PG8_SCHED; PG8_LDA(At, 1, 0); PG8_STAGE(PG8_SA(0, 1), a2 + hstep, voffA);
            PG8_WAIT_L(8); PG8_BAR; PG8_WAIT_L(0); PG8_MMA(0, 0, At, B0); PG8_BAR; PG8_SCHED;
            PG8_LDB(B1, 1, 1); PG8_STAGE(PG8_SB(1, 0), b3, voffB);
            PG8_BAR; PG8_WAIT_L(0); PG8_MMA(0, 1, At, B1); PG8_BAR;
            PG8_LDA(At, 1, 1); PG8_STAGE(PG8_SA(1, 0), a3, voffA);
            PG8_BAR; PG8_WAIT_L(0); PG8_MMA(1, 0, At, B0); PG8_BAR; PG8_SCHED;
            PG8_STAGE(PG8_SB(1, 1), b3 + hstep, voffB);
            PG8_WAIT_V(6); PG8_BAR; PG8_MMA(1, 1, At, B1); PG8_BAR;
            }
        }
        if constexpr (ALIGN_EPI) { if (wr == 0) PG8_BAR; }
        if constexpr (!Epi::AFTER_DRAIN) { E(acc, cur, wr, wc, fr, fq); S.done(cur); }
        if (!has_next) break;
#pragma unroll
        for (int a = 0; a < 2; ++a)
#pragma unroll
            for (int b = 0; b < 2; ++b)
#pragma unroll
                for (int m = 0; m < 4; ++m)
#pragma unroll
                    for (int n = 0; n < 2; ++n) acc[a][b][m][n] = (f32x4){0.f, 0.f, 0.f, 0.f};
        cur = nxt; cA = nA; cB = nB; ++ui;
        if constexpr (ALIGN_EPI) { if (wr == 1) PG8_BAR; }
    }
    PG8_WAIT_V(0);
    if constexpr (!ALIGN_EPI) { if (wr == 0) PG8_BAR; }
    PG8_BAR;
    if constexpr (Epi::AFTER_DRAIN) { E.fused(acc, cur, wr, wc, fr, fq, lds, wid, lane); S.done(cur); }
#undef PG8_SA
#undef PG8_SB
#undef PG8_STAGE
#undef PG8_LDA
#undef PG8_LDB
#undef PG8_MMA
#undef PG8_WAIT_V
#undef PG8_WAIT_L
#undef PG8_BAR
#undef PG8_SCHED
}
}


typedef unsigned short bf16_t;
typedef short bf16x8 __attribute__((ext_vector_type(8)));
typedef float f32x16 __attribute__((ext_vector_type(16)));
typedef pg8::f32x4 f32x4;
using pg8::Unit;

constexpr int NTHR = 512, NWV = 8;
constexpr int NTOK = 16384, NCTX = 8192, DM = 1024, DIN = 2336, DINP = 2560, DFF = 4096;
constexpr int LDS_RED = 131072;
constexpr int LDS_ROPEW = 131072 + 4096, LDS_ROPEM = LDS_ROPEW + 64 * 32 * 4;
constexpr int LDS_BYTES = LDS_ROPEM + 64 * 16 * 4;
constexpr float LOG2E = 1.4426950408889634f;
constexpr float L2_10000 = 13.287712379549449f;

#define AL256(x) (((x) + 255) & ~(size_t)255)
constexpr size_t OFF_mod = 0;
constexpr size_t OFF_ropeW = OFF_mod + AL256((size_t)2 * 9 * 6144 * 4);
constexpr size_t OFF_ropeM = OFF_ropeW + AL256((size_t)64 * 32 * 4);
constexpr size_t OFF_ctl = OFF_ropeM + AL256((size_t)64 * 16 * 4);
constexpr size_t OFF_rssA = OFF_ctl + AL256((size_t)256 * 4);
constexpr size_t OFF_rssB = OFF_rssA + AL256((size_t)NTOK * 16 * 4);
constexpr size_t OFF_sWin = OFF_rssB + AL256((size_t)NTOK * 16 * 4);
constexpr size_t OFF_sWup = OFF_sWin + AL256((size_t)2 * 9 * DINP * 4);
constexpr size_t OFF_WinT = OFF_sWup + AL256((size_t)2 * 9 * DFF * 4);
constexpr size_t OFF_WoutT = OFF_WinT + AL256((size_t)2 * DINP * DM * 2);
constexpr size_t OFF_WupT = OFF_WoutT + AL256((size_t)2 * DM * DM * 2);
constexpr size_t OFF_WdownT = OFF_WupT + AL256((size_t)2 * DFF * DM * 2);
constexpr size_t OFF_WkvbT = OFF_WdownT + AL256((size_t)2 * DM * DFF * 2);
constexpr size_t OFF_hbuf = OFF_WkvbT + AL256((size_t)2 * 512 * 128 * 2);
constexpr size_t OFF_Kwin_l = OFF_hbuf + AL256((size_t)NTOK * DM * 2);
constexpr size_t OFF_Vtwin_l = OFF_Kwin_l + AL256((size_t)2 * 8 * 1280 * 128 * 2);
constexpr size_t OFF_S0t = OFF_Vtwin_l + AL256((size_t)2 * 8 * 2 * 64 * 1280 * 2);
constexpr size_t OFF_ckvn = OFF_S0t + AL256((size_t)2 * 8 * 2 * 4 * 4096 * 2);
constexpr size_t OFF_Kmla_l = OFF_ckvn + AL256((size_t)2 * 18432 * 128 * 2);
constexpr size_t OFF_Vtmla_l = OFF_Kmla_l + AL256((size_t)2 * 8 * 4 * 1280 * 96 * 2);
constexpr size_t OFF_ubuf = OFF_Vtmla_l + AL256((size_t)2 * 8 * 4 * 64 * 1280 * 2);
constexpr size_t WS_END = OFF_ubuf + AL256((size_t)NTOK * DFF * 2);
constexpr size_t OFF_mix = OFF_ubuf + (size_t)96 * 1024 * 1024;
constexpr size_t OFF_Qwin = OFF_ubuf;
constexpr size_t OFF_Kwin_c = OFF_Qwin + AL256((size_t)NTOK * 512 * 2);
constexpr size_t OFF_Vtwin_c = OFF_Kwin_c + AL256((size_t)NCTX * 128 * 2);
constexpr size_t OFF_Qret = OFF_Vtwin_c + AL256((size_t)32 * 2 * 64 * 256 * 2);
constexpr size_t OFF_Kret = OFF_Qret + AL256((size_t)NTOK * 256 * 2);
constexpr size_t OFF_Gret = OFF_Kret + AL256((size_t)NTOK * 256 * 2);
constexpr size_t OFF_Vtret_c = OFF_Gret + AL256((size_t)NTOK * 256 * 2);
constexpr size_t OFF_Vtret_l = OFF_Vtret_c + AL256((size_t)32 * 4 * 64 * 256 * 2);
constexpr size_t OFF_Qmla = OFF_Vtret_l + AL256((size_t)8 * 4 * 64 * 1024 * 2);
constexpr size_t OFF_Kmla_c = OFF_Qmla + AL256((size_t)NTOK * 384 * 2);
constexpr size_t OFF_Vtmla_c = OFF_Kmla_c + AL256((size_t)32 * 4 * 256 * 96 * 2);
static_assert(OFF_Vtmla_c + (size_t)32 * 4 * 64 * 256 * 2 <= OFF_mix && OFF_mix + (size_t)NTOK * DM * 2 <= WS_END, "attention temporaries + mix must fit in the ubuf region");
static_assert(WS_END <= (size_t)256 * 1024 * 1024, "workspace must fit 256 MiB");

struct P {
  const float *x_prompt, *x_sample, *cache_win_k, *cache_win_v, *cache_mla_ckv, *cache_mla_krope, *state_ret,
      *c, *c_ctx, *w_mod, *b_mod, *norm1, *norm2, *w_in, *win_sink, *ret_decay, *ret_gn, *mla_kv_norm,
      *w_kv_b, *w_out, *w_up, *w_down, *final_norm;
  float* out;
  unsigned char* ws;
#define WSBUF(ty, name) __device__ __forceinline__ ty* name() const { return (ty*)(ws + OFF_##name); }
  WSBUF(unsigned, ctl) WSBUF(float, mod) WSBUF(float, ropeW) WSBUF(float, ropeM) WSBUF(float, rssA) WSBUF(float, rssB) WSBUF(float, sWin) WSBUF(float, sWup) WSBUF(bf16_t, WinT) WSBUF(bf16_t, WoutT) WSBUF(bf16_t, WupT) WSBUF(bf16_t, WdownT) WSBUF(bf16_t, WkvbT)
  WSBUF(bf16_t, hbuf) WSBUF(bf16_t, mix) WSBUF(bf16_t, Qwin) WSBUF(bf16_t, Kwin_c) WSBUF(bf16_t, Vtwin_c) WSBUF(bf16_t, Kwin_l)
  WSBUF(bf16_t, Vtwin_l) WSBUF(bf16_t, Qret) WSBUF(bf16_t, Kret) WSBUF(bf16_t, Gret) WSBUF(bf16_t, Vtret_c) WSBUF(bf16_t, Vtret_l)
  WSBUF(bf16_t, S0t) WSBUF(bf16_t, Qmla) WSBUF(bf16_t, ckvn) WSBUF(bf16_t, Kmla_c) WSBUF(bf16_t, Vtmla_c) WSBUF(bf16_t, Kmla_l)
  WSBUF(bf16_t, Vtmla_l) WSBUF(bf16_t, ubuf)
  __device__ __forceinline__ float* xw() const { return out; }
};

typedef float f32x2_t __attribute__((ext_vector_type(2)));
typedef __bf16 bf16x2_t __attribute__((ext_vector_type(2)));
__device__ __forceinline__ unsigned pk2(float lo, float hi) {
  const f32x2_t v = {lo, hi};
  const bf16x2_t b = __builtin_convertvector(v, bf16x2_t);
  return __builtin_bit_cast(unsigned, b);
}
__device__ __forceinline__ bf16_t f2bf(float f) { return (bf16_t)(pk2(f, 0.f) & 0xffffu); }
__device__ __forceinline__ float bf2f(bf16_t b) { return __uint_as_float(((unsigned)b) << 16); }
__device__ __forceinline__ float shx(float v, int mask, int ln) { return __int_as_float(__builtin_amdgcn_ds_bpermute((ln ^ mask) << 2, __float_as_int(v))); }
__device__ __forceinline__ float wave_sum(float v, int ln) {
#pragma unroll
  for (int o = 1; o < 64; o <<= 1) v += shx(v, o, ln);
  return v;
}
typedef const __attribute__((address_space(4))) unsigned char* kargp_t;
__device__ __forceinline__ P load_params(kargp_t kp) {
  asm volatile("" : "+s"(kp));
  P p;
  __builtin_memcpy(&p, kp, sizeof(P));
  return p;
}
__device__ __forceinline__ int my_tid(int wv) { int w = wv; asm volatile("" : "+s"(w)); int t = w * 64 + lane_id(); asm volatile("" : "+v"(t)); return t; }
__device__ __forceinline__ int my_bid() { int b = blockIdx.x; asm volatile("" : "+s"(b)); return b; }
__device__ __forceinline__ float fexp2(float x) { return __builtin_amdgcn_exp2f(x); }
__device__ __forceinline__ int mod_row(int m) { return m < NCTX ? 0 : 1 + ((m - NCTX) >> 10); }

__device__ __forceinline__ void st_rm_bf16(bf16_t* rp, int h, const f32x16& o) {
#pragma unroll
  for (int g = 0; g < 4; ++g) {
    uint2 u;
    u.x = pk2(o[4 * g], o[4 * g + 1]);
    u.y = pk2(o[4 * g + 2], o[4 * g + 3]);
    *(uint2*)(rp + 8 * g + 4 * h) = u;
  }
}
__device__ __forceinline__ void st_tr_bf16(bf16_t* bp, int stride, int h, const f32x16& o) {
#pragma unroll
  for (int i = 0; i < 16; ++i) bp[(size_t)((i & 3) + 8 * (i >> 2) + 4 * h) * stride] = f2bf(o[i]);
}

__device__ __forceinline__ void st8_bf16(bf16_t* rp, int fq, const f32x4& a, const f32x4& b) {
  *(uint2*)(rp + 4 * fq) = make_uint2(pk2(a[0], a[1]), pk2(a[2], a[3]));
  *(uint2*)(rp + 16 + 4 * fq) = make_uint2(pk2(b[0], b[1]), pk2(b[2], b[3]));
}
__device__ __forceinline__ void st8_f32(float* rp, int fq, const f32x4& a, const f32x4& b) {
  *(f32x4*)(rp + 4 * fq) = a;
  *(f32x4*)(rp + 16 + 4 * fq) = b;
}
__device__ __forceinline__ void st8_tr(bf16_t* bp, int stride, int fq, const f32x4& a, const f32x4& b) {
#pragma unroll
  for (int j = 0; j < 4; ++j) {
    bp[(size_t)(4 * fq + j) * stride] = f2bf(a[j]);
    bp[(size_t)(16 + 4 * fq + j) * stride] = f2bf(b[j]);
  }
}
__device__ __forceinline__ void rope8_win(f32x4& a, f32x4& b, int fq, const float* tab) {
  const f32x4 cs = *(const f32x4*)(tab + 4 * fq), sn = *(const f32x4*)(tab + 16 + 4 * fq);
  const f32x4 x = a, y = b;
  a = x * cs - y * sn;
  b = x * sn + y * cs;
}
__device__ __forceinline__ void rope8_mla(f32x4& a, f32x4& b, int fq, int ln, const float* tabr, const float* tabc) {
  const int fo = 4 * (fq & 1);
  {
    const f32x4 cs = *(const f32x4*)(tabr + fo), sn = *(const f32x4*)(tabr + 8 + fo);
#pragma unroll
    for (int j = 0; j < 4; ++j) { const float pa = shx(a[j], 32, ln); a[j] = fq < 2 ? a[j] * cs[j] - pa * sn[j] : pa * sn[j] + a[j] * cs[j]; }
  }
  asm volatile("" ::: "memory");
  {
    const f32x4 cs = *(const f32x4*)(tabc + fo), sn = *(const f32x4*)(tabc + 8 + fo);
#pragma unroll
    for (int j = 0; j < 4; ++j) { const float pb = shx(b[j], 32, ln); b[j] = fq < 2 ? b[j] * cs[j] - pb * sn[j] : pb * sn[j] + b[j] * cs[j]; }
  }
}

__device__ __forceinline__ float row_rstd(const float* rss, int m) {
  const f32x4 a = *(const f32x4*)(rss + (size_t)m * 16), b = *(const f32x4*)(rss + (size_t)m * 16 + 4);
  const f32x4 c = *(const f32x4*)(rss + (size_t)m * 16 + 8), d = *(const f32x4*)(rss + (size_t)m * 16 + 12);
  const f32x4 s = (a + b) + (c + d);
  return rsqrtf(((s[0] + s[1]) + (s[2] + s[3])) * (1.f / 1024.f) + 1e-6f);
}

typedef f32x4 acc_t[2][2][4][2];
template <int V> struct IC { static constexpr int value = V; };
extern __shared__ __attribute__((aligned(16))) unsigned char smem[];
struct EpiIn8 {
  static constexpr bool PERM = false, AFTER_DRAIN = false;
  P p0; int l; kargp_t kp;
  __device__ __forceinline__ void operator()(const acc_t& acc, const Unit& u, int wr, int wc, int fr_in, int fq_in) const {
    int fr = fr_in; asm volatile("" : "+v"(fr));
    int fq = fq_in; asm volatile("" : "+v"(fq));
    const int ln = fq * 16 + fr; (void)ln;
    P p = p0; asm volatile("" : "+s"(p.ws), "+s"(p.out));
    const bool lat = u.pm >= 32;
    const int rbase = u.pm * 256 + wr * 64 + fr;
#define ROWS_BEGIN _Pragma("unroll") for (int ai = 0; ai < 2; ++ai) _Pragma("unroll") for (int mm = 0; mm < 4; ++mm) { \
      int m = rbase + ai * 128 + mm * 16; asm volatile("" : "+v"(m)); int b, s; \
      if (!lat) { b = m >> 8; s = m & 255; } else { b = (m - NCTX) >> 10; s = (m - NCTX) & 1023; } \
      const float rsd = rsdv[ai][mm]; \
      f32x4 v0 = acc[ai][bj][mm][0] * rsd + sw0, v1 = acc[ai][bj][mm][1] * rsd + sw1; (void)b; (void)s;
#define ROWS_END }
    float rsdv[2][4];
    {
      const float* rss = p.rssA();
#pragma unroll
      for (int ai = 0; ai < 2; ++ai)
#pragma unroll
        for (int mm = 0; mm < 4; ++mm) rsdv[ai][mm] = row_rstd(rss, rbase + ai * 128 + mm * 16);
    }
    auto do_half = [&](auto BJ) {
      constexpr int bj = decltype(BJ)::value;
      const int nb = u.pn * 256 + bj * 128 + wc * 32;
      if (nb >= DIN) return;
      const float* swp = p.sWin() + ((size_t)(l * 9 + (lat ? 1 + ((u.pm - 32) >> 2) : 0))) * DINP + nb;
      const f32x4 sw0 = *(const f32x4*)(swp + 4 * fq), sw1 = *(const f32x4*)(swp + 16 + 4 * fq);
      if (nb < 512) {
        ROWS_BEGIN
          if (lat) rope8_win(v0, v1, fq, (const float*)(smem + LDS_ROPEW) + ((nb & 32) ? (s & 63) : (s >> 6)) * 32);
          st8_bf16(p.Qwin() + (size_t)m * 512 + nb, fq, v0, v1);
        ROWS_END
      } else if (nb < 640) {
        const int c = nb - 512;
        ROWS_BEGIN
          if (!lat) {
            st8_f32(p.out + 16777216 + ((size_t)((b * 2 + l) * 256 + s)) * 128 + c, fq, v0, v1);
            st8_bf16(p.Kwin_c() + (size_t)m * 128 + c, fq, v0, v1);
          } else {
            rope8_win(v0, v1, fq, (const float*)(smem + LDS_ROPEW) + ((nb & 32) ? (s & 63) : (s >> 6)) * 32);
            st8_bf16(p.Kwin_l() + ((size_t)((l * 8 + b) * 1280 + s)) * 128 + c, fq, v0, v1);
          }
        ROWS_END
      } else if (nb < 768) {
        const int c = nb - 640, kv = c >> 6, d0 = c & 63;
        ROWS_BEGIN
          if (!lat) {
            st8_f32(p.out + 18874368 + ((size_t)((b * 2 + l) * 256 + s)) * 128 + c, fq, v0, v1);
            st8_tr(p.Vtwin_c() + ((size_t)((b * 2 + kv) * 64 + d0)) * 256 + s, 256, fq, v0, v1);
          } else {
            st8_tr(p.Vtwin_l() + ((size_t)(((l * 8 + b) * 2 + kv) * 64 + d0)) * 1280 + s, 1280, fq, v0, v1);
          }
        ROWS_END
      } else if (nb < 1024) {
        ROWS_BEGIN
          st8_bf16(p.Qret() + (size_t)m * 256 + (nb - 768), fq, v0, v1);
        ROWS_END
      } else if (nb < 1280) {
        ROWS_BEGIN
          st8_bf16(p.Kret() + (size_t)m * 256 + (nb - 1024), fq, v0, v1);
        ROWS_END
      } else if (nb < 1536) {
        const int c = nb - 1280, hh = c >> 6, d0 = c & 63;
        ROWS_BEGIN
          if (!lat) st8_tr(p.Vtret_c() + ((size_t)((b * 4 + hh) * 64 + d0)) * 256 + s, 256, fq, v0, v1);
          else st8_tr(p.Vtret_l() + ((size_t)((b * 4 + hh) * 64 + d0)) * 1024 + s, 1024, fq, v0, v1);
        ROWS_END
      } else if (nb < 1792) {
        ROWS_BEGIN
          st8_bf16(p.Gret() + (size_t)m * 256 + (nb - 1536), fq, v0, v1);
        ROWS_END
      } else if (nb < 2176) {
        const int c = nb - 1792;
        const bool rp = lat && (c % 96) == 64;
        ROWS_BEGIN
          if (rp) rope8_mla(v0, v1, fq, ln, (const float*)(smem + LDS_ROPEM) + (s >> 6) * 16, (const float*)(smem + LDS_ROPEM) + (s & 63) * 16);
          st8_bf16(p.Qmla() + (size_t)m * 384 + c, fq, v0, v1);
        ROWS_END
      } else if (nb < 2304) {
        const int c = nb - 2176;
        float* red = (float*)(smem + LDS_RED);
        kargp_t k2 = kp; asm volatile("" : "+s"(k2));
        const float* g = ((const __attribute__((address_space(4))) P*)k2)->mla_kv_norm + l * 128 + c;
        const f32x4 g0 = *(const f32x4*)(g + 4 * fq), g1 = *(const f32x4*)(g + 16 + 4 * fq);
#pragma unroll
        for (int ai = 0; ai < 2; ++ai)
#pragma unroll
          for (int mm = 0; mm < 4; ++mm) {
            const float rsd0 = rsdv[ai][mm];
            const f32x4 a = acc[ai][bj][mm][0] * rsd0 + sw0, b4 = acc[ai][bj][mm][1] * rsd0 + sw1;
            float ss = a[0] * a[0] + a[1] * a[1] + a[2] * a[2] + a[3] * a[3] + b4[0] * b4[0] + b4[1] * b4[1] + b4[2] * b4[2] + b4[3] * b4[3];
            ss += shx(ss, 16, ln);
            ss += shx(ss, 32, ln);
            if (fq == 0) red[wc * 256 + ai * 128 + wr * 64 + mm * 16 + fr] = ss;
          }
        asm volatile("s_waitcnt lgkmcnt(0)" ::: "memory");
        __builtin_amdgcn_s_barrier();
        ROWS_BEGIN
          const int rt = ai * 128 + wr * 64 + mm * 16 + fr;
          const float rsv = rsqrtf((red[rt] + red[256 + rt] + red[512 + rt] + red[768 + rt]) * (1.f / 128.f) + 1e-6f);
          v0 = v0 * rsv * g0;
          v1 = v1 * rsv * g1;
          st8_bf16(p.ckvn() + ((size_t)l * 18432 + m) * 128 + c, fq, v0, v1);
          if (!lat) st8_f32(p.out + 20971520 + ((size_t)((b * 2 + l) * 256 + s)) * 128 + c, fq, v0, v1);
        ROWS_END
        asm volatile("s_waitcnt vmcnt(0) lgkmcnt(0)" ::: "memory");
        __builtin_amdgcn_s_barrier();
        if (wr == 0 && wc == 0 && ln == 0) {
          __builtin_amdgcn_fence(__ATOMIC_RELEASE, "agent");
          asm volatile("s_waitcnt vmcnt(0)" ::: "memory");
          __hip_atomic_fetch_add(p.ctl() + 64 * l, 1u, __ATOMIC_RELAXED, __HIP_MEMORY_SCOPE_AGENT);
        }
      } else {
        ROWS_BEGIN
          if (!lat) {
            st8_f32(p.out + 23068672 + ((size_t)((b * 2 + l) * 256 + s)) * 32, fq, v0, v1);
#pragma unroll
            for (int hh = 0; hh < 4; ++hh) st8_bf16(p.Kmla_c() + ((size_t)((b * 4 + hh) * 256 + s)) * 96 + 64, fq, v0, v1);
          } else {
            rope8_mla(v0, v1, fq, ln, (const float*)(smem + LDS_ROPEM) + (s >> 6) * 16, (const float*)(smem + LDS_ROPEM) + (s & 63) * 16);
#pragma unroll
            for (int hh = 0; hh < 4; ++hh) st8_bf16(p.Kmla_l() + ((size_t)(((l * 8 + b) * 4 + hh) * 1280 + s)) * 96 + 64, fq, v0, v1);
          }
        ROWS_END
      }
    };
    do_half(IC<0>{});
    do_half(IC<1>{});
#undef ROWS_BEGIN
#undef ROWS_END
  }
};

struct EpiOut8 {
  static constexpr bool PERM = true, AFTER_DRAIN = false;
  P p0; int l;
  __device__ __forceinline__ void operator()(const acc_t& acc, const Unit& u, int wr, int wc, int fr_in, int fq_in) const {
    int fr = fr_in; asm volatile("" : "+v"(fr));
    int fq = fq_in; asm volatile("" : "+v"(fq));
    const int ln = fq * 16 + fr; (void)ln;
    P p = p0; asm volatile("" : "+s"(p.ws), "+s"(p.out));
    const int rbase = u.pm * 256 + wr * 64 + fr;
    const int cb = u.pn * 256 + wc * 32 + 8 * fq;
    const float* md = p.mod() + ((size_t)(l * 9 + mod_row(u.pm * 256))) * 6144;
    const float* gate = md + 2 * 1024; const float* sc2 = md + 4 * 1024; const float* g2 = p.norm2 + l * DM;
#pragma unroll
    for (int ap = 0; ap < 4; ++ap) {
      constexpr int dummy = 0; (void)dummy;
      const int ai = ap >> 1, m2 = (ap & 1) * 2;
      int mb = rbase + ai * 128 + m2 * 16; asm volatile("" : "+v"(mb));
      f32x4 xv[2][2][2];
#pragma unroll
      for (int mq = 0; mq < 2; ++mq) {
        const int mm = m2 + mq;
        const int m = mb + mq * 16;
        if (l == 0) {
          const float* xr = m < NCTX ? p.x_prompt + (size_t)m * DM : p.x_sample + (size_t)(m - NCTX) * DM;
#pragma unroll
          for (int bj = 0; bj < 2; ++bj)
#pragma unroll
            for (int n = 0; n < 2; ++n) xv[mq][bj][n] = *(const f32x4*)(xr + cb + bj * 128 + n * 4);
        } else {
          const bf16_t* hr = p.hbuf() + (size_t)m * DM;
#pragma unroll
          for (int bj = 0; bj < 2; ++bj)
#pragma unroll
            for (int n = 0; n < 2; ++n) {
              const int c = cb + bj * 128 + n * 4;
              const uint2 hq = *(const uint2*)(hr + c);
              const f32x4 q1 = *(const f32x4*)(p.norm1 + DM + c) * (*(const f32x4*)(md + 1 * 1024 + c) + 1.f);
              f32x4 xm;
              xm[0] = __uint_as_float(hq.x << 16) * __builtin_amdgcn_rcpf(q1[0]); xm[1] = __uint_as_float(hq.x & 0xffff0000u) * __builtin_amdgcn_rcpf(q1[1]);
              xm[2] = __uint_as_float(hq.y << 16) * __builtin_amdgcn_rcpf(q1[2]); xm[3] = __uint_as_float(hq.y & 0xffff0000u) * __builtin_amdgcn_rcpf(q1[3]);
              xv[mq][bj][n] = xm;
            }
        }
      }
#pragma unroll
      for (int mq = 0; mq < 2; ++mq) {
        const int mm = m2 + mq;
        const int m = mb + mq * 16;
        bf16_t* ho = p.hbuf() + (size_t)m * DM;
        float ss = 0.f;
#pragma unroll
        for (int bj = 0; bj < 2; ++bj)
#pragma unroll
          for (int n = 0; n < 2; ++n) {
            const int c = cb + bj * 128 + n * 4;
            const f32x4 xn = xv[mq][bj][n] + *(const f32x4*)(gate + c) * acc[ai][bj][mm][n];
            const f32x4 hv = xn * (*(const f32x4*)(g2 + c) * (*(const f32x4*)(sc2 + c) + 1.f));
            *(uint2*)(ho + c) = make_uint2(pk2(hv[0], hv[1]), pk2(hv[2], hv[3]));
            ss += (xn[0] * xn[0] + xn[1] * xn[1]) + (xn[2] * xn[2] + xn[3] * xn[3]);
          }
        ss += shx(ss, 16, ln);
        ss += shx(ss, 32, ln);
        if (fq == 0) p.rssB()[(size_t)m * 16 + u.pn * 4 + wc] = ss;
      }
      asm volatile("" ::: "memory");
    }
  }
};
struct EpiUp8 {
  static constexpr bool PERM = true, AFTER_DRAIN = false;
  P p0; int l;
  __device__ __forceinline__ void operator()(const acc_t& acc, const Unit& u, int wr, int wc, int fr_in, int fq_in) const {
    int fr = fr_in; asm volatile("" : "+v"(fr));
    int fq = fq_in; asm volatile("" : "+v"(fq));
    const int ln = fq * 16 + fr; (void)ln;
    P p = p0; asm volatile("" : "+s"(p.ws), "+s"(p.out));
    const int rbase = u.pm * 256 + wr * 64 + fr;
    const int cb = u.pn * 256 + wc * 32 + 8 * fq;
    const float* swp = p.sWup() + ((size_t)(l * 9 + mod_row(u.pm * 256))) * DFF;
    float rsdv[2][4];
#pragma unroll
    for (int ai = 0; ai < 2; ++ai)
#pragma unroll
      for (int mm = 0; mm < 4; ++mm) rsdv[ai][mm] = row_rstd(p.rssB(), rbase + ai * 128 + mm * 16);
    f32x4 swv[2][2];
#pragma unroll
    for (int bj = 0; bj < 2; ++bj)
#pragma unroll
      for (int n = 0; n < 2; ++n) swv[bj][n] = *(const f32x4*)(swp + cb + bj * 128 + n * 4);
#pragma unroll
    for (int ai = 0; ai < 2; ++ai)
#pragma unroll
      for (int mm = 0; mm < 4; ++mm) {
        int m = rbase + ai * 128 + mm * 16; asm volatile("" : "+v"(m));
        bf16_t* uo = p.ubuf() + (size_t)m * DFF;
        const float rsd = rsdv[ai][mm];
#pragma unroll
        for (int bj = 0; bj < 2; ++bj) {
          f32x4 t0 = acc[ai][bj][mm][0] * rsd + swv[bj][0], t1 = acc[ai][bj][mm][1] * rsd + swv[bj][1];
#pragma unroll
          for (int j = 0; j < 4; ++j) { const float a = fmaxf(t0[j], 0.f), b = fmaxf(t1[j], 0.f); t0[j] = a * a; t1[j] = b * b; }
          *(uint4*)(uo + cb + bj * 128) = make_uint4(pk2(t0[0], t0[1]), pk2(t0[2], t0[3]), pk2(t1[0], t1[1]), pk2(t1[2], t1[3]));
        }
      }
  }
};
struct EpiDown8 {
  static constexpr bool PERM = true, AFTER_DRAIN = false;
  P p0; int l;
  __device__ __forceinline__ void operator()(const acc_t& acc, const Unit& u, int wr, int wc, int fr_in, int fq_in) const {
    int fr = fr_in; asm volatile("" : "+v"(fr));
    int fq = fq_in; asm volatile("" : "+v"(fq));
    const int ln = fq * 16 + fr; (void)ln;
    P p = p0; asm volatile("" : "+s"(p.ws), "+s"(p.out));
    const int rbase = u.pm * 256 + wr * 64 + fr;
    const int cb = u.pn * 256 + wc * 32 + 8 * fq;
    const int r = mod_row(u.pm * 256);
    const float* md = p.mod() + ((size_t)(l * 9 + r)) * 6144;
    const float* gate = md + 5 * 1024; const float* sc2 = md + 4 * 1024; const float* g2 = p.norm2 + l * DM;
    const float* sc1 = p.mod() + ((size_t)(9 + r)) * 6144 + 1 * 1024;
    const float* g1 = p.norm1 + DM;
    f32x4 riv[2][2];
#pragma unroll
    for (int bj = 0; bj < 2; ++bj)
#pragma unroll
      for (int n = 0; n < 2; ++n) {
        const int c = cb + bj * 128 + n * 4;
        const f32x4 q2 = *(const f32x4*)(g2 + c) * (*(const f32x4*)(sc2 + c) + 1.f);
#pragma unroll
        for (int j = 0; j < 4; ++j) riv[bj][n][j] = __builtin_amdgcn_rcpf(q2[j]);
      }
#pragma unroll
    for (int ap = 0; ap < 4; ++ap) {
      const int ai = ap >> 1, m2 = (ap & 1) * 2;
      int mb = rbase + ai * 128 + m2 * 16; asm volatile("" : "+v"(mb));
      uint2 hvv[2][2][2];
#pragma unroll
      for (int mq = 0; mq < 2; ++mq) {
        const bf16_t* hr = p.hbuf() + (size_t)(mb + mq * 16) * DM;
#pragma unroll
        for (int bj = 0; bj < 2; ++bj)
#pragma unroll
          for (int n = 0; n < 2; ++n) hvv[mq][bj][n] = *(const uint2*)(hr + cb + bj * 128 + n * 4);
      }
#pragma unroll
      for (int mq = 0; mq < 2; ++mq) {
        const int mm = m2 + mq;
        const int m = mb + mq * 16;
        float* xo = p.xw() + (size_t)m * DM;
        bf16_t* ho = p.hbuf() + (size_t)m * DM;
        float ss = 0.f;
#pragma unroll
        for (int bj = 0; bj < 2; ++bj)
#pragma unroll
          for (int n = 0; n < 2; ++n) {
            const int c = cb + bj * 128 + n * 4;
            const uint2 hq = hvv[mq][bj][n];
            f32x4 xm;
            xm[0] = __uint_as_float(hq.x << 16); xm[1] = __uint_as_float(hq.x & 0xffff0000u);
            xm[2] = __uint_as_float(hq.y << 16); xm[3] = __uint_as_float(hq.y & 0xffff0000u);
            const f32x4 xn = xm * riv[bj][n] + *(const f32x4*)(gate + c) * acc[ai][bj][mm][n];
            if (l != 0) *(f32x4*)(xo + c) = xn;
            if (l == 0) {
              const f32x4 hv = xn * (*(const f32x4*)(g1 + c) * (*(const f32x4*)(sc1 + c) + 1.f));
              *(uint2*)(ho + c) = make_uint2(pk2(hv[0], hv[1]), pk2(hv[2], hv[3]));
              ss += (xn[0] * xn[0] + xn[1] * xn[1]) + (xn[2] * xn[2] + xn[3] * xn[3]);
            }
          }
        if (l == 0) {
          ss += shx(ss, 16, ln);
          ss += shx(ss, 32, ln);
          if (fq == 0) p.rssA()[(size_t)m * 16 + u.pn * 4 + wc] = ss;
        }
      }
      asm volatile("" ::: "memory");
    }
  }
};

struct EpiKvb {
  P p; int l;
  __device__ __forceinline__ void operator()(int m, int nb, int h, const f32x16& v) const {
    const int hh = nb >> 7, j0 = nb & 127;
    bf16_t* Kb; bf16_t* Vb; int S, key;
    if (m < NCTX) {
      const int b = m >> 8; key = m & 255; S = 256;
      Kb = p.Kmla_c() + ((size_t)((b * 4 + hh) * 256)) * 96;
      Vb = p.Vtmla_c() + ((size_t)((b * 4 + hh) * 64)) * 256;
    } else {
      int b;
      if (m < NTOK) { b = (m - NCTX) >> 10; key = (m - NCTX) & 1023; }
      else { b = (m - NTOK) >> 8; key = 1024 + ((m - NTOK) & 255); }
      S = 1280;
      Kb = p.Kmla_l() + ((size_t)(((l * 8 + b) * 4 + hh) * 1280)) * 96;
      Vb = p.Vtmla_l() + ((size_t)(((l * 8 + b) * 4 + hh) * 64)) * 1280;
    }
    if (j0 < 64) st_rm_bf16(Kb + (size_t)key * 96 + j0, h, v);
    else st_tr_bf16(Vb + (size_t)(j0 - 64) * S + key, S, h, v);
  }
};

template <class Epi>
__device__ __forceinline__ void gemm_small(const bf16_t* __restrict__ A, int lda, const bf16_t* __restrict__ W, int ldw,
                                           int M, int N, int K, unsigned char* smem, const Epi& epi, const int wv, unsigned* ready, unsigned* ticket) {
  constexpr int TA = 256 * 72, TW = 128 * 72;
  bf16_t* sb = (bf16_t*)smem;
  const int tid = my_tid(wv), bid = my_bid(), lane = tid & 63, wave = tid >> 6;
  const int wm = wave >> 1, wn = wave & 1, r = lane & 31, h = lane >> 5;
  const int MT = M >> 8, NT = N >> 7, ntiles = MT * NT, nk = K >> 6;
  const int lc = tid & 7, lr = tid >> 3;
  (void)bid;
  if (tid == 0) {
    unsigned polls = 0;
    while (__hip_atomic_load(ready, __ATOMIC_RELAXED, __HIP_MEMORY_SCOPE_AGENT) < 64u && ++polls < (1u << 22)) __builtin_amdgcn_s_sleep(8);
    __builtin_amdgcn_fence(__ATOMIC_ACQUIRE, "agent");
    asm volatile("s_waitcnt vmcnt(0)" ::: "memory");
  }
  __syncthreads();
  volatile int* tks = (volatile int*)(smem + LDS_RED + 2048);
  for (;;) {
    __syncthreads();
    if (tid == 0) *tks = (int)__hip_atomic_fetch_add(ticket, 1u, __ATOMIC_RELAXED, __HIP_MEMORY_SCOPE_AGENT);
    __syncthreads();
    const int tile = *tks;
    if (tile >= ntiles) break;
    const int m0 = (tile % MT) << 8, n0 = (tile / MT) << 7;
    f32x16 acc[2][2];
#pragma unroll
    for (int a = 0; a < 2; ++a)
#pragma unroll
      for (int b = 0; b < 2; ++b)
#pragma unroll
        for (int i = 0; i < 16; ++i) acc[a][b][i] = 0.f;
    uint4 ra[4], rw[2];
    const bf16_t* Ap = A + (size_t)(m0 + lr) * lda + lc * 8;
    const bf16_t* Wp = W + (size_t)(n0 + lr) * ldw + lc * 8;
    auto gload = [&](int kt) {
#pragma unroll
      for (int i = 0; i < 4; ++i) ra[i] = *(const uint4*)(Ap + (size_t)(64 * i) * lda + kt * 64);
#pragma unroll
      for (int i = 0; i < 2; ++i) rw[i] = *(const uint4*)(Wp + (size_t)(64 * i) * ldw + kt * 64);
    };
    auto swrite = [&](int bsel) {
      bf16_t* sA = sb + bsel * (TA + TW); bf16_t* sW = sA + TA;
#pragma unroll
      for (int i = 0; i < 4; ++i) *(uint4*)(sA + (lr + 64 * i) * 72 + lc * 8) = ra[i];
#pragma unroll
      for (int i = 0; i < 2; ++i) *(uint4*)(sW + (lr + 64 * i) * 72 + lc * 8) = rw[i];
    };
    __syncthreads();
    gload(0); swrite(0);
    __syncthreads();
    for (int kt = 0; kt < nk; ++kt) {
      if (kt + 1 < nk) gload(kt + 1);
      const bf16_t* sA = sb + (kt & 1) * (TA + TW); const bf16_t* sW = sA + TA;
#pragma unroll
      for (int ks = 0; ks < 4; ++ks) {
        bf16x8 wf[2], af[2];
#pragma unroll
        for (int i = 0; i < 2; ++i) {
          wf[i] = *(const bf16x8*)(sW + (wn * 64 + i * 32 + r) * 72 + ks * 16 + h * 8);
          af[i] = *(const bf16x8*)(sA + (wm * 64 + i * 32 + r) * 72 + ks * 16 + h * 8);
        }
#pragma unroll
        for (int a = 0; a < 2; ++a)
#pragma unroll
          for (int b = 0; b < 2; ++b) acc[a][b] = __builtin_amdgcn_mfma_f32_32x32x16_bf16(wf[a], af[b], acc[a][b], 0, 0, 0);
      }
      if (kt + 1 < nk) swrite((kt + 1) & 1);
      __syncthreads();
    }
#pragma unroll
    for (int a = 0; a < 2; ++a)
#pragma unroll
      for (int b = 0; b < 2; ++b) epi(m0 + wm * 64 + b * 32 + r, n0 + wn * 64 + a * 32, h, acc[a][b]);
  }
}

struct AttnItem {
  const bf16_t* Q; int qs;
  const bf16_t* K; int ks;
  const bf16_t* Vt; int vs;
  int t0, t1, t2, t3;
  int qpos0, T;
  float scale, sink_l2; int has_sink;
  float lgf, lgb;
  const bf16_t *S0f, *S0b;
  const bf16_t* G; const float* gn;
  bf16_t* out;
  float* sout;
};

template <int DQK, int MODE>
__device__ __forceinline__ void attn_item(const AttnItem& it, unsigned char* smem, const int wv) {
  constexpr int KSTR = DQK + 8, NKS = DQK / 16, VSTR = 68, KCH = DQK / 8;
  bf16_t* Ks = (bf16_t*)smem;
  bf16_t* Vs = Ks + 64 * KSTR;
  const int tid = my_tid(wv), lane = tid & 63, wave = tid >> 6, r = lane & 31, h = lane >> 5;
  const int qrow = wave * 32 + r;
  bf16x8 qf[NKS];
  if constexpr (MODE == 3) {
    const int dq = (wave & 1) * 32 + r;
#pragma unroll
    for (int ks = 0; ks < NKS; ++ks) {
      const int e = dq - (ks * 16 + h * 8);
      uint4 v;
      v.x = e == 0 ? 0x3F80u : (e == 1 ? 0x3F800000u : 0u);
      v.y = e == 2 ? 0x3F80u : (e == 3 ? 0x3F800000u : 0u);
      v.z = e == 4 ? 0x3F80u : (e == 5 ? 0x3F800000u : 0u);
      v.w = e == 6 ? 0x3F80u : (e == 7 ? 0x3F800000u : 0u);
      qf[ks] = __builtin_bit_cast(bf16x8, v);
    }
  } else {
#pragma unroll
    for (int ks = 0; ks < NKS; ++ks) qf[ks] = *(const bf16x8*)(it.Q + (size_t)qrow * it.qs + ks * 16 + h * 8);
  }
  f32x16 o0, o1;
#pragma unroll
  for (int i = 0; i < 16; ++i) { o0[i] = 0.f; o1[i] = 0.f; }
  float mrun = it.has_sink ? it.sink_l2 : -1e30f, lrun = 0.f;
  const int qp = it.qpos0 + qrow;
  const int n1 = it.t1 - it.t0, ntl = n1 + (it.t3 - it.t2);
  constexpr int BUFE = 64 * KSTR + 64 * VSTR;
  const int krow0 = tid / KCH, kch0 = tid % KCH, krow1 = (tid + NTHR) / KCH, kch1 = (tid + NTHR) % KCH;
  const bool k2 = (KCH == 12) && (tid + NTHR < 64 * KCH);
  const int vrow = tid >> 3, vch = tid & 7;
  uint4 rk0, rk1, rv;
  auto tile_of = [&](int ti) { return ti < n1 ? it.t0 + ti : it.t2 + (ti - n1); };
  auto gload = [&](int t) {
    const bool stt = (MODE == 2) && (t >= 16);
    if (!stt) {
      const int key0 = t * 64;
      rk0 = *(const uint4*)(it.K + (size_t)(key0 + krow0) * it.ks + kch0 * 8);
      if (k2) rk1 = *(const uint4*)(it.K + (size_t)(key0 + krow1) * it.ks + kch1 * 8);
      rv = *(const uint4*)(it.Vt + (size_t)vrow * it.vs + key0 + vch * 8);
    } else {
      const bf16_t* S = (t == 16) ? it.S0f : it.S0b;
      const int e = krow0 - kch0 * 8;
      rk0.x = e == 0 ? 0x3F80u : (e == 1 ? 0x3F800000u : 0u);
      rk0.y = e == 2 ? 0x3F80u : (e == 3 ? 0x3F800000u : 0u);
      rk0.z = e == 4 ? 0x3F80u : (e == 5 ? 0x3F800000u : 0u);
      rk0.w = e == 6 ? 0x3F80u : (e == 7 ? 0x3F800000u : 0u);
      rv = *(const uint4*)(S + (size_t)vrow * 64 + vch * 8);
    }
  };
  auto swrite = [&](int bsel) {
    bf16_t* Kb = Ks + bsel * BUFE; bf16_t* Vb = Kb + 64 * KSTR;
    *(uint4*)(Kb + krow0 * KSTR + kch0 * 8) = rk0;
    if (k2) *(uint4*)(Kb + krow1 * KSTR + kch1 * 8) = rk1;
    uint2* d = (uint2*)(Vb + vrow * VSTR + vch * 8);
    d[0] = make_uint2(rv.x, rv.y); d[1] = make_uint2(rv.z, rv.w);
  };
  __syncthreads();
  gload(tile_of(0)); swrite(0);
  __syncthreads();
  for (int ti = 0; ti < ntl; ++ti) {
    const int t = tile_of(ti);
    const bool st_tile = (MODE == 2) && (t >= 16);
    const int key0 = t * 64;
    const bool more = ti + 1 < ntl;
    if (more) gload(tile_of(ti + 1));
    const bf16_t* Kc = Ks + (ti & 1) * BUFE; const bf16_t* Vc = Kc + 64 * KSTR;
    bool skip = (MODE == 3) && (wave >= 4);
    if (MODE == 1 && t < 16) {
      const int qlo = it.qpos0 + wave * 32;
      skip = (key0 > qlo + 31 + 128 || key0 + 63 < qlo - 128);
    }
    if (!skip) {
    f32x16 s0, s1;
#pragma unroll
    for (int i = 0; i < 16; ++i) { s0[i] = 0.f; s1[i] = 0.f; }
#pragma unroll
    for (int ks = 0; ks < NKS; ++ks) {
      const bf16x8 k0 = *(const bf16x8*)(Kc + r * KSTR + ks * 16 + h * 8);
      const bf16x8 k1 = *(const bf16x8*)(Kc + (32 + r) * KSTR + ks * 16 + h * 8);
      s0 = __builtin_amdgcn_mfma_f32_32x32x16_bf16(k0, qf[ks], s0, 0, 0, 0);
      s1 = __builtin_amdgcn_mfma_f32_32x32x16_bf16(k1, qf[ks], s1, 0, 0, 0);
    }
    if constexpr (MODE == 3) {
      if (wave < 2) {
        const float base = (float)(it.T - 1 - key0 - 4 * h) * it.lgf - 3.f;
#pragma unroll
        for (int i = 0; i < 16; ++i) {
          s0[i] *= fexp2(fmaf(-(float)((i & 3) + 8 * (i >> 2)), it.lgf, base));
          s1[i] *= fexp2(fmaf(-(float)(32 + (i & 3) + 8 * (i >> 2)), it.lgf, base));
        }
      } else {
        const float base = (float)(key0 + 4 * h) * it.lgb - 3.f;
#pragma unroll
        for (int i = 0; i < 16; ++i) {
          s0[i] *= fexp2(fmaf((float)((i & 3) + 8 * (i >> 2)), it.lgb, base));
          s1[i] *= fexp2(fmaf((float)(32 + (i & 3) + 8 * (i >> 2)), it.lgb, base));
        }
      }
    } else if constexpr (MODE == 2) {
      if (!st_tile) {
        const int qlo = it.qpos0 + wave * 32;
        if (key0 + 63 < qlo) {
          const float base = (float)(qp - key0 - 4 * h) * it.lgf - 3.f;
#pragma unroll
          for (int i = 0; i < 16; ++i) {
            s0[i] *= fexp2(fmaf(-(float)((i & 3) + 8 * (i >> 2)), it.lgf, base));
            s1[i] *= fexp2(fmaf(-(float)(32 + (i & 3) + 8 * (i >> 2)), it.lgf, base));
          }
        } else if (key0 > qlo + 31) {
          const float base = (float)(key0 + 4 * h - qp) * it.lgb - 3.f;
#pragma unroll
          for (int i = 0; i < 16; ++i) {
            s0[i] *= fexp2(fmaf((float)((i & 3) + 8 * (i >> 2)), it.lgb, base));
            s1[i] *= fexp2(fmaf((float)(32 + (i & 3) + 8 * (i >> 2)), it.lgb, base));
          }
        } else {
#pragma unroll
        for (int i = 0; i < 16; ++i) {
          const int key = key0 + (i & 3) + 8 * (i >> 2) + 4 * h;
          const int e0 = qp - key, e1 = e0 - 32;
          float d0 = fexp2((float)(e0 < 0 ? -e0 : e0) * (e0 > 0 ? it.lgf : it.lgb));
          float d1 = fexp2((float)(e1 < 0 ? -e1 : e1) * (e1 > 0 ? it.lgf : it.lgb));
          d0 = e0 == 0 ? 2.f : d0;
          d1 = e1 == 0 ? 2.f : d1;
          s0[i] *= it.scale * d0;
          s1[i] *= it.scale * d1;
        }
        }
      } else {
        const float dec = (t == 16) ? fexp2((float)(qp + 1) * it.lgf) : fexp2((float)(it.T - qp) * it.lgb);
#pragma unroll
        for (int i = 0; i < 16; ++i) { s0[i] *= dec; s1[i] *= dec; }
      }
    } else {
      float mx = -INFINITY;
      const int qlo1 = it.qpos0 + wave * 32;
      const bool need_mask = (MODE == 1) && (t < 16) && !(key0 >= qlo1 + 31 - 128 && key0 + 63 <= qlo1 + 128);
#pragma unroll
      for (int i = 0; i < 16; ++i) {
        float a = s0[i] * it.scale, b = s1[i] * it.scale;
        if (MODE == 1 && need_mask) {
          const int key = key0 + (i & 3) + 8 * (i >> 2) + 4 * h;
          const int e0 = key - qp, e1 = e0 + 32;
          if (e0 > 128 || e0 < -128) a = -INFINITY;
          if (e1 > 128 || e1 < -128) b = -INFINITY;
        }
        s0[i] = a; s1[i] = b;
        mx = fmaxf(mx, fmaxf(a, b));
      }
      mx = fmaxf(mx, shx(mx, 32, lane));
      const float mnew = fmaxf(mrun, mx);
      const float alpha = fexp2(mrun - mnew);
      float sum = 0.f;
#pragma unroll
      for (int i = 0; i < 16; ++i) {
        s0[i] = fexp2(s0[i] - mnew);
        s1[i] = fexp2(s1[i] - mnew);
        sum += s0[i] + s1[i];
      }
      lrun = lrun * alpha + sum;
      mrun = mnew;
#pragma unroll
      for (int i = 0; i < 16; ++i) { o0[i] *= alpha; o1[i] *= alpha; }
    }
#pragma unroll
    for (int kt = 0; kt < 2; ++kt) {
#pragma unroll
      for (int sbk = 0; sbk < 2; ++sbk) {
        uint4 pw;
        if (kt == 0) {
          pw.x = pk2(s0[8 * sbk + 0], s0[8 * sbk + 1]); pw.y = pk2(s0[8 * sbk + 2], s0[8 * sbk + 3]);
          pw.z = pk2(s0[8 * sbk + 4], s0[8 * sbk + 5]); pw.w = pk2(s0[8 * sbk + 6], s0[8 * sbk + 7]);
        } else {
          pw.x = pk2(s1[8 * sbk + 0], s1[8 * sbk + 1]); pw.y = pk2(s1[8 * sbk + 2], s1[8 * sbk + 3]);
          pw.z = pk2(s1[8 * sbk + 4], s1[8 * sbk + 5]); pw.w = pk2(s1[8 * sbk + 6], s1[8 * sbk + 7]);
        }
        const bf16x8 pf = __builtin_bit_cast(bf16x8, pw);
        const int koff = kt * 32 + sbk * 16 + 4 * h;
        const uint2 a0 = *(const uint2*)(Vc + r * VSTR + koff), a1 = *(const uint2*)(Vc + r * VSTR + koff + 8);
        const uint2 b0 = *(const uint2*)(Vc + (32 + r) * VSTR + koff), b1 = *(const uint2*)(Vc + (32 + r) * VSTR + koff + 8);
        const bf16x8 v0 = __builtin_bit_cast(bf16x8, make_uint4(a0.x, a0.y, a1.x, a1.y));
        const bf16x8 v1 = __builtin_bit_cast(bf16x8, make_uint4(b0.x, b0.y, b1.x, b1.y));
        o0 = __builtin_amdgcn_mfma_f32_32x32x16_bf16(v0, pf, o0, 0, 0, 0);
        o1 = __builtin_amdgcn_mfma_f32_32x32x16_bf16(v1, pf, o1, 0, 0, 0);
      }
    }
    }
    if (more) swrite((ti + 1) & 1);
    __syncthreads();
  }
  if constexpr (MODE == 3) {
    if (wave < 4) {
      float* rowp = it.sout + (size_t)(wave >> 1) * 16384 + (size_t)((wave & 1) * 32 + r) * 64;
#pragma unroll
      for (int g = 0; g < 4; ++g) {
        *(float4*)(rowp + 8 * g + 4 * h) = make_float4(o0[4 * g], o0[4 * g + 1], o0[4 * g + 2], o0[4 * g + 3]);
        *(float4*)(rowp + 32 + 8 * g + 4 * h) = make_float4(o1[4 * g], o1[4 * g + 1], o1[4 * g + 2], o1[4 * g + 3]);
      }
    }
    return;
  }
  bf16_t* orow = it.out + (size_t)qrow * DM;
  if constexpr (MODE == 2) {
    float sm = 0.f;
#pragma unroll
    for (int i = 0; i < 16; ++i) sm += o0[i] + o1[i];
    sm += shx(sm, 32, lane);
    const float mu = sm * (1.f / 64.f);
    float vr = 0.f;
#pragma unroll
    for (int i = 0; i < 16; ++i) { o0[i] -= mu; o1[i] -= mu; vr += o0[i] * o0[i] + o1[i] * o1[i]; }
    vr += shx(vr, 32, lane);
    const float rstd = rsqrtf(vr * (1.f / 64.f) + 1e-6f);
    const bf16_t* grow = it.G + (size_t)qrow * 256;
#pragma unroll
    for (int g = 0; g < 4; ++g) {
      const int d = 8 * g + 4 * h;
      const uint2 ga = *(const uint2*)(grow + d), gb = *(const uint2*)(grow + 32 + d);
      const float gav[4] = {__uint_as_float(ga.x << 16), __uint_as_float(ga.x & 0xffff0000u), __uint_as_float(ga.y << 16), __uint_as_float(ga.y & 0xffff0000u)};
      const float gbv[4] = {__uint_as_float(gb.x << 16), __uint_as_float(gb.x & 0xffff0000u), __uint_as_float(gb.y << 16), __uint_as_float(gb.y & 0xffff0000u)};
#pragma unroll
      for (int j = 0; j < 4; ++j) {
        const float x0 = gav[j], x1 = gbv[j];
        o0[4 * g + j] = o0[4 * g + j] * rstd * it.gn[d + j] * (x0 / (1.f + __expf(-x0)));
        o1[4 * g + j] = o1[4 * g + j] * rstd * it.gn[32 + d + j] * (x1 / (1.f + __expf(-x1)));
      }
    }
  } else {
    float lt = lrun + shx(lrun, 32, lane);
    if (it.has_sink) lt += fexp2(it.sink_l2 - mrun);
    const float inv = 1.f / lt;
#pragma unroll
    for (int i = 0; i < 16; ++i) { o0[i] *= inv; o1[i] *= inv; }
  }
  st_rm_bf16(orow, h, o0);
  st_rm_bf16(orow + 32, h, o1);
}

__device__ __forceinline__ float log2_sigmoid(float x) { return -log1pf(expf(-x)) * LOG2E; }

__device__ __forceinline__ void state_item(const P& p, int l, int idx, unsigned char* smem, const int wv) {
  const int b = idx >> 3, hh = (idx >> 1) & 3, dir = idx & 1;
  float* Ksm = (float*)smem;
  float* Vsm = Ksm + 4096;
  const int tid = my_tid(wv);
  const float lg = log2_sigmoid(p.ret_decay[(l * 2 + dir) * 4 + hh]);
  float acc[8];
#pragma unroll
  for (int i = 0; i < 8; ++i) acc[i] = 0.f;
  const int d = tid >> 3, e0 = (tid & 7) * 8;
  for (int c = 0; c < 4; ++c) {
    __syncthreads();
    for (int i = tid; i < 4096; i += NTHR) {
      const int j = i >> 6, dd = i & 63, tok = c * 64 + j;
      const float dec = dir == 0 ? fexp2((float)(255 - tok) * lg) : fexp2((float)tok * lg);
      Ksm[j * 64 + dd] = bf2f(p.Kret()[(size_t)(b * 256 + tok) * 256 + hh * 64 + dd]) * 0.125f * dec;
      const int e = i >> 6, jj = i & 63;
      Vsm[e * 65 + jj] = bf2f(p.Vtret_c()[((size_t)((b * 4 + hh) * 64 + e)) * 256 + c * 64 + jj]);
    }
    __syncthreads();
    for (int j = 0; j < 64; ++j) {
      const float kd = Ksm[j * 64 + d];
#pragma unroll
      for (int i = 0; i < 8; ++i) acc[i] += kd * Vsm[(e0 + i) * 65 + j];
    }
  }
  float* op = p.out + 23592960 + ((size_t)((((b * 2 + l) * 2 + dir) * 4 + hh) * 64 + d)) * 64 + e0;
  *(float4*)(op) = make_float4(acc[0], acc[1], acc[2], acc[3]);
  *(float4*)(op + 4) = make_float4(acc[4], acc[5], acc[6], acc[7]);
}

__device__ __forceinline__ void attn_phase(const P& p, int l, unsigned char* smem, const int wv) {
  constexpr int NA = 128, NB = 128, NC = 256, ND = 256, NE = 128, NF = 128, NG = 128;
  constexpr int TOT = NA + NB + NC + ND + NE + NF + NG;
  unsigned* ticket = p.ctl() + 32 + 64 * l;
  volatile int* tks = (volatile int*)(smem + LDS_RED + 2048);
  const int tid0 = my_tid(wv);
  for (;;) {
    __syncthreads();
    if (tid0 == 0) *tks = (int)__hip_atomic_fetch_add(ticket, 1u, __ATOMIC_RELAXED, __HIP_MEMORY_SCOPE_AGENT);
    __syncthreads();
    const int item = *tks;
    if (item >= TOT) break;
    int idx = item;
    AttnItem it;
    it.t2 = 0; it.t3 = 0; it.qpos0 = 0; it.T = 0; it.sink_l2 = 0.f; it.has_sink = 0; it.lgf = 0.f; it.lgb = 0.f;
    it.S0f = nullptr; it.S0b = nullptr; it.G = nullptr; it.gn = nullptr; it.sout = nullptr;
    if (idx < NA) {
      const int b = idx >> 4, hh = (idx >> 2) & 3, qb = idx & 3, row0 = NCTX + b * 1024 + qb * 256;
      it.Q = p.Qmla() + (size_t)row0 * 384 + hh * 96; it.qs = 384;
      it.K = p.Kmla_l() + ((size_t)(((l * 8 + b) * 4 + hh) * 1280)) * 96; it.ks = 96;
      it.Vt = p.Vtmla_l() + ((size_t)(((l * 8 + b) * 4 + hh) * 64)) * 1280; it.vs = 1280;
      it.t0 = 0; it.t1 = 20;
      it.scale = 0.10206207261596575f * LOG2E;
      it.out = p.mix() + (size_t)row0 * DM + 768 + hh * 64;
      attn_item<96, 0>(it, smem, wv);
      continue;
    }
    idx -= NA;
    if (idx < NB) {
      const int b = idx >> 4, hh = (idx >> 2) & 3, qb = idx & 3, row0 = NCTX + b * 1024 + qb * 256;
      it.Q = p.Qret() + (size_t)row0 * 256 + hh * 64; it.qs = 256;
      it.K = p.Kret() + (size_t)(NCTX + b * 1024) * 256 + hh * 64; it.ks = 256;
      it.Vt = p.Vtret_l() + ((size_t)((b * 4 + hh) * 64)) * 1024; it.vs = 1024;
      it.t0 = 0; it.t1 = 16; it.t2 = 16; it.t3 = 18;
      it.qpos0 = qb * 256; it.T = 1024; it.scale = 0.125f;
      it.lgf = log2_sigmoid(p.ret_decay[(l * 2 + 0) * 4 + hh]);
      it.lgb = log2_sigmoid(p.ret_decay[(l * 2 + 1) * 4 + hh]);
      it.S0f = p.S0t() + ((size_t)((((l * 8 + b) * 2 + 0) * 4 + hh))) * 4096;
      it.S0b = p.S0t() + ((size_t)((((l * 8 + b) * 2 + 1) * 4 + hh))) * 4096;
      it.G = p.Gret() + (size_t)row0 * 256 + hh * 64; it.gn = p.ret_gn + l * 256 + hh * 64;
      it.out = p.mix() + (size_t)row0 * DM + 512 + hh * 64;
      attn_item<64, 2>(it, smem, wv);
      continue;
    }
    idx -= NB;
    if (idx < NC) {
      const int b = idx >> 5, head = (idx >> 2) & 7, qb = idx & 3, kv = head >> 2, row0 = NCTX + b * 1024 + qb * 256;
      it.Q = p.Qwin() + (size_t)row0 * 512 + head * 64; it.qs = 512;
      it.K = p.Kwin_l() + ((size_t)((l * 8 + b) * 1280)) * 128 + kv * 64; it.ks = 128;
      it.Vt = p.Vtwin_l() + ((size_t)(((l * 8 + b) * 2 + kv) * 64)) * 1280; it.vs = 1280;
      it.t0 = max(0, qb * 4 - 2); it.t1 = min(16, qb * 4 + 6); it.t2 = 16; it.t3 = 20;
      it.qpos0 = qb * 256;
      it.scale = 0.125f * LOG2E; it.sink_l2 = p.win_sink[l * 8 + head] * LOG2E; it.has_sink = 1;
      it.out = p.mix() + (size_t)row0 * DM + head * 64;
      attn_item<64, 1>(it, smem, wv);
      continue;
    }
    idx -= NC;
    if (idx < ND) {
      const int b = idx >> 3, head = idx & 7, kv = head >> 2, row0 = b * 256;
      it.Q = p.Qwin() + (size_t)row0 * 512 + head * 64; it.qs = 512;
      it.K = p.Kwin_c() + (size_t)(b * 256) * 128 + kv * 64; it.ks = 128;
      it.Vt = p.Vtwin_c() + ((size_t)((b * 2 + kv) * 64)) * 256; it.vs = 256;
      it.t0 = 0; it.t1 = 4;
      it.scale = 0.125f * LOG2E; it.sink_l2 = p.win_sink[l * 8 + head] * LOG2E; it.has_sink = 1;
      it.out = p.mix() + (size_t)row0 * DM + head * 64;
      attn_item<64, 0>(it, smem, wv);
      continue;
    }
    idx -= ND;
    if (idx < NE) {
      const int b = idx >> 2, hh = idx & 3, row0 = b * 256;
      it.Q = p.Qmla() + (size_t)row0 * 384 + hh * 96; it.qs = 384;
      it.K = p.Kmla_c() + ((size_t)((b * 4 + hh) * 256)) * 96; it.ks = 96;
      it.Vt = p.Vtmla_c() + ((size_t)((b * 4 + hh) * 64)) * 256; it.vs = 256;
      it.t0 = 0; it.t1 = 4;
      it.scale = 0.10206207261596575f * LOG2E;
      it.out = p.mix() + (size_t)row0 * DM + 768 + hh * 64;
      attn_item<96, 0>(it, smem, wv);
      continue;
    }
    idx -= NE;
    if (idx < NF) {
      const int b = idx >> 2, hh = idx & 3, row0 = b * 256;
      it.Q = p.Qret() + (size_t)row0 * 256 + hh * 64; it.qs = 256;
      it.K = p.Kret() + (size_t)(b * 256) * 256 + hh * 64; it.ks = 256;
      it.Vt = p.Vtret_c() + ((size_t)((b * 4 + hh) * 64)) * 256; it.vs = 256;
      it.t0 = 0; it.t1 = 4;
      it.qpos0 = 0; it.T = 256; it.scale = 0.125f;
      it.lgf = log2_sigmoid(p.ret_decay[(l * 2 + 0) * 4 + hh]);
      it.lgb = log2_sigmoid(p.ret_decay[(l * 2 + 1) * 4 + hh]);
      it.G = p.Gret() + (size_t)row0 * 256 + hh * 64; it.gn = p.ret_gn + l * 256 + hh * 64;
      it.out = p.mix() + (size_t)row0 * DM + 512 + hh * 64;
      attn_item<64, 2>(it, smem, wv);
      continue;
    }
    idx -= NF;
    {
      const int b = idx >> 2, hh = idx & 3;
      it.Q = nullptr; it.qs = 0;
      it.K = p.Kret() + (size_t)(b * 256) * 256 + hh * 64; it.ks = 256;
      it.Vt = p.Vtret_c() + ((size_t)((b * 4 + hh) * 64)) * 256; it.vs = 256;
      it.t0 = 0; it.t1 = 4;
      it.T = 256; it.scale = 0.125f;
      it.lgf = log2_sigmoid(p.ret_decay[(l * 2 + 0) * 4 + hh]);
      it.lgb = log2_sigmoid(p.ret_decay[(l * 2 + 1) * 4 + hh]);
      it.out = nullptr;
      it.sout = p.out + 23592960 + ((size_t)((b * 2 + l) * 2 * 4 + hh)) * 4096;
      attn_item<64, 3>(it, smem, wv);
    }
  }
}

__device__ __forceinline__ void norm0_phase(const P& p, unsigned char* smem, const int wv) {
  const int tid = my_tid(wv), lane = tid & 63, gw = my_bid() * NWV + (tid >> 6), ngw = gridDim.x * NWV;
  const float* gain = p.norm1;
  for (int m0 = gw; m0 < NTOK; m0 += 2 * ngw) {
    float4 v[2][4];
    float ss[2] = {0.f, 0.f};
#pragma unroll
    for (int q = 0; q < 2; ++q) {
      const int m = m0 + q * ngw;
      const float* xr = m < NCTX ? p.x_prompt + (size_t)m * DM : p.x_sample + (size_t)(m - NCTX) * DM;
#pragma unroll
      for (int j = 0; j < 4; ++j) v[q][j] = ((const float4*)xr)[lane + 64 * j];
    }
#pragma unroll
    for (int q = 0; q < 2; ++q) {
#pragma unroll
      for (int j = 0; j < 4; ++j) ss[q] += v[q][j].x * v[q][j].x + v[q][j].y * v[q][j].y + v[q][j].z * v[q][j].z + v[q][j].w * v[q][j].w;
      ss[q] = wave_sum(ss[q], lane);
    }
#pragma unroll
    for (int q = 0; q < 2; ++q) {
      const int m = m0 + q * ngw;
      const float* scale = p.mod() + ((size_t)mod_row(m)) * 6144 + 1 * 1024;
#pragma unroll
      for (int j = 0; j < 4; ++j) {
        const int c = (lane + 64 * j) * 4;
        const float4 g = *(const float4*)(gain + c), sc = *(const float4*)(scale + c);
        uint2 u;
        u.x = pk2(v[q][j].x * g.x * (1.f + sc.x), v[q][j].y * g.y * (1.f + sc.y));
        u.y = pk2(v[q][j].z * g.z * (1.f + sc.z), v[q][j].w * g.w * (1.f + sc.w));
        *(uint2*)(p.hbuf() + (size_t)m * DM + c) = u;
      }
      if (lane < 16) p.rssA()[(size_t)m * 16 + lane] = lane == 0 ? ss[q] : 0.f;
    }
  }
  float* sc = (float*)smem;
  float* red = sc + 9216;
  constexpr int G_IN = DIN / 32, G_UP = DFF / 32, NIT = 2 * G_IN + 2 * G_UP;
  for (int item = my_bid(); item < NIT; item += gridDim.x) {
    int l, grp; const float* W; int N; float* outp; int ldo; int which;
    if (item < 2 * G_IN) { l = item / G_IN; grp = item % G_IN; W = p.w_in + (size_t)l * DM * DIN; N = DIN; outp = p.sWin() + (size_t)l * 9 * DINP; ldo = DINP; which = 0; }
    else { const int i2 = item - 2 * G_IN; l = i2 / G_UP; grp = i2 % G_UP; W = p.w_up + (size_t)l * DM * DFF; N = DFF; outp = p.sWup() + (size_t)l * 9 * DFF; ldo = DFF; which = 3; }
    __syncthreads();
    for (int i = tid; i < 9216; i += NTHR) sc[i] = p.mod()[((size_t)(l * 9 + (i >> 10))) * 6144 + which * 1024 + (i & 1023)];
    __syncthreads();
    const int n0 = grp * 32, j = tid & 31, kq = tid >> 5;
    float acc[9];
#pragma unroll
    for (int r = 0; r < 9; ++r) acc[r] = 0.f;
    const float* w = W + (size_t)(kq * 64) * N + n0 + j;
    const float* s = sc + kq * 64;
#pragma unroll 8
    for (int kk = 0; kk < 64; ++kk) {
      const float wv2 = w[(size_t)kk * N];
#pragma unroll
      for (int r = 0; r < 9; ++r) acc[r] += s[r * 1024 + kk] * wv2;
    }
#pragma unroll
    for (int r = 0; r < 9; ++r) red[(kq * 9 + r) * 32 + j] = acc[r];
    __syncthreads();
    for (int oo = tid; oo < 288; oo += NTHR) {
      const int r = oo >> 5, jj = oo & 31;
      float sum = 0.f;
#pragma unroll
      for (int q = 0; q < 16; ++q) sum += red[(q * 9 + r) * 32 + jj];
      outp[(size_t)r * ldo + n0 + jj] = sum;
    }
  }
}
__device__ __forceinline__ void final_norm_phase(const P& p, const int wv) {
  const int tid = my_tid(wv), lane = tid & 63, gw = my_bid() * NWV + (tid >> 6), ngw = gridDim.x * NWV;
  for (int m = gw; m < NTOK; m += ngw) {
    const float* xr = p.xw() + (size_t)m * DM;
    float4 v[4];
    float ss = 0.f;
#pragma unroll
    for (int j = 0; j < 4; ++j) {
      v[j] = ((const float4*)xr)[lane + 64 * j];
      ss += v[j].x * v[j].x + v[j].y * v[j].y + v[j].z * v[j].z + v[j].w * v[j].w;
    }
    ss = wave_sum(ss, lane);
    const float rstd = rsqrtf(ss * (1.f / 1024.f) + 1e-6f);
#pragma unroll
    for (int j = 0; j < 4; ++j) {
      const int c = (lane + 64 * j) * 4;
      const float4 g = *(const float4*)(p.final_norm + c);
      *(float4*)(p.out + (size_t)m * DM + c) = make_float4(v[j].x * rstd * g.x, v[j].y * rstd * g.y, v[j].z * rstd * g.z, v[j].w * rstd * g.w);
    }
  }
}

__device__ __forceinline__ void transpose_tile(const float* __restrict__ W, int K, int N, bf16_t* __restrict__ WT, int item, float* tile, const int tid) {
  const int ntn = (N + 63) >> 6, kt = item / ntn, nt = item % ntn, k0 = kt * 64, n0 = nt * 64;
  const int n4 = (tid & 15) * 4, kr = tid >> 4;
#pragma unroll
  for (int q = 0; q < 2; ++q) {
    const int k = q * 32 + kr;
    float4 v = make_float4(0.f, 0.f, 0.f, 0.f);
    if (n0 + n4 < N) v = *(const float4*)(W + (size_t)(k0 + k) * N + n0 + n4);
    float* t = tile + k * 65 + n4;
    t[0] = v.x; t[1] = v.y; t[2] = v.z; t[3] = v.w;
  }
  __syncthreads();
  {
    const int n = tid >> 3, kc = (tid & 7) * 8;
    const float* t = tile + kc * 65 + n;
    uint4 o;
    o.x = pk2(t[0 * 65], t[1 * 65]); o.y = pk2(t[2 * 65], t[3 * 65]); o.z = pk2(t[4 * 65], t[5 * 65]); o.w = pk2(t[6 * 65], t[7 * 65]);
    if (n0 + n < N) *(uint4*)(WT + (size_t)(n0 + n) * K + k0 + kc) = o;
  }
  __syncthreads();
}

__device__ __forceinline__ void prep_phase(const P& p, unsigned char* smem, const int wv) {
  const int tid = my_tid(wv);
  {
    float* sc = (float*)smem;
    float* red = sc + 9216;
    for (int i = tid; i < 9216; i += NTHR) {
      const int r = i >> 10, k = i & 1023;
      const float x = r == 0 ? p.c_ctx[k] : p.c[(r - 1) * 1024 + k];
      sc[i] = x / (1.f + expf(-x));
    }
    __syncthreads();
    for (int item = blockIdx.x; item < 384; item += gridDim.x) {
      const int l = item / 192, n0 = (item % 192) * 32, j = tid & 31, kq = tid >> 5;
      float acc[9];
#pragma unroll
      for (int r = 0; r < 9; ++r) acc[r] = 0.f;
      const float* w = p.w_mod + ((size_t)l * 1024 + kq * 64) * 6144 + n0 + j;
      const float* s = sc + kq * 64;
#pragma unroll 8
      for (int kk = 0; kk < 64; ++kk) {
        const float wv = w[(size_t)kk * 6144];
#pragma unroll
        for (int r = 0; r < 9; ++r) acc[r] += s[r * 1024 + kk] * wv;
      }
#pragma unroll
      for (int r = 0; r < 9; ++r) red[(kq * 9 + r) * 32 + j] = acc[r];
      __syncthreads();
      for (int oo = tid; oo < 288; oo += NTHR) {
        const int r = oo >> 5, jj = oo & 31;
        float sum = 0.f;
#pragma unroll
        for (int q = 0; q < 16; ++q) sum += red[(q * 9 + r) * 32 + jj];
        p.mod()[((size_t)(l * 9 + r)) * 6144 + n0 + jj] = sum + p.b_mod[l * 6144 + n0 + jj];
      }
      __syncthreads();
    }
  }
  __syncthreads();
  {
    float* tile = (float*)smem;
    constexpr int I_IN = 16 * 37, I_OUT = 16 * 16, I_UP = 16 * 64, I_DN = 64 * 16, I_KV = 2 * 8;
    constexpr int PER = I_IN + I_OUT + I_UP + I_DN + I_KV;
    for (int item = blockIdx.x; item < 2 * PER; item += gridDim.x) {
      const int l = item / PER;
      int r = item % PER;
      if (r < I_IN) { transpose_tile(p.w_in + (size_t)l * DM * DIN, DM, DIN, p.WinT() + (size_t)l * DINP * DM, r, tile, tid); continue; }
      r -= I_IN;
      if (r < I_OUT) { transpose_tile(p.w_out + (size_t)l * DM * DM, DM, DM, p.WoutT() + (size_t)l * DM * DM, r, tile, tid); continue; }
      r -= I_OUT;
      if (r < I_UP) { transpose_tile(p.w_up + (size_t)l * DM * DFF, DM, DFF, p.WupT() + (size_t)l * DFF * DM, r, tile, tid); continue; }
      r -= I_UP;
      if (r < I_DN) { transpose_tile(p.w_down + (size_t)l * DFF * DM, DFF, DM, p.WdownT() + (size_t)l * DM * DFF, r, tile, tid); continue; }
      r -= I_DN;
      transpose_tile(p.w_kv_b + (size_t)l * 128 * 512, 128, 512, p.WkvbT() + (size_t)l * 512 * 128, r, tile, tid);
    }
  }
  const int gt = blockIdx.x * NTHR + tid, gs = gridDim.x * NTHR;
  if (gt < 256) p.ctl()[gt] = 0u;
  for (int i = gt; i < 64 * 16; i += gs) {
    const int pos = i >> 4, f = i & 15;
    const float ang = (float)pos * exp2f(-(float)f * (L2_10000 / 16.f));
    p.ropeW()[pos * 32 + f] = __cosf(ang);
    p.ropeW()[pos * 32 + 16 + f] = __sinf(ang);
  }
  for (int i = gt; i < 64 * 8; i += gs) {
    const int pos = i >> 3, f = i & 7;
    const float ang = (float)pos * exp2f(-(float)f * (L2_10000 / 8.f));
    p.ropeM()[pos * 16 + f] = __cosf(ang);
    p.ropeM()[pos * 16 + 8 + f] = __sinf(ang);
  }
  for (int i = gt; i < 2 * (DINP - DIN) * DM / 8; i += gs) {
    const int l = i / ((DINP - DIN) * DM / 8), o = i % ((DINP - DIN) * DM / 8);
    *(uint4*)(p.WinT() + ((size_t)l * DINP + DIN) * DM + (size_t)o * 8) = make_uint4(0, 0, 0, 0);
  }
  for (int i = gt; i < 524288; i += gs) {
    const int d = i & 63, kv = (i >> 6) & 1, s = (i >> 7) & 255, l = (i >> 15) & 1, b = i >> 16;
    p.Kwin_l()[((size_t)((l * 8 + b) * 1280 + 1024 + s)) * 128 + kv * 64 + d] = f2bf(p.cache_win_k[i]);
    p.Vtwin_l()[((size_t)(((l * 8 + b) * 2 + kv) * 64 + d)) * 1280 + 1024 + s] = f2bf(p.cache_win_v[i]);
  }
  for (int i = gt; i < 524288; i += gs) {
    const int j = i & 127, s = (i >> 7) & 255, l = (i >> 15) & 1, b = i >> 16;
    p.ckvn()[((size_t)l * 18432 + 16384 + b * 256 + s) * 128 + j] = f2bf(p.cache_mla_ckv[i]);
  }
  for (int i = gt; i < 131072; i += gs) {
    const int j = i & 31, s = (i >> 5) & 255, l = (i >> 13) & 1, b = i >> 14;
    const bf16_t v = f2bf(p.cache_mla_krope[i]);
#pragma unroll
    for (int hh = 0; hh < 4; ++hh) p.Kmla_l()[((size_t)(((l * 8 + b) * 4 + hh) * 1280 + 1024 + s)) * 96 + 64 + j] = v;
  }
  for (int i = gt; i < 524288; i += gs) {
    const int e = i & 63, d = (i >> 6) & 63, hh = (i >> 12) & 3, dir = (i >> 14) & 1, l = (i >> 15) & 1, b = i >> 16;
    p.S0t()[((size_t)((((l * 8 + b) * 2 + dir) * 4 + hh) * 64 + e)) * 64 + d] = f2bf(p.state_ret[i]);
  }
}

struct RotOrder : pg8::StaticOrder {
  int rot;
  __device__ __forceinline__ bool next(int i, Unit& u) const {
    if (!pg8::StaticOrder::next(i, u)) return false;
    u.pn += rot; if (u.pn >= nN) u.pn -= nN;
    return true;
  }
};
template <class Epi>
__device__ __forceinline__ void big_gemm(unsigned char* smem, const bf16_t* A, const bf16_t* Bt, int N, int K, const Epi& E, const int wv, int rot = 0) {
  pg8::Gemm g{A, Bt, NTOK, N, K};
  RotOrder S;
  S.init(NTOK, N, (int)gridDim.x, my_bid());
  S.rot = rot;
  pg8::gemm_phase<Epi, RotOrder, true, true>((PG8_LAS unsigned char*)smem, g, S, E, wv);
}

#define GSYNC() grid.sync()
__global__ void __launch_bounds__(NTHR, 2) hybrid_fwd(P p_arg) {
  cg::grid_group grid = cg::this_grid();
  const kargp_t kp = (kargp_t)__builtin_amdgcn_kernarg_segment_ptr();
  const int wv = __builtin_amdgcn_readfirstlane((int)threadIdx.x >> 6);
  { const P p = load_params(kp); prep_phase(p, smem, wv); }
  GSYNC();
  { const P p = load_params(kp); norm0_phase(p, smem, wv); }
  GSYNC();
#pragma unroll
  for (int l = 0; l < 2; ++l) {
    { const P pc = load_params(kp); const int t0 = my_tid(wv);
      for (int i = t0; i < 64 * 32; i += NTHR) ((float*)(smem + LDS_ROPEW))[i] = pc.ropeW()[i];
      for (int i = t0; i < 64 * 16; i += NTHR) ((float*)(smem + LDS_ROPEM))[i] = pc.ropeM()[i];
      __syncthreads(); }
    { const P p = load_params(kp);
      big_gemm(smem, p.hbuf(), p.WinT() + (size_t)l * DINP * DM, DINP, DM, EpiIn8{p, l, kp}, wv, 8); }
    { const P p = load_params(kp); gemm_small(p.ckvn() + (size_t)l * 18432 * 128, 128, p.WkvbT() + (size_t)l * 512 * 128, 128, 18432, 512, 128, smem, EpiKvb{p, l}, wv, p.ctl() + 64 * l, p.ctl() + 128 + 64 * l); }
    GSYNC();
    { const P p = load_params(kp); attn_phase(p, l, smem, wv); }
    GSYNC();
    { const P p = load_params(kp); big_gemm(smem, p.mix(), p.WoutT() + (size_t)l * DM * DM, DM, DM, EpiOut8{p, l}, wv); }
    GSYNC();
    { const P p = load_params(kp); big_gemm(smem, p.hbuf(), p.WupT() + (size_t)l * DFF * DM, DFF, DM, EpiUp8{p, l}, wv); }
    GSYNC();
    { const P p = load_params(kp); big_gemm(smem, p.ubuf(), p.WdownT() + (size_t)l * DM * DFF, DM, DFF, EpiDown8{p, l}, wv); }
    GSYNC();
  }
  { const P p = load_params(kp); final_norm_phase(p, wv); }
}

extern "C" void kernel_launch(void* const* d_in, const int* in_sizes, int n_in, void* d_out, int out_size, void* d_ws, size_t ws_size,
                              hipStream_t stream) {
  static int grid_blocks = 0;
  if (grid_blocks == 0) {
    int dev = 0, cus = 0, per_cu = 0;
    (void)hipGetDevice(&dev);
    (void)hipDeviceGetAttribute(&cus, hipDeviceAttributeMultiprocessorCount, dev);
    (void)hipFuncSetAttribute((const void*)hybrid_fwd, hipFuncAttributeMaxDynamicSharedMemorySize, LDS_BYTES);
    (void)hipOccupancyMaxActiveBlocksPerMultiprocessor(&per_cu, (const void*)hybrid_fwd, NTHR, LDS_BYTES);
    if (per_cu < 1) { fprintf(stderr, "occupancy query returned %d\n", per_cu); per_cu = 1; }
    per_cu = 1;
    grid_blocks = cus * per_cu;
  }
  P p{};
  const float* const* in = (const float* const*)d_in;
  p.x_prompt = in[0]; p.x_sample = in[1]; p.cache_win_k = in[2]; p.cache_win_v = in[3]; p.cache_mla_ckv = in[4];
  p.cache_mla_krope = in[5]; p.state_ret = in[6]; p.c = in[7]; p.c_ctx = in[8]; p.w_mod = in[9]; p.b_mod = in[10];
  p.norm1 = in[11]; p.norm2 = in[12]; p.w_in = in[13]; p.win_sink = in[14]; p.ret_decay = in[15]; p.ret_gn = in[16];
  p.mla_kv_norm = in[17]; p.w_kv_b = in[18]; p.w_out = in[19]; p.w_up = in[20]; p.w_down = in[21]; p.final_norm = in[22];
  p.out = (float*)d_out;
  p.ws = (unsigned char*)d_ws;
  if (WS_END > ws_size) { fprintf(stderr, "kernel_launch: workspace too small: need %zu, have %zu\n", (size_t)WS_END, ws_size); return; }
  void* args[] = {&p};
  hipError_t e = hipLaunchCooperativeKernel((const void*)hybrid_fwd, dim3(grid_blocks), dim3(NTHR), args, LDS_BYTES, stream);
  if (e != hipSuccess) fprintf(stderr, "cooperative launch failed: %s (grid %d)\n", hipGetErrorString(e), grid_blocks);
}
```

```cpp
#include <hip/hip_runtime.h>
#include <hip/hip_cooperative_groups.h>
#include <cstdio>
#include <cstdint>
namespace cg = cooperative_groups;

__device__ __forceinline__ int lane_id() { return (int)__builtin_amdgcn_mbcnt_hi(~0u, __builtin_amdgcn_mbcnt_lo(~0u, 0u)); }

namespace pg8 {
#define PG8_LAS __attribute__((address_space(3)))
typedef unsigned short bf16_t;
typedef short bf16x8 __attribute__((ext_vector_type(8)));
typedef float f32x4 __attribute__((ext_vector_type(4)));
typedef unsigned u32x4 __attribute__((ext_vector_type(4)));
constexpr int BM = 256, BK = 64, HALF = 128, HTB = HALF * BK * 2  , STAGE_BYTES = 8 * HTB, NXCD = 8, WGM = 8;

__host__ __device__ __forceinline__ int lds_byte(int r, int c) { const int st = (r >> 4) * 2 + (c >> 5), rr = r & 15, cc = c & 31, ob = rr * 64 + cc * 2; return st * 1024 + (ob ^ (((ob >> 9) & 1) << 5)); }
__host__ __device__ __forceinline__ void stage_rc(int b, int& R, int& C) { const int st = b / 1024, sb = b % 1024, swz = sb ^ (((sb >> 9) & 1) << 5); R = (st >> 1) * 16 + swz / 64; C = (st & 1) * 32 + (swz % 64) / 2; }
__host__ __device__ __forceinline__ int perm32(int rho) { const int n = rho >> 4, i = rho & 15; return 8 * (i >> 2) + 4 * n + (i & 3); }

struct Unit { int pm, pn; };
struct Gemm { const bf16_t* A; const bf16_t* Bt; int M, N, K; };

struct StaticOrder {
    int nM, nN, nwg, G, c;
    __host__ __device__ void init(int M, int N, int G_, int c_) { nM = M / BM; nN = N / BM; nwg = nM * nN; G = G_; c = c_; }
    __host__ __device__ bool next(int i, Unit& u) const {
        const long L = (long)i * G + c; if (L >= nwg) return false;
        int wgid = (int)L; { const int q = nwg / NXCD, r = nwg % NXCD, xcd = wgid % NXCD, off = wgid / NXCD; wgid = (xcd < r ? xcd * (q + 1) : r * (q + 1) + (xcd - r) * q) + off; }
        const int nig = WGM * nN, gid = wgid / nig, fm = gid * WGM, gsz = (nM - fm) < WGM ? (nM - fm) : WGM;
        u.pm = fm + ((wgid % nig) % gsz); u.pn = (wgid % nig) / gsz; return true;
    }
    __device__ __forceinline__ void a_ready(const Unit&) const {}
    __device__ __forceinline__ void done(const Unit&) const {}
};
template <class Epi, class Sched, bool ALIGN_EPI = false, bool SP2 = false>
__device__ __forceinline__ void gemm_phase(PG8_LAS unsigned char* lds, const Gemm g, const Sched& S, const Epi& E, const int wvp) {
    const int wid = wvp, lane = lane_id(), tid = wid * 64 + lane, wr = wid >> 2, wc = wid & 3, fr = lane & 15, fq = lane >> 4;
    const int K = g.K, nt = K / BK;
    unsigned voffA[2], voffB[2];
#pragma unroll
    for (int i = 0; i < 2; ++i) { int R, C; stage_rc(tid * 16 + i * 8192, R, C); const int Rb = Epi::PERM ? ((R & ~31) + perm32(R & 31)) : R;
        voffA[i] = (unsigned)(R * K + C) * 2u; voffB[i] = (unsigned)(Rb * K + C) * 2u; }
    const size_t kstep = (size_t)(BK * 2);
    const size_t hstep = (size_t)HALF * K * 2;
    const size_t tstep = 2 * hstep;
    const unsigned ldsw = (unsigned)wid * 1024u;
    const int aoff = lds_byte(wr * 64 + fr, fq * 8), boff = lds_byte(wc * 32 + fr, fq * 8);
#define PG8_SA(b, h) (((b) * 2 + (h)) * HTB)
#define PG8_SB(b, h) ((4 + (b) * 2 + (h)) * HTB)
#define PG8_STAGE(bufoff, gbase, voff) do { _Pragma("unroll") for (int _i = 0; _i < 2; ++_i) \
        __builtin_amdgcn_global_load_lds((const unsigned*)((const char*)(gbase) + (voff)[_i]), (PG8_LAS unsigned*)(lds + (bufoff) + ldsw + _i * 8192), 16, 0, 0); } while (0)
#define PG8_LDA(dst, b, h) do { _Pragma("unroll") for (int m = 0; m < 4; ++m) _Pragma("unroll") for (int k = 0; k < 2; ++k) dst[m][k] = *(const PG8_LAS bf16x8*)(lds + PG8_SA(b, h) + aoff + m * 2048 + k * 1024); } while (0)
#define PG8_LDB(dst, b, h) do { _Pragma("unroll") for (int n = 0; n < 2; ++n) _Pragma("unroll") for (int k = 0; k < 2; ++k) dst[n][k] = *(const PG8_LAS bf16x8*)(lds + PG8_SB(b, h) + boff + n * 2048 + k * 1024); } while (0)
#define PG8_MMA(ai, bj, At, Bt) do { __builtin_amdgcn_s_setprio(1); _Pragma("unroll") for (int m = 0; m < 4; ++m) _Pragma("unroll") for (int n = 0; n < 2; ++n) _Pragma("unroll") for (int k = 0; k < 2; ++k) \
        acc[ai][bj][m][n] = __builtin_amdgcn_mfma_f32_16x16x32_bf16(Bt[n][k], At[m][k], acc[ai][bj][m][n], 0, 0, 0); __builtin_amdgcn_s_setprio(0); } while (0)
#define PG8_WAIT_V(n) asm volatile("s_waitcnt vmcnt(" #n ")" ::: "memory")
#define PG8_WAIT_L(n) asm volatile("s_waitcnt lgkmcnt(" #n ")" ::: "memory")
#define PG8_BAR __builtin_amdgcn_s_barrier()
#define PG8_SCHED __builtin_amdgcn_sched_barrier(0)
    Unit cur, nxt; int ui = 0;
    if (!S.next(0, cur)) return;
    f32x4 acc[2][2][4][2];
#pragma unroll
    for (int a = 0; a < 2; ++a)
#pragma unroll
        for (int b = 0; b < 2; ++b)
#pragma unroll
            for (int m = 0; m < 4; ++m)
#pragma unroll
                for (int n = 0; n < 2; ++n) acc[a][b][m][n] = (f32x4){0.f, 0.f, 0.f, 0.f};
    bf16x8 At[4][2], B0[2][2], B1[2][2];
    const char* cA = (const char*)g.A + (size_t)cur.pm * tstep; const char* cB = (const char*)g.Bt + (size_t)cur.pn * tstep;
    S.a_ready(cur);
    if constexpr (SP2) {
        PG8_STAGE(PG8_SB(0, 0), cB, voffB); PG8_STAGE(PG8_SB(0, 1), cB + hstep, voffB); PG8_STAGE(PG8_SA(0, 0), cA, voffA); PG8_STAGE(PG8_SA(0, 1), cA + hstep, voffA);
        if (wr == 1) PG8_BAR;
        PG8_WAIT_V(2); PG8_BAR;
        PG8_STAGE(PG8_SB(1, 0), cB + kstep, voffB); PG8_STAGE(PG8_SA(1, 0), cA + kstep, voffA); PG8_STAGE(PG8_SB(1, 1), cB + hstep + kstep, voffB);
        PG8_WAIT_V(6); PG8_BAR;
    } else {
        PG8_STAGE(PG8_SB(0, 0), cB, voffB); PG8_STAGE(PG8_SA(0, 0), cA, voffA); PG8_STAGE(PG8_SB(0, 1), cB + hstep, voffB); PG8_STAGE(PG8_SA(0, 1), cA + hstep, voffA);
        if (wr == 1) PG8_BAR;
        PG8_WAIT_V(4); PG8_BAR;
        PG8_STAGE(PG8_SB(1, 0), cB + kstep, voffB); PG8_STAGE(PG8_SA(1, 0), cA + kstep, voffA); PG8_STAGE(PG8_SB(1, 1), cB + hstep + kstep, voffB);
        PG8_WAIT_V(6); PG8_BAR;
    }
    for (;;) {
        const bool has_next = S.next(ui + 1, nxt);
        const char* nA = has_next ? (const char*)g.A + (size_t)nxt.pm * tstep : cA; const char* nB = has_next ? (const char*)g.Bt + (size_t)nxt.pn * tstep : cB;
        for (int t = 0; t < nt; t += 2) {
            const bool last = (t == nt - 2);
            const char* a1 = cA + (size_t)(t + 1) * kstep;
            const char* a2 = last ? nA : cA + (size_t)(t + 2) * kstep; const char* b2 = last ? nB : cB + (size_t)(t + 2) * kstep;
            const char* a3 = a2 + kstep; const char* b3 = b2 + kstep;
            if (last && has_next) S.a_ready(nxt);
            if constexpr (SP2) {
            PG8_LDB(B0, 0, 0); PG8_LDB(B1, 0, 1); PG8_SCHED; PG8_LDA(At, 0, 0); PG8_STAGE(PG8_SA(1, 1), a1 + hstep, voffA);
            PG8_WAIT_V(8); PG8_WAIT_L(0); PG8_BAR; PG8_MMA(0, 0, At, B0); PG8_MMA(0, 1, At, B1); PG8_BAR; PG8_SCHED;
            PG8_LDA(At, 0, 1); PG8_STAGE(PG8_SB(0, 0), b2, voffB); PG8_STAGE(PG8_SB(0, 1), b2 + hstep, voffB); PG8_STAGE(PG8_SA(0, 0), a2, voffA);
            PG8_WAIT_V(8); PG8_WAIT_L(0); PG8_BAR; PG8_MMA(1, 0, At, B0); PG8_MMA(1, 1, At, B1); PG8_BAR; PG8_SCHED;
            PG8_LDB(B0, 1, 0); PG8_LDB(B1, 1, 1); PG8_SCHED; PG8_LDA(At, 1, 0); PG8_STAGE(PG8_SA(0, 1), a2 + hstep, voffA);
            PG8_WAIT_V(8); PG8_WAIT_L(0); PG8_BAR; PG8_MMA(0, 0, At, B0); PG8_MMA(0, 1, At, B1); PG8_BAR; PG8_SCHED;
            PG8_LDA(At, 1, 1); PG8_STAGE(PG8_SB(1, 0), b3, voffB); PG8_STAGE(PG8_SB(1, 1), b3 + hstep, voffB); PG8_STAGE(PG8_SA(1, 0), a3, voffA);
            PG8_WAIT_V(8); PG8_WAIT_L(0); PG8_BAR; PG8_MMA(1, 0, At, B0); PG8_MMA(1, 1, At, B1); PG8_BAR; PG8_SCHED;
            } else {
            PG8_LDB(B0, 0, 0); PG8_SCHED; PG8_LDA(At, 0, 0); PG8_STAGE(PG8_SA(1, 1), a1 + hstep, voffA);
            PG8_WAIT_L(8); PG8_BAR; PG8_WAIT_L(0); PG8_MMA(0, 0, At, B0); PG8_BAR; PG8_SCHED;
            PG8_LDB(B1, 0, 1); PG8_STAGE(PG8_SB(0, 0), b2, voffB);
            PG8_BAR; PG8_WAIT_L(0); PG8_MMA(0, 1, At, B1); PG8_BAR;
            PG8_LDA(At, 0, 1); PG8_STAGE(PG8_SA(0, 0), a2, voffA);
            PG8_BAR; PG8_WAIT_L(0); PG8_MMA(1, 0, At, B0); PG8_BAR; PG8_SCHED;
            PG8_STAGE(PG8_SB(0, 1), b2 + hstep, voffB);
            PG8_WAIT_V(6); PG8_BAR; PG8_MMA(1, 1, At, B1); PG8_BAR;
            PG8_LDB(B0, 1, 0); PG8_SCHED; PG8_LDA(At, 1, 0); PG8_STAGE(PG8_SA(0, 1), a2 + hstep, voffA);
            PG8_WAIT_L(8); PG8_BAR; PG8_WAIT_L(0); PG8_MMA(0, 0, At, B0); PG8_BAR; PG8_SCHED;
            PG8_LDB(B1, 1, 1); PG8_STAGE(PG8_SB(1, 0), b3, voffB);
            PG8_BAR; PG8_WAIT_L(0); PG8_MMA(0, 1, At, B1); PG8_BAR;
            PG8_LDA(At, 1, 1); PG8_STAGE(PG8_SA(1, 0), a3, voffA);
            PG8_BAR; PG8_WAIT_L(0); PG8_MMA(1, 0, At, B0); PG8_BAR; PG8_SCHED;
            PG8_STAGE(PG8_SB(1, 1), b3 + hstep, voffB);
            PG8_WAIT_V(6); PG8_BAR; PG8_MMA(1, 1, At, B1); PG8_BAR;
            }
        }
        if constexpr (ALIGN_EPI) { if (wr == 0) PG8_BAR; }
        if constexpr (!Epi::AFTER_DRAIN) { E(acc, cur, wr, wc, fr, fq); S.done(cur); }
        if (!has_next) break;
#pragma unroll
        for (int a = 0; a < 2; ++a)
#pragma unroll
            for (int b = 0; b < 2; ++b)
#pragma unroll
                for (int m = 0; m < 4; ++m)
#pragma unroll
                    for (int n = 0; n < 2; ++n) acc[a][b][m][n] = (f32x4){0.f, 0.f, 0.f, 0.f};
        cur = nxt; cA = nA; cB = nB; ++ui;
        if constexpr (ALIGN_EPI) { if (wr == 1) PG8_BAR; }
    }
    PG8_WAIT_V(0);
    if constexpr (!ALIGN_EPI) { if (wr == 0) PG8_BAR; }
    PG8_BAR;
    if constexpr (Epi::AFTER_DRAIN) { E.fused(acc, cur, wr, wc, fr, fq, lds, wid, lane); S.done(cur); }
#undef PG8_SA
#undef PG8_SB
#undef PG8_STAGE
#undef PG8_LDA
#undef PG8_LDB
#undef PG8_MMA
#undef PG8_WAIT_V
#undef PG8_WAIT_L
#undef PG8_BAR
#undef PG8_SCHED
}
}


typedef unsigned short bf16_t;
typedef short bf16x8 __attribute__((ext_vector_type(8)));
typedef float f32x16 __attribute__((ext_vector_type(16)));
typedef pg8::f32x4 f32x4;
using pg8::Unit;

constexpr int NTHR = 512, NWV = 8;
constexpr int NTOK = 16384, NCTX = 8192, DM = 1024, DIN = 2336, DINP = 2560, DFF = 4096;
constexpr int LDS_RED = 131072;
constexpr int LDS_ROPEW = 131072 + 4096, LDS_ROPEM = LDS_ROPEW + 64 * 32 * 4;
constexpr int LDS_BYTES = LDS_ROPEM + 64 * 16 * 4;
constexpr float LOG2E = 1.4426950408889634f;
constexpr float L2_10000 = 13.287712379549449f;

#define AL256(x) (((x) + 255) & ~(size_t)255)
constexpr size_t OFF_mod = 0;
constexpr size_t OFF_ropeW = OFF_mod + AL256((size_t)2 * 9 * 6144 * 4);
constexpr size_t OFF_ropeM = OFF_ropeW + AL256((size_t)64 * 32 * 4);
constexpr size_t OFF_ctl = OFF_ropeM + AL256((size_t)64 * 16 * 4);
constexpr size_t OFF_rssA = OFF_ctl + AL256((size_t)256 * 4);
constexpr size_t OFF_rssB = OFF_rssA + AL256((size_t)NTOK * 16 * 4);
constexpr size_t OFF_sWin = OFF_rssB + AL256((size_t)NTOK * 16 * 4);
constexpr size_t OFF_sWup = OFF_sWin + AL256((size_t)2 * 9 * DINP * 4);
constexpr size_t OFF_WinT = OFF_sWup + AL256((size_t)2 * 9 * DFF * 4);
constexpr size_t OFF_WoutT = OFF_WinT + AL256((size_t)2 * DINP * DM * 2);
constexpr size_t OFF_WupT = OFF_WoutT + AL256((size_t)2 * DM * DM * 2);
constexpr size_t OFF_WdownT = OFF_WupT + AL256((size_t)2 * DFF * DM * 2);
constexpr size_t OFF_WkvbT = OFF_WdownT + AL256((size_t)2 * DM * DFF * 2);
constexpr size_t OFF_hbuf = OFF_WkvbT + AL256((size_t)2 * 512 * 128 * 2);
constexpr size_t OFF_Kwin_l = OFF_hbuf + AL256((size_t)NTOK * DM * 2);
constexpr size_t OFF_Vtwin_l = OFF_Kwin_l + AL256((size_t)2 * 8 * 1280 * 128 * 2);
constexpr size_t OFF_S0t = OFF_Vtwin_l + AL256((size_t)2 * 8 * 2 * 64 * 1280 * 2);
constexpr size_t OFF_ckvn = OFF_S0t + AL256((size_t)2 * 8 * 2 * 4 * 4096 * 2);
constexpr size_t OFF_Kmla_l = OFF_ckvn + AL256((size_t)2 * 18432 * 128 * 2);
constexpr size_t OFF_Vtmla_l = OFF_Kmla_l + AL256((size_t)2 * 8 * 4 * 1280 * 96 * 2);
constexpr size_t OFF_ubuf = OFF_Vtmla_l + AL256((size_t)2 * 8 * 4 * 64 * 1280 * 2);
constexpr size_t WS_END = OFF_ubuf + AL256((size_t)NTOK * DFF * 2);
constexpr size_t OFF_mix = OFF_ubuf + (size_t)96 * 1024 * 1024;
constexpr size_t OFF_Qwin = OFF_ubuf;
constexpr size_t OFF_Kwin_c = OFF_Qwin + AL256((size_t)NTOK * 512 * 2);
constexpr size_t OFF_Vtwin_c = OFF_Kwin_c + AL256((size_t)NCTX * 128 * 2);
constexpr size_t OFF_Qret = OFF_Vtwin_c + AL256((size_t)32 * 2 * 64 * 256 * 2);
constexpr size_t OFF_Kret = OFF_Qret + AL256((size_t)NTOK * 256 * 2);
constexpr size_t OFF_Gret = OFF_Kret + AL256((size_t)NTOK * 256 * 2);
constexpr size_t OFF_Vtret_c = OFF_Gret + AL256((size_t)NTOK * 256 * 2);
constexpr size_t OFF_Vtret_l = OFF_Vtret_c + AL256((size_t)32 * 4 * 64 * 256 * 2);
constexpr size_t OFF_Qmla = OFF_Vtret_l + AL256((size_t)8 * 4 * 64 * 1024 * 2);
constexpr size_t OFF_Kmla_c = OFF_Qmla + AL256((size_t)NTOK * 384 * 2);
constexpr size_t OFF_Vtmla_c = OFF_Kmla_c + AL256((size_t)32 * 4 * 256 * 96 * 2);
static_assert(OFF_Vtmla_c + (size_t)32 * 4 * 64 * 256 * 2 <= OFF_mix && OFF_mix + (size_t)NTOK * DM * 2 <= WS_END, "attention temporaries + mix must fit in the ubuf region");
static_assert(WS_END <= (size_t)256 * 1024 * 1024, "workspace must fit 256 MiB");

struct P {
  const float *x_prompt, *x_sample, *cache_win_k, *cache_win_v, *cache_mla_ckv, *cache_mla_krope, *state_ret,
      *c, *c_ctx, *w_mod, *b_mod, *norm1, *norm2, *w_in, *win_sink, *ret_decay, *ret_gn, *mla_kv_norm,
      *w_kv_b, *w_out, *w_up, *w_down, *final_norm;
  float* out;
  unsigned char* ws;
#define WSBUF(ty, name) __device__ __forceinline__ ty* name() const { return (ty*)(ws + OFF_##name); }
  WSBUF(unsigned, ctl) WSBUF(float, mod) WSBUF(float, ropeW) WSBUF(float, ropeM) WSBUF(float, rssA) WSBUF(float, rssB) WSBUF(float, sWin) WSBUF(float, sWup) WSBUF(bf16_t, WinT) WSBUF(bf16_t, WoutT) WSBUF(bf16_t, WupT) WSBUF(bf16_t, WdownT) WSBUF(bf16_t, WkvbT)
  WSBUF(bf16_t, hbuf) WSBUF(bf16_t, mix) WSBUF(bf16_t, Qwin) WSBUF(bf16_t, Kwin_c) WSBUF(bf16_t, Vtwin_c) WSBUF(bf16_t, Kwin_l)
  WSBUF(bf16_t, Vtwin_l) WSBUF(bf16_t, Qret) WSBUF(bf16_t, Kret) WSBUF(bf16_t, Gret) WSBUF(bf16_t, Vtret_c) WSBUF(bf16_t, Vtret_l)
  WSBUF(bf16_t, S0t) WSBUF(bf16_t, Qmla) WSBUF(bf16_t, ckvn) WSBUF(bf16_t, Kmla_c) WSBUF(bf16_t, Vtmla_c) WSBUF(bf16_t, Kmla_l)
  WSBUF(bf16_t, Vtmla_l) WSBUF(bf16_t, ubuf)
  __device__ __forceinline__ float* xw() const { return out; }
};

typedef float f32x2_t __attribute__((ext_vector_type(2)));
typedef __bf16 bf16x2_t __attribute__((ext_vector_type(2)));
__device__ __forceinline__ unsigned pk2(float lo, float hi) {
  const f32x2_t v = {lo, hi};
  const bf16x2_t b = __builtin_convertvector(v, bf16x2_t);
  return __builtin_bit_cast(unsigned, b);
}
__device__ __forceinline__ bf16_t f2bf(float f) { return (bf16_t)(pk2(f, 0.f) & 0xffffu); }
__device__ __forceinline__ float bf2f(bf16_t b) { return __uint_as_float(((unsigned)b) << 16); }
__device__ __forceinline__ float shx(float v, int mask, int ln) { return __int_as_float(__builtin_amdgcn_ds_bpermute((ln ^ mask) << 2, __float_as_int(v))); }
__device__ __forceinline__ float wave_sum(float v, int ln) {
#pragma unroll
  for (int o = 1; o < 64; o <<= 1) v += shx(v, o, ln);
  return v;
}
typedef const __attribute__((address_space(4))) unsigned char* kargp_t;
__device__ __forceinline__ P load_params(kargp_t kp) {
  asm volatile("" : "+s"(kp));
  P p;
  __builtin_memcpy(&p, kp, sizeof(P));
  return p;
}
__device__ __forceinline__ int my_tid(int wv) { int w = wv; asm volatile("" : "+s"(w)); int t = w * 64 + lane_id(); asm volatile("" : "+v"(t)); return t; }
__device__ __forceinline__ int my_bid() { int b = blockIdx.x; asm volatile("" : "+s"(b)); return b; }
__device__ __forceinline__ float fexp2(float x) { return __builtin_amdgcn_exp2f(x); }
__device__ __forceinline__ int mod_row(int m) { return m < NCTX ? 0 : 1 + ((m - NCTX) >> 10); }

__device__ __forceinline__ void st_rm_bf16(bf16_t* rp, int h, const f32x16& o) {
#pragma unroll
  for (int g = 0; g < 4; ++g) {
    uint2 u;
    u.x = pk2(o[4 * g], o[4 * g + 1]);
    u.y = pk2(o[4 * g + 2], o[4 * g + 3]);
    *(uint2*)(rp + 8 * g + 4 * h) = u;
  }
}
__device__ __forceinline__ void st_tr_bf16(bf16_t* bp, int stride, int h, const f32x16& o) {
#pragma unroll
  for (int i = 0; i < 16; ++i) bp[(size_t)((i & 3) + 8 * (i >> 2) + 4 * h) * stride] = f2bf(o[i]);
}

__device__ __forceinline__ void st8_bf16(bf16_t* rp, int fq, const f32x4& a, const f32x4& b) {
  *(uint2*)(rp + 4 * fq) = make_uint2(pk2(a[0], a[1]), pk2(a[2], a[3]));
  *(uint2*)(rp + 16 + 4 * fq) = make_uint2(pk2(b[0], b[1]), pk2(b[2], b[3]));
}
__device__ __forceinline__ void st8_f32(float* rp, int fq, const f32x4& a, const f32x4& b) {
  *(f32x4*)(rp + 4 * fq) = a;
  *(f32x4*)(rp + 16 + 4 * fq) = b;
}
__device__ __forceinline__ void st8_tr(bf16_t* bp, int stride, int fq, const f32x4& a, const f32x4& b) {
#pragma unroll
  for (int j = 0; j < 4; ++j) {
    bp[(size_t)(4 * fq + j) * stride] = f2bf(a[j]);
    bp[(size_t)(16 + 4 * fq + j) * stride] = f2bf(b[j]);
  }
}
__device__ __forceinline__ void rope8_win(f32x4& a, f32x4& b, int fq, const float* tab) {
  const f32x4 cs = *(const f32x4*)(tab + 4 * fq), sn = *(const f32x4*)(tab + 16 + 4 * fq);
  const f32x4 x = a, y = b;
  a = x * cs - y * sn;
  b = x * sn + y * cs;
}
__device__ __forceinline__ void rope8_mla(f32x4& a, f32x4& b, int fq, int ln, const float* tabr, const float* tabc) {
  const int fo = 4 * (fq & 1);
  {
    const f32x4 cs = *(const f32x4*)(tabr + fo), sn = *(const f32x4*)(tabr + 8 + fo);
#pragma unroll
    for (int j = 0; j < 4; ++j) { const float pa = shx(a[j], 32, ln); a[j] = fq < 2 ? a[j] * cs[j] - pa * sn[j] : pa * sn[j] + a[j] * cs[j]; }
  }
  asm volatile("" ::: "memory");
  {
    const f32x4 cs = *(const f32x4*)(tabc + fo), sn = *(const f32x4*)(tabc + 8 + fo);
#pragma unroll
    for (int j = 0; j < 4; ++j) { const float pb = shx(b[j], 32, ln); b[j] = fq < 2 ? b[j] * cs[j] - pb * sn[j] : pb * sn[j] + b[j] * cs[j]; }
  }
}

__device__ __forceinline__ float row_rstd(const float* rss, int m) {
  const f32x4 a = *(const f32x4*)(rss + (size_t)m * 16), b = *(const f32x4*)(rss + (size_t)m * 16 + 4);
  const f32x4 c = *(const f32x4*)(rss + (size_t)m * 16 + 8), d = *(const f32x4*)(rss + (size_t)m * 16 + 12);
  const f32x4 s = (a + b) + (c + d);
  return rsqrtf(((s[0] + s[1]) + (s[2] + s[3])) * (1.f / 1024.f) + 1e-6f);
}

typedef f32x4 acc_t[2][2][4][2];
template <int V> struct IC { static constexpr int value = V; };
extern __shared__ __attribute__((aligned(16))) unsigned char smem[];
struct EpiIn8 {
  static constexpr bool PERM = false, AFTER_DRAIN = false;
  P p0; int l; kargp_t kp;
  __device__ __forceinline__ void operator()(const acc_t& acc, const Unit& u, int wr, int wc, int fr_in, int fq_in) const {
    int fr = fr_in; asm volatile("" : "+v"(fr));
    int fq = fq_in; asm volatile("" : "+v"(fq));
    const int ln = fq * 16 + fr; (void)ln;
    P p = p0; asm volatile("" : "+s"(p.ws), "+s"(p.out));
    const bool lat = u.pm >= 32;
    const int rbase = u.pm * 256 + wr * 64 + fr;
#define ROWS_BEGIN _Pragma("unroll") for (int ai = 0; ai < 2; ++ai) _Pragma("unroll") for (int mm = 0; mm < 4; ++mm) { \
      int m = rbase + ai * 128 + mm * 16; asm volatile("" : "+v"(m)); int b, s; \
      if (!lat) { b = m >> 8; s = m & 255; } else { b = (m - NCTX) >> 10; s = (m - NCTX) & 1023; } \
      const float rsd = rsdv[ai][mm]; \
      f32x4 v0 = acc[ai][bj][mm][0] * rsd + sw0, v1 = acc[ai][bj][mm][1] * rsd + sw1; (void)b; (void)s;
#define ROWS_END }
    float rsdv[2][4];
    {
      const float* rss = p.rssA();
#pragma unroll
      for (int ai = 0; ai < 2; ++ai)
#pragma unroll
        for (int mm = 0; mm < 4; ++mm) rsdv[ai][mm] = row_rstd(rss, rbase + ai * 128 + mm * 16);
    }
    auto do_half = [&](auto BJ) {
      constexpr int bj = decltype(BJ)::value;
      const int nb = u.pn * 256 + bj * 128 + wc * 32;
      if (nb >= DIN) return;
      const float* swp = p.sWin() + ((size_t)(l * 9 + (lat ? 1 + ((u.pm - 32) >> 2) : 0))) * DINP + nb;
      const f32x4 sw0 = *(const f32x4*)(swp + 4 * fq), sw1 = *(const f32x4*)(swp + 16 + 4 * fq);
      if (nb < 512) {
        ROWS_BEGIN
          if (lat) rope8_win(v0, v1, fq, (const float*)(smem + LDS_ROPEW) + ((nb & 32) ? (s & 63) : (s >> 6)) * 32);
          st8_bf16(p.Qwin() + (size_t)m * 512 + nb, fq, v0, v1);
        ROWS_END
      } else if (nb < 640) {
        const int c = nb - 512;
        ROWS_BEGIN
          if (!lat) {
            st8_f32(p.out + 16777216 + ((size_t)((b * 2 + l) * 256 + s)) * 128 + c, fq, v0, v1);
            st8_bf16(p.Kwin_c() + (size_t)m * 128 + c, fq, v0, v1);
          } else {
            rope8_win(v0, v1, fq, (const float*)(smem + LDS_ROPEW) + ((nb & 32) ? (s & 63) : (s >> 6)) * 32);
            st8_bf16(p.Kwin_l() + ((size_t)((l * 8 + b) * 1280 + s)) * 128 + c, fq, v0, v1);
          }
        ROWS_END
      } else if (nb < 768) {
        const int c = nb - 640, kv = c >> 6, d0 = c & 63;
        ROWS_BEGIN
          if (!lat) {
            st8_f32(p.out + 18874368 + ((size_t)((b * 2 + l) * 256 + s)) * 128 + c, fq, v0, v1);
            st8_tr(p.Vtwin_c() + ((size_t)((b * 2 + kv) * 64 + d0)) * 256 + s, 256, fq, v0, v1);
          } else {
            st8_tr(p.Vtwin_l() + ((size_t)(((l * 8 + b) * 2 + kv) * 64 + d0)) * 1280 + s, 1280, fq, v0, v1);
          }
        ROWS_END
      } else if (nb < 1024) {
        ROWS_BEGIN
          st8_bf16(p.Qret() + (size_t)m * 256 + (nb - 768), fq, v0, v1);
        ROWS_END
      } else if (nb < 1280) {
        ROWS_BEGIN
          st8_bf16(p.Kret() + (size_t)m * 256 + (nb - 1024), fq, v0, v1);
        ROWS_END
      } else if (nb < 1536) {
        const int c = nb - 1280, hh = c >> 6, d0 = c & 63;
        ROWS_BEGIN
          if (!lat) st8_tr(p.Vtret_c() + ((size_t)((b * 4 + hh) * 64 + d0)) * 256 + s, 256, fq, v0, v1);
          else st8_tr(p.Vtret_l() + ((size_t)((b * 4 + hh) * 64 + d0)) * 1024 + s, 1024, fq, v0, v1);
        ROWS_END
      } else if (nb < 1792) {
        ROWS_BEGIN
          st8_bf16(p.Gret() + (size_t)m * 256 + (nb - 1536), fq, v0, v1);
        ROWS_END
      } else if (nb < 2176) {
        const int c = nb - 1792;
        const bool rp = lat && (c % 96) == 64;
        ROWS_BEGIN
          if (rp) rope8_mla(v0, v1, fq, ln, (const float*)(smem + LDS_ROPEM) + (s >> 6) * 16, (const float*)(smem + LDS_ROPEM) + (s & 63) * 16);
          st8_bf16(p.Qmla() + (size_t)m * 384 + c, fq, v0, v1);
        ROWS_END
      } else if (nb < 2304) {
        const int c = nb - 2176;
        float* red = (float*)(smem + LDS_RED);
        kargp_t k2 = kp; asm volatile("" : "+s"(k2));
        const float* g = ((const __attribute__((address_space(4))) P*)k2)->mla_kv_norm + l * 128 + c;
        const f32x4 g0 = *(const f32x4*)(g + 4 * fq), g1 = *(const f32x4*)(g + 16 + 4 * fq);
#pragma unroll
        for (int ai = 0; ai < 2; ++ai)
#pragma unroll
          for (int mm = 0; mm < 4; ++mm) {
            const float rsd0 = rsdv[ai][mm];
            const f32x4 a = acc[ai][bj][mm][0] * rsd0 + sw0, b4 = acc[ai][bj][mm][1] * rsd0 + sw1;
            float ss = a[0] * a[0] + a[1] * a[1] + a[2] * a[2] + a[3] * a[3] + b4[0] * b4[0] + b4[1] * b4[1] + b4[2] * b4[2] + b4[3] * b4[3];
            ss += shx(ss, 16, ln);
            ss += shx(ss, 32, ln);
            if (fq == 0) red[wc * 256 + ai * 128 + wr * 64 + mm * 16 + fr] = ss;
          }
        asm volatile("s_waitcnt lgkmcnt(0)" ::: "memory");
        __builtin_amdgcn_s_barrier();
        ROWS_BEGIN
          const int rt = ai * 128 + wr * 64 + mm * 16 + fr;
          const float rsv = rsqrtf((red[rt] + red[256 + rt] + red[512 + rt] + red[768 + rt]) * (1.f / 128.f) + 1e-6f);
          v0 = v0 * rsv * g0;
          v1 = v1 * rsv * g1;
          st8_bf16(p.ckvn() + ((size_t)l * 18432 + m) * 128 + c, fq, v0, v1);
          if (!lat) st8_f32(p.out + 20971520 + ((size_t)((b * 2 + l) * 256 + s)) * 128 + c, fq, v0, v1);
        ROWS_END
        asm volatile("s_waitcnt vmcnt(0) lgkmcnt(0)" ::: "memory");
        __builtin_amdgcn_s_barrier();
        if (wr == 0 && wc == 0 && ln == 0) {
          __builtin_amdgcn_fence(__ATOMIC_RELEASE, "agent");
          asm volatile("s_waitcnt vmcnt(0)" ::: "memory");
          __hip_atomic_fetch_add(p.ctl() + 64 * l, 1u, __ATOMIC_RELAXED, __HIP_MEMORY_SCOPE_AGENT);
        }
      } else {
        ROWS_BEGIN
          if (!lat) {
            st8_f32(p.out + 23068672 + ((size_t)((b * 2 + l) * 256 + s)) * 32, fq, v0, v1);
#pragma unroll
            for (int hh = 0; hh < 4; ++hh) st8_bf16(p.Kmla_c() + ((size_t)((b * 4 + hh) * 256 + s)) * 96 + 64, fq, v0, v1);
          } else {
            rope8_mla(v0, v1, fq, ln, (const float*)(smem + LDS_ROPEM) + (s >> 6) * 16, (const float*)(smem + LDS_ROPEM) + (s & 63) * 16);
#pragma unroll
            for (int hh = 0; hh < 4; ++hh) st8_bf16(p.Kmla_l() + ((size_t)(((l * 8 + b) * 4 + hh) * 1280 + s)) * 96 + 64, fq, v0, v1);
          }
        ROWS_END
      }
    };
    do_half(IC<0>{});
    do_half(IC<1>{});
#undef ROWS_BEGIN
#undef ROWS_END
  }
};

struct EpiOut8 {
  static constexpr bool PERM = true, AFTER_DRAIN = false;
  P p0; int l;
  __device__ __forceinline__ void operator()(const acc_t& acc, const Unit& u, int wr, int wc, int fr_in, int fq_in) const {
    int fr = fr_in; asm volatile("" : "+v"(fr));
    int fq = fq_in; asm volatile("" : "+v"(fq));
    const int ln = fq * 16 + fr; (void)ln;
    P p = p0; asm volatile("" : "+s"(p.ws), "+s"(p.out));
    const int rbase = u.pm * 256 + wr * 64 + fr;
    const int cb = u.pn * 256 + wc * 32 + 8 * fq;
    const float* md = p.mod() + ((size_t)(l * 9 + mod_row(u.pm * 256))) * 6144;
    const float* gate = md + 2 * 1024; const float* sc2 = md + 4 * 1024; const float* g2 = p.norm2 + l * DM;
#pragma unroll
    for (int ap = 0; ap < 4; ++ap) {
      constexpr int dummy = 0; (void)dummy;
      const int ai = ap >> 1, m2 = (ap & 1) * 2;
      int mb = rbase + ai * 128 + m2 * 16; asm volatile("" : "+v"(mb));
      f32x4 xv[2][2][2];
#pragma unroll
      for (int mq = 0; mq < 2; ++mq) {
        const int mm = m2 + mq;
        const int m = mb + mq * 16;
        if (l == 0) {
          const float* xr = m < NCTX ? p.x_prompt + (size_t)m * DM : p.x_sample + (size_t)(m - NCTX) * DM;
#pragma unroll
          for (int bj = 0; bj < 2; ++bj)
#pragma unroll
            for (int n = 0; n < 2; ++n) xv[mq][bj][n] = *(const f32x4*)(xr + cb + bj * 128 + n * 4);
        } else {
          const bf16_t* hr = p.hbuf() + (size_t)m * DM;
#pragma unroll
          for (int bj = 0; bj < 2; ++bj)
#pragma unroll
            for (int n = 0; n < 2; ++n) {
              const int c = cb + bj * 128 + n * 4;
              const uint2 hq = *(const uint2*)(hr + c);
              const f32x4 q1 = *(const f32x4*)(p.norm1 + DM + c) * (*(const f32x4*)(md + 1 * 1024 + c) + 1.f);
              f32x4 xm;
              xm[0] = __uint_as_float(hq.x << 16) * __builtin_amdgcn_rcpf(q1[0]); xm[1] = __uint_as_float(hq.x & 0xffff0000u) * __builtin_amdgcn_rcpf(q1[1]);
              xm[2] = __uint_as_float(hq.y << 16) * __builtin_amdgcn_rcpf(q1[2]); xm[3] = __uint_as_float(hq.y & 0xffff0000u) * __builtin_amdgcn_rcpf(q1[3]);
              xv[mq][bj][n] = xm;
            }
        }
      }
#pragma unroll
      for (int mq = 0; mq < 2; ++mq) {
        const int mm = m2 + mq;
        const int m = mb + mq * 16;
        bf16_t* ho = p.hbuf() + (size_t)m * DM;
        float ss = 0.f;
#pragma unroll
        for (int bj = 0; bj < 2; ++bj)
#pragma unroll
          for (int n = 0; n < 2; ++n) {
            const int c = cb + bj * 128 + n * 4;
            const f32x4 xn = xv[mq][bj][n] + *(const f32x4*)(gate + c) * acc[ai][bj][mm][n];
            const f32x4 hv = xn * (*(const f32x4*)(g2 + c) * (*(const f32x4*)(sc2 + c) + 1.f));
            *(uint2*)(ho + c) = make_uint2(pk2(hv[0], hv[1]), pk2(hv[2], hv[3]));
            ss += (xn[0] * xn[0] + xn[1] * xn[1]) + (xn[2] * xn[2] + xn[3] * xn[3]);
          }
        ss += shx(ss, 16, ln);
        ss += shx(ss, 32, ln);
        if (fq == 0) p.rssB()[(size_t)m * 16 + u.pn * 4 + wc] = ss;
      }
      asm volatile("" ::: "memory");
    }
  }
};
struct EpiUp8 {
  static constexpr bool PERM = true, AFTER_DRAIN = false;
  P p0; int l;
  __device__ __forceinline__ void operator()(const acc_t& acc, const Unit& u, int wr, int wc, int fr_in, int fq_in) const {
    int fr = fr_in; asm volatile("" : "+v"(fr));
    int fq = fq_in; asm volatile("" : "+v"(fq));
    const int ln = fq * 16 + fr; (void)ln;
    P p = p0; asm volatile("" : "+s"(p.ws), "+s"(p.out));
    const int rbase = u.pm * 256 + wr * 64 + fr;
    const int cb = u.pn * 256 + wc * 32 + 8 * fq;
    const float* swp = p.sWup() + ((size_t)(l * 9 + mod_row(u.pm * 256))) * DFF;
    float rsdv[2][4];
#pragma unroll
    for (int ai = 0; ai < 2; ++ai)
#pragma unroll
      for (int mm = 0; mm < 4; ++mm) rsdv[ai][mm] = row_rstd(p.rssB(), rbase + ai * 128 + mm * 16);
    f32x4 swv[2][2];
#pragma unroll
    for (int bj = 0; bj < 2; ++bj)
#pragma unroll
      for (int n = 0; n < 2; ++n) swv[bj][n] = *(const f32x4*)(swp + cb + bj * 128 + n * 4);
#pragma unroll
    for (int ai = 0; ai < 2; ++ai)
#pragma unroll
      for (int mm = 0; mm < 4; ++mm) {
        int m = rbase + ai * 128 + mm * 16; asm volatile("" : "+v"(m));
        bf16_t* uo = p.ubuf() + (size_t)m * DFF;
        const float rsd = rsdv[ai][mm];
#pragma unroll
        for (int bj = 0; bj < 2; ++bj) {
          f32x4 t0 = acc[ai][bj][mm][0] * rsd + swv[bj][0], t1 = acc[ai][bj][mm][1] * rsd + swv[bj][1];
#pragma unroll
          for (int j = 0; j < 4; ++j) { const float a = fmaxf(t0[j], 0.f), b = fmaxf(t1[j], 0.f); t0[j] = a * a; t1[j] = b * b; }
          *(uint4*)(uo + cb + bj * 128) = make_uint4(pk2(t0[0], t0[1]), pk2(t0[2], t0[3]), pk2(t1[0], t1[1]), pk2(t1[2], t1[3]));
        }
      }
  }
};
struct EpiDown8 {
  static constexpr bool PERM = true, AFTER_DRAIN = false;
  P p0; int l;
  __device__ __forceinline__ void operator()(const acc_t& acc, const Unit& u, int wr, int wc, int fr_in, int fq_in) const {
    int fr = fr_in; asm volatile("" : "+v"(fr));
    int fq = fq_in; asm volatile("" : "+v"(fq));
    const int ln = fq * 16 + fr; (void)ln;
    P p = p0; asm volatile("" : "+s"(p.ws), "+s"(p.out));
    const int rbase = u.pm * 256 + wr * 64 + fr;
    const int cb = u.pn * 256 + wc * 32 + 8 * fq;
    const int r = mod_row(u.pm * 256);
    const float* md = p.mod() + ((size_t)(l * 9 + r)) * 6144;
    const float* gate = md + 5 * 1024; const float* sc2 = md + 4 * 1024; const float* g2 = p.norm2 + l * DM;
    const float* sc1 = p.mod() + ((size_t)(9 + r)) * 6144 + 1 * 1024;
    const float* g1 = p.norm1 + DM;
    f32x4 riv[2][2];
#pragma unroll
    for (int bj = 0; bj < 2; ++bj)
#pragma unroll
      for (int n = 0; n < 2; ++n) {
        const int c = cb + bj * 128 + n * 4;
        const f32x4 q2 = *(const f32x4*)(g2 + c) * (*(const f32x4*)(sc2 + c) + 1.f);
#pragma unroll
        for (int j = 0; j < 4; ++j) riv[bj][n][j] = __builtin_amdgcn_rcpf(q2[j]);
      }
#pragma unroll
    for (int ap = 0; ap < 4; ++ap) {
      const int ai = ap >> 1, m2 = (ap & 1) * 2;
      int mb = rbase + ai * 128 + m2 * 16; asm volatile("" : "+v"(mb));
      uint2 hvv[2][2][2];
#pragma unroll
      for (int mq = 0; mq < 2; ++mq) {
        const bf16_t* hr = p.hbuf() + (size_t)(mb + mq * 16) * DM;
#pragma unroll
        for (int bj = 0; bj < 2; ++bj)
#pragma unroll
          for (int n = 0; n < 2; ++n) hvv[mq][bj][n] = *(const uint2*)(hr + cb + bj * 128 + n * 4);
      }
#pragma unroll
      for (int mq = 0; mq < 2; ++mq) {
        const int mm = m2 + mq;
        const int m = mb + mq * 16;
        float* xo = p.xw() + (size_t)m * DM;
        bf16_t* ho = p.hbuf() + (size_t)m * DM;
        float ss = 0.f;
#pragma unroll
        for (int bj = 0; bj < 2; ++bj)
#pragma unroll
          for (int n = 0; n < 2; ++n) {
            const int c = cb + bj * 128 + n * 4;
            const uint2 hq = hvv[mq][bj][n];
            f32x4 xm;
            xm[0] = __uint_as_float(hq.x << 16); xm[1] = __uint_as_float(hq.x & 0xffff0000u);
            xm[2] = __uint_as_float(hq.y << 16); xm[3] = __uint_as_float(hq.y & 0xffff0000u);
            const f32x4 xn = xm * riv[bj][n] + *(const f32x4*)(gate + c) * acc[ai][bj][mm][n];
            if (l != 0) *(f32x4*)(xo + c) = xn;
            if (l == 0) {
              const f32x4 hv = xn * (*(const f32x4*)(g1 + c) * (*(const f32x4*)(sc1 + c) + 1.f));
              *(uint2*)(ho + c) = make_uint2(pk2(hv[0], hv[1]), pk2(hv[2], hv[3]));
              ss += (xn[0] * xn[0] + xn[1] * xn[1]) + (xn[2] * xn[2] + xn[3] * xn[3]);
            }
          }
        if (l == 0) {
          ss += shx(ss, 16, ln);
          ss += shx(ss, 32, ln);
          if (fq == 0) p.rssA()[(size_t)m * 16 + u.pn * 4 + wc] = ss;
        }
      }
      asm volatile("" ::: "memory");
    }
  }
};

struct EpiKvb {
  P p; int l;
  __device__ __forceinline__ void operator()(int m, int nb, int h, const f32x16& v) const {
    const int hh = nb >> 7, j0 = nb & 127;
    bf16_t* Kb; bf16_t* Vb; int S, key;
    if (m < NCTX) {
      const int b = m >> 8; key = m & 255; S = 256;
      Kb = p.Kmla_c() + ((size_t)((b * 4 + hh) * 256)) * 96;
      Vb = p.Vtmla_c() + ((size_t)((b * 4 + hh) * 64)) * 256;
    } else {
      int b;
      if (m < NTOK) { b = (m - NCTX) >> 10; key = (m - NCTX) & 1023; }
      else { b = (m - NTOK) >> 8; key = 1024 + ((m - NTOK) & 255); }
      S = 1280;
      Kb = p.Kmla_l() + ((size_t)(((l * 8 + b) * 4 + hh) * 1280)) * 96;
      Vb = p.Vtmla_l() + ((size_t)(((l * 8 + b) * 4 + hh) * 64)) * 1280;
    }
    if (j0 < 64) st_rm_bf16(Kb + (size_t)key * 96 + j0, h, v);
    else st_tr_bf16(Vb + (size_t)(j0 - 64) * S + key, S, h, v);
  }
};

template <class Epi>
__device__ __forceinline__ void gemm_small(const bf16_t* __restrict__ A, int lda, const bf16_t* __restrict__ W, int ldw,
                                           int M, int N, int K, unsigned char* smem, const Epi& epi, const int wv, unsigned* ready, unsigned* ticket) {
  constexpr int TA = 256 * 72, TW = 128 * 72;
  bf16_t* sb = (bf16_t*)smem;
  const int tid = my_tid(wv), bid = my_bid(), lane = tid & 63, wave = tid >> 6;
  const int wm = wave >> 1, wn = wave & 1, r = lane & 31, h = lane >> 5;
  const int MT = M >> 8, NT = N >> 7, ntiles = MT * NT, nk = K >> 6;
  const int lc = tid & 7, lr = tid >> 3;
  (void)bid;
  if (tid == 0) {
    unsigned polls = 0;
    while (__hip_atomic_load(ready, __ATOMIC_RELAXED, __HIP_MEMORY_SCOPE_AGENT) < 64u && ++polls < (1u << 22)) __builtin_amdgcn_s_sleep(8);
    __builtin_amdgcn_fence(__ATOMIC_ACQUIRE, "agent");
    asm volatile("s_waitcnt vmcnt(0)" ::: "memory");
  }
  __syncthreads();
  volatile int* tks = (volatile int*)(smem + LDS_RED + 2048);
  for (;;) {
    __syncthreads();
    if (tid == 0) *tks = (int)__hip_atomic_fetch_add(ticket, 1u, __ATOMIC_RELAXED, __HIP_MEMORY_SCOPE_AGENT);
    __syncthreads();
    const int tile = *tks;
    if (tile >= ntiles) break;
    const int m0 = (tile % MT) << 8, n0 = (tile / MT) << 7;
    f32x16 acc[2][2];
#pragma unroll
    for (int a = 0; a < 2; ++a)
#pragma unroll
      for (int b = 0; b < 2; ++b)
#pragma unroll
        for (int i = 0; i < 16; ++i) acc[a][b][i] = 0.f;
    uint4 ra[4], rw[2];
    const bf16_t* Ap = A + (size_t)(m0 + lr) * lda + lc * 8;
    const bf16_t* Wp = W + (size_t)(n0 + lr) * ldw + lc * 8;
    auto gload = [&](int kt) {
#pragma unroll
      for (int i = 0; i < 4; ++i) ra[i] = *(const uint4*)(Ap + (size_t)(64 * i) * lda + kt * 64);
#pragma unroll
      for (int i = 0; i < 2; ++i) rw[i] = *(const uint4*)(Wp + (size_t)(64 * i) * ldw + kt * 64);
    };
    auto swrite = [&](int bsel) {
      bf16_t* sA = sb + bsel * (TA + TW); bf16_t* sW = sA + TA;
#pragma unroll
      for (int i = 0; i < 4; ++i) *(uint4*)(sA + (lr + 64 * i) * 72 + lc * 8) = ra[i];
#pragma unroll
      for (int i = 0; i < 2; ++i) *(uint4*)(sW + (lr + 64 * i) * 72 + lc * 8) = rw[i];
    };
    __syncthreads();
    gload(0); swrite(0);
    __syncthreads();
    for (int kt = 0; kt < nk; ++kt) {
      if (kt + 1 < nk) gload(kt + 1);
      const bf16_t* sA = sb + (kt & 1) * (TA + TW); const bf16_t* sW = sA + TA;
#pragma unroll
      for (int ks = 0; ks < 4; ++ks) {
        bf16x8 wf[2], af[2];
#pragma unroll
        for (int i = 0; i < 2; ++i) {
          wf[i] = *(const bf16x8*)(sW + (wn * 64 + i * 32 + r) * 72 + ks * 16 + h * 8);
          af[i] = *(const bf16x8*)(sA + (wm * 64 + i * 32 + r) * 72 + ks * 16 + h * 8);
        }
#pragma unroll
        for (int a = 0; a < 2; ++a)
#pragma unroll
          for (int b = 0; b < 2; ++b) acc[a][b] = __builtin_amdgcn_mfma_f32_32x32x16_bf16(wf[a], af[b], acc[a][b], 0, 0, 0);
      }
      if (kt + 1 < nk) swrite((kt + 1) & 1);
      __syncthreads();
    }
#pragma unroll
    for (int a = 0; a < 2; ++a)
#pragma unroll
      for (int b = 0; b < 2; ++b) epi(m0 + wm * 64 + b * 32 + r, n0 + wn * 64 + a * 32, h, acc[a][b]);
  }
}

struct AttnItem {
  const bf16_t* Q; int qs;
  const bf16_t* K; int ks;
  const bf16_t* Vt; int vs;
  int t0, t1, t2, t3;
  int qpos0, T;
  float scale, sink_l2; int has_sink;
  float lgf, lgb;
  const bf16_t *S0f, *S0b;
  const bf16_t* G; const float* gn;
  bf16_t* out;
  float* sout;
};

template <int DQK, int MODE>
__device__ __forceinline__ void attn_item(const AttnItem& it, unsigned char* smem, const int wv) {
  constexpr int KSTR = DQK + 8, NKS = DQK / 16, VSTR = 68, KCH = DQK / 8;
  bf16_t* Ks = (bf16_t*)smem;
  bf16_t* Vs = Ks + 64 * KSTR;
  const int tid = my_tid(wv), lane = tid & 63, wave = tid >> 6, r = lane & 31, h = lane >> 5;
  const int qrow = wave * 32 + r;
  bf16x8 qf[NKS];
  if constexpr (MODE == 3) {
    const int dq = (wave & 1) * 32 + r;
#pragma unroll
    for (int ks = 0; ks < NKS; ++ks) {
      const int e = dq - (ks * 16 + h * 8);
      uint4 v;
      v.x = e == 0 ? 0x3F80u : (e == 1 ? 0x3F800000u : 0u);
      v.y = e == 2 ? 0x3F80u : (e == 3 ? 0x3F800000u : 0u);
      v.z = e == 4 ? 0x3F80u : (e == 5 ? 0x3F800000u : 0u);
      v.w = e == 6 ? 0x3F80u : (e == 7 ? 0x3F800000u : 0u);
      qf[ks] = __builtin_bit_cast(bf16x8, v);
    }
  } else {
#pragma unroll
    for (int ks = 0; ks < NKS; ++ks) qf[ks] = *(const bf16x8*)(it.Q + (size_t)qrow * it.qs + ks * 16 + h * 8);
  }
  f32x16 o0, o1;
#pragma unroll
  for (int i = 0; i < 16; ++i) { o0[i] = 0.f; o1[i] = 0.f; }
  float mrun = it.has_sink ? it.sink_l2 : -1e30f, lrun = 0.f;
  const int qp = it.qpos0 + qrow;
  const int n1 = it.t1 - it.t0, ntl = n1 + (it.t3 - it.t2);
  constexpr int BUFE = 64 * KSTR + 64 * VSTR;
  const int krow0 = tid / KCH, kch0 = tid % KCH, krow1 = (tid + NTHR) / KCH, kch1 = (tid + NTHR) % KCH;
  const bool k2 = (KCH == 12) && (tid + NTHR < 64 * KCH);
  const int vrow = tid >> 3, vch = tid & 7;
  uint4 rk0, rk1, rv;
  auto tile_of = [&](int ti) { return ti < n1 ? it.t0 + ti : it.t2 + (ti - n1); };
  auto gload = [&](int t) {
    const bool stt = (MODE == 2) && (t >= 16);
    if (!stt) {
      const int key0 = t * 64;
      rk0 = *(const uint4*)(it.K + (size_t)(key0 + krow0) * it.ks + kch0 * 8);
      if (k2) rk1 = *(const uint4*)(it.K + (size_t)(key0 + krow1) * it.ks + kch1 * 8);
      rv = *(const uint4*)(it.Vt + (size_t)vrow * it.vs + key0 + vch * 8);
    } else {
      const bf16_t* S = (t == 16) ? it.S0f : it.S0b;
      const int e = krow0 - kch0 * 8;
      rk0.x = e == 0 ? 0x3F80u : (e == 1 ? 0x3F800000u : 0u);
      rk0.y = e == 2 ? 0x3F80u : (e == 3 ? 0x3F800000u : 0u);
      rk0.z = e == 4 ? 0x3F80u : (e == 5 ? 0x3F800000u : 0u);
      rk0.w = e == 6 ? 0x3F80u : (e == 7 ? 0x3F800000u : 0u);
      rv = *(const uint4*)(S + (size_t)vrow * 64 + vch * 8);
    }
  };
  auto swrite = [&](int bsel) {
    bf16_t* Kb = Ks + bsel * BUFE; bf16_t* Vb = Kb + 64 * KSTR;
    *(uint4*)(Kb + krow0 * KSTR + kch0 * 8) = rk0;
    if (k2) *(uint4*)(Kb + krow1 * KSTR + kch1 * 8) = rk1;
    uint2* d = (uint2*)(Vb + vrow * VSTR + vch * 8);
    d[0] = make_uint2(rv.x, rv.y); d[1] = make_uint2(rv.z, rv.w);
  };
  __syncthreads();
  gload(tile_of(0)); swrite(0);
  __syncthreads();
  for (int ti = 0; ti < ntl; ++ti) {
    const int t = tile_of(ti);
    const bool st_tile = (MODE == 2) && (t >= 16);
    const int key0 = t * 64;
    const bool more = ti + 1 < ntl;
    if (more) gload(tile_of(ti + 1));
    const bf16_t* Kc = Ks + (ti & 1) * BUFE; const bf16_t* Vc = Kc + 64 * KSTR;
    bool skip = (MODE == 3) && (wave >= 4);
    if (MODE == 1 && t < 16) {
      const int qlo = it.qpos0 + wave * 32;
      skip = (key0 > qlo + 31 + 128 || key0 + 63 < qlo - 128);
    }
    if (!skip) {
    f32x16 s0, s1;
#pragma unroll
    for (int i = 0; i < 16; ++i) { s0[i] = 0.f; s1[i] = 0.f; }
#pragma unroll
    for (int ks = 0; ks < NKS; ++ks) {
      const bf16x8 k0 = *(const bf16x8*)(Kc + r * KSTR + ks * 16 + h * 8);
      const bf16x8 k1 = *(const bf16x8*)(Kc + (32 + r) * KSTR + ks * 16 + h * 8);
      s0 = __builtin_amdgcn_mfma_f32_32x32x16_bf16(k0, qf[ks], s0, 0, 0, 0);
      s1 = __builtin_amdgcn_mfma_f32_32x32x16_bf16(k1, qf[ks], s1, 0, 0, 0);
    }
    if constexpr (MODE == 3) {
      if (wave < 2) {
        const float base = (float)(it.T - 1 - key0 - 4 * h) * it.lgf - 3.f;
#pragma unroll
        for (int i = 0; i < 16; ++i) {
          s0[i] *= fexp2(fmaf(-(float)((i & 3) + 8 * (i >> 2)), it.lgf, base));
          s1[i] *= fexp2(fmaf(-(float)(32 + (i & 3) + 8 * (i >> 2)), it.lgf, base));
        }
      } else {
        const float base = (float)(key0 + 4 * h) * it.lgb - 3.f;
#pragma unroll
        for (int i = 0; i < 16; ++i) {
          s0[i] *= fexp2(fmaf((float)((i & 3) + 8 * (i >> 2)), it.lgb, base));
          s1[i] *= fexp2(fmaf((float)(32 + (i & 3) + 8 * (i >> 2)), it.lgb, base));
        }
      }
    } else if constexpr (MODE == 2) {
      if (!st_tile) {
        const int qlo = it.qpos0 + wave * 32;
        if (key0 + 63 < qlo) {
          const float base = (float)(qp - key0 - 4 * h) * it.lgf - 3.f;
#pragma unroll
          for (int i = 0; i < 16; ++i) {
            s0[i] *= fexp2(fmaf(-(float)((i & 3) + 8 * (i >> 2)), it.lgf, base));
            s1[i] *= fexp2(fmaf(-(float)(32 + (i & 3) + 8 * (i >> 2)), it.lgf, base));
          }
        } else if (key0 > qlo + 31) {
          const float base = (float)(key0 + 4 * h - qp) * it.lgb - 3.f;
#pragma unroll
          for (int i = 0; i < 16; ++i) {
            s0[i] *= fexp2(fmaf((float)((i & 3) + 8 * (i >> 2)), it.lgb, base));
            s1[i] *= fexp2(fmaf((float)(32 + (i & 3) + 8 * (i >> 2)), it.lgb, base));
          }
        } else {
#pragma unroll
        for (int i = 0; i < 16; ++i) {
          const int key = key0 + (i & 3) + 8 * (i >> 2) + 4 * h;
          const int e0 = qp - key, e1 = e0 - 32;
          float d0 = fexp2((float)(e0 < 0 ? -e0 : e0) * (e0 > 0 ? it.lgf : it.lgb));
          float d1 = fexp2((float)(e1 < 0 ? -e1 : e1) * (e1 > 0 ? it.lgf : it.lgb));
          d0 = e0 == 0 ? 2.f : d0;
          d1 = e1 == 0 ? 2.f : d1;
          s0[i] *= it.scale * d0;
          s1[i] *= it.scale * d1;
        }
        }
      } else {
        const float dec = (t == 16) ? fexp2((float)(qp + 1) * it.lgf) : fexp2((float)(it.T - qp) * it.lgb);
#pragma unroll
        for (int i = 0; i < 16; ++i) { s0[i] *= dec; s1[i] *= dec; }
      }
    } else {
      float mx = -INFINITY;
      const int qlo1 = it.qpos0 + wave * 32;
      const bool need_mask = (MODE == 1) && (t < 16) && !(key0 >= qlo1 + 31 - 128 && key0 + 63 <= qlo1 + 128);
#pragma unroll
      for (int i = 0; i < 16; ++i) {
        float a = s0[i] * it.scale, b = s1[i] * it.scale;
        if (MODE == 1 && need_mask) {
          const int key = key0 + (i & 3) + 8 * (i >> 2) + 4 * h;
          const int e0 = key - qp, e1 = e0 + 32;
          if (e0 > 128 || e0 < -128) a = -INFINITY;
          if (e1 > 128 || e1 < -128) b = -INFINITY;
        }
        s0[i] = a; s1[i] = b;
        mx = fmaxf(mx, fmaxf(a, b));
      }
      mx = fmaxf(mx, shx(mx, 32, lane));
      const float mnew = fmaxf(mrun, mx);
      const float alpha = fexp2(mrun - mnew);
      float sum = 0.f;
#pragma unroll
      for (int i = 0; i < 16; ++i) {
        s0[i] = fexp2(s0[i] - mnew);
        s1[i] = fexp2(s1[i] - mnew);
        sum += s0[i] + s1[i];
      }
      lrun = lrun * alpha + sum;
      mrun = mnew;
#pragma unroll
      for (int i = 0; i < 16; ++i) { o0[i] *= alpha; o1[i] *= alpha; }
    }
#pragma unroll
    for (int kt = 0; kt < 2; ++kt) {
#pragma unroll
      for (int sbk = 0; sbk < 2; ++sbk) {
        uint4 pw;
        if (kt == 0) {
          pw.x = pk2(s0[8 * sbk + 0], s0[8 * sbk + 1]); pw.y = pk2(s0[8 * sbk + 2], s0[8 * sbk + 3]);
          pw.z = pk2(s0[8 * sbk + 4], s0[8 * sbk + 5]); pw.w = pk2(s0[8 * sbk + 6], s0[8 * sbk + 7]);
        } else {
          pw.x = pk2(s1[8 * sbk + 0], s1[8 * sbk + 1]); pw.y = pk2(s1[8 * sbk + 2], s1[8 * sbk + 3]);
          pw.z = pk2(s1[8 * sbk + 4], s1[8 * sbk + 5]); pw.w = pk2(s1[8 * sbk + 6], s1[8 * sbk + 7]);
        }
        const bf16x8 pf = __builtin_bit_cast(bf16x8, pw);
        const int koff = kt * 32 + sbk * 16 + 4 * h;
        const uint2 a0 = *(const uint2*)(Vc + r * VSTR + koff), a1 = *(const uint2*)(Vc + r * VSTR + koff + 8);
        const uint2 b0 = *(const uint2*)(Vc + (32 + r) * VSTR + koff), b1 = *(const uint2*)(Vc + (32 + r) * VSTR + koff + 8);
        const bf16x8 v0 = __builtin_bit_cast(bf16x8, make_uint4(a0.x, a0.y, a1.x, a1.y));
        const bf16x8 v1 = __builtin_bit_cast(bf16x8, make_uint4(b0.x, b0.y, b1.x, b1.y));
        o0 = __builtin_amdgcn_mfma_f32_32x32x16_bf16(v0, pf, o0, 0, 0, 0);
        o1 = __builtin_amdgcn_mfma_f32_32x32x16_bf16(v1, pf, o1, 0, 0, 0);
      }
    }
    }
    if (more) swrite((ti + 1) & 1);
    __syncthreads();
  }
  if constexpr (MODE == 3) {
    if (wave < 4) {
      float* rowp = it.sout + (size_t)(wave >> 1) * 16384 + (size_t)((wave & 1) * 32 + r) * 64;
#pragma unroll
      for (int g = 0; g < 4; ++g) {
        *(float4*)(rowp + 8 * g + 4 * h) = make_float4(o0[4 * g], o0[4 * g + 1], o0[4 * g + 2], o0[4 * g + 3]);
        *(float4*)(rowp + 32 + 8 * g + 4 * h) = make_float4(o1[4 * g], o1[4 * g + 1], o1[4 * g + 2], o1[4 * g + 3]);
      }
    }
    return;
  }
  bf16_t* orow = it.out + (size_t)qrow * DM;
  if constexpr (MODE == 2) {
    float sm = 0.f;
#pragma unroll
    for (int i = 0; i < 16; ++i) sm += o0[i] + o1[i];
    sm += shx(sm, 32, lane);
    const float mu = sm * (1.f / 64.f);
    float vr = 0.f;
#pragma unroll
    for (int i = 0; i < 16; ++i) { o0[i] -= mu; o1[i] -= mu; vr += o0[i] * o0[i] + o1[i] * o1[i]; }
    vr += shx(vr, 32, lane);
    const float rstd = rsqrtf(vr * (1.f / 64.f) + 1e-6f);
    const bf16_t* grow = it.G + (size_t)qrow * 256;
#pragma unroll
    for (int g = 0; g < 4; ++g) {
      const int d = 8 * g + 4 * h;
      const uint2 ga = *(const uint2*)(grow + d), gb = *(const uint2*)(grow + 32 + d);
      const float gav[4] = {__uint_as_float(ga.x << 16), __uint_as_float(ga.x & 0xffff0000u), __uint_as_float(ga.y << 16), __uint_as_float(ga.y & 0xffff0000u)};
      const float gbv[4] = {__uint_as_float(gb.x << 16), __uint_as_float(gb.x & 0xffff0000u), __uint_as_float(gb.y << 16), __uint_as_float(gb.y & 0xffff0000u)};
#pragma unroll
      for (int j = 0; j < 4; ++j) {
        const float x0 = gav[j], x1 = gbv[j];
        o0[4 * g + j] = o0[4 * g + j] * rstd * it.gn[d + j] * (x0 / (1.f + __expf(-x0)));
        o1[4 * g + j] = o1[4 * g + j] * rstd * it.gn[32 + d + j] * (x1 / (1.f + __expf(-x1)));
      }
    }
  } else {
    float lt = lrun + shx(lrun, 32, lane);
    if (it.has_sink) lt += fexp2(it.sink_l2 - mrun);
    const float inv = 1.f / lt;
#pragma unroll
    for (int i = 0; i < 16; ++i) { o0[i] *= inv; o1[i] *= inv; }
  }
  st_rm_bf16(orow, h, o0);
  st_rm_bf16(orow + 32, h, o1);
}

__device__ __forceinline__ float log2_sigmoid(float x) { return -log1pf(expf(-x)) * LOG2E; }

__device__ __forceinline__ void state_item(const P& p, int l, int idx, unsigned char* smem, const int wv) {
  const int b = idx >> 3, hh = (idx >> 1) & 3, dir = idx & 1;
  float* Ksm = (float*)smem;
  float* Vsm = Ksm + 4096;
  const int tid = my_tid(wv);
  const float lg = log2_sigmoid(p.ret_decay[(l * 2 + dir) * 4 + hh]);
  float acc[8];
#pragma unroll
  for (int i = 0; i < 8; ++i) acc[i] = 0.f;
  const int d = tid >> 3, e0 = (tid & 7) * 8;
  for (int c = 0; c < 4; ++c) {
    __syncthreads();
    for (int i = tid; i < 4096; i += NTHR) {
      const int j = i >> 6, dd = i & 63, tok = c * 64 + j;
      const float dec = dir == 0 ? fexp2((float)(255 - tok) * lg) : fexp2((float)tok * lg);
      Ksm[j * 64 + dd] = bf2f(p.Kret()[(size_t)(b * 256 + tok) * 256 + hh * 64 + dd]) * 0.125f * dec;
      const int e = i >> 6, jj = i & 63;
      Vsm[e * 65 + jj] = bf2f(p.Vtret_c()[((size_t)((b * 4 + hh) * 64 + e)) * 256 + c * 64 + jj]);
    }
    __syncthreads();
    for (int j = 0; j < 64; ++j) {
      const float kd = Ksm[j * 64 + d];
#pragma unroll
      for (int i = 0; i < 8; ++i) acc[i] += kd * Vsm[(e0 + i) * 65 + j];
    }
  }
  float* op = p.out + 23592960 + ((size_t)((((b * 2 + l) * 2 + dir) * 4 + hh) * 64 + d)) * 64 + e0;
  *(float4*)(op) = make_float4(acc[0], acc[1], acc[2], acc[3]);
  *(float4*)(op + 4) = make_float4(acc[4], acc[5], acc[6], acc[7]);
}

__device__ __forceinline__ void attn_phase(const P& p, int l, unsigned char* smem, const int wv) {
  constexpr int NA = 128, NB = 128, NC = 256, ND = 256, NE = 128, NF = 128, NG = 128;
  constexpr int TOT = NA + NB + NC + ND + NE + NF + NG;
  unsigned* ticket = p.ctl() + 32 + 64 * l;
  volatile int* tks = (volatile int*)(smem + LDS_RED + 2048);
  const int tid0 = my_tid(wv);
  for (;;) {
    __syncthreads();
    if (tid0 == 0) *tks = (int)__hip_atomic_fetch_add(ticket, 1u, __ATOMIC_RELAXED, __HIP_MEMORY_SCOPE_AGENT);
    __syncthreads();
    const int item = *tks;
    if (item >= TOT) break;
    int idx = item;
    AttnItem it;
    it.t2 = 0; it.t3 = 0; it.qpos0 = 0; it.T = 0; it.sink_l2 = 0.f; it.has_sink = 0; it.lgf = 0.f; it.lgb = 0.f;
    it.S0f = nullptr; it.S0b = nullptr; it.G = nullptr; it.gn = nullptr; it.sout = nullptr;
    if (idx < NA) {
      const int b = idx >> 4, hh = (idx >> 2) & 3, qb = idx & 3, row0 = NCTX + b * 1024 + qb * 256;
      it.Q = p.Qmla() + (size_t)row0 * 384 + hh * 96; it.qs = 384;
      it.K = p.Kmla_l() + ((size_t)(((l * 8 + b) * 4 + hh) * 1280)) * 96; it.ks = 96;
      it.Vt = p.Vtmla_l() + ((size_t)(((l * 8 + b) * 4 + hh) * 64)) * 1280; it.vs = 1280;
      it.t0 = 0; it.t1 = 20;
      it.scale = 0.10206207261596575f * LOG2E;
      it.out = p.mix() + (size_t)row0 * DM + 768 + hh * 64;
      attn_item<96, 0>(it, smem, wv);
      continue;
    }
    idx -= NA;
    if (idx < NB) {
      const int b = idx >> 4, hh = (idx >> 2) & 3, qb = idx & 3, row0 = NCTX + b * 1024 + qb * 256;
      it.Q = p.Qret() + (size_t)row0 * 256 + hh * 64; it.qs = 256;
      it.K = p.Kret() + (size_t)(NCTX + b * 1024) * 256 + hh * 64; it.ks = 256;
      it.Vt = p.Vtret_l() + ((size_t)((b * 4 + hh) * 64)) * 1024; it.vs = 1024;
      it.t0 = 0; it.t1 = 16; it.t2 = 16; it.t3 = 18;
      it.qpos0 = qb * 256; it.T = 1024; it.scale = 0.125f;
      it.lgf = log2_sigmoid(p.ret_decay[(l * 2 + 0) * 4 + hh]);
      it.lgb = log2_sigmoid(p.ret_decay[(l * 2 + 1) * 4 + hh]);
      it.S0f = p.S0t() + ((size_t)((((l * 8 + b) * 2 + 0) * 4 + hh))) * 4096;
      it.S0b = p.S0t() + ((size_t)((((l * 8 + b) * 2 + 1) * 4 + hh))) * 4096;
      it.G = p.Gret() + (size_t)row0 * 256 + hh * 64; it.gn = p.ret_gn + l * 256 + hh * 64;
      it.out = p.mix() + (size_t)row0 * DM + 512 + hh * 64;
      attn_item<64, 2>(it, smem, wv);
      continue;
    }
    idx -= NB;
    if (idx < NC) {
      const int b = idx >> 5, head = (idx >> 2) & 7, qb = idx & 3, kv = head >> 2, row0 = NCTX + b * 1024 + qb * 256;
      it.Q = p.Qwin() + (size_t)row0 * 512 + head * 64; it.qs = 512;
      it.K = p.Kwin_l() + ((size_t)((l * 8 + b) * 1280)) * 128 + kv * 64; it.ks = 128;
      it.Vt = p.Vtwin_l() + ((size_t)(((l * 8 + b) * 2 + kv) * 64)) * 1280; it.vs = 1280;
      it.t0 = max(0, qb * 4 - 2); it.t1 = min(16, qb * 4 + 6); it.t2 = 16; it.t3 = 20;
      it.qpos0 = qb * 256;
      it.scale = 0.125f * LOG2E; it.sink_l2 = p.win_sink[l * 8 + head] * LOG2E; it.has_sink = 1;
      it.out = p.mix() + (size_t)row0 * DM + head * 64;
      attn_item<64, 1>(it, smem, wv);
      continue;
    }
    idx -= NC;
    if (idx < ND) {
      const int b = idx >> 3, head = idx & 7, kv = head >> 2, row0 = b * 256;
      it.Q = p.Qwin() + (size_t)row0 * 512 + head * 64; it.qs = 512;
      it.K = p.Kwin_c() + (size_t)(b * 256) * 128 + kv * 64; it.ks = 128;
      it.Vt = p.Vtwin_c() + ((size_t)((b * 2 + kv) * 64)) * 256; it.vs = 256;
      it.t0 = 0; it.t1 = 4;
      it.scale = 0.125f * LOG2E; it.sink_l2 = p.win_sink[l * 8 + head] * LOG2E; it.has_sink = 1;
      it.out = p.mix() + (size_t)row0 * DM + head * 64;
      attn_item<64, 0>(it, smem, wv);
      continue;
    }
    idx -= ND;
    if (idx < NE) {
      const int b = idx >> 2, hh = idx & 3, row0 = b * 256;
      it.Q = p.Qmla() + (size_t)row0 * 384 + hh * 96; it.qs = 384;
      it.K = p.Kmla_c() + ((size_t)((b * 4 + hh) * 256)) * 96; it.ks = 96;
      it.Vt = p.Vtmla_c() + ((size_t)((b * 4 + hh) * 64)) * 256; it.vs = 256;
      it.t0 = 0; it.t1 = 4;
      it.scale = 0.10206207261596575f * LOG2E;
      it.out = p.mix() + (size_t)row0 * DM + 768 + hh * 64;
      attn_item<96, 0>(it, smem, wv);
      continue;
    }
    idx -= NE;
    if (idx < NF) {
      const int b = idx >> 2, hh = idx & 3, row0 = b * 256;
      it.Q = p.Qret() + (size_t)row0 * 256 + hh * 64; it.qs = 256;
      it.K = p.Kret() + (size_t)(b * 256) * 256 + hh * 64; it.ks = 256;
      it.Vt = p.Vtret_c() + ((size_t)((b * 4 + hh) * 64)) * 256; it.vs = 256;
      it.t0 = 0; it.t1 = 4;
      it.qpos0 = 0; it.T = 256; it.scale = 0.125f;
      it.lgf = log2_sigmoid(p.ret_decay[(l * 2 + 0) * 4 + hh]);
      it.lgb = log2_sigmoid(p.ret_decay[(l * 2 + 1) * 4 + hh]);
      it.G = p.Gret() + (size_t)row0 * 256 + hh * 64; it.gn = p.ret_gn + l * 256 + hh * 64;
      it.out = p.mix() + (size_t)row0 * DM + 512 + hh * 64;
      attn_item<64, 2>(it, smem, wv);
      continue;
    }
    idx -= NF;
    {
      const int b = idx >> 2, hh = idx & 3;
      it.Q = nullptr; it.qs = 0;
      it.K = p.Kret() + (size_t)(b * 256) * 256 + hh * 64; it.ks = 256;
      it.Vt = p.Vtret_c() + ((size_t)((b * 4 + hh) * 64)) * 256; it.vs = 256;
      it.t0 = 0; it.t1 = 4;
      it.T = 256; it.scale = 0.125f;
      it.lgf = log2_sigmoid(p.ret_decay[(l * 2 + 0) * 4 + hh]);
      it.lgb = log2_sigmoid(p.ret_decay[(l * 2 + 1) * 4 + hh]);
      it.out = nullptr;
      it.sout = p.out + 23592960 + ((size_t)((b * 2 + l) * 2 * 4 + hh)) * 4096;
      attn_item<64, 3>(it, smem, wv);
    }
  }
}

__device__ __forceinline__ void gemv9_item(const float* sc, float* red, const float* __restrict__ W, int N, int n0, float* outp, int ldo,
                                           const float* bias, const int tid) {
  const int j4 = (tid & 7) * 4, kq = tid >> 3;
  f32x4 acc[9];
#pragma unroll
  for (int r = 0; r < 9; ++r) acc[r] = (f32x4){0.f, 0.f, 0.f, 0.f};
  const float* w = W + (size_t)(kq * 16) * N + n0 + j4;
  const float* s = sc + kq * 16;
#pragma unroll
  for (int kk = 0; kk < 16; ++kk) {
    const f32x4 wv = *(const f32x4*)(w + (size_t)kk * N);
#pragma unroll
    for (int r = 0; r < 9; ++r) acc[r] += wv * s[r * 1024 + kk];
  }
#pragma unroll
  for (int r = 0; r < 9; ++r) *(f32x4*)(red + (kq * 9 + r) * 32 + j4) = acc[r];
  __syncthreads();
  for (int oo = tid; oo < 288; oo += NTHR) {
    const int r = oo >> 5, jj = oo & 31;
    float sum = 0.f;
#pragma unroll 16
    for (int q = 0; q < 64; ++q) sum += red[(q * 9 + r) * 32 + jj];
    outp[(size_t)r * ldo + n0 + jj] = sum + (bias ? bias[n0 + jj] : 0.f);
  }
  __syncthreads();
}

__device__ __forceinline__ void norm0_phase(const P& p, unsigned char* smem, const int wv) {
  const int tid = my_tid(wv), lane = tid & 63, gw = my_bid() * NWV + (tid >> 6), ngw = gridDim.x * NWV;
  const float* gain = p.norm1;
  for (int m0 = gw; m0 < NTOK; m0 += 2 * ngw) {
    float4 v[2][4];
    float ss[2] = {0.f, 0.f};
#pragma unroll
    for (int q = 0; q < 2; ++q) {
      const int m = m0 + q * ngw;
      const float* xr = m < NCTX ? p.x_prompt + (size_t)m * DM : p.x_sample + (size_t)(m - NCTX) * DM;
#pragma unroll
      for (int j = 0; j < 4; ++j) v[q][j] = ((const float4*)xr)[lane + 64 * j];
    }
#pragma unroll
    for (int q = 0; q < 2; ++q) {
#pragma unroll
      for (int j = 0; j < 4; ++j) ss[q] += v[q][j].x * v[q][j].x + v[q][j].y * v[q][j].y + v[q][j].z * v[q][j].z + v[q][j].w * v[q][j].w;
      ss[q] = wave_sum(ss[q], lane);
    }
#pragma unroll
    for (int q = 0; q < 2; ++q) {
      const int m = m0 + q * ngw;
      const float* scale = p.mod() + ((size_t)mod_row(m)) * 6144 + 1 * 1024;
#pragma unroll
      for (int j = 0; j < 4; ++j) {
        const int c = (lane + 64 * j) * 4;
        const float4 g = *(const float4*)(gain + c), sc = *(const float4*)(scale + c);
        uint2 u;
        u.x = pk2(v[q][j].x * g.x * (1.f + sc.x), v[q][j].y * g.y * (1.f + sc.y));
        u.y = pk2(v[q][j].z * g.z * (1.f + sc.z), v[q][j].w * g.w * (1.f + sc.w));
        *(uint2*)(p.hbuf() + (size_t)m * DM + c) = u;
      }
      if (lane < 16) p.rssA()[(size_t)m * 16 + lane] = lane == 0 ? ss[q] : 0.f;
    }
  }
  float* sc = (float*)smem;
  float* red = sc + 9216;
  constexpr int G_IN = DIN / 32, G_UP = DFF / 32, NIT = 2 * G_IN + 2 * G_UP;
  for (int item = my_bid(); item < NIT; item += gridDim.x) {
    int l, grp; const float* W; int N; float* outp; int ldo; int which;
    if (item < 2 * G_IN) { l = item / G_IN; grp = item % G_IN; W = p.w_in + (size_t)l * DM * DIN; N = DIN; outp = p.sWin() + (size_t)l * 9 * DINP; ldo = DINP; which = 0; }
    else { const int i2 = item - 2 * G_IN; l = i2 / G_UP; grp = i2 % G_UP; W = p.w_up + (size_t)l * DM * DFF; N = DFF; outp = p.sWup() + (size_t)l * 9 * DFF; ldo = DFF; which = 3; }
    __syncthreads();
    for (int i = tid; i < 9216; i += NTHR) sc[i] = p.mod()[((size_t)(l * 9 + (i >> 10))) * 6144 + which * 1024 + (i & 1023)];
    __syncthreads();
    gemv9_item(sc, red, W, N, grp * 32, outp, ldo, nullptr, tid);
  }
}
__device__ __forceinline__ void final_norm_phase(const P& p, const int wv) {
  const int tid = my_tid(wv), lane = tid & 63, gw = my_bid() * NWV + (tid >> 6), ngw = gridDim.x * NWV;
  for (int m = gw; m < NTOK; m += ngw) {
    const float* xr = p.xw() + (size_t)m * DM;
    float4 v[4];
    float ss = 0.f;
#pragma unroll
    for (int j = 0; j < 4; ++j) {
      v[j] = ((const float4*)xr)[lane + 64 * j];
      ss += v[j].x * v[j].x + v[j].y * v[j].y + v[j].z * v[j].z + v[j].w * v[j].w;
    }
    ss = wave_sum(ss, lane);
    const float rstd = rsqrtf(ss * (1.f / 1024.f) + 1e-6f);
#pragma unroll
    for (int j = 0; j < 4; ++j) {
      const int c = (lane + 64 * j) * 4;
      const float4 g = *(const float4*)(p.final_norm + c);
      *(float4*)(p.out + (size_t)m * DM + c) = make_float4(v[j].x * rstd * g.x, v[j].y * rstd * g.y, v[j].z * rstd * g.z, v[j].w * rstd * g.w);
    }
  }
}

__device__ __forceinline__ void transpose_tile(const float* __restrict__ W, int K, int N, bf16_t* __restrict__ WT, int item, float* tile, const int tid) {
  const int ntn = (N + 63) >> 6, kt = item / ntn, nt = item % ntn, k0 = kt * 64, n0 = nt * 64;
  const int n4 = (tid & 15) * 4, kr = tid >> 4;
#pragma unroll
  for (int q = 0; q < 2; ++q) {
    const int k = q * 32 + kr;
    float4 v = make_float4(0.f, 0.f, 0.f, 0.f);
    if (n0 + n4 < N) v = *(const float4*)(W + (size_t)(k0 + k) * N + n0 + n4);
    float* t = tile + k * 65 + n4;
    t[0] = v.x; t[1] = v.y; t[2] = v.z; t[3] = v.w;
  }
  __syncthreads();
  {
    const int n = tid >> 3, kc = (tid & 7) * 8;
    const float* t = tile + kc * 65 + n;
    uint4 o;
    o.x = pk2(t[0 * 65], t[1 * 65]); o.y = pk2(t[2 * 65], t[3 * 65]); o.z = pk2(t[4 * 65], t[5 * 65]); o.w = pk2(t[6 * 65], t[7 * 65]);
    if (n0 + n < N) *(uint4*)(WT + (size_t)(n0 + n) * K + k0 + kc) = o;
  }
  __syncthreads();
}

__device__ __forceinline__ void prep_phase(const P& p, unsigned char* smem, const int wv) {
  const int tid = my_tid(wv);
  {
    float* sc = (float*)smem;
    float* red = sc + 9216;
    for (int i = tid; i < 9216; i += NTHR) {
      const int r = i >> 10, k = i & 1023;
      const float x = r == 0 ? p.c_ctx[k] : p.c[(r - 1) * 1024 + k];
      sc[i] = x / (1.f + expf(-x));
    }
    __syncthreads();
    for (int item = blockIdx.x; item < 384; item += gridDim.x) {
      const int l = item / 192, n0 = (item % 192) * 32;
      gemv9_item(sc, red, p.w_mod + (size_t)l * 1024 * 6144, 6144, n0, p.mod() + (size_t)l * 9 * 6144, 6144, p.b_mod + l * 6144, tid);
    }
  }
  __syncthreads();
  {
    float* tile = (float*)smem;
    constexpr int I_IN = 16 * 37, I_OUT = 16 * 16, I_UP = 16 * 64, I_DN = 64 * 16, I_KV = 2 * 8;
    constexpr int PER = I_IN + I_OUT + I_UP + I_DN + I_KV;
    for (int item = blockIdx.x; item < 2 * PER; item += gridDim.x) {
      const int l = item / PER;
      int r = item % PER;
      if (r < I_IN) { transpose_tile(p.w_in + (size_t)l * DM * DIN, DM, DIN, p.WinT() + (size_t)l * DINP * DM, r, tile, tid); continue; }
      r -= I_IN;
      if (r < I_OUT) { transpose_tile(p.w_out + (size_t)l * DM * DM, DM, DM, p.WoutT() + (size_t)l * DM * DM, r, tile, tid); continue; }
      r -= I_OUT;
      if (r < I_UP) { transpose_tile(p.w_up + (size_t)l * DM * DFF, DM, DFF, p.WupT() + (size_t)l * DFF * DM, r, tile, tid); continue; }
      r -= I_UP;
      if (r < I_DN) { transpose_tile(p.w_down + (size_t)l * DFF * DM, DFF, DM, p.WdownT() + (size_t)l * DM * DFF, r, tile, tid); continue; }
      r -= I_DN;
      transpose_tile(p.w_kv_b + (size_t)l * 128 * 512, 128, 512, p.WkvbT() + (size_t)l * 512 * 128, r, tile, tid);
    }
  }
  const int gt = blockIdx.x * NTHR + tid, gs = gridDim.x * NTHR;
  if (gt < 256) p.ctl()[gt] = 0u;
  for (int i = gt; i < 64 * 16; i += gs) {
    const int pos = i >> 4, f = i & 15;
    const float ang = (float)pos * exp2f(-(float)f * (L2_10000 / 16.f));
    p.ropeW()[pos * 32 + f] = __cosf(ang);
    p.ropeW()[pos * 32 + 16 + f] = __sinf(ang);
  }
  for (int i = gt; i < 64 * 8; i += gs) {
    const int pos = i >> 3, f = i & 7;
    const float ang = (float)pos * exp2f(-(float)f * (L2_10000 / 8.f));
    p.ropeM()[pos * 16 + f] = __cosf(ang);
    p.ropeM()[pos * 16 + 8 + f] = __sinf(ang);
  }
  for (int i = gt; i < 2 * (DINP - DIN) * DM / 8; i += gs) {
    const int l = i / ((DINP - DIN) * DM / 8), o = i % ((DINP - DIN) * DM / 8);
    *(uint4*)(p.WinT() + ((size_t)l * DINP + DIN) * DM + (size_t)o * 8) = make_uint4(0, 0, 0, 0);
  }
  for (int i = gt; i < 524288; i += gs) {
    const int d = i & 63, kv = (i >> 6) & 1, s = (i >> 7) & 255, l = (i >> 15) & 1, b = i >> 16;
    p.Kwin_l()[((size_t)((l * 8 + b) * 1280 + 1024 + s)) * 128 + kv * 64 + d] = f2bf(p.cache_win_k[i]);
    p.Vtwin_l()[((size_t)(((l * 8 + b) * 2 + kv) * 64 + d)) * 1280 + 1024 + s] = f2bf(p.cache_win_v[i]);
  }
  for (int i = gt; i < 524288; i += gs) {
    const int j = i & 127, s = (i >> 7) & 255, l = (i >> 15) & 1, b = i >> 16;
    p.ckvn()[((size_t)l * 18432 + 16384 + b * 256 + s) * 128 + j] = f2bf(p.cache_mla_ckv[i]);
  }
  for (int i = gt; i < 131072; i += gs) {
    const int j = i & 31, s = (i >> 5) & 255, l = (i >> 13) & 1, b = i >> 14;
    const bf16_t v = f2bf(p.cache_mla_krope[i]);
#pragma unroll
    for (int hh = 0; hh < 4; ++hh) p.Kmla_l()[((size_t)(((l * 8 + b) * 4 + hh) * 1280 + 1024 + s)) * 96 + 64 + j] = v;
  }
  for (int i = gt; i < 524288; i += gs) {
    const int e = i & 63, d = (i >> 6) & 63, hh = (i >> 12) & 3, dir = (i >> 14) & 1, l = (i >> 15) & 1, b = i >> 16;
    p.S0t()[((size_t)((((l * 8 + b) * 2 + dir) * 4 + hh) * 64 + e)) * 64 + d] = f2bf(p.state_ret[i]);
  }
}

struct RotOrder : pg8::StaticOrder {
  int rot;
  __device__ __forceinline__ bool next(int i, Unit& u) const {
    if (!pg8::StaticOrder::next(i, u)) return false;
    u.pn += rot; if (u.pn >= nN) u.pn -= nN;
    return true;
  }
};
template <class Epi>
__device__ __forceinline__ void big_gemm(unsigned char* smem, const bf16_t* A, const bf16_t* Bt, int N, int K, const Epi& E, const int wv, int rot = 0) {
  pg8::Gemm g{A, Bt, NTOK, N, K};
  RotOrder S;
  S.init(NTOK, N, (int)gridDim.x, my_bid());
  S.rot = rot;
  pg8::gemm_phase<Epi, RotOrder, true, true>((PG8_LAS unsigned char*)smem, g, S, E, wv);
}

#define GSYNC() grid.sync()
__global__ void __launch_bounds__(NTHR, 2) hybrid_fwd(P p_arg) {
  cg::grid_group grid = cg::this_grid();
  const kargp_t kp = (kargp_t)__builtin_amdgcn_kernarg_segment_ptr();
  const int wv = __builtin_amdgcn_readfirstlane((int)threadIdx.x >> 6);
  { const P p = load_params(kp); prep_phase(p, smem, wv); }
  GSYNC();
  { const P p = load_params(kp); norm0_phase(p, smem, wv); }
  GSYNC();
#pragma unroll
  for (int l = 0; l < 2; ++l) {
    { const P pc = load_params(kp); const int t0 = my_tid(wv);
      for (int i = t0; i < 64 * 32; i += NTHR) ((float*)(smem + LDS_ROPEW))[i] = pc.ropeW()[i];
      for (int i = t0; i < 64 * 16; i += NTHR) ((float*)(smem + LDS_ROPEM))[i] = pc.ropeM()[i];
      __syncthreads(); }
    { const P p = load_params(kp);
      big_gemm(smem, p.hbuf(), p.WinT() + (size_t)l * DINP * DM, DINP, DM, EpiIn8{p, l, kp}, wv, 8); }
    { const P p = load_params(kp); gemm_small(p.ckvn() + (size_t)l * 18432 * 128, 128, p.WkvbT() + (size_t)l * 512 * 128, 128, 18432, 512, 128, smem, EpiKvb{p, l}, wv, p.ctl() + 64 * l, p.ctl() + 128 + 64 * l); }
    GSYNC();
    { const P p = load_params(kp); attn_phase(p, l, smem, wv); }
    GSYNC();
    { const P p = load_params(kp); big_gemm(smem, p.mix(), p.WoutT() + (size_t)l * DM * DM, DM, DM, EpiOut8{p, l}, wv); }
    GSYNC();
    { const P p = load_params(kp); big_gemm(smem, p.hbuf(), p.WupT() + (size_t)l * DFF * DM, DFF, DM, EpiUp8{p, l}, wv); }
    GSYNC();
    { const P p = load_params(kp); big_gemm(smem, p.ubuf(), p.WdownT() + (size_t)l * DM * DFF, DM, DFF, EpiDown8{p, l}, wv); }
    GSYNC();
  }
  { const P p = load_params(kp); final_norm_phase(p, wv); }
}

extern "C" void kernel_launch(void* const* d_in, const int* in_sizes, int n_in, void* d_out, int out_size, void* d_ws, size_t ws_size,
                              hipStream_t stream) {
  static int grid_blocks = 0;
  if (grid_blocks == 0) {
    int dev = 0, cus = 0, per_cu = 0;
    (void)hipGetDevice(&dev);
    (void)hipDeviceGetAttribute(&cus, hipDeviceAttributeMultiprocessorCount, dev);
    (void)hipFuncSetAttribute((const void*)hybrid_fwd, hipFuncAttributeMaxDynamicSharedMemorySize, LDS_BYTES);
    (void)hipOccupancyMaxActiveBlocksPerMultiprocessor(&per_cu, (const void*)hybrid_fwd, NTHR, LDS_BYTES);
    if (per_cu < 1) { fprintf(stderr, "occupancy query returned %d\n", per_cu); per_cu = 1; }
    per_cu = 1;
    grid_blocks = cus * per_cu;
  }
  P p{};
  const float* const* in = (const float* const*)d_in;
  p.x_prompt = in[0]; p.x_sample = in[1]; p.cache_win_k = in[2]; p.cache_win_v = in[3]; p.cache_mla_ckv = in[4];
  p.cache_mla_krope = in[5]; p.state_ret = in[6]; p.c = in[7]; p.c_ctx = in[8]; p.w_mod = in[9]; p.b_mod = in[10];
  p.norm1 = in[11]; p.norm2 = in[12]; p.w_in = in[13]; p.win_sink = in[14]; p.ret_decay = in[15]; p.ret_gn = in[16];
  p.mla_kv_norm = in[17]; p.w_kv_b = in[18]; p.w_out = in[19]; p.w_up = in[20]; p.w_down = in[21]; p.final_norm = in[22];
  p.out = (float*)d_out;
  p.ws = (unsigned char*)d_ws;
  if (WS_END > ws_size) { fprintf(stderr, "kernel_launch: workspace too small: need %zu, have %zu\n", (size_t)WS_END, ws_size); return; }
  void* args[] = {&p};
  hipError_t e = hipLaunchCooperativeKernel((const void*)hybrid_fwd, dim3(grid_blocks), dim3(NTHR), args, LDS_BYTES, stream);
  if (e != hipSuccess) fprintf(stderr, "cooperative launch failed: %s (grid %d)\n", hipGetErrorString(e), grid_blocks);
}
```

```cpp
#include <hip/hip_runtime.h>
#include <hip/hip_cooperative_groups.h>
#include <cstdio>
#include <cstdint>
namespace cg = cooperative_groups;

__device__ __forceinline__ int lane_id() { return (int)__builtin_amdgcn_mbcnt_hi(~0u, __builtin_amdgcn_mbcnt_lo(~0u, 0u)); }

namespace pg8 {
#define PG8_LAS __attribute__((address_space(3)))
typedef unsigned short bf16_t;
typedef short bf16x8 __attribute__((ext_vector_type(8)));
typedef float f32x4 __attribute__((ext_vector_type(4)));
typedef unsigned u32x4 __attribute__((ext_vector_type(4)));
constexpr int BM = 256, BK = 64, HALF = 128, HTB = HALF * BK * 2  , STAGE_BYTES = 8 * HTB, NXCD = 8, WGM = 8;

__host__ __device__ __forceinline__ int lds_byte(int r, int c) { const int st = (r >> 4) * 2 + (c >> 5), rr = r & 15, cc = c & 31, ob = rr * 64 + cc * 2; return st * 1024 + (ob ^ (((ob >> 9) & 1) << 5)); }
__host__ __device__ __forceinline__ void stage_rc(int b, int& R, int& C) { const int st = b / 1024, sb = b % 1024, swz = sb ^ (((sb >> 9) & 1) << 5); R = (st >> 1) * 16 + swz / 64; C = (st & 1) * 32 + (swz % 64) / 2; }
__host__ __device__ __forceinline__ int perm32(int rho) { const int n = rho >> 4, i = rho & 15; return 8 * (i >> 2) + 4 * n + (i & 3); }

struct Unit { int pm, pn; };
struct Gemm { const bf16_t* A; const bf16_t* Bt; int M, N, K; };

struct StaticOrder {
    int nM, nN, nwg, G, c;
    __host__ __device__ void init(int M, int N, int G_, int c_) { nM = M / BM; nN = N / BM; nwg = nM * nN; G = G_; c = c_; }
    __host__ __device__ bool next(int i, Unit& u) const {
        const long L = (long)i * G + c; if (L >= nwg) return false;
        int wgid = (int)L; { const int q = nwg / NXCD, r = nwg % NXCD, xcd = wgid % NXCD, off = wgid / NXCD; wgid = (xcd < r ? xcd * (q + 1) : r * (q + 1) + (xcd - r) * q) + off; }
        const int nig = WGM * nN, gid = wgid / nig, fm = gid * WGM, gsz = (nM - fm) < WGM ? (nM - fm) : WGM;
        u.pm = fm + ((wgid % nig) % gsz); u.pn = (wgid % nig) / gsz; return true;
    }
    __device__ __forceinline__ void a_ready(const Unit&) const {}
    __device__ __forceinline__ void done(const Unit&) const {}
};
template <class Epi, class Sched, bool ALIGN_EPI = false, bool SP2 = false>
__device__ __forceinline__ void gemm_phase(PG8_LAS unsigned char* lds, const Gemm g, const Sched& S, const Epi& E, const int wvp) {
    const int wid = wvp, lane = lane_id(), tid = wid * 64 + lane, wr = wid >> 2, wc = wid & 3, fr = lane & 15, fq = lane >> 4;
    const int K = g.K, nt = K / BK;
    unsigned voffA[2], voffB[2];
#pragma unroll
    for (int i = 0; i < 2; ++i) { int R, C; stage_rc(tid * 16 + i * 8192, R, C); const int Rb = Epi::PERM ? ((R & ~31) + perm32(R & 31)) : R;
        voffA[i] = (unsigned)(R * K + C) * 2u; voffB[i] = (unsigned)(Rb * K + C) * 2u; }
    const size_t kstep = (size_t)(BK * 2);
    const size_t hstep = (size_t)HALF * K * 2;
    const size_t tstep = 2 * hstep;
    const unsigned ldsw = (unsigned)wid * 1024u;
    const int aoff = lds_byte(wr * 64 + fr, fq * 8), boff = lds_byte(wc * 32 + fr, fq * 8);
#define PG8_SA(b, h) (((b) * 2 + (h)) * HTB)
#define PG8_SB(b, h) ((4 + (b) * 2 + (h)) * HTB)
#define PG8_STAGE(bufoff, gbase, voff) do { _Pragma("unroll") for (int _i = 0; _i < 2; ++_i) \
        __builtin_amdgcn_global_load_lds((const unsigned*)((const char*)(gbase) + (voff)[_i]), (PG8_LAS unsigned*)(lds + (bufoff) + ldsw + _i * 8192), 16, 0, 0); } while (0)
#define PG8_LDA(dst, b, h) do { _Pragma("unroll") for (int m = 0; m < 4; ++m) _Pragma("unroll") for (int k = 0; k < 2; ++k) dst[m][k] = *(const PG8_LAS bf16x8*)(lds + PG8_SA(b, h) + aoff + m * 2048 + k * 1024); } while (0)
#define PG8_LDB(dst, b, h) do { _Pragma("unroll") for (int n = 0; n < 2; ++n) _Pragma("unroll") for (int k = 0; k < 2; ++k) dst[n][k] = *(const PG8_LAS bf16x8*)(lds + PG8_SB(b, h) + boff + n * 2048 + k * 1024); } while (0)
#define PG8_MMA(ai, bj, At, Bt) do { __builtin_amdgcn_s_setprio(1); _Pragma("unroll") for (int m = 0; m < 4; ++m) _Pragma("unroll") for (int n = 0; n < 2; ++n) _Pragma("unroll") for (int k = 0; k < 2; ++k) \
        acc[ai][bj][m][n] = __builtin_amdgcn_mfma_f32_16x16x32_bf16(Bt[n][k], At[m][k], acc[ai][bj][m][n], 0, 0, 0); __builtin_amdgcn_s_setprio(0); } while (0)
#define PG8_WAIT_V(n) asm volatile("s_waitcnt vmcnt(" #n ")" ::: "memory")
#define PG8_WAIT_L(n) asm volatile("s_waitcnt lgkmcnt(" #n ")" ::: "memory")
#define PG8_BAR __builtin_amdgcn_s_barrier()
#define PG8_SCHED __builtin_amdgcn_sched_barrier(0)
    Unit cur, nxt; int ui = 0;
    if (!S.next(0, cur)) return;
    f32x4 acc[2][2][4][2];
#pragma unroll
    for (int a = 0; a < 2; ++a)
#pragma unroll
        for (int b = 0; b < 2; ++b)
#pragma unroll
            for (int m = 0; m < 4; ++m)
#pragma unroll
                for (int n = 0; n < 2; ++n) acc[a][b][m][n] = (f32x4){0.f, 0.f, 0.f, 0.f};
    bf16x8 At[4][2], B0[2][2], B1[2][2];
    const char* cA = (const char*)g.A + (size_t)cur.pm * tstep; const char* cB = (const char*)g.Bt + (size_t)cur.pn * tstep;
    S.a_ready(cur);
    if constexpr (SP2) {
        PG8_STAGE(PG8_SB(0, 0), cB, voffB); PG8_STAGE(PG8_SB(0, 1), cB + hstep, voffB); PG8_STAGE(PG8_SA(0, 0), cA, voffA); PG8_STAGE(PG8_SA(0, 1), cA + hstep, voffA);
        if (wr == 1) PG8_BAR;
        PG8_WAIT_V(2); PG8_BAR;
        PG8_STAGE(PG8_SB(1, 0), cB + kstep, voffB); PG8_STAGE(PG8_SA(1, 0), cA + kstep, voffA); PG8_STAGE(PG8_SB(1, 1), cB + hstep + kstep, voffB);
        PG8_WAIT_V(6); PG8_BAR;
    } else {
        PG8_STAGE(PG8_SB(0, 0), cB, voffB); PG8_STAGE(PG8_SA(0, 0), cA, voffA); PG8_STAGE(PG8_SB(0, 1), cB + hstep, voffB); PG8_STAGE(PG8_SA(0, 1), cA + hstep, voffA);
        if (wr == 1) PG8_BAR;
        PG8_WAIT_V(4); PG8_BAR;
        PG8_STAGE(PG8_SB(1, 0), cB + kstep, voffB); PG8_STAGE(PG8_SA(1, 0), cA + kstep, voffA); PG8_STAGE(PG8_SB(1, 1), cB + hstep + kstep, voffB);
        PG8_WAIT_V(6); PG8_BAR;
    }
    for (;;) {
        const bool has_next = S.next(ui + 1, nxt);
        const char* nA = has_next ? (const char*)g.A + (size_t)nxt.pm * tstep : cA; const char* nB = has_next ? (const char*)g.Bt + (size_t)nxt.pn * tstep : cB;
        for (int t = 0; t < nt; t += 2) {
            const bool last = (t == nt - 2);
            const char* a1 = cA + (size_t)(t + 1) * kstep;
            const char* a2 = last ? nA : cA + (size_t)(t + 2) * kstep; const char* b2 = last ? nB : cB + (size_t)(t + 2) * kstep;
            const char* a3 = a2 + kstep; const char* b3 = b2 + kstep;
            if (last && has_next) S.a_ready(nxt);
            if constexpr (SP2) {
            PG8_LDB(B0, 0, 0); PG8_LDB(B1, 0, 1); PG8_SCHED; PG8_LDA(At, 0, 0); PG8_STAGE(PG8_SA(1, 1), a1 + hstep, voffA);
            PG8_WAIT_V(8); PG8_WAIT_L(0); PG8_BAR; PG8_MMA(0, 0, At, B0); PG8_MMA(0, 1, At, B1); PG8_BAR; PG8_SCHED;
            PG8_LDA(At, 0, 1); PG8_STAGE(PG8_SB(0, 0), b2, voffB); PG8_STAGE(PG8_SB(0, 1), b2 + hstep, voffB); PG8_STAGE(PG8_SA(0, 0), a2, voffA);
            PG8_WAIT_V(8); PG8_WAIT_L(0); PG8_BAR; PG8_MMA(1, 0, At, B0); PG8_MMA(1, 1, At, B1); PG8_BAR; PG8_SCHED;
            PG8_LDB(B0, 1, 0); PG8_LDB(B1, 1, 1); PG8_SCHED; PG8_LDA(At, 1, 0); PG8_STAGE(PG8_SA(0, 1), a2 + hstep, voffA);
            PG8_WAIT_V(8); PG8_WAIT_L(0); PG8_BAR; PG8_MMA(0, 0, At, B0); PG8_MMA(0, 1, At, B1); PG8_BAR; PG8_SCHED;
            PG8_LDA(At, 1, 1); PG8_STAGE(PG8_SB(1, 0), b3, voffB); PG8_STAGE(PG8_SB(1, 1), b3 + hstep, voffB); PG8_STAGE(PG8_SA(1, 0), a3, voffA);
            PG8_WAIT_V(8); PG8_WAIT_L(0); PG8_BAR; PG8_MMA(1, 0, At, B0); PG8_MMA(1, 1, At, B1); PG8_BAR; PG8_SCHED;
            } else {
            PG8_LDB(B0, 0, 0); PG8_SCHED; PG8_LDA(At, 0, 0); PG8_STAGE(PG8_SA(1, 1), a1 + hstep, voffA);
            PG8_WAIT_L(8); PG8_BAR; PG8_WAIT_L(0); PG8_MMA(0, 0, At, B0); PG8_BAR; PG8_SCHED;
            PG8_LDB(B1, 0, 1); PG8_STAGE(PG8_SB(0, 0), b2, voffB);
            PG8_BAR; PG8_WAIT_L(0); PG8_MMA(0, 1, At, B1); PG8_BAR;
            PG8_LDA(At, 0, 1); PG8_STAGE(PG8_SA(0, 0), a2, voffA);
            PG8_BAR; PG8_WAIT_L(0); PG8_MMA(1, 0, At, B0); PG8_BAR; PG8_SCHED;
            PG8_STAGE(PG8_SB(0, 1), b2 + hstep, voffB);
            PG8_WAIT_V(6); PG8_BAR; PG8_MMA(1, 1, At, B1); PG8_BAR;
            PG8_LDB(B0, 1, 0); PG8_SCHED; PG8_LDA(At, 1, 0); PG8_STAGE(PG8_SA(0, 1), a2 + hstep, voffA);
            PG8_WAIT_L(8); PG8_BAR; PG8_WAIT_L(0); PG8_MMA(0, 0, At, B0); PG8_BAR; PG8_SCHED;
            PG8_LDB(B1, 1, 1); PG8_STAGE(PG8_SB(1, 0), b3, voffB);
            PG8_BAR; PG8_WAIT_L(0); PG8_MMA(0, 1, At, B1); PG8_BAR;
            PG8_LDA(At, 1, 1); PG8_STAGE(PG8_SA(1, 0), a3, voffA);
            PG8_BAR; PG8_WAIT_L(0); PG8_MMA(1, 0, At, B0); PG8_BAR; PG8_SCHED;
            PG8_STAGE(PG8_SB(1, 1), b3 + hstep, voffB);
            PG8_WAIT_V(6); PG8_BAR; PG8_MMA(1, 1, At, B1); PG8_BAR;
            }
        }
        if constexpr (ALIGN_EPI) { if (wr == 0) PG8_BAR; }
        if constexpr (!Epi::AFTER_DRAIN) { E(acc, cur, wr, wc, fr, fq); S.done(cur); }
        if (!has_next) break;
#pragma unroll
        for (int a = 0; a < 2; ++a)
#pragma unroll
            for (int b = 0; b < 2; ++b)
#pragma unroll
                for (int m = 0; m < 4; ++m)
#pragma unroll
                    for (int n = 0; n < 2; ++n) acc[a][b][m][n] = (f32x4){0.f, 0.f, 0.f, 0.f};
        cur = nxt; cA = nA; cB = nB; ++ui;
        if constexpr (ALIGN_EPI) { if (wr == 1) PG8_BAR; }
    }
    PG8_WAIT_V(0);
    if constexpr (!ALIGN_EPI) { if (wr == 0) PG8_BAR; }
    PG8_BAR;
    if constexpr (Epi::AFTER_DRAIN) { E.fused(acc, cur, wr, wc, fr, fq, lds, wid, lane); S.done(cur); }
#undef PG8_SA
#undef PG8_SB
#undef PG8_STAGE
#undef PG8_LDA
#undef PG8_LDB
#undef PG8_MMA
#undef PG8_WAIT_V
#undef PG8_WAIT_L
#undef PG8_BAR
#undef PG8_SCHED
}
}


typedef unsigned short bf16_t;
typedef short bf16x8 __attribute__((ext_vector_type(8)));
typedef float f32x16 __attribute__((ext_vector_type(16)));
typedef pg8::f32x4 f32x4;
using pg8::Unit;

constexpr int NTHR = 512, NWV = 8;
constexpr int NTOK = 16384, NCTX = 8192, DM = 1024, DIN = 2336, DINP = 2560, DFF = 4096;
constexpr int LDS_RED = 131072;
constexpr int LDS_ROPEW = 131072 + 4096, LDS_ROPEM = LDS_ROPEW + 64 * 32 * 4;
constexpr int LDS_BYTES = LDS_ROPEM + 64 * 16 * 4;
constexpr float LOG2E = 1.4426950408889634f;
constexpr float L2_10000 = 13.287712379549449f;

#define AL256(x) (((x) + 255) & ~(size_t)255)
constexpr size_t OFF_mod = 0;
constexpr size_t OFF_ropeW = OFF_mod + AL256((size_t)2 * 9 * 6144 * 4);
constexpr size_t OFF_ropeM = OFF_ropeW + AL256((size_t)64 * 32 * 4);
constexpr size_t OFF_ctl = OFF_ropeM + AL256((size_t)64 * 16 * 4);
constexpr size_t OFF_rssA = OFF_ctl + AL256((size_t)256 * 4);
constexpr size_t OFF_rssB = OFF_rssA + AL256((size_t)NTOK * 16 * 4);
constexpr size_t OFF_sWin = OFF_rssB + AL256((size_t)NTOK * 16 * 4);
constexpr size_t OFF_sWup = OFF_sWin + AL256((size_t)2 * 9 * DINP * 4);
constexpr size_t OFF_WinT = OFF_sWup + AL256((size_t)2 * 9 * DFF * 4);
constexpr size_t OFF_WoutT = OFF_WinT + AL256((size_t)2 * DINP * DM * 2);
constexpr size_t OFF_WupT = OFF_WoutT + AL256((size_t)2 * DM * DM * 2);
constexpr size_t OFF_WdownT = OFF_WupT + AL256((size_t)2 * DFF * DM * 2);
constexpr size_t OFF_WkvbT = OFF_WdownT + AL256((size_t)2 * DM * DFF * 2);
constexpr size_t OFF_hbuf = OFF_WkvbT + AL256((size_t)2 * 512 * 128 * 2);
constexpr size_t OFF_Kwin_l = OFF_hbuf + AL256((size_t)NTOK * DM * 2);
constexpr size_t OFF_Vtwin_l = OFF_Kwin_l + AL256((size_t)2 * 8 * 1280 * 128 * 2);
constexpr size_t OFF_S0t = OFF_Vtwin_l + AL256((size_t)2 * 8 * 2 * 64 * 1280 * 2);
constexpr size_t OFF_ckvn = OFF_S0t + AL256((size_t)2 * 8 * 2 * 4 * 4096 * 2);
constexpr size_t OFF_Kmla_l = OFF_ckvn + AL256((size_t)2 * 18432 * 128 * 2);
constexpr size_t OFF_Vtmla_l = OFF_Kmla_l + AL256((size_t)2 * 8 * 4 * 1280 * 96 * 2);
constexpr size_t OFF_ubuf = OFF_Vtmla_l + AL256((size_t)2 * 8 * 4 * 64 * 1280 * 2);
constexpr size_t WS_END = OFF_ubuf + AL256((size_t)NTOK * DFF * 2);
constexpr size_t OFF_mix = OFF_ubuf + (size_t)96 * 1024 * 1024;
constexpr size_t OFF_Qwin = OFF_ubuf;
constexpr size_t OFF_Kwin_c = OFF_Qwin + AL256((size_t)NTOK * 512 * 2);
constexpr size_t OFF_Vtwin_c = OFF_Kwin_c + AL256((size_t)NCTX * 128 * 2);
constexpr size_t OFF_Qret = OFF_Vtwin_c + AL256((size_t)32 * 2 * 64 * 256 * 2);
constexpr size_t OFF_Kret = OFF_Qret + AL256((size_t)NTOK * 256 * 2);
constexpr size_t OFF_Gret = OFF_Kret + AL256((size_t)NTOK * 256 * 2);
constexpr size_t OFF_Vtret_c = OFF_Gret + AL256((size_t)NTOK * 256 * 2);
constexpr size_t OFF_Vtret_l = OFF_Vtret_c + AL256((size_t)32 * 4 * 64 * 256 * 2);
constexpr size_t OFF_Qmla = OFF_Vtret_l + AL256((size_t)8 * 4 * 64 * 1024 * 2);
constexpr size_t OFF_Kmla_c = OFF_Qmla + AL256((size_t)NTOK * 384 * 2);
constexpr size_t OFF_Vtmla_c = OFF_Kmla_c + AL256((size_t)32 * 4 * 256 * 96 * 2);
static_assert(OFF_Vtmla_c + (size_t)32 * 4 * 64 * 256 * 2 <= OFF_mix && OFF_mix + (size_t)NTOK * DM * 2 <= WS_END, "attention temporaries + mix must fit in the ubuf region");
static_assert(WS_END <= (size_t)256 * 1024 * 1024, "workspace must fit 256 MiB");

struct P {
  const float *x_prompt, *x_sample, *cache_win_k, *cache_win_v, *cache_mla_ckv, *cache_mla_krope, *state_ret,
      *c, *c_ctx, *w_mod, *b_mod, *norm1, *norm2, *w_in, *win_sink, *ret_decay, *ret_gn, *mla_kv_norm,
      *w_kv_b, *w_out, *w_up, *w_down, *final_norm;
  float* out;
  unsigned char* ws;
#define WSBUF(ty, name) __device__ __forceinline__ ty* name() const { return (ty*)(ws + OFF_##name); }
  WSBUF(unsigned, ctl) WSBUF(float, mod) WSBUF(float, ropeW) WSBUF(float, ropeM) WSBUF(float, rssA) WSBUF(float, rssB) WSBUF(float, sWin) WSBUF(float, sWup) WSBUF(bf16_t, WinT) WSBUF(bf16_t, WoutT) WSBUF(bf16_t, WupT) WSBUF(bf16_t, WdownT) WSBUF(bf16_t, WkvbT)
  WSBUF(bf16_t, hbuf) WSBUF(bf16_t, mix) WSBUF(bf16_t, Qwin) WSBUF(bf16_t, Kwin_c) WSBUF(bf16_t, Vtwin_c) WSBUF(bf16_t, Kwin_l)
  WSBUF(bf16_t, Vtwin_l) WSBUF(bf16_t, Qret) WSBUF(bf16_t, Kret) WSBUF(bf16_t, Gret) WSBUF(bf16_t, Vtret_c) WSBUF(bf16_t, Vtret_l)
  WSBUF(bf16_t, S0t) WSBUF(bf16_t, Qmla) WSBUF(bf16_t, ckvn) WSBUF(bf16_t, Kmla_c) WSBUF(bf16_t, Vtmla_c) WSBUF(bf16_t, Kmla_l)
  WSBUF(bf16_t, Vtmla_l) WSBUF(bf16_t, ubuf)
  __device__ __forceinline__ float* xw() const { return out; }
};

typedef float f32x2_t __attribute__((ext_vector_type(2)));
typedef __bf16 bf16x2_t __attribute__((ext_vector_type(2)));
__device__ __forceinline__ unsigned pk2(float lo, float hi) {
  const f32x2_t v = {lo, hi};
  const bf16x2_t b = __builtin_convertvector(v, bf16x2_t);
  return __builtin_bit_cast(unsigned, b);
}
__device__ __forceinline__ bf16_t f2bf(float f) { return (bf16_t)(pk2(f, 0.f) & 0xffffu); }
__device__ __forceinline__ float bf2f(bf16_t b) { return __uint_as_float(((unsigned)b) << 16); }
__device__ __forceinline__ float shx(float v, int mask, int ln) { return __int_as_float(__builtin_amdgcn_ds_bpermute((ln ^ mask) << 2, __float_as_int(v))); }
__device__ __forceinline__ float wave_sum(float v, int ln) {
#pragma unroll
  for (int o = 1; o < 64; o <<= 1) v += shx(v, o, ln);
  return v;
}
typedef const __attribute__((address_space(4))) unsigned char* kargp_t;
__device__ __forceinline__ P load_params(kargp_t kp) {
  asm volatile("" : "+s"(kp));
  P p;
  __builtin_memcpy(&p, kp, sizeof(P));
  return p;
}
__device__ __forceinline__ int my_tid(int wv) { int w = wv; asm volatile("" : "+s"(w)); int t = w * 64 + lane_id(); asm volatile("" : "+v"(t)); return t; }
__device__ __forceinline__ int my_bid() { int b = blockIdx.x; asm volatile("" : "+s"(b)); return b; }
__device__ __forceinline__ float fexp2(float x) { return __builtin_amdgcn_exp2f(x); }
__device__ __forceinline__ int mod_row(int m) { return m < NCTX ? 0 : 1 + ((m - NCTX) >> 10); }

__device__ __forceinline__ void st_rm_bf16(bf16_t* rp, int h, const f32x16& o) {
#pragma unroll
  for (int g = 0; g < 4; ++g) {
    uint2 u;
    u.x = pk2(o[4 * g], o[4 * g + 1]);
    u.y = pk2(o[4 * g + 2], o[4 * g + 3]);
    *(uint2*)(rp + 8 * g + 4 * h) = u;
  }
}
__device__ __forceinline__ void st_tr_bf16(bf16_t* bp, int stride, int h, const f32x16& o) {
#pragma unroll
  for (int i = 0; i < 16; ++i) bp[(size_t)((i & 3) + 8 * (i >> 2) + 4 * h) * stride] = f2bf(o[i]);
}

__device__ __forceinline__ void st8_bf16(bf16_t* rp, int fq, const f32x4& a, const f32x4& b) {
  *(uint2*)(rp + 4 * fq) = make_uint2(pk2(a[0], a[1]), pk2(a[2], a[3]));
  *(uint2*)(rp + 16 + 4 * fq) = make_uint2(pk2(b[0], b[1]), pk2(b[2], b[3]));
}
__device__ __forceinline__ void st8_f32(float* rp, int fq, const f32x4& a, const f32x4& b) {
  *(f32x4*)(rp + 4 * fq) = a;
  *(f32x4*)(rp + 16 + 4 * fq) = b;
}
__device__ __forceinline__ void st8_tr(bf16_t* bp, int stride, int fq, const f32x4& a, const f32x4& b) {
#pragma unroll
  for (int j = 0; j < 4; ++j) {
    bp[(size_t)(4 * fq + j) * stride] = f2bf(a[j]);
    bp[(size_t)(16 + 4 * fq + j) * stride] = f2bf(b[j]);
  }
}
__device__ __forceinline__ void rope8_win(f32x4& a, f32x4& b, int fq, const float* tab) {
  const f32x4 cs = *(const f32x4*)(tab + 4 * fq), sn = *(const f32x4*)(tab + 16 + 4 * fq);
  const f32x4 x = a, y = b;
  a = x * cs - y * sn;
  b = x * sn + y * cs;
}
__device__ __forceinline__ void rope8_mla(f32x4& a, f32x4& b, int fq, int ln, const float* tabr, const float* tabc) {
  const int fo = 4 * (fq & 1);
  {
    const f32x4 cs = *(const f32x4*)(tabr + fo), sn = *(const f32x4*)(tabr + 8 + fo);
#pragma unroll
    for (int j = 0; j < 4; ++j) { const float pa = shx(a[j], 32, ln); a[j] = fq < 2 ? a[j] * cs[j] - pa * sn[j] : pa * sn[j] + a[j] * cs[j]; }
  }
  asm volatile("" ::: "memory");
  {
    const f32x4 cs = *(const f32x4*)(tabc + fo), sn = *(const f32x4*)(tabc + 8 + fo);
#pragma unroll
    for (int j = 0; j < 4; ++j) { const float pb = shx(b[j], 32, ln); b[j] = fq < 2 ? b[j] * cs[j] - pb * sn[j] : pb * sn[j] + b[j] * cs[j]; }
  }
}

__device__ __forceinline__ float row_rstd(const float* rss, int m) {
  const f32x4 a = *(const f32x4*)(rss + (size_t)m * 16), b = *(const f32x4*)(rss + (size_t)m * 16 + 4);
  const f32x4 c = *(const f32x4*)(rss + (size_t)m * 16 + 8), d = *(const f32x4*)(rss + (size_t)m * 16 + 12);
  const f32x4 s = (a + b) + (c + d);
  return rsqrtf(((s[0] + s[1]) + (s[2] + s[3])) * (1.f / 1024.f) + 1e-6f);
}

typedef f32x4 acc_t[2][2][4][2];
template <int V> struct IC { static constexpr int value = V; };
extern __shared__ __attribute__((aligned(16))) unsigned char smem[];
struct EpiIn8 {
  static constexpr bool PERM = false, AFTER_DRAIN = false;
  P p0; int l; kargp_t kp;
  __device__ __forceinline__ void operator()(const acc_t& acc, const Unit& u, int wr, int wc, int fr_in, int fq_in) const {
    int fr = fr_in; asm volatile("" : "+v"(fr));
    int fq = fq_in; asm volatile("" : "+v"(fq));
    const int ln = fq * 16 + fr; (void)ln;
    P p = p0; asm volatile("" : "+s"(p.ws), "+s"(p.out));
    const bool lat = u.pm >= 32;
    const int rbase = u.pm * 256 + wr * 64 + fr;
#define ROWS_BEGIN _Pragma("unroll") for (int ai = 0; ai < 2; ++ai) _Pragma("unroll") for (int mm = 0; mm < 4; ++mm) { \
      int m = rbase + ai * 128 + mm * 16; asm volatile("" : "+v"(m)); int b, s; \
      if (!lat) { b = m >> 8; s = m & 255; } else { b = (m - NCTX) >> 10; s = (m - NCTX) & 1023; } \
      const float rsd = rsdv[ai][mm]; \
      f32x4 v0 = acc[ai][bj][mm][0] * rsd + sw0, v1 = acc[ai][bj][mm][1] * rsd + sw1; (void)b; (void)s;
#define ROWS_END }
    float rsdv[2][4];
    {
      const float* rss = p.rssA();
#pragma unroll
      for (int ai = 0; ai < 2; ++ai)
#pragma unroll
        for (int mm = 0; mm < 4; ++mm) rsdv[ai][mm] = row_rstd(rss, rbase + ai * 128 + mm * 16);
    }
    auto do_half = [&](auto BJ) {
      constexpr int bj = decltype(BJ)::value;
      const int nb = u.pn * 256 + bj * 128 + wc * 32;
      if (nb >= DIN) return;
      const float* swp = p.sWin() + ((size_t)(l * 9 + (lat ? 1 + ((u.pm - 32) >> 2) : 0))) * DINP + nb;
      const f32x4 sw0 = *(const f32x4*)(swp + 4 * fq), sw1 = *(const f32x4*)(swp + 16 + 4 * fq);
      if (nb < 512) {
        ROWS_BEGIN
          if (lat) rope8_win(v0, v1, fq, (const float*)(smem + LDS_ROPEW) + ((nb & 32) ? (s & 63) : (s >> 6)) * 32);
          st8_bf16(p.Qwin() + (size_t)m * 512 + nb, fq, v0, v1);
        ROWS_END
      } else if (nb < 640) {
        const int c = nb - 512;
        ROWS_BEGIN
          if (!lat) {
            st8_f32(p.out + 16777216 + ((size_t)((b * 2 + l) * 256 + s)) * 128 + c, fq, v0, v1);
            st8_bf16(p.Kwin_c() + (size_t)m * 128 + c, fq, v0, v1);
          } else {
            rope8_win(v0, v1, fq, (const float*)(smem + LDS_ROPEW) + ((nb & 32) ? (s & 63) : (s >> 6)) * 32);
            st8_bf16(p.Kwin_l() + ((size_t)((l * 8 + b) * 1280 + s)) * 128 + c, fq, v0, v1);
          }
        ROWS_END
      } else if (nb < 768) {
        const int c = nb - 640, kv = c >> 6, d0 = c & 63;
        ROWS_BEGIN
          if (!lat) {
            st8_f32(p.out + 18874368 + ((size_t)((b * 2 + l) * 256 + s)) * 128 + c, fq, v0, v1);
            st8_tr(p.Vtwin_c() + ((size_t)((b * 2 + kv) * 64 + d0)) * 256 + s, 256, fq, v0, v1);
          } else {
            st8_tr(p.Vtwin_l() + ((size_t)(((l * 8 + b) * 2 + kv) * 64 + d0)) * 1280 + s, 1280, fq, v0, v1);
          }
        ROWS_END
      } else if (nb < 1024) {
        ROWS_BEGIN
          st8_bf16(p.Qret() + (size_t)m * 256 + (nb - 768), fq, v0, v1);
        ROWS_END
      } else if (nb < 1280) {
        ROWS_BEGIN
          st8_bf16(p.Kret() + (size_t)m * 256 + (nb - 1024), fq, v0, v1);
        ROWS_END
      } else if (nb < 1536) {
        const int c = nb - 1280, hh = c >> 6, d0 = c & 63;
        ROWS_BEGIN
          if (!lat) st8_tr(p.Vtret_c() + ((size_t)((b * 4 + hh) * 64 + d0)) * 256 + s, 256, fq, v0, v1);
          else st8_tr(p.Vtret_l() + ((size_t)((b * 4 + hh) * 64 + d0)) * 1024 + s, 1024, fq, v0, v1);
        ROWS_END
      } else if (nb < 1792) {
        ROWS_BEGIN
          st8_bf16(p.Gret() + (size_t)m * 256 + (nb - 1536), fq, v0, v1);
        ROWS_END
      } else if (nb < 2176) {
        const int c = nb - 1792;
        const bool rp = lat && (c % 96) == 64;
        ROWS_BEGIN
          if (rp) rope8_mla(v0, v1, fq, ln, (const float*)(smem + LDS_ROPEM) + (s >> 6) * 16, (const float*)(smem + LDS_ROPEM) + (s & 63) * 16);
          st8_bf16(p.Qmla() + (size_t)m * 384 + c, fq, v0, v1);
        ROWS_END
      } else if (nb < 2304) {
        const int c = nb - 2176;
        float* red = (float*)(smem + LDS_RED);
        kargp_t k2 = kp; asm volatile("" : "+s"(k2));
        const float* g = ((const __attribute__((address_space(4))) P*)k2)->mla_kv_norm + l * 128 + c;
        const f32x4 g0 = *(const f32x4*)(g + 4 * fq), g1 = *(const f32x4*)(g + 16 + 4 * fq);
#pragma unroll
        for (int ai = 0; ai < 2; ++ai)
#pragma unroll
          for (int mm = 0; mm < 4; ++mm) {
            const float rsd0 = rsdv[ai][mm];
            const f32x4 a = acc[ai][bj][mm][0] * rsd0 + sw0, b4 = acc[ai][bj][mm][1] * rsd0 + sw1;
            float ss = a[0] * a[0] + a[1] * a[1] + a[2] * a[2] + a[3] * a[3] + b4[0] * b4[0] + b4[1] * b4[1] + b4[2] * b4[2] + b4[3] * b4[3];
            ss += shx(ss, 16, ln);
            ss += shx(ss, 32, ln);
            if (fq == 0) red[wc * 256 + ai * 128 + wr * 64 + mm * 16 + fr] = ss;
          }
        asm volatile("s_waitcnt lgkmcnt(0)" ::: "memory");
        __builtin_amdgcn_s_barrier();
        ROWS_BEGIN
          const int rt = ai * 128 + wr * 64 + mm * 16 + fr;
          const float rsv = rsqrtf((red[rt] + red[256 + rt] + red[512 + rt] + red[768 + rt]) * (1.f / 128.f) + 1e-6f);
          v0 = v0 * rsv * g0;
          v1 = v1 * rsv * g1;
          st8_bf16(p.ckvn() + ((size_t)l * 18432 + m) * 128 + c, fq, v0, v1);
          if (!lat) st8_f32(p.out + 20971520 + ((size_t)((b * 2 + l) * 256 + s)) * 128 + c, fq, v0, v1);
        ROWS_END
        asm volatile("s_waitcnt vmcnt(0) lgkmcnt(0)" ::: "memory");
        __builtin_amdgcn_s_barrier();
        if (wr == 0 && wc == 0 && ln == 0) {
          __builtin_amdgcn_fence(__ATOMIC_RELEASE, "agent");
          asm volatile("s_waitcnt vmcnt(0)" ::: "memory");
          __hip_atomic_fetch_add(p.ctl() + 64 * l, 1u, __ATOMIC_RELAXED, __HIP_MEMORY_SCOPE_AGENT);
        }
      } else {
        ROWS_BEGIN
          if (!lat) {
            st8_f32(p.out + 23068672 + ((size_t)((b * 2 + l) * 256 + s)) * 32, fq, v0, v1);
#pragma unroll
            for (int hh = 0; hh < 4; ++hh) st8_bf16(p.Kmla_c() + ((size_t)((b * 4 + hh) * 256 + s)) * 96 + 64, fq, v0, v1);
          } else {
            rope8_mla(v0, v1, fq, ln, (const float*)(smem + LDS_ROPEM) + (s >> 6) * 16, (const float*)(smem + LDS_ROPEM) + (s & 63) * 16);
#pragma unroll
            for (int hh = 0; hh < 4; ++hh) st8_bf16(p.Kmla_l() + ((size_t)(((l * 8 + b) * 4 + hh) * 1280 + s)) * 96 + 64, fq, v0, v1);
          }
        ROWS_END
      }
    };
    do_half(IC<0>{});
    do_half(IC<1>{});
#undef ROWS_BEGIN
#undef ROWS_END
  }
};

struct EpiOut8 {
  static constexpr bool PERM = true, AFTER_DRAIN = false;
  P p0; int l;
  __device__ __forceinline__ void operator()(const acc_t& acc, const Unit& u, int wr, int wc, int fr_in, int fq_in) const {
    int fr = fr_in; asm volatile("" : "+v"(fr));
    int fq = fq_in; asm volatile("" : "+v"(fq));
    const int ln = fq * 16 + fr; (void)ln;
    P p = p0; asm volatile("" : "+s"(p.ws), "+s"(p.out));
    const int rbase = u.pm * 256 + wr * 64 + fr;
    const int cb = u.pn * 256 + wc * 32 + 8 * fq;
    const float* md = p.mod() + ((size_t)(l * 9 + mod_row(u.pm * 256))) * 6144;
    const float* gate = md + 2 * 1024; const float* sc2 = md + 4 * 1024; const float* g2 = p.norm2 + l * DM;
#pragma unroll
    for (int ap = 0; ap < 4; ++ap) {
      constexpr int dummy = 0; (void)dummy;
      const int ai = ap >> 1, m2 = (ap & 1) * 2;
      int mb = rbase + ai * 128 + m2 * 16; asm volatile("" : "+v"(mb));
      f32x4 xv[2][2][2];
#pragma unroll
      for (int mq = 0; mq < 2; ++mq) {
        const int mm = m2 + mq;
        const int m = mb + mq * 16;
        if (l == 0) {
          const float* xr = m < NCTX ? p.x_prompt + (size_t)m * DM : p.x_sample + (size_t)(m - NCTX) * DM;
#pragma unroll
          for (int bj = 0; bj < 2; ++bj)
#pragma unroll
            for (int n = 0; n < 2; ++n) xv[mq][bj][n] = *(const f32x4*)(xr + cb + bj * 128 + n * 4);
        } else {
          const bf16_t* hr = p.hbuf() + (size_t)m * DM;
#pragma unroll
          for (int bj = 0; bj < 2; ++bj)
#pragma unroll
            for (int n = 0; n < 2; ++n) {
              const int c = cb + bj * 128 + n * 4;
              const uint2 hq = *(const uint2*)(hr + c);
              const f32x4 q1 = *(const f32x4*)(p.norm1 + DM + c) * (*(const f32x4*)(md + 1 * 1024 + c) + 1.f);
              f32x4 xm;
              xm[0] = __uint_as_float(hq.x << 16) * __builtin_amdgcn_rcpf(q1[0]); xm[1] = __uint_as_float(hq.x & 0xffff0000u) * __builtin_amdgcn_rcpf(q1[1]);
              xm[2] = __uint_as_float(hq.y << 16) * __builtin_amdgcn_rcpf(q1[2]); xm[3] = __uint_as_float(hq.y & 0xffff0000u) * __builtin_amdgcn_rcpf(q1[3]);
              xv[mq][bj][n] = xm;
            }
        }
      }
#pragma unroll
      for (int mq = 0; mq < 2; ++mq) {
        const int mm = m2 + mq;
        const int m = mb + mq * 16;
        bf16_t* ho = p.hbuf() + (size_t)m * DM;
        float ss = 0.f;
#pragma unroll
        for (int bj = 0; bj < 2; ++bj)
#pragma unroll
          for (int n = 0; n < 2; ++n) {
            const int c = cb + bj * 128 + n * 4;
            const f32x4 xn = xv[mq][bj][n] + *(const f32x4*)(gate + c) * acc[ai][bj][mm][n];
            const f32x4 hv = xn * (*(const f32x4*)(g2 + c) * (*(const f32x4*)(sc2 + c) + 1.f));
            *(uint2*)(ho + c) = make_uint2(pk2(hv[0], hv[1]), pk2(hv[2], hv[3]));
            ss += (xn[0] * xn[0] + xn[1] * xn[1]) + (xn[2] * xn[2] + xn[3] * xn[3]);
          }
        ss += shx(ss, 16, ln);
        ss += shx(ss, 32, ln);
        if (fq == 0) p.rssB()[(size_t)m * 16 + u.pn * 4 + wc] = ss;
      }
      asm volatile("" ::: "memory");
    }
  }
};
struct EpiUp8 {
  static constexpr bool PERM = true, AFTER_DRAIN = false;
  P p0; int l;
  __device__ __forceinline__ void operator()(const acc_t& acc, const Unit& u, int wr, int wc, int fr_in, int fq_in) const {
    int fr = fr_in; asm volatile("" : "+v"(fr));
    int fq = fq_in; asm volatile("" : "+v"(fq));
    const int ln = fq * 16 + fr; (void)ln;
    P p = p0; asm volatile("" : "+s"(p.ws), "+s"(p.out));
    const int rbase = u.pm * 256 + wr * 64 + fr;
    const int cb = u.pn * 256 + wc * 32 + 8 * fq;
    const float* swp = p.sWup() + ((size_t)(l * 9 + mod_row(u.pm * 256))) * DFF;
    float rsdv[2][4];
#pragma unroll
    for (int ai = 0; ai < 2; ++ai)
#pragma unroll
      for (int mm = 0; mm < 4; ++mm) rsdv[ai][mm] = row_rstd(p.rssB(), rbase + ai * 128 + mm * 16);
    f32x4 swv[2][2];
#pragma unroll
    for (int bj = 0; bj < 2; ++bj)
#pragma unroll
      for (int n = 0; n < 2; ++n) swv[bj][n] = *(const f32x4*)(swp + cb + bj * 128 + n * 4);
#pragma unroll
    for (int ai = 0; ai < 2; ++ai)
#pragma unroll
      for (int mm = 0; mm < 4; ++mm) {
        int m = rbase + ai * 128 + mm * 16; asm volatile("" : "+v"(m));
        bf16_t* uo = p.ubuf() + (size_t)m * DFF;
        const float rsd = rsdv[ai][mm];
#pragma unroll
        for (int bj = 0; bj < 2; ++bj) {
          f32x4 t0 = acc[ai][bj][mm][0] * rsd + swv[bj][0], t1 = acc[ai][bj][mm][1] * rsd + swv[bj][1];
#pragma unroll
          for (int j = 0; j < 4; ++j) { const float a = fmaxf(t0[j], 0.f), b = fmaxf(t1[j], 0.f); t0[j] = a * a; t1[j] = b * b; }
          *(uint4*)(uo + cb + bj * 128) = make_uint4(pk2(t0[0], t0[1]), pk2(t0[2], t0[3]), pk2(t1[0], t1[1]), pk2(t1[2], t1[3]));
        }
      }
  }
};
struct EpiDown8 {
  static constexpr bool PERM = true, AFTER_DRAIN = false;
  P p0; int l;
  __device__ __forceinline__ void operator()(const acc_t& acc, const Unit& u, int wr, int wc, int fr_in, int fq_in) const {
    int fr = fr_in; asm volatile("" : "+v"(fr));
    int fq = fq_in; asm volatile("" : "+v"(fq));
    const int ln = fq * 16 + fr; (void)ln;
    P p = p0; asm volatile("" : "+s"(p.ws), "+s"(p.out));
    const int rbase = u.pm * 256 + wr * 64 + fr;
    const int cb = u.pn * 256 + wc * 32 + 8 * fq;
    const int r = mod_row(u.pm * 256);
    const float* md = p.mod() + ((size_t)(l * 9 + r)) * 6144;
    const float* gate = md + 5 * 1024; const float* sc2 = md + 4 * 1024; const float* g2 = p.norm2 + l * DM;
    const float* sc1 = p.mod() + ((size_t)(9 + r)) * 6144 + 1 * 1024;
    const float* g1 = p.norm1 + DM;
    f32x4 riv[2][2];
#pragma unroll
    for (int bj = 0; bj < 2; ++bj)
#pragma unroll
      for (int n = 0; n < 2; ++n) {
        const int c = cb + bj * 128 + n * 4;
        const f32x4 q2 = *(const f32x4*)(g2 + c) * (*(const f32x4*)(sc2 + c) + 1.f);
#pragma unroll
        for (int j = 0; j < 4; ++j) riv[bj][n][j] = __builtin_amdgcn_rcpf(q2[j]);
      }
#pragma unroll
    for (int ap = 0; ap < 4; ++ap) {
      const int ai = ap >> 1, m2 = (ap & 1) * 2;
      int mb = rbase + ai * 128 + m2 * 16; asm volatile("" : "+v"(mb));
      uint2 hvv[2][2][2];
#pragma unroll
      for (int mq = 0; mq < 2; ++mq) {
        const bf16_t* hr = p.hbuf() + (size_t)(mb + mq * 16) * DM;
#pragma unroll
        for (int bj = 0; bj < 2; ++bj)
#pragma unroll
          for (int n = 0; n < 2; ++n) hvv[mq][bj][n] = *(const uint2*)(hr + cb + bj * 128 + n * 4);
      }
#pragma unroll
      for (int mq = 0; mq < 2; ++mq) {
        const int mm = m2 + mq;
        const int m = mb + mq * 16;
        float* xo = p.xw() + (size_t)m * DM;
        bf16_t* ho = p.hbuf() + (size_t)m * DM;
        float ss = 0.f;
#pragma unroll
        for (int bj = 0; bj < 2; ++bj)
#pragma unroll
          for (int n = 0; n < 2; ++n) {
            const int c = cb + bj * 128 + n * 4;
            const uint2 hq = hvv[mq][bj][n];
            f32x4 xm;
            xm[0] = __uint_as_float(hq.x << 16); xm[1] = __uint_as_float(hq.x & 0xffff0000u);
            xm[2] = __uint_as_float(hq.y << 16); xm[3] = __uint_as_float(hq.y & 0xffff0000u);
            const f32x4 xn = xm * riv[bj][n] + *(const f32x4*)(gate + c) * acc[ai][bj][mm][n];
            if (l != 0) *(f32x4*)(xo + c) = xn;
            if (l == 0) {
              const f32x4 hv = xn * (*(const f32x4*)(g1 + c) * (*(const f32x4*)(sc1 + c) + 1.f));
              *(uint2*)(ho + c) = make_uint2(pk2(hv[0], hv[1]), pk2(hv[2], hv[3]));
              ss += (xn[0] * xn[0] + xn[1] * xn[1]) + (xn[2] * xn[2] + xn[3] * xn[3]);
            }
          }
        if (l == 0) {
          ss += shx(ss, 16, ln);
          ss += shx(ss, 32, ln);
          if (fq == 0) p.rssA()[(size_t)m * 16 + u.pn * 4 + wc] = ss;
        }
      }
      asm volatile("" ::: "memory");
    }
  }
};

struct EpiKvb {
  P p; int l;
  __device__ __forceinline__ void operator()(int m, int nb, int h, const f32x16& v) const {
    const int hh = nb >> 7, j0 = nb & 127;
    bf16_t* Kb; bf16_t* Vb; int S, key;
    if (m < NCTX) {
      const int b = m >> 8; key = m & 255; S = 256;
      Kb = p.Kmla_c() + ((size_t)((b * 4 + hh) * 256)) * 96;
      Vb = p.Vtmla_c() + ((size_t)((b * 4 + hh) * 64)) * 256;
    } else {
      int b;
      if (m < NTOK) { b = (m - NCTX) >> 10; key = (m - NCTX) & 1023; }
      else { b = (m - NTOK) >> 8; key = 1024 + ((m - NTOK) & 255); }
      S = 1280;
      Kb = p.Kmla_l() + ((size_t)(((l * 8 + b) * 4 + hh) * 1280)) * 96;
      Vb = p.Vtmla_l() + ((size_t)(((l * 8 + b) * 4 + hh) * 64)) * 1280;
    }
    if (j0 < 64) st_rm_bf16(Kb + (size_t)key * 96 + j0, h, v);
    else st_tr_bf16(Vb + (size_t)(j0 - 64) * S + key, S, h, v);
  }
};

template <class Epi>
__device__ __forceinline__ void gemm_small(const bf16_t* __restrict__ A, int lda, const bf16_t* __restrict__ W, int ldw,
                                           int M, int N, int K, unsigned char* smem, const Epi& epi, const int wv, unsigned* ready, unsigned* ticket) {
  constexpr int TA = 256 * 72, TW = 128 * 72;
  bf16_t* sb = (bf16_t*)smem;
  const int tid = my_tid(wv), bid = my_bid(), lane = tid & 63, wave = tid >> 6;
  const int wm = wave >> 1, wn = wave & 1, r = lane & 31, h = lane >> 5;
  const int MT = M >> 8, NT = N >> 7, ntiles = MT * NT, nk = K >> 6;
  const int lc = tid & 7, lr = tid >> 3;
  (void)bid;
  if (tid == 0) {
    unsigned polls = 0;
    while (__hip_atomic_load(ready, __ATOMIC_RELAXED, __HIP_MEMORY_SCOPE_AGENT) < 64u && ++polls < (1u << 22)) __builtin_amdgcn_s_sleep(8);
    __builtin_amdgcn_fence(__ATOMIC_ACQUIRE, "agent");
    asm volatile("s_waitcnt vmcnt(0)" ::: "memory");
  }
  __syncthreads();
  volatile int* tks = (volatile int*)(smem + LDS_RED + 2048);
  for (;;) {
    __syncthreads();
    if (tid == 0) *tks = (int)__hip_atomic_fetch_add(ticket, 1u, __ATOMIC_RELAXED, __HIP_MEMORY_SCOPE_AGENT);
    __syncthreads();
    const int tile = *tks;
    if (tile >= ntiles) break;
    const int m0 = (tile % MT) << 8, n0 = (tile / MT) << 7;
    f32x16 acc[2][2];
#pragma unroll
    for (int a = 0; a < 2; ++a)
#pragma unroll
      for (int b = 0; b < 2; ++b)
#pragma unroll
        for (int i = 0; i < 16; ++i) acc[a][b][i] = 0.f;
    uint4 ra[4], rw[2];
    const bf16_t* Ap = A + (size_t)(m0 + lr) * lda + lc * 8;
    const bf16_t* Wp = W + (size_t)(n0 + lr) * ldw + lc * 8;
    auto gload = [&](int kt) {
#pragma unroll
      for (int i = 0; i < 4; ++i) ra[i] = *(const uint4*)(Ap + (size_t)(64 * i) * lda + kt * 64);
#pragma unroll
      for (int i = 0; i < 2; ++i) rw[i] = *(const uint4*)(Wp + (size_t)(64 * i) * ldw + kt * 64);
    };
    auto swrite = [&](int bsel) {
      bf16_t* sA = sb + bsel * (TA + TW); bf16_t* sW = sA + TA;
#pragma unroll
      for (int i = 0; i < 4; ++i) *(uint4*)(sA + (lr + 64 * i) * 72 + lc * 8) = ra[i];
#pragma unroll
      for (int i = 0; i < 2; ++i) *(uint4*)(sW + (lr + 64 * i) * 72 + lc * 8) = rw[i];
    };
    __syncthreads();
    gload(0); swrite(0);
    __syncthreads();
    for (int kt = 0; kt < nk; ++kt) {
      if (kt + 1 < nk) gload(kt + 1);
      const bf16_t* sA = sb + (kt & 1) * (TA + TW); const bf16_t* sW = sA + TA;
#pragma unroll
      for (int ks = 0; ks < 4; ++ks) {
        bf16x8 wf[2], af[2];
#pragma unroll
        for (int i = 0; i < 2; ++i) {
          wf[i] = *(const bf16x8*)(sW + (wn * 64 + i * 32 + r) * 72 + ks * 16 + h * 8);
          af[i] = *(const bf16x8*)(sA + (wm * 64 + i * 32 + r) * 72 + ks * 16 + h * 8);
        }
#pragma unroll
        for (int a = 0; a < 2; ++a)
#pragma unroll
          for (int b = 0; b < 2; ++b) acc[a][b] = __builtin_amdgcn_mfma_f32_32x32x16_bf16(wf[a], af[b], acc[a][b], 0, 0, 0);
      }
      if (kt + 1 < nk) swrite((kt + 1) & 1);
      __syncthreads();
    }
#pragma unroll
    for (int a = 0; a < 2; ++a)
#pragma unroll
      for (int b = 0; b < 2; ++b) epi(m0 + wm * 64 + b * 32 + r, n0 + wn * 64 + a * 32, h, acc[a][b]);
  }
}

struct AttnItem {
  const bf16_t* Q; int qs;
  const bf16_t* K; int ks;
  const bf16_t* Vt; int vs;
  int t0, t1, t2, t3;
  int qpos0, T;
  float scale, sink_l2; int has_sink;
  float lgf, lgb;
  const bf16_t *S0f, *S0b;
  const bf16_t* G; const float* gn;
  bf16_t* out;
  float* sout;
};

template <int DQK, int MODE>
__device__ __forceinline__ void attn_item(const AttnItem& it, unsigned char* smem, const int wv) {
  constexpr int KSTR = DQK + 8, NKS = DQK / 16, VSTR = 68, KCH = DQK / 8;
  bf16_t* Ks = (bf16_t*)smem;
  bf16_t* Vs = Ks + 64 * KSTR;
  const int tid = my_tid(wv), lane = tid & 63, wave = tid >> 6, r = lane & 31, h = lane >> 5;
  const int qrow = wave * 32 + r;
  bf16x8 qf[NKS];
  if constexpr (MODE == 3) {
    const int dq = (wave & 1) * 32 + r;
#pragma unroll
    for (int ks = 0; ks < NKS; ++ks) {
      const int e = dq - (ks * 16 + h * 8);
      uint4 v;
      v.x = e == 0 ? 0x3F80u : (e == 1 ? 0x3F800000u : 0u);
      v.y = e == 2 ? 0x3F80u : (e == 3 ? 0x3F800000u : 0u);
      v.z = e == 4 ? 0x3F80u : (e == 5 ? 0x3F800000u : 0u);
      v.w = e == 6 ? 0x3F80u : (e == 7 ? 0x3F800000u : 0u);
      qf[ks] = __builtin_bit_cast(bf16x8, v);
    }
  } else {
#pragma unroll
    for (int ks = 0; ks < NKS; ++ks) qf[ks] = *(const bf16x8*)(it.Q + (size_t)qrow * it.qs + ks * 16 + h * 8);
  }
  f32x16 o0, o1;
#pragma unroll
  for (int i = 0; i < 16; ++i) { o0[i] = 0.f; o1[i] = 0.f; }
  float mrun = it.has_sink ? it.sink_l2 : -1e30f, lrun = 0.f;
  const int qp = it.qpos0 + qrow;
  const int n1 = it.t1 - it.t0, ntl = n1 + (it.t3 - it.t2);
  constexpr int BUFE = 64 * KSTR + 64 * VSTR;
  const int krow0 = tid / KCH, kch0 = tid % KCH, krow1 = (tid + NTHR) / KCH, kch1 = (tid + NTHR) % KCH;
  const bool k2 = (KCH == 12) && (tid + NTHR < 64 * KCH);
  const int vrow = tid >> 3, vch = tid & 7;
  uint4 rk0, rk1, rv;
  auto tile_of = [&](int ti) { return ti < n1 ? it.t0 + ti : it.t2 + (ti - n1); };
  auto gload = [&](int t) {
    const bool stt = (MODE == 2) && (t >= 16);
    if (!stt) {
      const int key0 = t * 64;
      rk0 = *(const uint4*)(it.K + (size_t)(key0 + krow0) * it.ks + kch0 * 8);
      if (k2) rk1 = *(const uint4*)(it.K + (size_t)(key0 + krow1) * it.ks + kch1 * 8);
      rv = *(const uint4*)(it.Vt + (size_t)vrow * it.vs + key0 + vch * 8);
    } else {
      const bf16_t* S = (t == 16) ? it.S0f : it.S0b;
      const int e = krow0 - kch0 * 8;
      rk0.x = e == 0 ? 0x3F80u : (e == 1 ? 0x3F800000u : 0u);
      rk0.y = e == 2 ? 0x3F80u : (e == 3 ? 0x3F800000u : 0u);
      rk0.z = e == 4 ? 0x3F80u : (e == 5 ? 0x3F800000u : 0u);
      rk0.w = e == 6 ? 0x3F80u : (e == 7 ? 0x3F800000u : 0u);
      rv = *(const uint4*)(S + (size_t)vrow * 64 + vch * 8);
    }
  };
  auto swrite = [&](int bsel) {
    bf16_t* Kb = Ks + bsel * BUFE; bf16_t* Vb = Kb + 64 * KSTR;
    *(uint4*)(Kb + krow0 * KSTR + kch0 * 8) = rk0;
    if (k2) *(uint4*)(Kb + krow1 * KSTR + kch1 * 8) = rk1;
    uint2* d = (uint2*)(Vb + vrow * VSTR + vch * 8);
    d[0] = make_uint2(rv.x, rv.y); d[1] = make_uint2(rv.z, rv.w);
  };
  __syncthreads();
  gload(tile_of(0)); swrite(0);
  __syncthreads();
  for (int ti = 0; ti < ntl; ++ti) {
    const int t = tile_of(ti);
    const bool st_tile = (MODE == 2) && (t >= 16);
    const int key0 = t * 64;
    const bool more = ti + 1 < ntl;
    if (more) gload(tile_of(ti + 1));
    const bf16_t* Kc = Ks + (ti & 1) * BUFE; const bf16_t* Vc = Kc + 64 * KSTR;
    bool skip = (MODE == 3) && (wave >= 4);
    if (MODE == 1 && t < 16) {
      const int qlo = it.qpos0 + wave * 32;
      skip = (key0 > qlo + 31 + 128 || key0 + 63 < qlo - 128);
    }
    if (!skip) {
    f32x16 s0, s1;
#pragma unroll
    for (int i = 0; i < 16; ++i) { s0[i] = 0.f; s1[i] = 0.f; }
#pragma unroll
    for (int ks = 0; ks < NKS; ++ks) {
      const bf16x8 k0 = *(const bf16x8*)(Kc + r * KSTR + ks * 16 + h * 8);
      const bf16x8 k1 = *(const bf16x8*)(Kc + (32 + r) * KSTR + ks * 16 + h * 8);
      s0 = __builtin_amdgcn_mfma_f32_32x32x16_bf16(k0, qf[ks], s0, 0, 0, 0);
      s1 = __builtin_amdgcn_mfma_f32_32x32x16_bf16(k1, qf[ks], s1, 0, 0, 0);
    }
    if constexpr (MODE == 3) {
      if (wave < 2) {
        const float base = (float)(it.T - 1 - key0 - 4 * h) * it.lgf - 3.f;
#pragma unroll
        for (int i = 0; i < 16; ++i) {
          s0[i] *= fexp2(fmaf(-(float)((i & 3) + 8 * (i >> 2)), it.lgf, base));
          s1[i] *= fexp2(fmaf(-(float)(32 + (i & 3) + 8 * (i >> 2)), it.lgf, base));
        }
      } else {
        const float base = (float)(key0 + 4 * h) * it.lgb - 3.f;
#pragma unroll
        for (int i = 0; i < 16; ++i) {
          s0[i] *= fexp2(fmaf((float)((i & 3) + 8 * (i >> 2)), it.lgb, base));
          s1[i] *= fexp2(fmaf((float)(32 + (i & 3) + 8 * (i >> 2)), it.lgb, base));
        }
      }
    } else if constexpr (MODE == 2) {
      if (!st_tile) {
        const int qlo = it.qpos0 + wave * 32;
        if (key0 + 63 < qlo) {
          const float base = (float)(qp - key0 - 4 * h) * it.lgf - 3.f;
#pragma unroll
          for (int i = 0; i < 16; ++i) {
            s0[i] *= fexp2(fmaf(-(float)((i & 3) + 8 * (i >> 2)), it.lgf, base));
            s1[i] *= fexp2(fmaf(-(float)(32 + (i & 3) + 8 * (i >> 2)), it.lgf, base));
          }
        } else if (key0 > qlo + 31) {
          const float base = (float)(key0 + 4 * h - qp) * it.lgb - 3.f;
#pragma unroll
          for (int i = 0; i < 16; ++i) {
            s0[i] *= fexp2(fmaf((float)((i & 3) + 8 * (i >> 2)), it.lgb, base));
            s1[i] *= fexp2(fmaf((float)(32 + (i & 3) + 8 * (i >> 2)), it.lgb, base));
          }
        } else {
#pragma unroll
        for (int i = 0; i < 16; ++i) {
          const int key = key0 + (i & 3) + 8 * (i >> 2) + 4 * h;
          const int e0 = qp - key, e1 = e0 - 32;
          float d0 = fexp2((float)(e0 < 0 ? -e0 : e0) * (e0 > 0 ? it.lgf : it.lgb));
          float d1 = fexp2((float)(e1 < 0 ? -e1 : e1) * (e1 > 0 ? it.lgf : it.lgb));
          d0 = e0 == 0 ? 2.f : d0;
          d1 = e1 == 0 ? 2.f : d1;
          s0[i] *= it.scale * d0;
          s1[i] *= it.scale * d1;
        }
        }
      } else {
        const float dec = (t == 16) ? fexp2((float)(qp + 1) * it.lgf) : fexp2((float)(it.T - qp) * it.lgb);
#pragma unroll
        for (int i = 0; i < 16; ++i) { s0[i] *= dec; s1[i] *= dec; }
      }
    } else {
      float mx = -INFINITY;
      const int qlo1 = it.qpos0 + wave * 32;
      const bool need_mask = (MODE == 1) && (t < 16) && !(key0 >= qlo1 + 31 - 128 && key0 + 63 <= qlo1 + 128);
#pragma unroll
      for (int i = 0; i < 16; ++i) {
        float a = s0[i] * it.scale, b = s1[i] * it.scale;
        if (MODE == 1 && need_mask) {
          const int key = key0 + (i & 3) + 8 * (i >> 2) + 4 * h;
          const int e0 = key - qp, e1 = e0 + 32;
          if (e0 > 128 || e0 < -128) a = -INFINITY;
          if (e1 > 128 || e1 < -128) b = -INFINITY;
        }
        s0[i] = a; s1[i] = b;
        mx = fmaxf(mx, fmaxf(a, b));
      }
      mx = fmaxf(mx, shx(mx, 32, lane));
      const float mnew = fmaxf(mrun, mx);
      const float alpha = fexp2(mrun - mnew);
      float sum = 0.f;
#pragma unroll
      for (int i = 0; i < 16; ++i) {
        s0[i] = fexp2(s0[i] - mnew);
        s1[i] = fexp2(s1[i] - mnew);
        sum += s0[i] + s1[i];
      }
      lrun = lrun * alpha + sum;
      mrun = mnew;
#pragma unroll
      for (int i = 0; i < 16; ++i) { o0[i] *= alpha; o1[i] *= alpha; }
    }
#pragma unroll
    for (int kt = 0; kt < 2; ++kt) {
#pragma unroll
      for (int sbk = 0; sbk < 2; ++sbk) {
        uint4 pw;
        if (kt == 0) {
          pw.x = pk2(s0[8 * sbk + 0], s0[8 * sbk + 1]); pw.y = pk2(s0[8 * sbk + 2], s0[8 * sbk + 3]);
          pw.z = pk2(s0[8 * sbk + 4], s0[8 * sbk + 5]); pw.w = pk2(s0[8 * sbk + 6], s0[8 * sbk + 7]);
        } else {
          pw.x = pk2(s1[8 * sbk + 0], s1[8 * sbk + 1]); pw.y = pk2(s1[8 * sbk + 2], s1[8 * sbk + 3]);
          pw.z = pk2(s1[8 * sbk + 4], s1[8 * sbk + 5]); pw.w = pk2(s1[8 * sbk + 6], s1[8 * sbk + 7]);
        }
        const bf16x8 pf = __builtin_bit_cast(bf16x8, pw);
        const int koff = kt * 32 + sbk * 16 + 4 * h;
        const uint2 a0 = *(const uint2*)(Vc + r * VSTR + koff), a1 = *(const uint2*)(Vc + r * VSTR + koff + 8);
        const uint2 b0 = *(const uint2*)(Vc + (32 + r) * VSTR + koff), b1 = *(const uint2*)(Vc + (32 + r) * VSTR + koff + 8);
        const bf16x8 v0 = __builtin_bit_cast(bf16x8, make_uint4(a0.x, a0.y, a1.x, a1.y));
        const bf16x8 v1 = __builtin_bit_cast(bf16x8, make_uint4(b0.x, b0.y, b1.x, b1.y));
        o0 = __builtin_amdgcn_mfma_f32_32x32x16_bf16(v0, pf, o0, 0, 0, 0);
        o1 = __builtin_amdgcn_mfma_f32_32x32x16_bf16(v1, pf, o1, 0, 0, 0);
      }
    }
    }
    if (more) swrite((ti + 1) & 1);
    __syncthreads();
  }
  if constexpr (MODE == 3) {
    if (wave < 4) {
      float* rowp = it.sout + (size_t)(wave >> 1) * 16384 + (size_t)((wave & 1) * 32 + r) * 64;
#pragma unroll
      for (int g = 0; g < 4; ++g) {
        *(float4*)(rowp + 8 * g + 4 * h) = make_float4(o0[4 * g], o0[4 * g + 1], o0[4 * g + 2], o0[4 * g + 3]);
        *(float4*)(rowp + 32 + 8 * g + 4 * h) = make_float4(o1[4 * g], o1[4 * g + 1], o1[4 * g + 2], o1[4 * g + 3]);
      }
    }
    return;
  }
  bf16_t* orow = it.out + (size_t)qrow * DM;
  if constexpr (MODE == 2) {
    float sm = 0.f;
#pragma unroll
    for (int i = 0; i < 16; ++i) sm += o0[i] + o1[i];
    sm += shx(sm, 32, lane);
    const float mu = sm * (1.f / 64.f);
    float vr = 0.f;
#pragma unroll
    for (int i = 0; i < 16; ++i) { o0[i] -= mu; o1[i] -= mu; vr += o0[i] * o0[i] + o1[i] * o1[i]; }
    vr += shx(vr, 32, lane);
    const float rstd = rsqrtf(vr * (1.f / 64.f) + 1e-6f);
    const bf16_t* grow = it.G + (size_t)qrow * 256;
#pragma unroll
    for (int g = 0; g < 4; ++g) {
      const int d = 8 * g + 4 * h;
      const uint2 ga = *(const uint2*)(grow + d), gb = *(const uint2*)(grow + 32 + d);
      const float gav[4] = {__uint_as_float(ga.x << 16), __uint_as_float(ga.x & 0xffff0000u), __uint_as_float(ga.y << 16), __uint_as_float(ga.y & 0xffff0000u)};
      const float gbv[4] = {__uint_as_float(gb.x << 16), __uint_as_float(gb.x & 0xffff0000u), __uint_as_float(gb.y << 16), __uint_as_float(gb.y & 0xffff0000u)};
#pragma unroll
      for (int j = 0; j < 4; ++j) {
        const float x0 = gav[j], x1 = gbv[j];
        o0[4 * g + j] = o0[4 * g + j] * rstd * it.gn[d + j] * (x0 / (1.f + __expf(-x0)));
        o1[4 * g + j] = o1[4 * g + j] * rstd * it.gn[32 + d + j] * (x1 / (1.f + __expf(-x1)));
      }
    }
  } else {
    float lt = lrun + shx(lrun, 32, lane);
    if (it.has_sink) lt += fexp2(it.sink_l2 - mrun);
    const float inv = 1.f / lt;
#pragma unroll
    for (int i = 0; i < 16; ++i) { o0[i] *= inv; o1[i] *= inv; }
  }
  st_rm_bf16(orow, h, o0);
  st_rm_bf16(orow + 32, h, o1);
}

__device__ __forceinline__ float log2_sigmoid(float x) { return -log1pf(expf(-x)) * LOG2E; }

__device__ __forceinline__ void state_item(const P& p, int l, int idx, unsigned char* smem, const int wv) {
  const int b = idx >> 3, hh = (idx >> 1) & 3, dir = idx & 1;
  float* Ksm = (float*)smem;
  float* Vsm = Ksm + 4096;
  const int tid = my_tid(wv);
  const float lg = log2_sigmoid(p.ret_decay[(l * 2 + dir) * 4 + hh]);
  float acc[8];
#pragma unroll
  for (int i = 0; i < 8; ++i) acc[i] = 0.f;
  const int d = tid >> 3, e0 = (tid & 7) * 8;
  for (int c = 0; c < 4; ++c) {
    __syncthreads();
    for (int i = tid; i < 4096; i += NTHR) {
      const int j = i >> 6, dd = i & 63, tok = c * 64 + j;
      const float dec = dir == 0 ? fexp2((float)(255 - tok) * lg) : fexp2((float)tok * lg);
      Ksm[j * 64 + dd] = bf2f(p.Kret()[(size_t)(b * 256 + tok) * 256 + hh * 64 + dd]) * 0.125f * dec;
      const int e = i >> 6, jj = i & 63;
      Vsm[e * 65 + jj] = bf2f(p.Vtret_c()[((size_t)((b * 4 + hh) * 64 + e)) * 256 + c * 64 + jj]);
    }
    __syncthreads();
    for (int j = 0; j < 64; ++j) {
      const float kd = Ksm[j * 64 + d];
#pragma unroll
      for (int i = 0; i < 8; ++i) acc[i] += kd * Vsm[(e0 + i) * 65 + j];
    }
  }
  float* op = p.out + 23592960 + ((size_t)((((b * 2 + l) * 2 + dir) * 4 + hh) * 64 + d)) * 64 + e0;
  *(float4*)(op) = make_float4(acc[0], acc[1], acc[2], acc[3]);
  *(float4*)(op + 4) = make_float4(acc[4], acc[5], acc[6], acc[7]);
}

__device__ __forceinline__ void attn_phase(const P& p, int l, unsigned char* smem, const int wv) {
  constexpr int NA = 128, NB = 128, NC = 256, ND = 256, NE = 128, NF = 128, NG = 128;
  constexpr int TOT = NA + NB + NC + ND + NE + NF + NG;
  unsigned* ticket = p.ctl() + 32 + 64 * l;
  volatile int* tks = (volatile int*)(smem + LDS_RED + 2048);
  const int tid0 = my_tid(wv);
  for (;;) {
    __syncthreads();
    if (tid0 == 0) *tks = (int)__hip_atomic_fetch_add(ticket, 1u, __ATOMIC_RELAXED, __HIP_MEMORY_SCOPE_AGENT);
    __syncthreads();
    const int item = *tks;
    if (item >= TOT) break;
    int idx = item;
    AttnItem it;
    it.t2 = 0; it.t3 = 0; it.qpos0 = 0; it.T = 0; it.sink_l2 = 0.f; it.has_sink = 0; it.lgf = 0.f; it.lgb = 0.f;
    it.S0f = nullptr; it.S0b = nullptr; it.G = nullptr; it.gn = nullptr; it.sout = nullptr;
    if (idx < NA) {
      const int b = idx >> 4, hh = (idx >> 2) & 3, qb = idx & 3, row0 = NCTX + b * 1024 + qb * 256;
      it.Q = p.Qmla() + (size_t)row0 * 384 + hh * 96; it.qs = 384;
      it.K = p.Kmla_l() + ((size_t)(((l * 8 + b) * 4 + hh) * 1280)) * 96; it.ks = 96;
      it.Vt = p.Vtmla_l() + ((size_t)(((l * 8 + b) * 4 + hh) * 64)) * 1280; it.vs = 1280;
      it.t0 = 0; it.t1 = 20;
      it.scale = 0.10206207261596575f * LOG2E;
      it.out = p.mix() + (size_t)row0 * DM + 768 + hh * 64;
      attn_item<96, 0>(it, smem, wv);
      continue;
    }
    idx -= NA;
    if (idx < NB) {
      const int b = idx >> 4, hh = (idx >> 2) & 3, qb = idx & 3, row0 = NCTX + b * 1024 + qb * 256;
      it.Q = p.Qret() + (size_t)row0 * 256 + hh * 64; it.qs = 256;
      it.K = p.Kret() + (size_t)(NCTX + b * 1024) * 256 + hh * 64; it.ks = 256;
      it.Vt = p.Vtret_l() + ((size_t)((b * 4 + hh) * 64)) * 1024; it.vs = 1024;
      it.t0 = 0; it.t1 = 16; it.t2 = 16; it.t3 = 18;
      it.qpos0 = qb * 256; it.T = 1024; it.scale = 0.125f;
      it.lgf = log2_sigmoid(p.ret_decay[(l * 2 + 0) * 4 + hh]);
      it.lgb = log2_sigmoid(p.ret_decay[(l * 2 + 1) * 4 + hh]);
      it.S0f = p.S0t() + ((size_t)((((l * 8 + b) * 2 + 0) * 4 + hh))) * 4096;
      it.S0b = p.S0t() + ((size_t)((((l * 8 + b) * 2 + 1) * 4 + hh))) * 4096;
      it.G = p.Gret() + (size_t)row0 * 256 + hh * 64; it.gn = p.ret_gn + l * 256 + hh * 64;
      it.out = p.mix() + (size_t)row0 * DM + 512 + hh * 64;
      attn_item<64, 2>(it, smem, wv);
      continue;
    }
    idx -= NB;
    if (idx < NC) {
      const int b = idx >> 5, head = (idx >> 2) & 7, qb = idx & 3, kv = head >> 2, row0 = NCTX + b * 1024 + qb * 256;
      it.Q = p.Qwin() + (size_t)row0 * 512 + head * 64; it.qs = 512;
      it.K = p.Kwin_l() + ((size_t)((l * 8 + b) * 1280)) * 128 + kv * 64; it.ks = 128;
      it.Vt = p.Vtwin_l() + ((size_t)(((l * 8 + b) * 2 + kv) * 64)) * 1280; it.vs = 1280;
      it.t0 = max(0, qb * 4 - 2); it.t1 = min(16, qb * 4 + 6); it.t2 = 16; it.t3 = 20;
      it.qpos0 = qb * 256;
      it.scale = 0.125f * LOG2E; it.sink_l2 = p.win_sink[l * 8 + head] * LOG2E; it.has_sink = 1;
      it.out = p.mix() + (size_t)row0 * DM + head * 64;
      attn_item<64, 1>(it, smem, wv);
      continue;
    }
    idx -= NC;
    if (idx < ND) {
      const int b = idx >> 3, head = idx & 7, kv = head >> 2, row0 = b * 256;
      it.Q = p.Qwin() + (size_t)row0 * 512 + head * 64; it.qs = 512;
      it.K = p.Kwin_c() + (size_t)(b * 256) * 128 + kv * 64; it.ks = 128;
      it.Vt = p.Vtwin_c() + ((size_t)((b * 2 + kv) * 64)) * 256; it.vs = 256;
      it.t0 = 0; it.t1 = 4;
      it.scale = 0.125f * LOG2E; it.sink_l2 = p.win_sink[l * 8 + head] * LOG2E; it.has_sink = 1;
      it.out = p.mix() + (size_t)row0 * DM + head * 64;
      attn_item<64, 0>(it, smem, wv);
      continue;
    }
    idx -= ND;
    if (idx < NE) {
      const int b = idx >> 2, hh = idx & 3, row0 = b * 256;
      it.Q = p.Qmla() + (size_t)row0 * 384 + hh * 96; it.qs = 384;
      it.K = p.Kmla_c() + ((size_t)((b * 4 + hh) * 256)) * 96; it.ks = 96;
      it.Vt = p.Vtmla_c() + ((size_t)((b * 4 + hh) * 64)) * 256; it.vs = 256;
      it.t0 = 0; it.t1 = 4;
      it.scale = 0.10206207261596575f * LOG2E;
      it.out = p.mix() + (size_t)row0 * DM + 768 + hh * 64;
      attn_item<96, 0>(it, smem, wv);
      continue;
    }
    idx -= NE;
    if (idx < NF) {
      const int b = idx >> 2, hh = idx & 3, row0 = b * 256;
      it.Q = p.Qret() + (size_t)row0 * 256 + hh * 64; it.qs = 256;
      it.K = p.Kret() + (size_t)(b * 256) * 256 + hh * 64; it.ks = 256;
      it.Vt = p.Vtret_c() + ((size_t)((b * 4 + hh) * 64)) * 256; it.vs = 256;
      it.t0 = 0; it.t1 = 4;
      it.qpos0 = 0; it.T = 256; it.scale = 0.125f;
      it.lgf = log2_sigmoid(p.ret_decay[(l * 2 + 0) * 4 + hh]);
      it.lgb = log2_sigmoid(p.ret_decay[(l * 2 + 1) * 4 + hh]);
      it.G = p.Gret() + (size_t)row0 * 256 + hh * 64; it.gn = p.ret_gn + l * 256 + hh * 64;
      it.out = p.mix() + (size_t)row0 * DM + 512 + hh * 64;
      attn_item<64, 2>(it, smem, wv);
      continue;
    }
    idx -= NF;
    {
      const int b = idx >> 2, hh = idx & 3;
      it.Q = nullptr; it.qs = 0;
      it.K = p.Kret() + (size_t)(b * 256) * 256 + hh * 64; it.ks = 256;
      it.Vt = p.Vtret_c() + ((size_t)((b * 4 + hh) * 64)) * 256; it.vs = 256;
      it.t0 = 0; it.t1 = 4;
      it.T = 256; it.scale = 0.125f;
      it.lgf = log2_sigmoid(p.ret_decay[(l * 2 + 0) * 4 + hh]);
      it.lgb = log2_sigmoid(p.ret_decay[(l * 2 + 1) * 4 + hh]);
      it.out = nullptr;
      it.sout = p.out + 23592960 + ((size_t)((b * 2 + l) * 2 * 4 + hh)) * 4096;
      attn_item<64, 3>(it, smem, wv);
    }
  }
}

__device__ __forceinline__ void gemv9_item(const float* sc, float* red, const float* __restrict__ W, int N, int n0, float* outp, int ldo,
                                           const float* bias, const int tid) {
  const int j4 = (tid & 7) * 4, kq = tid >> 3;
  f32x4 acc[9];
#pragma unroll
  for (int r = 0; r < 9; ++r) acc[r] = (f32x4){0.f, 0.f, 0.f, 0.f};
  const float* w = W + (size_t)(kq * 16) * N + n0 + j4;
  const float* s = sc + kq * 16;
#pragma unroll
  for (int kk = 0; kk < 16; ++kk) {
    const f32x4 wv = *(const f32x4*)(w + (size_t)kk * N);
#pragma unroll
    for (int r = 0; r < 9; ++r) acc[r] += wv * s[r * 1024 + kk];
  }
#pragma unroll
  for (int r = 0; r < 9; ++r) *(f32x4*)(red + (kq * 9 + r) * 32 + j4) = acc[r];
  __syncthreads();
  for (int oo = tid; oo < 288; oo += NTHR) {
    const int r = oo >> 5, jj = oo & 31;
    float sum = 0.f;
#pragma unroll 16
    for (int q = 0; q < 64; ++q) sum += red[(q * 9 + r) * 32 + jj];
    outp[(size_t)r * ldo + n0 + jj] = sum + (bias ? bias[n0 + jj] : 0.f);
  }
  __syncthreads();
}

__device__ __forceinline__ void norm0_phase(const P& p, unsigned char* smem, const int wv) {
  const int tid = my_tid(wv), lane = tid & 63, gw = my_bid() * NWV + (tid >> 6), ngw = gridDim.x * NWV;
  const float* gain = p.norm1;
  for (int m0 = gw; m0 < NTOK; m0 += 2 * ngw) {
    float4 v[2][4];
    float ss[2] = {0.f, 0.f};
#pragma unroll
    for (int q = 0; q < 2; ++q) {
      const int m = m0 + q * ngw;
      const float* xr = m < NCTX ? p.x_prompt + (size_t)m * DM : p.x_sample + (size_t)(m - NCTX) * DM;
#pragma unroll
      for (int j = 0; j < 4; ++j) v[q][j] = ((const float4*)xr)[lane + 64 * j];
    }
#pragma unroll
    for (int q = 0; q < 2; ++q) {
#pragma unroll
      for (int j = 0; j < 4; ++j) ss[q] += v[q][j].x * v[q][j].x + v[q][j].y * v[q][j].y + v[q][j].z * v[q][j].z + v[q][j].w * v[q][j].w;
      ss[q] = wave_sum(ss[q], lane);
    }
#pragma unroll
    for (int q = 0; q < 2; ++q) {
      const int m = m0 + q * ngw;
      const float* scale = p.mod() + ((size_t)mod_row(m)) * 6144 + 1 * 1024;
#pragma unroll
      for (int j = 0; j < 4; ++j) {
        const int c = (lane + 64 * j) * 4;
        const float4 g = *(const float4*)(gain + c), sc = *(const float4*)(scale + c);
        uint2 u;
        u.x = pk2(v[q][j].x * g.x * (1.f + sc.x), v[q][j].y * g.y * (1.f + sc.y));
        u.y = pk2(v[q][j].z * g.z * (1.f + sc.z), v[q][j].w * g.w * (1.f + sc.w));
        *(uint2*)(p.hbuf() + (size_t)m * DM + c) = u;
      }
      if (lane < 16) p.rssA()[(size_t)m * 16 + lane] = lane == 0 ? ss[q] : 0.f;
    }
  }
  float* sc = (float*)smem;
  float* red = sc + 9216;
  constexpr int G_IN = DIN / 32, G_UP = DFF / 32, NIT = 2 * G_IN + 2 * G_UP;
  for (int item = my_bid(); item < NIT; item += gridDim.x) {
    int l, grp; const float* W; int N; float* outp; int ldo; int which;
    if (item < 2 * G_IN) { l = item / G_IN; grp = item % G_IN; W = p.w_in + (size_t)l * DM * DIN; N = DIN; outp = p.sWin() + (size_t)l * 9 * DINP; ldo = DINP; which = 0; }
    else { const int i2 = item - 2 * G_IN; l = i2 / G_UP; grp = i2 % G_UP; W = p.w_up + (size_t)l * DM * DFF; N = DFF; outp = p.sWup() + (size_t)l * 9 * DFF; ldo = DFF; which = 3; }
    __syncthreads();
    for (int i = tid; i < 9216; i += NTHR) sc[i] = p.mod()[((size_t)(l * 9 + (i >> 10))) * 6144 + which * 1024 + (i & 1023)];
    __syncthreads();
    gemv9_item(sc, red, W, N, grp * 32, outp, ldo, nullptr, tid);
  }
}
__device__ __forceinline__ void final_norm_phase(const P& p, const int wv) {
  const int tid = my_tid(wv), lane = tid & 63, gw = my_bid() * NWV + (tid >> 6), ngw = gridDim.x * NWV;
  for (int m = gw; m < NTOK; m += ngw) {
    const float* xr = p.xw() + (size_t)m * DM;
    float4 v[4];
    float ss = 0.f;
#pragma unroll
    for (int j = 0; j < 4; ++j) {
      v[j] = ((const float4*)xr)[lane + 64 * j];
      ss += v[j].x * v[j].x + v[j].y * v[j].y + v[j].z * v[j].z + v[j].w * v[j].w;
    }
    ss = wave_sum(ss, lane);
    const float rstd = rsqrtf(ss * (1.f / 1024.f) + 1e-6f);
#pragma unroll
    for (int j = 0; j < 4; ++j) {
      const int c = (lane + 64 * j) * 4;
      const float4 g = *(const float4*)(p.final_norm + c);
      *(float4*)(p.out + (size_t)m * DM + c) = make_float4(v[j].x * rstd * g.x, v[j].y * rstd * g.y, v[j].z * rstd * g.z, v[j].w * rstd * g.w);
    }
  }
}

__device__ __forceinline__ void transpose_tile(const float* __restrict__ W, int K, int N, bf16_t* __restrict__ WT, int item, float* tile, const int tid) {
  const int ntn = (N + 63) >> 6, kt = item / ntn, nt = item % ntn, k0 = kt * 64, n0 = nt * 64;
  const int n4 = (tid & 15) * 4, kr = tid >> 4;
#pragma unroll
  for (int q = 0; q < 2; ++q) {
    const int k = q * 32 + kr;
    float4 v = make_float4(0.f, 0.f, 0.f, 0.f);
    if (n0 + n4 < N) v = *(const float4*)(W + (size_t)(k0 + k) * N + n0 + n4);
    float* t = tile + k * 65 + n4;
    t[0] = v.x; t[1] = v.y; t[2] = v.z; t[3] = v.w;
  }
  __syncthreads();
  {
    const int n = tid >> 3, kc = (tid & 7) * 8;
    const float* t = tile + kc * 65 + n;
    uint4 o;
    o.x = pk2(t[0 * 65], t[1 * 65]); o.y = pk2(t[2 * 65], t[3 * 65]); o.z = pk2(t[4 * 65], t[5 * 65]); o.w = pk2(t[6 * 65], t[7 * 65]);
    if (n0 + n < N) *(uint4*)(WT + (size_t)(n0 + n) * K + k0 + kc) = o;
  }
  __syncthreads();
}

__device__ __forceinline__ void prep_phase(const P& p, unsigned char* smem, const int wv) {
  const int tid = my_tid(wv);
  {
    float* sc = (float*)smem;
    float* red = sc + 9216;
    for (int i = tid; i < 9216; i += NTHR) {
      const int r = i >> 10, k = i & 1023;
      const float x = r == 0 ? p.c_ctx[k] : p.c[(r - 1) * 1024 + k];
      sc[i] = x / (1.f + expf(-x));
    }
    __syncthreads();
    for (int item = blockIdx.x; item < 384; item += gridDim.x) {
      const int l = item / 192, n0 = (item % 192) * 32;
      gemv9_item(sc, red, p.w_mod + (size_t)l * 1024 * 6144, 6144, n0, p.mod() + (size_t)l * 9 * 6144, 6144, p.b_mod + l * 6144, tid);
    }
  }
  __syncthreads();
  {
    float* tile = (float*)smem;
    constexpr int I_IN = 16 * 37, I_OUT = 16 * 16, I_UP = 16 * 64, I_DN = 64 * 16, I_KV = 2 * 8;
    constexpr int PER = I_IN + I_OUT + I_UP + I_DN + I_KV;
    for (int item = blockIdx.x; item < 2 * PER; item += gridDim.x) {
      const int l = item / PER;
      int r = item % PER;
      if (r < I_IN) { transpose_tile(p.w_in + (size_t)l * DM * DIN, DM, DIN, p.WinT() + (size_t)l * DINP * DM, r, tile, tid); continue; }
      r -= I_IN;
      if (r < I_OUT) { transpose_tile(p.w_out + (size_t)l * DM * DM, DM, DM, p.WoutT() + (size_t)l * DM * DM, r, tile, tid); continue; }
      r -= I_OUT;
      if (r < I_UP) { transpose_tile(p.w_up + (size_t)l * DM * DFF, DM, DFF, p.WupT() + (size_t)l * DFF * DM, r, tile, tid); continue; }
      r -= I_UP;
      if (r < I_DN) { transpose_tile(p.w_down + (size_t)l * DFF * DM, DFF, DM, p.WdownT() + (size_t)l * DM * DFF, r, tile, tid); continue; }
      r -= I_DN;
      transpose_tile(p.w_kv_b + (size_t)l * 128 * 512, 128, 512, p.WkvbT() + (size_t)l * 512 * 128, r, tile, tid);
    }
  }
  const int gt = blockIdx.x * NTHR + tid, gs = gridDim.x * NTHR;
  if (gt < 256) p.ctl()[gt] = 0u;
  for (int i = gt; i < 64 * 16; i += gs) {
    const int pos = i >> 4, f = i & 15;
    const float ang = (float)pos * exp2f(-(float)f * (L2_10000 / 16.f));
    p.ropeW()[pos * 32 + f] = __cosf(ang);
    p.ropeW()[pos * 32 + 16 + f] = __sinf(ang);
  }
  for (int i = gt; i < 64 * 8; i += gs) {
    const int pos = i >> 3, f = i & 7;
    const float ang = (float)pos * exp2f(-(float)f * (L2_10000 / 8.f));
    p.ropeM()[pos * 16 + f] = __cosf(ang);
    p.ropeM()[pos * 16 + 8 + f] = __sinf(ang);
  }
  for (int i = gt; i < 2 * (DINP - DIN) * DM / 8; i += gs) {
    const int l = i / ((DINP - DIN) * DM / 8), o = i % ((DINP - DIN) * DM / 8);
    *(uint4*)(p.WinT() + ((size_t)l * DINP + DIN) * DM + (size_t)o * 8) = make_uint4(0, 0, 0, 0);
  }
  for (int i = gt; i < 524288 / 8; i += gs) {
    const int d8 = i & 7, kv = (i >> 3) & 1, s = (i >> 4) & 255, l = (i >> 12) & 1, b = i >> 13;
    const float4 a = *(const float4*)(p.cache_win_k + (size_t)i * 8), c = *(const float4*)(p.cache_win_k + (size_t)i * 8 + 4);
    *(uint4*)(p.Kwin_l() + ((size_t)((l * 8 + b) * 1280 + 1024 + s)) * 128 + kv * 64 + d8 * 8) = make_uint4(pk2(a.x, a.y), pk2(a.z, a.w), pk2(c.x, c.y), pk2(c.z, c.w));
  }
  for (int i = gt; i < 524288 / 8; i += gs) {
    const int d = i & 63, kv = (i >> 6) & 1, s8 = (i >> 7) & 31, l = (i >> 12) & 1, b = i >> 13;
    const float* src = p.cache_win_v + ((size_t)((b * 2 + l) * 256 + s8 * 8) * 2 + kv) * 64 + d;
    float v[8];
#pragma unroll
    for (int j = 0; j < 8; ++j) v[j] = src[(size_t)j * 128];
    *(uint4*)(p.Vtwin_l() + ((size_t)(((l * 8 + b) * 2 + kv) * 64 + d)) * 1280 + 1024 + s8 * 8) = make_uint4(pk2(v[0], v[1]), pk2(v[2], v[3]), pk2(v[4], v[5]), pk2(v[6], v[7]));
  }
  for (int i = gt; i < 524288 / 8; i += gs) {
    const int j8 = i & 15, s = (i >> 4) & 255, l = (i >> 12) & 1, b = i >> 13;
    const float4 a = *(const float4*)(p.cache_mla_ckv + (size_t)i * 8), c = *(const float4*)(p.cache_mla_ckv + (size_t)i * 8 + 4);
    *(uint4*)(p.ckvn() + ((size_t)l * 18432 + 16384 + b * 256 + s) * 128 + j8 * 8) = make_uint4(pk2(a.x, a.y), pk2(a.z, a.w), pk2(c.x, c.y), pk2(c.z, c.w));
  }
  for (int i = gt; i < 131072 / 8; i += gs) {
    const int j8 = i & 3, s = (i >> 2) & 255, l = (i >> 10) & 1, b = i >> 11;
    const float4 a = *(const float4*)(p.cache_mla_krope + (size_t)i * 8), c = *(const float4*)(p.cache_mla_krope + (size_t)i * 8 + 4);
    const uint4 o = make_uint4(pk2(a.x, a.y), pk2(a.z, a.w), pk2(c.x, c.y), pk2(c.z, c.w));
#pragma unroll
    for (int hh = 0; hh < 4; ++hh) *(uint4*)(p.Kmla_l() + ((size_t)(((l * 8 + b) * 4 + hh) * 1280 + 1024 + s)) * 96 + 64 + j8 * 8) = o;
  }
  for (int i = gt; i < 524288 / 8; i += gs) {
    const int e = i & 63, d8 = (i >> 6) & 7, blk = i >> 9;
    const int hh = blk & 3, dir = (blk >> 2) & 1, l = (blk >> 3) & 1, b = blk >> 4;
    const float* src = p.state_ret + (size_t)blk * 4096 + (size_t)(d8 * 8) * 64 + e;
    float v[8];
#pragma unroll
    for (int j = 0; j < 8; ++j) v[j] = src[(size_t)j * 64];
    *(uint4*)(p.S0t() + ((size_t)((((l * 8 + b) * 2 + dir) * 4 + hh) * 64 + e)) * 64 + d8 * 8) = make_uint4(pk2(v[0], v[1]), pk2(v[2], v[3]), pk2(v[4], v[5]), pk2(v[6], v[7]));
  }
}

struct RotOrder : pg8::StaticOrder {
  int rot;
  __device__ __forceinline__ bool next(int i, Unit& u) const {
    if (!pg8::StaticOrder::next(i, u)) return false;
    u.pn += rot; if (u.pn >= nN) u.pn -= nN;
    return true;
  }
};
template <class Epi>
__device__ __forceinline__ void big_gemm(unsigned char* smem, const bf16_t* A, const bf16_t* Bt, int N, int K, const Epi& E, const int wv, int rot = 0) {
  pg8::Gemm g{A, Bt, NTOK, N, K};
  RotOrder S;
  S.init(NTOK, N, (int)gridDim.x, my_bid());
  S.rot = rot;
  pg8::gemm_phase<Epi, RotOrder, true, true>((PG8_LAS unsigned char*)smem, g, S, E, wv);
}

#define GSYNC() grid.sync()
__global__ void __launch_bounds__(NTHR, 2) hybrid_fwd(P p_arg) {
  cg::grid_group grid = cg::this_grid();
  const kargp_t kp = (kargp_t)__builtin_amdgcn_kernarg_segment_ptr();
  const int wv = __builtin_amdgcn_readfirstlane((int)threadIdx.x >> 6);
  { const P p = load_params(kp); prep_phase(p, smem, wv); }
  GSYNC();
  { const P p = load_params(kp); norm0_phase(p, smem, wv); }
  GSYNC();
#pragma unroll
  for (int l = 0; l < 2; ++l) {
    { const P pc = load_params(kp); const int t0 = my_tid(wv);
      for (int i = t0; i < 64 * 32; i += NTHR) ((float*)(smem + LDS_ROPEW))[i] = pc.ropeW()[i];
      for (int i = t0; i < 64 * 16; i += NTHR) ((float*)(smem + LDS_ROPEM))[i] = pc.ropeM()[i];
      __syncthreads(); }
    { const P p = load_params(kp);
      big_gemm(smem, p.hbuf(), p.WinT() + (size_t)l * DINP * DM, DINP, DM, EpiIn8{p, l, kp}, wv, 8); }
    { const P p = load_params(kp); gemm_small(p.ckvn() + (size_t)l * 18432 * 128, 128, p.WkvbT() + (size_t)l * 512 * 128, 128, 18432, 512, 128, smem, EpiKvb{p, l}, wv, p.ctl() + 64 * l, p.ctl() + 128 + 64 * l); }
    GSYNC();
    { const P p = load_params(kp); attn_phase(p, l, smem, wv); }
    GSYNC();
    { const P p = load_params(kp); big_gemm(smem, p.mix(), p.WoutT() + (size_t)l * DM * DM, DM, DM, EpiOut8{p, l}, wv); }
    GSYNC();
    { const P p = load_params(kp); big_gemm(smem, p.hbuf(), p.WupT() + (size_t)l * DFF * DM, DFF, DM, EpiUp8{p, l}, wv); }
    GSYNC();
    { const P p = load_params(kp); big_gemm(smem, p.ubuf(), p.WdownT() + (size_t)l * DM * DFF, DM, DFF, EpiDown8{p, l}, wv); }
    GSYNC();
  }
  { const P p = load_params(kp); final_norm_phase(p, wv); }
}

extern "C" void kernel_launch(void* const* d_in, const int* in_sizes, int n_in, void* d_out, int out_size, void* d_ws, size_t ws_size,
                              hipStream_t stream) {
  static int grid_blocks = 0;
  if (grid_blocks == 0) {
    int dev = 0, cus = 0, per_cu = 0;
    (void)hipGetDevice(&dev);
    (void)hipDeviceGetAttribute(&cus, hipDeviceAttributeMultiprocessorCount, dev);
    (void)hipFuncSetAttribute((const void*)hybrid_fwd, hipFuncAttributeMaxDynamicSharedMemorySize, LDS_BYTES);
    (void)hipOccupancyMaxActiveBlocksPerMultiprocessor(&per_cu, (const void*)hybrid_fwd, NTHR, LDS_BYTES);
    if (per_cu < 1) { fprintf(stderr, "occupancy query returned %d\n", per_cu); per_cu = 1; }
    per_cu = 1;
    grid_blocks = cus * per_cu;
  }
  P p{};
  const float* const* in = (const float* const*)d_in;
  p.x_prompt = in[0]; p.x_sample = in[1]; p.cache_win_k = in[2]; p.cache_win_v = in[3]; p.cache_mla_ckv = in[4];
  p.cache_mla_krope = in[5]; p.state_ret = in[6]; p.c = in[7]; p.c_ctx = in[8]; p.w_mod = in[9]; p.b_mod = in[10];
  p.norm1 = in[11]; p.norm2 = in[12]; p.w_in = in[13]; p.win_sink = in[14]; p.ret_decay = in[15]; p.ret_gn = in[16];
  p.mla_kv_norm = in[17]; p.w_kv_b = in[18]; p.w_out = in[19]; p.w_up = in[20]; p.w_down = in[21]; p.final_norm = in[22];
  p.out = (float*)d_out;
  p.ws = (unsigned char*)d_ws;
  if (WS_END > ws_size) { fprintf(stderr, "kernel_launch: workspace too small: need %zu, have %zu\n", (size_t)WS_END, ws_size); return; }
  void* args[] = {&p};
  hipError_t e = hipLaunchCooperativeKernel((const void*)hybrid_fwd, dim3(grid_blocks), dim3(NTHR), args, LDS_BYTES, stream);
  if (e != hipSuccess) fprintf(stderr, "cooperative launch failed: %s (grid %d)\n", hipGetErrorString(e), grid_blocks);
}
```

```cpp
#include <hip/hip_runtime.h>
#include <hip/hip_cooperative_groups.h>
#include <cstdio>
#include <cstdint>
namespace cg = cooperative_groups;

__device__ __forceinline__ int lane_id() { return (int)__builtin_amdgcn_mbcnt_hi(~0u, __builtin_amdgcn_mbcnt_lo(~0u, 0u)); }

namespace pg8 {
#define PG8_LAS __attribute__((address_space(3)))
typedef unsigned short bf16_t;
typedef short bf16x8 __attribute__((ext_vector_type(8)));
typedef float f32x4 __attribute__((ext_vector_type(4)));
typedef unsigned u32x4 __attribute__((ext_vector_type(4)));
constexpr int BM = 256, BK = 64, HALF = 128, HTB = HALF * BK * 2  , STAGE_BYTES = 8 * HTB, NXCD = 8, WGM = 8;

__host__ __device__ __forceinline__ int lds_byte(int r, int c) { const int st = (r >> 4) * 2 + (c >> 5), rr = r & 15, cc = c & 31, ob = rr * 64 + cc * 2; return st * 1024 + (ob ^ (((ob >> 9) & 1) << 5)); }
__host__ __device__ __forceinline__ void stage_rc(int b, int& R, int& C) { const int st = b / 1024, sb = b % 1024, swz = sb ^ (((sb >> 9) & 1) << 5); R = (st >> 1) * 16 + swz / 64; C = (st & 1) * 32 + (swz % 64) / 2; }
__host__ __device__ __forceinline__ int perm32(int rho) { const int n = rho >> 4, i = rho & 15; return 8 * (i >> 2) + 4 * n + (i & 3); }

struct Unit { int pm, pn; };
struct Gemm { const bf16_t* A; const bf16_t* Bt; int M, N, K; };

struct StaticOrder {
    int nM, nN, nwg, G, c;
    __host__ __device__ void init(int M, int N, int G_, int c_) { nM = M / BM; nN = N / BM; nwg = nM * nN; G = G_; c = c_; }
    __host__ __device__ bool next(int i, Unit& u) const {
        const long L = (long)i * G + c; if (L >= nwg) return false;
        int wgid = (int)L; { const int q = nwg / NXCD, r = nwg % NXCD, xcd = wgid % NXCD, off = wgid / NXCD; wgid = (xcd < r ? xcd * (q + 1) : r * (q + 1) + (xcd - r) * q) + off; }
        const int nig = WGM * nN, gid = wgid / nig, fm = gid * WGM, gsz = (nM - fm) < WGM ? (nM - fm) : WGM;
        u.pm = fm + ((wgid % nig) % gsz); u.pn = (wgid % nig) / gsz; return true;
    }
    __device__ __forceinline__ void a_ready(const Unit&) const {}
    __device__ __forceinline__ void done(const Unit&) const {}
};
template <class Epi, class Sched, bool ALIGN_EPI = false, bool SP2 = false>
__device__ __forceinline__ void gemm_phase(PG8_LAS unsigned char* lds, const Gemm g, const Sched& S, const Epi& E, const int wvp) {
    const int wid = wvp, lane = lane_id(), tid = wid * 64 + lane, wr = wid >> 2, wc = wid & 3, fr = lane & 15, fq = lane >> 4;
    const int K = g.K, nt = K / BK;
    unsigned voffA[2], voffB[2];
#pragma unroll
    for (int i = 0; i < 2; ++i) { int R, C; stage_rc(tid * 16 + i * 8192, R, C); const int Rb = Epi::PERM ? ((R & ~31) + perm32(R & 31)) : R;
        voffA[i] = (unsigned)(R * K + C) * 2u; voffB[i] = (unsigned)(Rb * K + C) * 2u; }
    const size_t kstep = (size_t)(BK * 2);
    const size_t hstep = (size_t)HALF * K * 2;
    const size_t tstep = 2 * hstep;
    const unsigned ldsw = (unsigned)wid * 1024u;
    const int aoff = lds_byte(wr * 64 + fr, fq * 8), boff = lds_byte(wc * 32 + fr, fq * 8);
#define PG8_SA(b, h) (((b) * 2 + (h)) * HTB)
#define PG8_SB(b, h) ((4 + (b) * 2 + (h)) * HTB)
#define PG8_STAGE(bufoff, gbase, voff) do { _Pragma("unroll") for (int _i = 0; _i < 2; ++_i) \
        __builtin_amdgcn_global_load_lds((const unsigned*)((const char*)(gbase) + (voff)[_i]), (PG8_LAS unsigned*)(lds + (bufoff) + ldsw + _i * 8192), 16, 0, 0); } while (0)
#define PG8_LDA(dst, b, h) do { _Pragma("unroll") for (int m = 0; m < 4; ++m) _Pragma("unroll") for (int k = 0; k < 2; ++k) dst[m][k] = *(const PG8_LAS bf16x8*)(lds + PG8_SA(b, h) + aoff + m * 2048 + k * 1024); } while (0)
#define PG8_LDB(dst, b, h) do { _Pragma("unroll") for (int n = 0; n < 2; ++n) _Pragma("unroll") for (int k = 0; k < 2; ++k) dst[n][k] = *(const PG8_LAS bf16x8*)(lds + PG8_SB(b, h) + boff + n * 2048 + k * 1024); } while (0)
#define PG8_MMA(ai, bj, At, Bt) do { __builtin_amdgcn_s_setprio(1); _Pragma("unroll") for (int m = 0; m < 4; ++m) _Pragma("unroll") for (int n = 0; n < 2; ++n) _Pragma("unroll") for (int k = 0; k < 2; ++k) \
        acc[ai][bj][m][n] = __builtin_amdgcn_mfma_f32_16x16x32_bf16(Bt[n][k], At[m][k], acc[ai][bj][m][n], 0, 0, 0); __builtin_amdgcn_s_setprio(0); } while (0)
#define PG8_WAIT_V(n) asm volatile("s_waitcnt vmcnt(" #n ")" ::: "memory")
#define PG8_WAIT_L(n) asm volatile("s_waitcnt lgkmcnt(" #n ")" ::: "memory")
#define PG8_BAR __builtin_amdgcn_s_barrier()
#define PG8_SCHED __builtin_amdgcn_sched_barrier(0)
    Unit cur, nxt; int ui = 0;
    if (!S.next(0, cur)) return;
    f32x4 acc[2][2][4][2];
#pragma unroll
    for (int a = 0; a < 2; ++a)
#pragma unroll
        for (int b = 0; b < 2; ++b)
#pragma unroll
            for (int m = 0; m < 4; ++m)
#pragma unroll
                for (int n = 0; n < 2; ++n) acc[a][b][m][n] = (f32x4){0.f, 0.f, 0.f, 0.f};
    bf16x8 At[4][2], B0[2][2], B1[2][2];
    const char* cA = (const char*)g.A + (size_t)cur.pm * tstep; const char* cB = (const char*)g.Bt + (size_t)cur.pn * tstep;
    S.a_ready(cur);
    if constexpr (SP2) {
        PG8_STAGE(PG8_SB(0, 0), cB, voffB); PG8_STAGE(PG8_SB(0, 1), cB + hstep, voffB); PG8_STAGE(PG8_SA(0, 0), cA, voffA); PG8_STAGE(PG8_SA(0, 1), cA + hstep, voffA);
        if (wr == 1) PG8_BAR;
        PG8_WAIT_V(2); PG8_BAR;
        PG8_STAGE(PG8_SB(1, 0), cB + kstep, voffB); PG8_STAGE(PG8_SA(1, 0), cA + kstep, voffA); PG8_STAGE(PG8_SB(1, 1), cB + hstep + kstep, voffB);
        PG8_WAIT_V(6); PG8_BAR;
    } else {
        PG8_STAGE(PG8_SB(0, 0), cB, voffB); PG8_STAGE(PG8_SA(0, 0), cA, voffA); PG8_STAGE(PG8_SB(0, 1), cB + hstep, voffB); PG8_STAGE(PG8_SA(0, 1), cA + hstep, voffA);
        if (wr == 1) PG8_BAR;
        PG8_WAIT_V(4); PG8_BAR;
        PG8_STAGE(PG8_SB(1, 0), cB + kstep, voffB); PG8_STAGE(PG8_SA(1, 0), cA + kstep, voffA); PG8_STAGE(PG8_SB(1, 1), cB + hstep + kstep, voffB);
        PG8_WAIT_V(6); PG8_BAR;
    }
    for (;;) {
        const bool has_next = S.next(ui + 1, nxt);
        const char* nA = has_next ? (const char*)g.A + (size_t)nxt.pm * tstep : cA; const char* nB = has_next ? (const char*)g.Bt + (size_t)nxt.pn * tstep : cB;
        for (int t = 0; t < nt; t += 2) {
            const bool last = (t == nt - 2);
            const char* a1 = cA + (size_t)(t + 1) * kstep;
            const char* a2 = last ? nA : cA + (size_t)(t + 2) * kstep; const char* b2 = last ? nB : cB + (size_t)(t + 2) * kstep;
            const char* a3 = a2 + kstep; const char* b3 = b2 + kstep;
            if (last && has_next) S.a_ready(nxt);
            if constexpr (SP2) {
            PG8_LDB(B0, 0, 0); PG8_LDB(B1, 0, 1); PG8_SCHED; PG8_LDA(At, 0, 0); PG8_STAGE(PG8_SA(1, 1), a1 + hstep, voffA);
            PG8_WAIT_V(8); PG8_WAIT_L(0); PG8_BAR; PG8_MMA(0, 0, At, B0); PG8_MMA(0, 1, At, B1); PG8_BAR; PG8_SCHED;
            PG8_LDA(At, 0, 1); PG8_STAGE(PG8_SB(0, 0), b2, voffB); PG8_STAGE(PG8_SB(0, 1), b2 + hstep, voffB); PG8_STAGE(PG8_SA(0, 0), a2, voffA);
            PG8_WAIT_V(8); PG8_WAIT_L(0); PG8_BAR; PG8_MMA(1, 0, At, B0); PG8_MMA(1, 1, At, B1); PG8_BAR; PG8_SCHED;
            PG8_LDB(B0, 1, 0); PG8_LDB(B1, 1, 1); PG8_SCHED; PG8_LDA(At, 1, 0); PG8_STAGE(PG8_SA(0, 1), a2 + hstep, voffA);
            PG8_WAIT_V(8); PG8_WAIT_L(0); PG8_BAR; PG8_MMA(0, 0, At, B0); PG8_MMA(0, 1, At, B1); PG8_BAR; PG8_SCHED;
            PG8_LDA(At, 1, 1); PG8_STAGE(PG8_SB(1, 0), b3, voffB); PG8_STAGE(PG8_SB(1, 1), b3 + hstep, voffB); PG8_STAGE(PG8_SA(1, 0), a3, voffA);
            PG8_WAIT_V(8); PG8_WAIT_L(0); PG8_BAR; PG8_MMA(1, 0, At, B0); PG8_MMA(1, 1, At, B1); PG8_BAR; PG8_SCHED;
            } else {
            PG8_LDB(B0, 0, 0); PG8_SCHED; PG8_LDA(At, 0, 0); PG8_STAGE(PG8_SA(1, 1), a1 + hstep, voffA);
            PG8_WAIT_L(8); PG8_BAR; PG8_WAIT_L(0); PG8_MMA(0, 0, At, B0); PG8_BAR; PG8_SCHED;
            PG8_LDB(B1, 0, 1); PG8_STAGE(PG8_SB(0, 0), b2, voffB);
            PG8_BAR; PG8_WAIT_L(0); PG8_MMA(0, 1, At, B1); PG8_BAR;
            PG8_LDA(At, 0, 1); PG8_STAGE(PG8_SA(0, 0), a2, voffA);
            PG8_BAR; PG8_WAIT_L(0); PG8_MMA(1, 0, At, B0); PG8_BAR; PG8_SCHED;
            PG8_STAGE(PG8_SB(0, 1), b2 + hstep, voffB);
            PG8_WAIT_V(6); PG8_BAR; PG8_MMA(1, 1, At, B1); PG8_BAR;
            PG8_LDB(B0, 1, 0); PG8_SCHED; PG8_LDA(At, 1, 0); PG8_STAGE(PG8_SA(0, 1), a2 + hstep, voffA);
            PG8_WAIT_L(8); PG8_BAR; PG8_WAIT_L(0); PG8_MMA(0, 0, At, B0); PG8_BAR; PG8_SCHED;
            PG8_LDB(B1, 1, 1); PG8_STAGE(PG8_SB(1, 0), b3, voffB);
            PG8_BAR; PG8_WAIT_L(0); PG8_MMA(0, 1, At, B1); PG8_BAR;
            PG8_LDA(At, 1, 1); PG8_STAGE(PG8_SA(1, 0), a3, voffA);
            PG8_BAR; PG8_WAIT_L(0); PG8_MMA(1, 0, At, B0); PG8_BAR; PG8_SCHED;
            PG8_STAGE(PG8_SB(1, 1), b3 + hstep, voffB);
            PG8_WAIT_V(6); PG8_BAR; PG8_MMA(1, 1, At, B1); PG8_BAR;
            }
        }
        if constexpr (ALIGN_EPI) { if (wr == 0) PG8_BAR; }
        if constexpr (!Epi::AFTER_DRAIN) { E(acc, cur, wr, wc, fr, fq); S.done(cur); }
        if (!has_next) break;
#pragma unroll
        for (int a = 0; a < 2; ++a)
#pragma unroll
            for (int b = 0; b < 2; ++b)
#pragma unroll
                for (int m = 0; m < 4; ++m)
#pragma unroll
                    for (int n = 0; n < 2; ++n) acc[a][b][m][n] = (f32x4){0.f, 0.f, 0.f, 0.f};
        cur = nxt; cA = nA; cB = nB; ++ui;
        if constexpr (ALIGN_EPI) { if (wr == 1) PG8_BAR; }
    }
    PG8_WAIT_V(0);
    if constexpr (!ALIGN_EPI) { if (wr == 0) PG8_BAR; }
    PG8_BAR;
    if constexpr (Epi::AFTER_DRAIN) { E.fused(acc, cur, wr, wc, fr, fq, lds, wid, lane); S.done(cur); }
#undef PG8_SA
#undef PG8_SB
#undef PG8_STAGE
#undef PG8_LDA
#undef PG8_LDB
#undef PG8_MMA
#undef PG8_WAIT_V
#undef PG8_WAIT_L
#undef PG8_BAR
#undef PG8_SCHED
}
}


typedef unsigned short bf16_t;
typedef short bf16x8 __attribute__((ext_vector_type(8)));
typedef float f32x16 __attribute__((ext_vector_type(16)));
typedef pg8::f32x4 f32x4;
using pg8::Unit;

constexpr int NTHR = 512, NWV = 8;
constexpr int NTOK = 16384, NCTX = 8192, DM = 1024, DIN = 2336, DINP = 2560, DFF = 4096;
constexpr int LDS_RED = 131072;
constexpr int LDS_ROPEW = 131072 + 4096, LDS_ROPEM = LDS_ROPEW + 64 * 32 * 4;
constexpr int LDS_BYTES = LDS_ROPEM + 64 * 16 * 4;
constexpr float LOG2E = 1.4426950408889634f;
constexpr float L2_10000 = 13.287712379549449f;

#define AL256(x) (((x) + 255) & ~(size_t)255)
constexpr size_t OFF_mod = 0;
constexpr size_t OFF_ropeW = OFF_mod + AL256((size_t)2 * 9 * 6144 * 4);
constexpr size_t OFF_ropeM = OFF_ropeW + AL256((size_t)64 * 32 * 4);
constexpr size_t OFF_ctl = OFF_ropeM + AL256((size_t)64 * 16 * 4);
constexpr size_t OFF_rssA = OFF_ctl + AL256((size_t)256 * 4);
constexpr size_t OFF_rssB = OFF_rssA + AL256((size_t)NTOK * 16 * 4);
constexpr size_t OFF_sWin = OFF_rssB + AL256((size_t)NTOK * 16 * 4);
constexpr size_t OFF_sWup = OFF_sWin + AL256((size_t)2 * 9 * DINP * 4);
constexpr size_t OFF_WinT = OFF_sWup + AL256((size_t)2 * 9 * DFF * 4);
constexpr size_t OFF_WoutT = OFF_WinT + AL256((size_t)2 * DINP * DM * 2);
constexpr size_t OFF_WupT = OFF_WoutT + AL256((size_t)2 * DM * DM * 2);
constexpr size_t OFF_WdownT = OFF_WupT + AL256((size_t)2 * DFF * DM * 2);
constexpr size_t OFF_WkvbT = OFF_WdownT + AL256((size_t)2 * DM * DFF * 2);
constexpr size_t OFF_hbuf = OFF_WkvbT + AL256((size_t)2 * 512 * 128 * 2);
constexpr size_t OFF_Kwin_l = OFF_hbuf + AL256((size_t)NTOK * DM * 2);
constexpr size_t OFF_Vtwin_l = OFF_Kwin_l + AL256((size_t)2 * 8 * 1280 * 128 * 2);
constexpr size_t OFF_S0t = OFF_Vtwin_l + AL256((size_t)2 * 8 * 2 * 64 * 1280 * 2);
constexpr size_t OFF_ckvn = OFF_S0t + AL256((size_t)2 * 8 * 2 * 4 * 4096 * 2);
constexpr size_t OFF_Kmla_l = OFF_ckvn + AL256((size_t)2 * 18432 * 128 * 2);
constexpr size_t OFF_Vtmla_l = OFF_Kmla_l + AL256((size_t)2 * 8 * 4 * 1280 * 96 * 2);
constexpr size_t OFF_ubuf = OFF_Vtmla_l + AL256((size_t)2 * 8 * 4 * 64 * 1280 * 2);
constexpr size_t WS_END = OFF_ubuf + AL256((size_t)NTOK * DFF * 2);
constexpr size_t OFF_mix = OFF_ubuf + (size_t)96 * 1024 * 1024;
constexpr size_t OFF_Qwin = OFF_ubuf;
constexpr size_t OFF_Kwin_c = OFF_Qwin + AL256((size_t)NTOK * 512 * 2);
constexpr size_t OFF_Vtwin_c = OFF_Kwin_c + AL256((size_t)NCTX * 128 * 2);
constexpr size_t OFF_Qret = OFF_Vtwin_c + AL256((size_t)32 * 2 * 64 * 256 * 2);
constexpr size_t OFF_Kret = OFF_Qret + AL256((size_t)NTOK * 256 * 2);
constexpr size_t OFF_Gret = OFF_Kret + AL256((size_t)NTOK * 256 * 2);
constexpr size_t OFF_Vtret_c = OFF_Gret + AL256((size_t)NTOK * 256 * 2);
constexpr size_t OFF_Vtret_l = OFF_Vtret_c + AL256((size_t)32 * 4 * 64 * 256 * 2);
constexpr size_t OFF_Qmla = OFF_Vtret_l + AL256((size_t)8 * 4 * 64 * 1024 * 2);
constexpr size_t OFF_Kmla_c = OFF_Qmla + AL256((size_t)NTOK * 384 * 2);
constexpr size_t OFF_Vtmla_c = OFF_Kmla_c + AL256((size_t)32 * 4 * 256 * 96 * 2);
static_assert(OFF_Vtmla_c + (size_t)32 * 4 * 64 * 256 * 2 <= OFF_mix && OFF_mix + (size_t)NTOK * DM * 2 <= WS_END, "attention temporaries + mix must fit in the ubuf region");
static_assert(WS_END <= (size_t)256 * 1024 * 1024, "workspace must fit 256 MiB");

struct P {
  const float *x_prompt, *x_sample, *cache_win_k, *cache_win_v, *cache_mla_ckv, *cache_mla_krope, *state_ret,
      *c, *c_ctx, *w_mod, *b_mod, *norm1, *norm2, *w_in, *win_sink, *ret_decay, *ret_gn, *mla_kv_norm,
      *w_kv_b, *w_out, *w_up, *w_down, *final_norm;
  float* out;
  unsigned char* ws;
#define WSBUF(ty, name) __device__ __forceinline__ ty* name() const { return (ty*)(ws + OFF_##name); }
  WSBUF(unsigned, ctl) WSBUF(float, mod) WSBUF(float, ropeW) WSBUF(float, ropeM) WSBUF(float, rssA) WSBUF(float, rssB) WSBUF(float, sWin) WSBUF(float, sWup) WSBUF(bf16_t, WinT) WSBUF(bf16_t, WoutT) WSBUF(bf16_t, WupT) WSBUF(bf16_t, WdownT) WSBUF(bf16_t, WkvbT)
  WSBUF(bf16_t, hbuf) WSBUF(bf16_t, mix) WSBUF(bf16_t, Qwin) WSBUF(bf16_t, Kwin_c) WSBUF(bf16_t, Vtwin_c) WSBUF(bf16_t, Kwin_l)
  WSBUF(bf16_t, Vtwin_l) WSBUF(bf16_t, Qret) WSBUF(bf16_t, Kret) WSBUF(bf16_t, Gret) WSBUF(bf16_t, Vtret_c) WSBUF(bf16_t, Vtret_l)
  WSBUF(bf16_t, S0t) WSBUF(bf16_t, Qmla) WSBUF(bf16_t, ckvn) WSBUF(bf16_t, Kmla_c) WSBUF(bf16_t, Vtmla_c) WSBUF(bf16_t, Kmla_l)
  WSBUF(bf16_t, Vtmla_l) WSBUF(bf16_t, ubuf)
  __device__ __forceinline__ float* xw() const { return out; }
};

typedef float f32x2_t __attribute__((ext_vector_type(2)));
typedef __bf16 bf16x2_t __attribute__((ext_vector_type(2)));
__device__ __forceinline__ unsigned pk2(float lo, float hi) {
  const f32x2_t v = {lo, hi};
  const bf16x2_t b = __builtin_convertvector(v, bf16x2_t);
  return __builtin_bit_cast(unsigned, b);
}
__device__ __forceinline__ bf16_t f2bf(float f) { return (bf16_t)(pk2(f, 0.f) & 0xffffu); }
__device__ __forceinline__ float bf2f(bf16_t b) { return __uint_as_float(((unsigned)b) << 16); }
__device__ __forceinline__ float shx(float v, int mask, int ln) { return __int_as_float(__builtin_amdgcn_ds_bpermute((ln ^ mask) << 2, __float_as_int(v))); }
__device__ __forceinline__ float wave_sum(float v, int ln) {
#pragma unroll
  for (int o = 1; o < 64; o <<= 1) v += shx(v, o, ln);
  return v;
}
typedef const __attribute__((address_space(4))) unsigned char* kargp_t;
__device__ __forceinline__ P load_params(kargp_t kp) {
  asm volatile("" : "+s"(kp));
  P p;
  __builtin_memcpy(&p, kp, sizeof(P));
  return p;
}
__device__ __forceinline__ int my_tid(int wv) { int w = wv; asm volatile("" : "+s"(w)); int t = w * 64 + lane_id(); asm volatile("" : "+v"(t)); return t; }
__device__ __forceinline__ int my_bid() { int b = blockIdx.x; asm volatile("" : "+s"(b)); return b; }
__device__ __forceinline__ float fexp2(float x) { return __builtin_amdgcn_exp2f(x); }
__device__ __forceinline__ int mod_row(int m) { return m < NCTX ? 0 : 1 + ((m - NCTX) >> 10); }

__device__ __forceinline__ void st_rm_bf16(bf16_t* rp, int h, const f32x16& o) {
#pragma unroll
  for (int g = 0; g < 4; ++g) {
    uint2 u;
    u.x = pk2(o[4 * g], o[4 * g + 1]);
    u.y = pk2(o[4 * g + 2], o[4 * g + 3]);
    *(uint2*)(rp + 8 * g + 4 * h) = u;
  }
}
__device__ __forceinline__ void st_tr_bf16(bf16_t* bp, int stride, int h, const f32x16& o) {
#pragma unroll
  for (int i = 0; i < 16; ++i) bp[(size_t)((i & 3) + 8 * (i >> 2) + 4 * h) * stride] = f2bf(o[i]);
}

__device__ __forceinline__ void st8_bf16(bf16_t* rp, int fq, const f32x4& a, const f32x4& b) {
  *(uint2*)(rp + 4 * fq) = make_uint2(pk2(a[0], a[1]), pk2(a[2], a[3]));
  *(uint2*)(rp + 16 + 4 * fq) = make_uint2(pk2(b[0], b[1]), pk2(b[2], b[3]));
}
__device__ __forceinline__ void st8_f32(float* rp, int fq, const f32x4& a, const f32x4& b) {
  *(f32x4*)(rp + 4 * fq) = a;
  *(f32x4*)(rp + 16 + 4 * fq) = b;
}
__device__ __forceinline__ void st8_tr(bf16_t* bp, int stride, int fq, const f32x4& a, const f32x4& b) {
#pragma unroll
  for (int j = 0; j < 4; ++j) {
    bp[(size_t)(4 * fq + j) * stride] = f2bf(a[j]);
    bp[(size_t)(16 + 4 * fq + j) * stride] = f2bf(b[j]);
  }
}
__device__ __forceinline__ void rope8_win(f32x4& a, f32x4& b, int fq, const float* tab) {
  const f32x4 cs = *(const f32x4*)(tab + 4 * fq), sn = *(const f32x4*)(tab + 16 + 4 * fq);
  const f32x4 x = a, y = b;
  a = x * cs - y * sn;
  b = x * sn + y * cs;
}
__device__ __forceinline__ void rope8_mla(f32x4& a, f32x4& b, int fq, int ln, const float* tabr, const float* tabc) {
  const int fo = 4 * (fq & 1);
  {
    const f32x4 cs = *(const f32x4*)(tabr + fo), sn = *(const f32x4*)(tabr + 8 + fo);
#pragma unroll
    for (int j = 0; j < 4; ++j) { const float pa = shx(a[j], 32, ln); a[j] = fq < 2 ? a[j] * cs[j] - pa * sn[j] : pa * sn[j] + a[j] * cs[j]; }
  }
  asm volatile("" ::: "memory");
  {
    const f32x4 cs = *(const f32x4*)(tabc + fo), sn = *(const f32x4*)(tabc + 8 + fo);
#pragma unroll
    for (int j = 0; j < 4; ++j) { const float pb = shx(b[j], 32, ln); b[j] = fq < 2 ? b[j] * cs[j] - pb * sn[j] : pb * sn[j] + b[j] * cs[j]; }
  }
}


__device__ __forceinline__ void st8p_bf16(bf16_t* rp, int fq, const f32x4& a, const f32x4& b) {
  *(uint4*)(rp + 8 * fq) = make_uint4(pk2(a[0], a[1]), pk2(a[2], a[3]), pk2(b[0], b[1]), pk2(b[2], b[3]));
}
__device__ __forceinline__ void st8p_f32(float* rp, int fq, const f32x4& a, const f32x4& b) {
  *(f32x4*)(rp + 8 * fq) = a;
  *(f32x4*)(rp + 8 * fq + 4) = b;
}
__device__ __forceinline__ void st8p_tr(bf16_t* bp, int stride, int fq, const f32x4& a, const f32x4& b) {
#pragma unroll
  for (int j = 0; j < 4; ++j) {
    bp[(size_t)(8 * fq + j) * stride] = f2bf(a[j]);
    bp[(size_t)(8 * fq + 4 + j) * stride] = f2bf(b[j]);
  }
}
__device__ __forceinline__ void rope8p_win(f32x4& a, f32x4& b, int fq, int ln, const float* tab) {
  const int f0 = 8 * (fq & 1);
  const f32x4 ca = *(const f32x4*)(tab + f0), cb4 = *(const f32x4*)(tab + f0 + 4), sa = *(const f32x4*)(tab + 16 + f0), sb = *(const f32x4*)(tab + 16 + f0 + 4);
#pragma unroll
  for (int j = 0; j < 4; ++j) {
    const float pa = shx(a[j], 32, ln), pb = shx(b[j], 32, ln);
    a[j] = fq < 2 ? a[j] * ca[j] - pa * sa[j] : pa * sa[j] + a[j] * ca[j];
    b[j] = fq < 2 ? b[j] * cb4[j] - pb * sb[j] : pb * sb[j] + b[j] * cb4[j];
  }
}
__device__ __forceinline__ void rope8p_mla(f32x4& a, f32x4& b, int fq, int ln, const float* tabr, const float* tabc) {
  const float* tab = fq < 2 ? tabr : tabc;
  const f32x4 ca = *(const f32x4*)(tab), cb4 = *(const f32x4*)(tab + 4), sa = *(const f32x4*)(tab + 8), sb = *(const f32x4*)(tab + 12);
#pragma unroll
  for (int j = 0; j < 4; ++j) {
    const float pa = shx(a[j], 16, ln), pb = shx(b[j], 16, ln);
    a[j] = (fq & 1) == 0 ? a[j] * ca[j] - pa * sa[j] : pa * sa[j] + a[j] * ca[j];
    b[j] = (fq & 1) == 0 ? b[j] * cb4[j] - pb * sb[j] : pb * sb[j] + b[j] * cb4[j];
  }
}

__device__ __forceinline__ float row_rstd(const float* rss, int m) {
  const f32x4 a = *(const f32x4*)(rss + (size_t)m * 16), b = *(const f32x4*)(rss + (size_t)m * 16 + 4);
  const f32x4 c = *(const f32x4*)(rss + (size_t)m * 16 + 8), d = *(const f32x4*)(rss + (size_t)m * 16 + 12);
  const f32x4 s = (a + b) + (c + d);
  return rsqrtf(((s[0] + s[1]) + (s[2] + s[3])) * (1.f / 1024.f) + 1e-6f);
}

typedef f32x4 acc_t[2][2][4][2];
template <int V> struct IC { static constexpr int value = V; };
extern __shared__ __attribute__((aligned(16))) unsigned char smem[];
struct EpiIn8 {
  static constexpr bool PERM = true, AFTER_DRAIN = false;
  P p0; int l; kargp_t kp;
  __device__ __forceinline__ void operator()(const acc_t& acc, const Unit& u, int wr, int wc, int fr_in, int fq_in) const {
    int fr = fr_in; asm volatile("" : "+v"(fr));
    int fq = fq_in; asm volatile("" : "+v"(fq));
    const int ln = fq * 16 + fr; (void)ln;
    P p = p0; asm volatile("" : "+s"(p.ws), "+s"(p.out));
    const bool lat = u.pm >= 32;
    const int rbase = u.pm * 256 + wr * 64 + fr;
#define ROWS_BEGIN _Pragma("unroll") for (int ai = 0; ai < 2; ++ai) _Pragma("unroll") for (int mm = 0; mm < 4; ++mm) { \
      int m = rbase + ai * 128 + mm * 16; asm volatile("" : "+v"(m)); int b, s; \
      if (!lat) { b = m >> 8; s = m & 255; } else { b = (m - NCTX) >> 10; s = (m - NCTX) & 1023; } \
      const float rsd = rsdv[ai][mm]; \
      f32x4 v0 = acc[ai][bj][mm][0] * rsd + sw0, v1 = acc[ai][bj][mm][1] * rsd + sw1; (void)b; (void)s;
#define ROWS_END }
    float rsdv[2][4];
    {
      const float* rss = p.rssA();
#pragma unroll
      for (int ai = 0; ai < 2; ++ai)
#pragma unroll
        for (int mm = 0; mm < 4; ++mm) rsdv[ai][mm] = row_rstd(rss, rbase + ai * 128 + mm * 16);
    }
    auto do_half = [&](auto BJ) {
      constexpr int bj = decltype(BJ)::value;
      const int nb = u.pn * 256 + bj * 128 + wc * 32;
      if (nb >= DIN) return;
      const float* swp = p.sWin() + ((size_t)(l * 9 + (lat ? 1 + ((u.pm - 32) >> 2) : 0))) * DINP + nb;
      const f32x4 sw0 = *(const f32x4*)(swp + 8 * fq), sw1 = *(const f32x4*)(swp + 8 * fq + 4);
      if (nb < 512) {
        ROWS_BEGIN
          if (lat) rope8p_win(v0, v1, fq, ln, (const float*)(smem + LDS_ROPEW) + ((nb & 32) ? (s & 63) : (s >> 6)) * 32);
          st8p_bf16(p.Qwin() + (size_t)m * 512 + nb, fq, v0, v1);
        ROWS_END
      } else if (nb < 640) {
        const int c = nb - 512;
        ROWS_BEGIN
          if (!lat) {
            st8p_f32(p.out + 16777216 + ((size_t)((b * 2 + l) * 256 + s)) * 128 + c, fq, v0, v1);
            st8p_bf16(p.Kwin_c() + (size_t)m * 128 + c, fq, v0, v1);
          } else {
            rope8p_win(v0, v1, fq, ln, (const float*)(smem + LDS_ROPEW) + ((nb & 32) ? (s & 63) : (s >> 6)) * 32);
            st8p_bf16(p.Kwin_l() + ((size_t)((l * 8 + b) * 1280 + s)) * 128 + c, fq, v0, v1);
          }
        ROWS_END
      } else if (nb < 768) {
        const int c = nb - 640, kv = c >> 6, d0 = c & 63;
        ROWS_BEGIN
          if (!lat) {
            st8p_f32(p.out + 18874368 + ((size_t)((b * 2 + l) * 256 + s)) * 128 + c, fq, v0, v1);
            st8p_tr(p.Vtwin_c() + ((size_t)((b * 2 + kv) * 64 + d0)) * 256 + s, 256, fq, v0, v1);
          } else {
            st8p_tr(p.Vtwin_l() + ((size_t)(((l * 8 + b) * 2 + kv) * 64 + d0)) * 1280 + s, 1280, fq, v0, v1);
          }
        ROWS_END
      } else if (nb < 1024) {
        ROWS_BEGIN
          st8p_bf16(p.Qret() + (size_t)m * 256 + (nb - 768), fq, v0, v1);
        ROWS_END
      } else if (nb < 1280) {
        ROWS_BEGIN
          st8p_bf16(p.Kret() + (size_t)m * 256 + (nb - 1024), fq, v0, v1);
        ROWS_END
      } else if (nb < 1536) {
        const int c = nb - 1280, hh = c >> 6, d0 = c & 63;
        ROWS_BEGIN
          if (!lat) st8p_tr(p.Vtret_c() + ((size_t)((b * 4 + hh) * 64 + d0)) * 256 + s, 256, fq, v0, v1);
          else st8p_tr(p.Vtret_l() + ((size_t)((b * 4 + hh) * 64 + d0)) * 1024 + s, 1024, fq, v0, v1);
        ROWS_END
      } else if (nb < 1792) {
        ROWS_BEGIN
          st8p_bf16(p.Gret() + (size_t)m * 256 + (nb - 1536), fq, v0, v1);
        ROWS_END
      } else if (nb < 2176) {
        const int c = nb - 1792;
        const bool rp = lat && (c % 96) == 64;
        ROWS_BEGIN
          if (rp) rope8p_mla(v0, v1, fq, ln, (const float*)(smem + LDS_ROPEM) + (s >> 6) * 16, (const float*)(smem + LDS_ROPEM) + (s & 63) * 16);
          st8p_bf16(p.Qmla() + (size_t)m * 384 + c, fq, v0, v1);
        ROWS_END
      } else if (nb < 2304) {
        const int c = nb - 2176;
        float* red = (float*)(smem + LDS_RED);
        kargp_t k2 = kp; asm volatile("" : "+s"(k2));
        const float* g = ((const __attribute__((address_space(4))) P*)k2)->mla_kv_norm + l * 128 + c;
        const f32x4 g0 = *(const f32x4*)(g + 8 * fq), g1 = *(const f32x4*)(g + 8 * fq + 4);
#pragma unroll
        for (int ai = 0; ai < 2; ++ai)
#pragma unroll
          for (int mm = 0; mm < 4; ++mm) {
            const float rsd0 = rsdv[ai][mm];
            const f32x4 a = acc[ai][bj][mm][0] * rsd0 + sw0, b4 = acc[ai][bj][mm][1] * rsd0 + sw1;
            float ss = a[0] * a[0] + a[1] * a[1] + a[2] * a[2] + a[3] * a[3] + b4[0] * b4[0] + b4[1] * b4[1] + b4[2] * b4[2] + b4[3] * b4[3];
            ss += shx(ss, 16, ln);
            ss += shx(ss, 32, ln);
            if (fq == 0) red[wc * 256 + ai * 128 + wr * 64 + mm * 16 + fr] = ss;
          }
        asm volatile("s_waitcnt lgkmcnt(0)" ::: "memory");
        __builtin_amdgcn_s_barrier();
        ROWS_BEGIN
          const int rt = ai * 128 + wr * 64 + mm * 16 + fr;
          const float rsv = rsqrtf((red[rt] + red[256 + rt] + red[512 + rt] + red[768 + rt]) * (1.f / 128.f) + 1e-6f);
          v0 = v0 * rsv * g0;
          v1 = v1 * rsv * g1;
          st8p_bf16(p.ckvn() + ((size_t)l * 18432 + m) * 128 + c, fq, v0, v1);
          if (!lat) st8p_f32(p.out + 20971520 + ((size_t)((b * 2 + l) * 256 + s)) * 128 + c, fq, v0, v1);
        ROWS_END
        asm volatile("s_waitcnt vmcnt(0) lgkmcnt(0)" ::: "memory");
        __builtin_amdgcn_s_barrier();
        if (wr == 0 && wc == 0 && ln == 0) {
          __builtin_amdgcn_fence(__ATOMIC_RELEASE, "agent");
          asm volatile("s_waitcnt vmcnt(0)" ::: "memory");
          __hip_atomic_fetch_add(p.ctl() + 64 * l, 1u, __ATOMIC_RELAXED, __HIP_MEMORY_SCOPE_AGENT);
        }
      } else {
        ROWS_BEGIN
          if (!lat) {
            st8p_f32(p.out + 23068672 + ((size_t)((b * 2 + l) * 256 + s)) * 32, fq, v0, v1);
#pragma unroll
            for (int hh = 0; hh < 4; ++hh) st8p_bf16(p.Kmla_c() + ((size_t)((b * 4 + hh) * 256 + s)) * 96 + 64, fq, v0, v1);
          } else {
            rope8p_mla(v0, v1, fq, ln, (const float*)(smem + LDS_ROPEM) + (s >> 6) * 16, (const float*)(smem + LDS_ROPEM) + (s & 63) * 16);
#pragma unroll
            for (int hh = 0; hh < 4; ++hh) st8p_bf16(p.Kmla_l() + ((size_t)(((l * 8 + b) * 4 + hh) * 1280 + s)) * 96 + 64, fq, v0, v1);
          }
        ROWS_END
      }
    };
    do_half(IC<0>{});
    do_half(IC<1>{});
#undef ROWS_BEGIN
#undef ROWS_END
  }
};

struct EpiOut8 {
  static constexpr bool PERM = true, AFTER_DRAIN = false;
  P p0; int l;
  __device__ __forceinline__ void operator()(const acc_t& acc, const Unit& u, int wr, int wc, int fr_in, int fq_in) const {
    int fr = fr_in; asm volatile("" : "+v"(fr));
    int fq = fq_in; asm volatile("" : "+v"(fq));
    const int ln = fq * 16 + fr; (void)ln;
    P p = p0; asm volatile("" : "+s"(p.ws), "+s"(p.out));
    const int rbase = u.pm * 256 + wr * 64 + fr;
    const int cb = u.pn * 256 + wc * 32 + 8 * fq;
    const float* md = p.mod() + ((size_t)(l * 9 + mod_row(u.pm * 256))) * 6144;
    const float* gate = md + 2 * 1024; const float* sc2 = md + 4 * 1024; const float* g2 = p.norm2 + l * DM;
#pragma unroll
    for (int ap = 0; ap < 4; ++ap) {
      constexpr int dummy = 0; (void)dummy;
      const int ai = ap >> 1, m2 = (ap & 1) * 2;
      int mb = rbase + ai * 128 + m2 * 16; asm volatile("" : "+v"(mb));
      f32x4 xv[2][2][2];
#pragma unroll
      for (int mq = 0; mq < 2; ++mq) {
        const int mm = m2 + mq;
        const int m = mb + mq * 16;
        if (l == 0) {
          const float* xr = m < NCTX ? p.x_prompt + (size_t)m * DM : p.x_sample + (size_t)(m - NCTX) * DM;
#pragma unroll
          for (int bj = 0; bj < 2; ++bj)
#pragma unroll
            for (int n = 0; n < 2; ++n) xv[mq][bj][n] = *(const f32x4*)(xr + cb + bj * 128 + n * 4);
        } else {
          const bf16_t* hr = p.hbuf() + (size_t)m * DM;
#pragma unroll
          for (int bj = 0; bj < 2; ++bj)
#pragma unroll
            for (int n = 0; n < 2; ++n) {
              const int c = cb + bj * 128 + n * 4;
              const uint2 hq = *(const uint2*)(hr + c);
              const f32x4 q1 = *(const f32x4*)(p.norm1 + DM + c) * (*(const f32x4*)(md + 1 * 1024 + c) + 1.f);
              f32x4 xm;
              xm[0] = __uint_as_float(hq.x << 16) * __builtin_amdgcn_rcpf(q1[0]); xm[1] = __uint_as_float(hq.x & 0xffff0000u) * __builtin_amdgcn_rcpf(q1[1]);
              xm[2] = __uint_as_float(hq.y << 16) * __builtin_amdgcn_rcpf(q1[2]); xm[3] = __uint_as_float(hq.y & 0xffff0000u) * __builtin_amdgcn_rcpf(q1[3]);
              xv[mq][bj][n] = xm;
            }
        }
      }
#pragma unroll
      for (int mq = 0; mq < 2; ++mq) {
        const int mm = m2 + mq;
        const int m = mb + mq * 16;
        bf16_t* ho = p.hbuf() + (size_t)m * DM;
        float ss = 0.f;
#pragma unroll
        for (int bj = 0; bj < 2; ++bj)
#pragma unroll
          for (int n = 0; n < 2; ++n) {
            const int c = cb + bj * 128 + n * 4;
            const f32x4 xn = xv[mq][bj][n] + *(const f32x4*)(gate + c) * acc[ai][bj][mm][n];
            const f32x4 hv = xn * (*(const f32x4*)(g2 + c) * (*(const f32x4*)(sc2 + c) + 1.f));
            *(uint2*)(ho + c) = make_uint2(pk2(hv[0], hv[1]), pk2(hv[2], hv[3]));
            ss += (xn[0] * xn[0] + xn[1] * xn[1]) + (xn[2] * xn[2] + xn[3] * xn[3]);
          }
        ss += shx(ss, 16, ln);
        ss += shx(ss, 32, ln);
        if (fq == 0) p.rssB()[(size_t)m * 16 + u.pn * 4 + wc] = ss;
      }
      asm volatile("" ::: "memory");
    }
  }
};
struct EpiUp8 {
  static constexpr bool PERM = true, AFTER_DRAIN = false;
  P p0; int l;
  __device__ __forceinline__ void operator()(const acc_t& acc, const Unit& u, int wr, int wc, int fr_in, int fq_in) const {
    int fr = fr_in; asm volatile("" : "+v"(fr));
    int fq = fq_in; asm volatile("" : "+v"(fq));
    const int ln = fq * 16 + fr; (void)ln;
    P p = p0; asm volatile("" : "+s"(p.ws), "+s"(p.out));
    const int rbase = u.pm * 256 + wr * 64 + fr;
    const int cb = u.pn * 256 + wc * 32 + 8 * fq;
    const float* swp = p.sWup() + ((size_t)(l * 9 + mod_row(u.pm * 256))) * DFF;
    float rsdv[2][4];
#pragma unroll
    for (int ai = 0; ai < 2; ++ai)
#pragma unroll
      for (int mm = 0; mm < 4; ++mm) rsdv[ai][mm] = row_rstd(p.rssB(), rbase + ai * 128 + mm * 16);
    f32x4 swv[2][2];
#pragma unroll
    for (int bj = 0; bj < 2; ++bj)
#pragma unroll
      for (int n = 0; n < 2; ++n) swv[bj][n] = *(const f32x4*)(swp + cb + bj * 128 + n * 4);
#pragma unroll
    for (int ai = 0; ai < 2; ++ai)
#pragma unroll
      for (int mm = 0; mm < 4; ++mm) {
        int m = rbase + ai * 128 + mm * 16; asm volatile("" : "+v"(m));
        bf16_t* uo = p.ubuf() + (size_t)m * DFF;
        const float rsd = rsdv[ai][mm];
#pragma unroll
        for (int bj = 0; bj < 2; ++bj) {
          f32x4 t0 = acc[ai][bj][mm][0] * rsd + swv[bj][0], t1 = acc[ai][bj][mm][1] * rsd + swv[bj][1];
#pragma unroll
          for (int j = 0; j < 4; ++j) { const float a = fmaxf(t0[j], 0.f), b = fmaxf(t1[j], 0.f); t0[j] = a * a; t1[j] = b * b; }
          *(uint4*)(uo + cb + bj * 128) = make_uint4(pk2(t0[0], t0[1]), pk2(t0[2], t0[3]), pk2(t1[0], t1[1]), pk2(t1[2], t1[3]));
        }
      }
  }
};
struct EpiDown8 {
  static constexpr bool PERM = true, AFTER_DRAIN = false;
  P p0; int l;
  __device__ __forceinline__ void operator()(const acc_t& acc, const Unit& u, int wr, int wc, int fr_in, int fq_in) const {
    int fr = fr_in; asm volatile("" : "+v"(fr));
    int fq = fq_in; asm volatile("" : "+v"(fq));
    const int ln = fq * 16 + fr; (void)ln;
    P p = p0; asm volatile("" : "+s"(p.ws), "+s"(p.out));
    const int rbase = u.pm * 256 + wr * 64 + fr;
    const int cb = u.pn * 256 + wc * 32 + 8 * fq;
    const int r = mod_row(u.pm * 256);
    const float* md = p.mod() + ((size_t)(l * 9 + r)) * 6144;
    const float* gate = md + 5 * 1024; const float* sc2 = md + 4 * 1024; const float* g2 = p.norm2 + l * DM;
    const float* sc1 = p.mod() + ((size_t)(9 + r)) * 6144 + 1 * 1024;
    const float* g1 = p.norm1 + DM;
    f32x4 riv[2][2];
#pragma unroll
    for (int bj = 0; bj < 2; ++bj)
#pragma unroll
      for (int n = 0; n < 2; ++n) {
        const int c = cb + bj * 128 + n * 4;
        const f32x4 q2 = *(const f32x4*)(g2 + c) * (*(const f32x4*)(sc2 + c) + 1.f);
#pragma unroll
        for (int j = 0; j < 4; ++j) riv[bj][n][j] = __builtin_amdgcn_rcpf(q2[j]);
      }
#pragma unroll
    for (int ap = 0; ap < 4; ++ap) {
      const int ai = ap >> 1, m2 = (ap & 1) * 2;
      int mb = rbase + ai * 128 + m2 * 16; asm volatile("" : "+v"(mb));
      uint2 hvv[2][2][2];
#pragma unroll
      for (int mq = 0; mq < 2; ++mq) {
        const bf16_t* hr = p.hbuf() + (size_t)(mb + mq * 16) * DM;
#pragma unroll
        for (int bj = 0; bj < 2; ++bj)
#pragma unroll
          for (int n = 0; n < 2; ++n) hvv[mq][bj][n] = *(const uint2*)(hr + cb + bj * 128 + n * 4);
      }
#pragma unroll
      for (int mq = 0; mq < 2; ++mq) {
        const int mm = m2 + mq;
        const int m = mb + mq * 16;
        float* xo = p.xw() + (size_t)m * DM;
        bf16_t* ho = p.hbuf() + (size_t)m * DM;
        float ss = 0.f;
#pragma unroll
        for (int bj = 0; bj < 2; ++bj)
#pragma unroll
          for (int n = 0; n < 2; ++n) {
            const int c = cb + bj * 128 + n * 4;
            const uint2 hq = hvv[mq][bj][n];
            f32x4 xm;
            xm[0] = __uint_as_float(hq.x << 16); xm[1] = __uint_as_float(hq.x & 0xffff0000u);
            xm[2] = __uint_as_float(hq.y << 16); xm[3] = __uint_as_float(hq.y & 0xffff0000u);
            const f32x4 xn = xm * riv[bj][n] + *(const f32x4*)(gate + c) * acc[ai][bj][mm][n];
            if (l != 0) *(f32x4*)(xo + c) = xn;
            if (l == 0) {
              const f32x4 hv = xn * (*(const f32x4*)(g1 + c) * (*(const f32x4*)(sc1 + c) + 1.f));
              *(uint2*)(ho + c) = make_uint2(pk2(hv[0], hv[1]), pk2(hv[2], hv[3]));
              ss += (xn[0] * xn[0] + xn[1] * xn[1]) + (xn[2] * xn[2] + xn[3] * xn[3]);
            }
          }
        if (l == 0) {
          ss += shx(ss, 16, ln);
          ss += shx(ss, 32, ln);
          if (fq == 0) p.rssA()[(size_t)m * 16 + u.pn * 4 + wc] = ss;
        }
      }
      asm volatile("" ::: "memory");
    }
  }
};

struct EpiKvb {
  P p; int l;
  __device__ __forceinline__ void operator()(int m, int nb, int h, const f32x16& v) const {
    const int hh = nb >> 7, j0 = nb & 127;
    bf16_t* Kb; bf16_t* Vb; int S, key;
    if (m < NCTX) {
      const int b = m >> 8; key = m & 255; S = 256;
      Kb = p.Kmla_c() + ((size_t)((b * 4 + hh) * 256)) * 96;
      Vb = p.Vtmla_c() + ((size_t)((b * 4 + hh) * 64)) * 256;
    } else {
      int b;
      if (m < NTOK) { b = (m - NCTX) >> 10; key = (m - NCTX) & 1023; }
      else { b = (m - NTOK) >> 8; key = 1024 + ((m - NTOK) & 255); }
      S = 1280;
      Kb = p.Kmla_l() + ((size_t)(((l * 8 + b) * 4 + hh) * 1280)) * 96;
      Vb = p.Vtmla_l() + ((size_t)(((l * 8 + b) * 4 + hh) * 64)) * 1280;
    }
    if (j0 < 64) st_rm_bf16(Kb + (size_t)key * 96 + j0, h, v);
    else st_tr_bf16(Vb + (size_t)(j0 - 64) * S + key, S, h, v);
  }
};

template <class Epi>
__device__ __forceinline__ void gemm_small(const bf16_t* __restrict__ A, int lda, const bf16_t* __restrict__ W, int ldw,
                                           int M, int N, int K, unsigned char* smem, const Epi& epi, const int wv, unsigned* ready, unsigned* ticket) {
  constexpr int TA = 256 * 72, TW = 128 * 72;
  bf16_t* sb = (bf16_t*)smem;
  const int tid = my_tid(wv), bid = my_bid(), lane = tid & 63, wave = tid >> 6;
  const int wm = wave >> 1, wn = wave & 1, r = lane & 31, h = lane >> 5;
  const int MT = M >> 8, NT = N >> 7, ntiles = MT * NT, nk = K >> 6;
  const int lc = tid & 7, lr = tid >> 3;
  (void)bid;
  if (tid == 0) {
    unsigned polls = 0;
    while (__hip_atomic_load(ready, __ATOMIC_RELAXED, __HIP_MEMORY_SCOPE_AGENT) < 64u && ++polls < (1u << 22)) __builtin_amdgcn_s_sleep(8);
    __builtin_amdgcn_fence(__ATOMIC_ACQUIRE, "agent");
    asm volatile("s_waitcnt vmcnt(0)" ::: "memory");
  }
  __syncthreads();
  volatile int* tks = (volatile int*)(smem + LDS_RED + 2048);
  for (;;) {
    __syncthreads();
    if (tid == 0) *tks = (int)__hip_atomic_fetch_add(ticket, 1u, __ATOMIC_RELAXED, __HIP_MEMORY_SCOPE_AGENT);
    __syncthreads();
    const int tile = *tks;
    if (tile >= ntiles) break;
    const int m0 = (tile % MT) << 8, n0 = (tile / MT) << 7;
    f32x16 acc[2][2];
#pragma unroll
    for (int a = 0; a < 2; ++a)
#pragma unroll
      for (int b = 0; b < 2; ++b)
#pragma unroll
        for (int i = 0; i < 16; ++i) acc[a][b][i] = 0.f;
    uint4 ra[4], rw[2];
    const bf16_t* Ap = A + (size_t)(m0 + lr) * lda + lc * 8;
    const bf16_t* Wp = W + (size_t)(n0 + lr) * ldw + lc * 8;
    auto gload = [&](int kt) {
#pragma unroll
      for (int i = 0; i < 4; ++i) ra[i] = *(const uint4*)(Ap + (size_t)(64 * i) * lda + kt * 64);
#pragma unroll
      for (int i = 0; i < 2; ++i) rw[i] = *(const uint4*)(Wp + (size_t)(64 * i) * ldw + kt * 64);
    };
    auto swrite = [&](int bsel) {
      bf16_t* sA = sb + bsel * (TA + TW); bf16_t* sW = sA + TA;
#pragma unroll
      for (int i = 0; i < 4; ++i) *(uint4*)(sA + (lr + 64 * i) * 72 + lc * 8) = ra[i];
#pragma unroll
      for (int i = 0; i < 2; ++i) *(uint4*)(sW + (lr + 64 * i) * 72 + lc * 8) = rw[i];
    };
    __syncthreads();
    gload(0); swrite(0);
    __syncthreads();
    for (int kt = 0; kt < nk; ++kt) {
      if (kt + 1 < nk) gload(kt + 1);
      const bf16_t* sA = sb + (kt & 1) * (TA + TW); const bf16_t* sW = sA + TA;
#pragma unroll
      for (int ks = 0; ks < 4; ++ks) {
        bf16x8 wf[2], af[2];
#pragma unroll
        for (int i = 0; i < 2; ++i) {
          wf[i] = *(const bf16x8*)(sW + (wn * 64 + i * 32 + r) * 72 + ks * 16 + h * 8);
          af[i] = *(const bf16x8*)(sA + (wm * 64 + i * 32 + r) * 72 + ks * 16 + h * 8);
        }
#pragma unroll
        for (int a = 0; a < 2; ++a)
#pragma unroll
          for (int b = 0; b < 2; ++b) acc[a][b] = __builtin_amdgcn_mfma_f32_32x32x16_bf16(wf[a], af[b], acc[a][b], 0, 0, 0);
      }
      if (kt + 1 < nk) swrite((kt + 1) & 1);
      __syncthreads();
    }
#pragma unroll
    for (int a = 0; a < 2; ++a)
#pragma unroll
      for (int b = 0; b < 2; ++b) epi(m0 + wm * 64 + b * 32 + r, n0 + wn * 64 + a * 32, h, acc[a][b]);
  }
}

struct AttnItem {
  const bf16_t* Q; int qs;
  const bf16_t* K; int ks;
  const bf16_t* Vt; int vs;
  int t0, t1, t2, t3;
  int qpos0, T;
  float scale, sink_l2; int has_sink;
  float lgf, lgb;
  const bf16_t *S0f, *S0b;
  const bf16_t* G; const float* gn;
  bf16_t* out;
  float* sout;
};

template <int DQK, int MODE>
__device__ __forceinline__ void attn_item(const AttnItem& it, unsigned char* smem, const int wv) {
  constexpr int KSTR = DQK + 8, NKS = DQK / 16, VSTR = 68, KCH = DQK / 8;
  bf16_t* Ks = (bf16_t*)smem;
  bf16_t* Vs = Ks + 64 * KSTR;
  const int tid = my_tid(wv), lane = tid & 63, wave = tid >> 6, r = lane & 31, h = lane >> 5;
  const int qrow = wave * 32 + r;
  bf16x8 qf[NKS];
  if constexpr (MODE == 3) {
    const int dq = (wave & 1) * 32 + r;
#pragma unroll
    for (int ks = 0; ks < NKS; ++ks) {
      const int e = dq - (ks * 16 + h * 8);
      uint4 v;
      v.x = e == 0 ? 0x3F80u : (e == 1 ? 0x3F800000u : 0u);
      v.y = e == 2 ? 0x3F80u : (e == 3 ? 0x3F800000u : 0u);
      v.z = e == 4 ? 0x3F80u : (e == 5 ? 0x3F800000u : 0u);
      v.w = e == 6 ? 0x3F80u : (e == 7 ? 0x3F800000u : 0u);
      qf[ks] = __builtin_bit_cast(bf16x8, v);
    }
  } else {
#pragma unroll
    for (int ks = 0; ks < NKS; ++ks) qf[ks] = *(const bf16x8*)(it.Q + (size_t)qrow * it.qs + ks * 16 + h * 8);
  }
  f32x16 o0, o1;
#pragma unroll
  for (int i = 0; i < 16; ++i) { o0[i] = 0.f; o1[i] = 0.f; }
  float mrun = it.has_sink ? it.sink_l2 : -1e30f, lrun = 0.f;
  const int qp = it.qpos0 + qrow;
  const int n1 = it.t1 - it.t0, ntl = n1 + (it.t3 - it.t2);
  constexpr int BUFE = 64 * KSTR + 64 * VSTR;
  const int krow0 = tid / KCH, kch0 = tid % KCH, krow1 = (tid + NTHR) / KCH, kch1 = (tid + NTHR) % KCH;
  const bool k2 = (KCH == 12) && (tid + NTHR < 64 * KCH);
  const int vrow = tid >> 3, vch = tid & 7;
  uint4 rk0, rk1, rv;
  auto tile_of = [&](int ti) { return ti < n1 ? it.t0 + ti : it.t2 + (ti - n1); };
  auto gload = [&](int t) {
    const bool stt = (MODE == 2) && (t >= 16);
    if (!stt) {
      const int key0 = t * 64;
      rk0 = *(const uint4*)(it.K + (size_t)(key0 + krow0) * it.ks + kch0 * 8);
      if (k2) rk1 = *(const uint4*)(it.K + (size_t)(key0 + krow1) * it.ks + kch1 * 8);
      rv = *(const uint4*)(it.Vt + (size_t)vrow * it.vs + key0 + vch * 8);
    } else {
      const bf16_t* S = (t == 16) ? it.S0f : it.S0b;
      const int e = krow0 - kch0 * 8;
      rk0.x = e == 0 ? 0x3F80u : (e == 1 ? 0x3F800000u : 0u);
      rk0.y = e == 2 ? 0x3F80u : (e == 3 ? 0x3F800000u : 0u);
      rk0.z = e == 4 ? 0x3F80u : (e == 5 ? 0x3F800000u : 0u);
      rk0.w = e == 6 ? 0x3F80u : (e == 7 ? 0x3F800000u : 0u);
      rv = *(const uint4*)(S + (size_t)vrow * 64 + vch * 8);
    }
  };
  auto swrite = [&](int bsel) {
    bf16_t* Kb = Ks + bsel * BUFE; bf16_t* Vb = Kb + 64 * KSTR;
    *(uint4*)(Kb + krow0 * KSTR + kch0 * 8) = rk0;
    if (k2) *(uint4*)(Kb + krow1 * KSTR + kch1 * 8) = rk1;
    uint2* d = (uint2*)(Vb + vrow * VSTR + vch * 8);
    d[0] = make_uint2(rv.x, rv.y); d[1] = make_uint2(rv.z, rv.w);
  };
  __syncthreads();
  gload(tile_of(0)); swrite(0);
  __syncthreads();
  for (int ti = 0; ti < ntl; ++ti) {
    const int t = tile_of(ti);
    const bool st_tile = (MODE == 2) && (t >= 16);
    const int key0 = t * 64;
    const bool more = ti + 1 < ntl;
    if (more) gload(tile_of(ti + 1));
    const bf16_t* Kc = Ks + (ti & 1) * BUFE; const bf16_t* Vc = Kc + 64 * KSTR;
    bool skip = (MODE == 3) && (wave >= 4);
    if (MODE == 1 && t < 16) {
      const int qlo = it.qpos0 + wave * 32;
      skip = (key0 > qlo + 31 + 128 || key0 + 63 < qlo - 128);
    }
    if (!skip) {
    f32x16 s0, s1;
#pragma unroll
    for (int i = 0; i < 16; ++i) { s0[i] = 0.f; s1[i] = 0.f; }
#pragma unroll
    for (int ks = 0; ks < NKS; ++ks) {
      const bf16x8 k0 = *(const bf16x8*)(Kc + r * KSTR + ks * 16 + h * 8);
      const bf16x8 k1 = *(const bf16x8*)(Kc + (32 + r) * KSTR + ks * 16 + h * 8);
      s0 = __builtin_amdgcn_mfma_f32_32x32x16_bf16(k0, qf[ks], s0, 0, 0, 0);
      s1 = __builtin_amdgcn_mfma_f32_32x32x16_bf16(k1, qf[ks], s1, 0, 0, 0);
    }
    if constexpr (MODE == 3) {
      if (wave < 2) {
        const float base = (float)(it.T - 1 - key0 - 4 * h) * it.lgf - 3.f;
#pragma unroll
        for (int i = 0; i < 16; ++i) {
          s0[i] *= fexp2(fmaf(-(float)((i & 3) + 8 * (i >> 2)), it.lgf, base));
          s1[i] *= fexp2(fmaf(-(float)(32 + (i & 3) + 8 * (i >> 2)), it.lgf, base));
        }
      } else {
        const float base = (float)(key0 + 4 * h) * it.lgb - 3.f;
#pragma unroll
        for (int i = 0; i < 16; ++i) {
          s0[i] *= fexp2(fmaf((float)((i & 3) + 8 * (i >> 2)), it.lgb, base));
          s1[i] *= fexp2(fmaf((float)(32 + (i & 3) + 8 * (i >> 2)), it.lgb, base));
        }
      }
    } else if constexpr (MODE == 2) {
      if (!st_tile) {
        const int qlo = it.qpos0 + wave * 32;
        if (key0 + 63 < qlo) {
          const float base = (float)(qp - key0 - 4 * h) * it.lgf - 3.f;
#pragma unroll
          for (int i = 0; i < 16; ++i) {
            s0[i] *= fexp2(fmaf(-(float)((i & 3) + 8 * (i >> 2)), it.lgf, base));
            s1[i] *= fexp2(fmaf(-(float)(32 + (i & 3) + 8 * (i >> 2)), it.lgf, base));
          }
        } else if (key0 > qlo + 31) {
          const float base = (float)(key0 + 4 * h - qp) * it.lgb - 3.f;
#pragma unroll
          for (int i = 0; i < 16; ++i) {
            s0[i] *= fexp2(fmaf((float)((i & 3) + 8 * (i >> 2)), it.lgb, base));
            s1[i] *= fexp2(fmaf((float)(32 + (i & 3) + 8 * (i >> 2)), it.lgb, base));
          }
        } else {
#pragma unroll
        for (int i = 0; i < 16; ++i) {
          const int key = key0 + (i & 3) + 8 * (i >> 2) + 4 * h;
          const int e0 = qp - key, e1 = e0 - 32;
          float d0 = fexp2((float)(e0 < 0 ? -e0 : e0) * (e0 > 0 ? it.lgf : it.lgb));
          float d1 = fexp2((float)(e1 < 0 ? -e1 : e1) * (e1 > 0 ? it.lgf : it.lgb));
          d0 = e0 == 0 ? 2.f : d0;
          d1 = e1 == 0 ? 2.f : d1;
          s0[i] *= it.scale * d0;
          s1[i] *= it.scale * d1;
        }
        }
      } else {
        const float dec = (t == 16) ? fexp2((float)(qp + 1) * it.lgf) : fexp2((float)(it.T - qp) * it.lgb);
#pragma unroll
        for (int i = 0; i < 16; ++i) { s0[i] *= dec; s1[i] *= dec; }
      }
    } else {
      float mx = -INFINITY;
      const int qlo1 = it.qpos0 + wave * 32;
      const bool need_mask = (MODE == 1) && (t < 16) && !(key0 >= qlo1 + 31 - 128 && key0 + 63 <= qlo1 + 128);
#pragma unroll
      for (int i = 0; i < 16; ++i) {
        float a = s0[i] * it.scale, b = s1[i] * it.scale;
        if (MODE == 1 && need_mask) {
          const int key = key0 + (i & 3) + 8 * (i >> 2) + 4 * h;
          const int e0 = key - qp, e1 = e0 + 32;
          if (e0 > 128 || e0 < -128) a = -INFINITY;
          if (e1 > 128 || e1 < -128) b = -INFINITY;
        }
        s0[i] = a; s1[i] = b;
        mx = fmaxf(mx, fmaxf(a, b));
      }
      mx = fmaxf(mx, shx(mx, 32, lane));
      const float mnew = fmaxf(mrun, mx);
      const float alpha = fexp2(mrun - mnew);
      float sum = 0.f;
#pragma unroll
      for (int i = 0; i < 16; ++i) {
        s0[i] = fexp2(s0[i] - mnew);
        s1[i] = fexp2(s1[i] - mnew);
        sum += s0[i] + s1[i];
      }
      lrun = lrun * alpha + sum;
      mrun = mnew;
#pragma unroll
      for (int i = 0; i < 16; ++i) { o0[i] *= alpha; o1[i] *= alpha; }
    }
#pragma unroll
    for (int kt = 0; kt < 2; ++kt) {
#pragma unroll
      for (int sbk = 0; sbk < 2; ++sbk) {
        uint4 pw;
        if (kt == 0) {
          pw.x = pk2(s0[8 * sbk + 0], s0[8 * sbk + 1]); pw.y = pk2(s0[8 * sbk + 2], s0[8 * sbk + 3]);
          pw.z = pk2(s0[8 * sbk + 4], s0[8 * sbk + 5]); pw.w = pk2(s0[8 * sbk + 6], s0[8 * sbk + 7]);
        } else {
          pw.x = pk2(s1[8 * sbk + 0], s1[8 * sbk + 1]); pw.y = pk2(s1[8 * sbk + 2], s1[8 * sbk + 3]);
          pw.z = pk2(s1[8 * sbk + 4], s1[8 * sbk + 5]); pw.w = pk2(s1[8 * sbk + 6], s1[8 * sbk + 7]);
        }
        const bf16x8 pf = __builtin_bit_cast(bf16x8, pw);
        const int koff = kt * 32 + sbk * 16 + 4 * h;
        const uint2 a0 = *(const uint2*)(Vc + r * VSTR + koff), a1 = *(const uint2*)(Vc + r * VSTR + koff + 8);
        const uint2 b0 = *(const uint2*)(Vc + (32 + r) * VSTR + koff), b1 = *(const uint2*)(Vc + (32 + r) * VSTR + koff + 8);
        const bf16x8 v0 = __builtin_bit_cast(bf16x8, make_uint4(a0.x, a0.y, a1.x, a1.y));
        const bf16x8 v1 = __builtin_bit_cast(bf16x8, make_uint4(b0.x, b0.y, b1.x, b1.y));
        o0 = __builtin_amdgcn_mfma_f32_32x32x16_bf16(v0, pf, o0, 0, 0, 0);
        o1 = __builtin_amdgcn_mfma_f32_32x32x16_bf16(v1, pf, o1, 0, 0, 0);
      }
    }
    }
    if (more) swrite((ti + 1) & 1);
    __syncthreads();
  }
  if constexpr (MODE == 3) {
    if (wave < 4) {
      float* rowp = it.sout + (size_t)(wave >> 1) * 16384 + (size_t)((wave & 1) * 32 + r) * 64;
#pragma unroll
      for (int g = 0; g < 4; ++g) {
        *(float4*)(rowp + 8 * g + 4 * h) = make_float4(o0[4 * g], o0[4 * g + 1], o0[4 * g + 2], o0[4 * g + 3]);
        *(float4*)(rowp + 32 + 8 * g + 4 * h) = make_float4(o1[4 * g], o1[4 * g + 1], o1[4 * g + 2], o1[4 * g + 3]);
      }
    }
    return;
  }
  bf16_t* orow = it.out + (size_t)qrow * DM;
  if constexpr (MODE == 2) {
    float sm = 0.f;
#pragma unroll
    for (int i = 0; i < 16; ++i) sm += o0[i] + o1[i];
    sm += shx(sm, 32, lane);
    const float mu = sm * (1.f / 64.f);
    float vr = 0.f;
#pragma unroll
    for (int i = 0; i < 16; ++i) { o0[i] -= mu; o1[i] -= mu; vr += o0[i] * o0[i] + o1[i] * o1[i]; }
    vr += shx(vr, 32, lane);
    const float rstd = rsqrtf(vr * (1.f / 64.f) + 1e-6f);
    const bf16_t* grow = it.G + (size_t)qrow * 256;
#pragma unroll
    for (int g = 0; g < 4; ++g) {
      const int d = 8 * g + 4 * h;
      const uint2 ga = *(const uint2*)(grow + d), gb = *(const uint2*)(grow + 32 + d);
      const float gav[4] = {__uint_as_float(ga.x << 16), __uint_as_float(ga.x & 0xffff0000u), __uint_as_float(ga.y << 16), __uint_as_float(ga.y & 0xffff0000u)};
      const float gbv[4] = {__uint_as_float(gb.x << 16), __uint_as_float(gb.x & 0xffff0000u), __uint_as_float(gb.y << 16), __uint_as_float(gb.y & 0xffff0000u)};
#pragma unroll
      for (int j = 0; j < 4; ++j) {
        const float x0 = gav[j], x1 = gbv[j];
        o0[4 * g + j] = o0[4 * g + j] * rstd * it.gn[d + j] * (x0 / (1.f + __expf(-x0)));
        o1[4 * g + j] = o1[4 * g + j] * rstd * it.gn[32 + d + j] * (x1 / (1.f + __expf(-x1)));
      }
    }
  } else {
    float lt = lrun + shx(lrun, 32, lane);
    if (it.has_sink) lt += fexp2(it.sink_l2 - mrun);
    const float inv = 1.f / lt;
#pragma unroll
    for (int i = 0; i < 16; ++i) { o0[i] *= inv; o1[i] *= inv; }
  }
  st_rm_bf16(orow, h, o0);
  st_rm_bf16(orow + 32, h, o1);
}

__device__ __forceinline__ float log2_sigmoid(float x) { return -log1pf(expf(-x)) * LOG2E; }

__device__ __forceinline__ void state_item(const P& p, int l, int idx, unsigned char* smem, const int wv) {
  const int b = idx >> 3, hh = (idx >> 1) & 3, dir = idx & 1;
  float* Ksm = (float*)smem;
  float* Vsm = Ksm + 4096;
  const int tid = my_tid(wv);
  const float lg = log2_sigmoid(p.ret_decay[(l * 2 + dir) * 4 + hh]);
  float acc[8];
#pragma unroll
  for (int i = 0; i < 8; ++i) acc[i] = 0.f;
  const int d = tid >> 3, e0 = (tid & 7) * 8;
  for (int c = 0; c < 4; ++c) {
    __syncthreads();
    for (int i = tid; i < 4096; i += NTHR) {
      const int j = i >> 6, dd = i & 63, tok = c * 64 + j;
      const float dec = dir == 0 ? fexp2((float)(255 - tok) * lg) : fexp2((float)tok * lg);
      Ksm[j * 64 + dd] = bf2f(p.Kret()[(size_t)(b * 256 + tok) * 256 + hh * 64 + dd]) * 0.125f * dec;
      const int e = i >> 6, jj = i & 63;
      Vsm[e * 65 + jj] = bf2f(p.Vtret_c()[((size_t)((b * 4 + hh) * 64 + e)) * 256 + c * 64 + jj]);
    }
    __syncthreads();
    for (int j = 0; j < 64; ++j) {
      const float kd = Ksm[j * 64 + d];
#pragma unroll
      for (int i = 0; i < 8; ++i) acc[i] += kd * Vsm[(e0 + i) * 65 + j];
    }
  }
  float* op = p.out + 23592960 + ((size_t)((((b * 2 + l) * 2 + dir) * 4 + hh) * 64 + d)) * 64 + e0;
  *(float4*)(op) = make_float4(acc[0], acc[1], acc[2], acc[3]);
  *(float4*)(op + 4) = make_float4(acc[4], acc[5], acc[6], acc[7]);
}

__device__ __forceinline__ void attn_phase(const P& p, int l, unsigned char* smem, const int wv) {
  constexpr int NA = 128, NB = 128, NC = 256, ND = 256, NE = 128, NF = 128, NG = 128;
  constexpr int TOT = NA + NB + NC + ND + NE + NF + NG;
  unsigned* ticket = p.ctl() + 32 + 64 * l;
  volatile int* tks = (volatile int*)(smem + LDS_RED + 2048);
  const int tid0 = my_tid(wv);
  for (;;) {
    __syncthreads();
    if (tid0 == 0) *tks = (int)__hip_atomic_fetch_add(ticket, 1u, __ATOMIC_RELAXED, __HIP_MEMORY_SCOPE_AGENT);
    __syncthreads();
    const int item = *tks;
    if (item >= TOT) break;
    int idx = item;
    AttnItem it;
    it.t2 = 0; it.t3 = 0; it.qpos0 = 0; it.T = 0; it.sink_l2 = 0.f; it.has_sink = 0; it.lgf = 0.f; it.lgb = 0.f;
    it.S0f = nullptr; it.S0b = nullptr; it.G = nullptr; it.gn = nullptr; it.sout = nullptr;
    if (idx < NA) {
      const int b = idx >> 4, hh = (idx >> 2) & 3, qb = idx & 3, row0 = NCTX + b * 1024 + qb * 256;
      it.Q = p.Qmla() + (size_t)row0 * 384 + hh * 96; it.qs = 384;
      it.K = p.Kmla_l() + ((size_t)(((l * 8 + b) * 4 + hh) * 1280)) * 96; it.ks = 96;
      it.Vt = p.Vtmla_l() + ((size_t)(((l * 8 + b) * 4 + hh) * 64)) * 1280; it.vs = 1280;
      it.t0 = 0; it.t1 = 20;
      it.scale = 0.10206207261596575f * LOG2E;
      it.out = p.mix() + (size_t)row0 * DM + 768 + hh * 64;
      attn_item<96, 0>(it, smem, wv);
      continue;
    }
    idx -= NA;
    if (idx < NB) {
      const int b = idx >> 4, hh = (idx >> 2) & 3, qb = idx & 3, row0 = NCTX + b * 1024 + qb * 256;
      it.Q = p.Qret() + (size_t)row0 * 256 + hh * 64; it.qs = 256;
      it.K = p.Kret() + (size_t)(NCTX + b * 1024) * 256 + hh * 64; it.ks = 256;
      it.Vt = p.Vtret_l() + ((size_t)((b * 4 + hh) * 64)) * 1024; it.vs = 1024;
      it.t0 = 0; it.t1 = 16; it.t2 = 16; it.t3 = 18;
      it.qpos0 = qb * 256; it.T = 1024; it.scale = 0.125f;
      it.lgf = log2_sigmoid(p.ret_decay[(l * 2 + 0) * 4 + hh]);
      it.lgb = log2_sigmoid(p.ret_decay[(l * 2 + 1) * 4 + hh]);
      it.S0f = p.S0t() + ((size_t)((((l * 8 + b) * 2 + 0) * 4 + hh))) * 4096;
      it.S0b = p.S0t() + ((size_t)((((l * 8 + b) * 2 + 1) * 4 + hh))) * 4096;
      it.G = p.Gret() + (size_t)row0 * 256 + hh * 64; it.gn = p.ret_gn + l * 256 + hh * 64;
      it.out = p.mix() + (size_t)row0 * DM + 512 + hh * 64;
      attn_item<64, 2>(it, smem, wv);
      continue;
    }
    idx -= NB;
    if (idx < NC) {
      const int b = idx >> 5, head = (idx >> 2) & 7, qb = idx & 3, kv = head >> 2, row0 = NCTX + b * 1024 + qb * 256;
      it.Q = p.Qwin() + (size_t)row0 * 512 + head * 64; it.qs = 512;
      it.K = p.Kwin_l() + ((size_t)((l * 8 + b) * 1280)) * 128 + kv * 64; it.ks = 128;
      it.Vt = p.Vtwin_l() + ((size_t)(((l * 8 + b) * 2 + kv) * 64)) * 1280; it.vs = 1280;
      it.t0 = max(0, qb * 4 - 2); it.t1 = min(16, qb * 4 + 6); it.t2 = 16; it.t3 = 20;
      it.qpos0 = qb * 256;
      it.scale = 0.125f * LOG2E; it.sink_l2 = p.win_sink[l * 8 + head] * LOG2E; it.has_sink = 1;
      it.out = p.mix() + (size_t)row0 * DM + head * 64;
      attn_item<64, 1>(it, smem, wv);
      continue;
    }
    idx -= NC;
    if (idx < ND) {
      const int b = idx >> 3, head = idx & 7, kv = head >> 2, row0 = b * 256;
      it.Q = p.Qwin() + (size_t)row0 * 512 + head * 64; it.qs = 512;
      it.K = p.Kwin_c() + (size_t)(b * 256) * 128 + kv * 64; it.ks = 128;
      it.Vt = p.Vtwin_c() + ((size_t)((b * 2 + kv) * 64)) * 256; it.vs = 256;
      it.t0 = 0; it.t1 = 4;
      it.scale = 0.125f * LOG2E; it.sink_l2 = p.win_sink[l * 8 + head] * LOG2E; it.has_sink = 1;
      it.out = p.mix() + (size_t)row0 * DM + head * 64;
      attn_item<64, 0>(it, smem, wv);
      continue;
    }
    idx -= ND;
    if (idx < NE) {
      const int b = idx >> 2, hh = idx & 3, row0 = b * 256;
      it.Q = p.Qmla() + (size_t)row0 * 384 + hh * 96; it.qs = 384;
      it.K = p.Kmla_c() + ((size_t)((b * 4 + hh) * 256)) * 96; it.ks = 96;
      it.Vt = p.Vtmla_c() + ((size_t)((b * 4 + hh) * 64)) * 256; it.vs = 256;
      it.t0 = 0; it.t1 = 4;
      it.scale = 0.10206207261596575f * LOG2E;
      it.out = p.mix() + (size_t)row0 * DM + 768 + hh * 64;
      attn_item<96, 0>(it, smem, wv);
      continue;
    }
    idx -= NE;
    if (idx < NF) {
      const int b = idx >> 2, hh = idx & 3, row0 = b * 256;
      it.Q = p.Qret() + (size_t)row0 * 256 + hh * 64; it.qs = 256;
      it.K = p.Kret() + (size_t)(b * 256) * 256 + hh * 64; it.ks = 256;
      it.Vt = p.Vtret_c() + ((size_t)((b * 4 + hh) * 64)) * 256; it.vs = 256;
      it.t0 = 0; it.t1 = 4;
      it.qpos0 = 0; it.T = 256; it.scale = 0.125f;
      it.lgf = log2_sigmoid(p.ret_decay[(l * 2 + 0) * 4 + hh]);
      it.lgb = log2_sigmoid(p.ret_decay[(l * 2 + 1) * 4 + hh]);
      it.G = p.Gret() + (size_t)row0 * 256 + hh * 64; it.gn = p.ret_gn + l * 256 + hh * 64;
      it.out = p.mix() + (size_t)row0 * DM + 512 + hh * 64;
      attn_item<64, 2>(it, smem, wv);
      continue;
    }
    idx -= NF;
    {
      const int b = idx >> 2, hh = idx & 3;
      it.Q = nullptr; it.qs = 0;
      it.K = p.Kret() + (size_t)(b * 256) * 256 + hh * 64; it.ks = 256;
      it.Vt = p.Vtret_c() + ((size_t)((b * 4 + hh) * 64)) * 256; it.vs = 256;
      it.t0 = 0; it.t1 = 4;
      it.T = 256; it.scale = 0.125f;
      it.lgf = log2_sigmoid(p.ret_decay[(l * 2 + 0) * 4 + hh]);
      it.lgb = log2_sigmoid(p.ret_decay[(l * 2 + 1) * 4 + hh]);
      it.out = nullptr;
      it.sout = p.out + 23592960 + ((size_t)((b * 2 + l) * 2 * 4 + hh)) * 4096;
      attn_item<64, 3>(it, smem, wv);
    }
  }
}

__device__ __forceinline__ void gemv9_item(const float* sc, float* red, const float* __restrict__ W, int N, int n0, float* outp, int ldo,
                                           const float* bias, const int tid) {
  const int j4 = (tid & 7) * 4, kq = tid >> 3;
  f32x4 acc[9];
#pragma unroll
  for (int r = 0; r < 9; ++r) acc[r] = (f32x4){0.f, 0.f, 0.f, 0.f};
  const float* w = W + (size_t)(kq * 16) * N + n0 + j4;
  const float* s = sc + kq * 16;
#pragma unroll
  for (int kk = 0; kk < 16; ++kk) {
    const f32x4 wv = *(const f32x4*)(w + (size_t)kk * N);
#pragma unroll
    for (int r = 0; r < 9; ++r) acc[r] += wv * s[r * 1024 + kk];
  }
#pragma unroll
  for (int r = 0; r < 9; ++r) *(f32x4*)(red + (kq * 9 + r) * 32 + j4) = acc[r];
  __syncthreads();
  for (int oo = tid; oo < 288; oo += NTHR) {
    const int r = oo >> 5, jj = oo & 31;
    float sum = 0.f;
#pragma unroll 16
    for (int q = 0; q < 64; ++q) sum += red[(q * 9 + r) * 32 + jj];
    outp[(size_t)r * ldo + n0 + jj] = sum + (bias ? bias[n0 + jj] : 0.f);
  }
  __syncthreads();
}

__device__ __forceinline__ void norm0_phase(const P& p, unsigned char* smem, const int wv) {
  const int tid = my_tid(wv), lane = tid & 63, gw = my_bid() * NWV + (tid >> 6), ngw = gridDim.x * NWV;
  const float* gain = p.norm1;
  for (int m0 = gw; m0 < NTOK; m0 += 2 * ngw) {
    float4 v[2][4];
    float ss[2] = {0.f, 0.f};
#pragma unroll
    for (int q = 0; q < 2; ++q) {
      const int m = m0 + q * ngw;
      const float* xr = m < NCTX ? p.x_prompt + (size_t)m * DM : p.x_sample + (size_t)(m - NCTX) * DM;
#pragma unroll
      for (int j = 0; j < 4; ++j) v[q][j] = ((const float4*)xr)[lane + 64 * j];
    }
#pragma unroll
    for (int q = 0; q < 2; ++q) {
#pragma unroll
      for (int j = 0; j < 4; ++j) ss[q] += v[q][j].x * v[q][j].x + v[q][j].y * v[q][j].y + v[q][j].z * v[q][j].z + v[q][j].w * v[q][j].w;
      ss[q] = wave_sum(ss[q], lane);
    }
#pragma unroll
    for (int q = 0; q < 2; ++q) {
      const int m = m0 + q * ngw;
      const float* scale = p.mod() + ((size_t)mod_row(m)) * 6144 + 1 * 1024;
#pragma unroll
      for (int j = 0; j < 4; ++j) {
        const int c = (lane + 64 * j) * 4;
        const float4 g = *(const float4*)(gain + c), sc = *(const float4*)(scale + c);
        uint2 u;
        u.x = pk2(v[q][j].x * g.x * (1.f + sc.x), v[q][j].y * g.y * (1.f + sc.y));
        u.y = pk2(v[q][j].z * g.z * (1.f + sc.z), v[q][j].w * g.w * (1.f + sc.w));
        *(uint2*)(p.hbuf() + (size_t)m * DM + c) = u;
      }
      if (lane < 16) p.rssA()[(size_t)m * 16 + lane] = lane == 0 ? ss[q] : 0.f;
    }
  }
  float* sc = (float*)smem;
  float* red = sc + 9216;
  constexpr int G_IN = DIN / 32, G_UP = DFF / 32, NIT = 2 * G_IN + 2 * G_UP;
  for (int item = my_bid(); item < NIT; item += gridDim.x) {
    int l, grp; const float* W; int N; float* outp; int ldo; int which;
    if (item < 2 * G_IN) { l = item / G_IN; grp = item % G_IN; W = p.w_in + (size_t)l * DM * DIN; N = DIN; outp = p.sWin() + (size_t)l * 9 * DINP; ldo = DINP; which = 0; }
    else { const int i2 = item - 2 * G_IN; l = i2 / G_UP; grp = i2 % G_UP; W = p.w_up + (size_t)l * DM * DFF; N = DFF; outp = p.sWup() + (size_t)l * 9 * DFF; ldo = DFF; which = 3; }
    __syncthreads();
    for (int i = tid; i < 9216; i += NTHR) sc[i] = p.mod()[((size_t)(l * 9 + (i >> 10))) * 6144 + which * 1024 + (i & 1023)];
    __syncthreads();
    gemv9_item(sc, red, W, N, grp * 32, outp, ldo, nullptr, tid);
  }
}
__device__ __forceinline__ void final_norm_phase(const P& p, const int wv) {
  const int tid = my_tid(wv), lane = tid & 63, gw = my_bid() * NWV + (tid >> 6), ngw = gridDim.x * NWV;
  for (int m = gw; m < NTOK; m += ngw) {
    const float* xr = p.xw() + (size_t)m * DM;
    float4 v[4];
    float ss = 0.f;
#pragma unroll
    for (int j = 0; j < 4; ++j) {
      v[j] = ((const float4*)xr)[lane + 64 * j];
      ss += v[j].x * v[j].x + v[j].y * v[j].y + v[j].z * v[j].z + v[j].w * v[j].w;
    }
    ss = wave_sum(ss, lane);
    const float rstd = rsqrtf(ss * (1.f / 1024.f) + 1e-6f);
#pragma unroll
    for (int j = 0; j < 4; ++j) {
      const int c = (lane + 64 * j) * 4;
      const float4 g = *(const float4*)(p.final_norm + c);
      *(float4*)(p.out + (size_t)m * DM + c) = make_float4(v[j].x * rstd * g.x, v[j].y * rstd * g.y, v[j].z * rstd * g.z, v[j].w * rstd * g.w);
    }
  }
}

__device__ __forceinline__ void transpose_tile(const float* __restrict__ W, int K, int N, bf16_t* __restrict__ WT, int item, float* tile, const int tid) {
  const int ntn = (N + 63) >> 6, kt = item / ntn, nt = item % ntn, k0 = kt * 64, n0 = nt * 64;
  const int n4 = (tid & 15) * 4, kr = tid >> 4;
#pragma unroll
  for (int q = 0; q < 2; ++q) {
    const int k = q * 32 + kr;
    float4 v = make_float4(0.f, 0.f, 0.f, 0.f);
    if (n0 + n4 < N) v = *(const float4*)(W + (size_t)(k0 + k) * N + n0 + n4);
    float* t = tile + k * 65 + n4;
    t[0] = v.x; t[1] = v.y; t[2] = v.z; t[3] = v.w;
  }
  __syncthreads();
  {
    const int n = tid >> 3, kc = (tid & 7) * 8;
    const float* t = tile + kc * 65 + n;
    uint4 o;
    o.x = pk2(t[0 * 65], t[1 * 65]); o.y = pk2(t[2 * 65], t[3 * 65]); o.z = pk2(t[4 * 65], t[5 * 65]); o.w = pk2(t[6 * 65], t[7 * 65]);
    if (n0 + n < N) *(uint4*)(WT + (size_t)(n0 + n) * K + k0 + kc) = o;
  }
  __syncthreads();
}

__device__ __forceinline__ void prep_phase(const P& p, unsigned char* smem, const int wv) {
  const int tid = my_tid(wv);
  {
    float* sc = (float*)smem;
    float* red = sc + 9216;
    for (int i = tid; i < 9216; i += NTHR) {
      const int r = i >> 10, k = i & 1023;
      const float x = r == 0 ? p.c_ctx[k] : p.c[(r - 1) * 1024 + k];
      sc[i] = x / (1.f + expf(-x));
    }
    __syncthreads();
    for (int item = blockIdx.x; item < 384; item += gridDim.x) {
      const int l = item / 192, n0 = (item % 192) * 32;
      gemv9_item(sc, red, p.w_mod + (size_t)l * 1024 * 6144, 6144, n0, p.mod() + (size_t)l * 9 * 6144, 6144, p.b_mod + l * 6144, tid);
    }
  }
  __syncthreads();
  {
    float* tile = (float*)smem;
    constexpr int I_IN = 16 * 37, I_OUT = 16 * 16, I_UP = 16 * 64, I_DN = 64 * 16, I_KV = 2 * 8;
    constexpr int PER = I_IN + I_OUT + I_UP + I_DN + I_KV;
    for (int item = blockIdx.x; item < 2 * PER; item += gridDim.x) {
      const int l = item / PER;
      int r = item % PER;
      if (r < I_IN) { transpose_tile(p.w_in + (size_t)l * DM * DIN, DM, DIN, p.WinT() + (size_t)l * DINP * DM, r, tile, tid); continue; }
      r -= I_IN;
      if (r < I_OUT) { transpose_tile(p.w_out + (size_t)l * DM * DM, DM, DM, p.WoutT() + (size_t)l * DM * DM, r, tile, tid); continue; }
      r -= I_OUT;
      if (r < I_UP) { transpose_tile(p.w_up + (size_t)l * DM * DFF, DM, DFF, p.WupT() + (size_t)l * DFF * DM, r, tile, tid); continue; }
      r -= I_UP;
      if (r < I_DN) { transpose_tile(p.w_down + (size_t)l * DFF * DM, DFF, DM, p.WdownT() + (size_t)l * DM * DFF, r, tile, tid); continue; }
      r -= I_DN;
      transpose_tile(p.w_kv_b + (size_t)l * 128 * 512, 128, 512, p.WkvbT() + (size_t)l * 512 * 128, r, tile, tid);
    }
  }
  const int gt = blockIdx.x * NTHR + tid, gs = gridDim.x * NTHR;
  if (gt < 256) p.ctl()[gt] = 0u;
  for (int i = gt; i < 64 * 16; i += gs) {
    const int pos = i >> 4, f = i & 15;
    const float ang = (float)pos * exp2f(-(float)f * (L2_10000 / 16.f));
    p.ropeW()[pos * 32 + f] = __cosf(ang);
    p.ropeW()[pos * 32 + 16 + f] = __sinf(ang);
  }
  for (int i = gt; i < 64 * 8; i += gs) {
    const int pos = i >> 3, f = i & 7;
    const float ang = (float)pos * exp2f(-(float)f * (L2_10000 / 8.f));
    p.ropeM()[pos * 16 + f] = __cosf(ang);
    p.ropeM()[pos * 16 + 8 + f] = __sinf(ang);
  }
  for (int i = gt; i < 2 * (DINP - DIN) * DM / 8; i += gs) {
    const int l = i / ((DINP - DIN) * DM / 8), o = i % ((DINP - DIN) * DM / 8);
    *(uint4*)(p.WinT() + ((size_t)l * DINP + DIN) * DM + (size_t)o * 8) = make_uint4(0, 0, 0, 0);
  }
  for (int i = gt; i < 524288 / 8; i += gs) {
    const int d8 = i & 7, kv = (i >> 3) & 1, s = (i >> 4) & 255, l = (i >> 12) & 1, b = i >> 13;
    const float4 a = *(const float4*)(p.cache_win_k + (size_t)i * 8), c = *(const float4*)(p.cache_win_k + (size_t)i * 8 + 4);
    *(uint4*)(p.Kwin_l() + ((size_t)((l * 8 + b) * 1280 + 1024 + s)) * 128 + kv * 64 + d8 * 8) = make_uint4(pk2(a.x, a.y), pk2(a.z, a.w), pk2(c.x, c.y), pk2(c.z, c.w));
  }
  for (int i = gt; i < 524288 / 8; i += gs) {
    const int d = i & 63, kv = (i >> 6) & 1, s8 = (i >> 7) & 31, l = (i >> 12) & 1, b = i >> 13;
    const float* src = p.cache_win_v + ((size_t)((b * 2 + l) * 256 + s8 * 8) * 2 + kv) * 64 + d;
    float v[8];
#pragma unroll
    for (int j = 0; j < 8; ++j) v[j] = src[(size_t)j * 128];
    *(uint4*)(p.Vtwin_l() + ((size_t)(((l * 8 + b) * 2 + kv) * 64 + d)) * 1280 + 1024 + s8 * 8) = make_uint4(pk2(v[0], v[1]), pk2(v[2], v[3]), pk2(v[4], v[5]), pk2(v[6], v[7]));
  }
  for (int i = gt; i < 524288 / 8; i += gs) {
    const int j8 = i & 15, s = (i >> 4) & 255, l = (i >> 12) & 1, b = i >> 13;
    const float4 a = *(const float4*)(p.cache_mla_ckv + (size_t)i * 8), c = *(const float4*)(p.cache_mla_ckv + (size_t)i * 8 + 4);
    *(uint4*)(p.ckvn() + ((size_t)l * 18432 + 16384 + b * 256 + s) * 128 + j8 * 8) = make_uint4(pk2(a.x, a.y), pk2(a.z, a.w), pk2(c.x, c.y), pk2(c.z, c.w));
  }
  for (int i = gt; i < 131072 / 8; i += gs) {
    const int j8 = i & 3, s = (i >> 2) & 255, l = (i >> 10) & 1, b = i >> 11;
    const float4 a = *(const float4*)(p.cache_mla_krope + (size_t)i * 8), c = *(const float4*)(p.cache_mla_krope + (size_t)i * 8 + 4);
    const uint4 o = make_uint4(pk2(a.x, a.y), pk2(a.z, a.w), pk2(c.x, c.y), pk2(c.z, c.w));
#pragma unroll
    for (int hh = 0; hh < 4; ++hh) *(uint4*)(p.Kmla_l() + ((size_t)(((l * 8 + b) * 4 + hh) * 1280 + 1024 + s)) * 96 + 64 + j8 * 8) = o;
  }
  for (int i = gt; i < 524288 / 8; i += gs) {
    const int e = i & 63, d8 = (i >> 6) & 7, blk = i >> 9;
    const int hh = blk & 3, dir = (blk >> 2) & 1, l = (blk >> 3) & 1, b = blk >> 4;
    const float* src = p.state_ret + (size_t)blk * 4096 + (size_t)(d8 * 8) * 64 + e;
    float v[8];
#pragma unroll
    for (int j = 0; j < 8; ++j) v[j] = src[(size_t)j * 64];
    *(uint4*)(p.S0t() + ((size_t)((((l * 8 + b) * 2 + dir) * 4 + hh) * 64 + e)) * 64 + d8 * 8) = make_uint4(pk2(v[0], v[1]), pk2(v[2], v[3]), pk2(v[4], v[5]), pk2(v[6], v[7]));
  }
}

struct RotOrder : pg8::StaticOrder {
  int rot;
  __device__ __forceinline__ bool next(int i, Unit& u) const {
    if (!pg8::StaticOrder::next(i, u)) return false;
    u.pn += rot; if (u.pn >= nN) u.pn -= nN;
    return true;
  }
};
template <class Epi>
__device__ __forceinline__ void big_gemm(unsigned char* smem, const bf16_t* A, const bf16_t* Bt, int N, int K, const Epi& E, const int wv, int rot = 0) {
  pg8::Gemm g{A, Bt, NTOK, N, K};
  RotOrder S;
  S.init(NTOK, N, (int)gridDim.x, my_bid());
  S.rot = rot;
  pg8::gemm_phase<Epi, RotOrder, true, true>((PG8_LAS unsigned char*)smem, g, S, E, wv);
}

#define GSYNC() grid.sync()
__global__ void __launch_bounds__(NTHR, 2) hybrid_fwd(P p_arg) {
  cg::grid_group grid = cg::this_grid();
  const kargp_t kp = (kargp_t)__builtin_amdgcn_kernarg_segment_ptr();
  const int wv = __builtin_amdgcn_readfirstlane((int)threadIdx.x >> 6);
  { const P p = load_params(kp); prep_phase(p, smem, wv); }
  GSYNC();
  { const P p = load_params(kp); norm0_phase(p, smem, wv); }
  GSYNC();
#pragma unroll
  for (int l = 0; l < 2; ++l) {
    { const P pc = load_params(kp); const int t0 = my_tid(wv);
      for (int i = t0; i < 64 * 32; i += NTHR) ((float*)(smem + LDS_ROPEW))[i] = pc.ropeW()[i];
      for (int i = t0; i < 64 * 16; i += NTHR) ((float*)(smem + LDS_ROPEM))[i] = pc.ropeM()[i];
      __syncthreads(); }
    { const P p = load_params(kp);
      big_gemm(smem, p.hbuf(), p.WinT() + (size_t)l * DINP * DM, DINP, DM, EpiIn8{p, l, kp}, wv, 8); }
    { const P p = load_params(kp); gemm_small(p.ckvn() + (size_t)l * 18432 * 128, 128, p.WkvbT() + (size_t)l * 512 * 128, 128, 18432, 512, 128, smem, EpiKvb{p, l}, wv, p.ctl() + 64 * l, p.ctl() + 128 + 64 * l); }
    GSYNC();
    { const P p = load_params(kp); attn_phase(p, l, smem, wv); }
    GSYNC();
    { const P p = load_params(kp); big_gemm(smem, p.mix(), p.WoutT() + (size_t)l * DM * DM, DM, DM, EpiOut8{p, l}, wv); }
    GSYNC();
    { const P p = load_params(kp); big_gemm(smem, p.hbuf(), p.WupT() + (size_t)l * DFF * DM, DFF, DM, EpiUp8{p, l}, wv); }
    GSYNC();
    { const P p = load_params(kp); big_gemm(smem, p.ubuf(), p.WdownT() + (size_t)l * DM * DFF, DM, DFF, EpiDown8{p, l}, wv); }
    GSYNC();
  }
  { const P p = load_params(kp); final_norm_phase(p, wv); }
}

extern "C" void kernel_launch(void* const* d_in, const int* in_sizes, int n_in, void* d_out, int out_size, void* d_ws, size_t ws_size,
                              hipStream_t stream) {
  static int grid_blocks = 0;
  if (grid_blocks == 0) {
    int dev = 0, cus = 0, per_cu = 0;
    (void)hipGetDevice(&dev);
    (void)hipDeviceGetAttribute(&cus, hipDeviceAttributeMultiprocessorCount, dev);
    (void)hipFuncSetAttribute((const void*)hybrid_fwd, hipFuncAttributeMaxDynamicSharedMemorySize, LDS_BYTES);
    (void)hipOccupancyMaxActiveBlocksPerMultiprocessor(&per_cu, (const void*)hybrid_fwd, NTHR, LDS_BYTES);
    if (per_cu < 1) { fprintf(stderr, "occupancy query returned %d\n", per_cu); per_cu = 1; }
    per_cu = 1;
    grid_blocks = cus * per_cu;
  }
  P p{};
  const float* const* in = (const float* const*)d_in;
  p.x_prompt = in[0]; p.x_sample = in[1]; p.cache_win_k = in[2]; p.cache_win_v = in[3]; p.cache_mla_ckv = in[4];
  p.cache_mla_krope = in[5]; p.state_ret = in[6]; p.c = in[7]; p.c_ctx = in[8]; p.w_mod = in[9]; p.b_mod = in[10];
  p.norm1 = in[11]; p.norm2 = in[12]; p.w_in = in[13]; p.win_sink = in[14]; p.ret_decay = in[15]; p.ret_gn = in[16];
  p.mla_kv_norm = in[17]; p.w_kv_b = in[18]; p.w_out = in[19]; p.w_up = in[20]; p.w_down = in[21]; p.final_norm = in[22];
  p.out = (float*)d_out;
  p.ws = (unsigned char*)d_ws;
  if (WS_END > ws_size) { fprintf(stderr, "kernel_launch: workspace too small: need %zu, have %zu\n", (size_t)WS_END, ws_size); return; }
  void* args[] = {&p};
  hipError_t e = hipLaunchCooperativeKernel((const void*)hybrid_fwd, dim3(grid_blocks), dim3(NTHR), args, LDS_BYTES, stream);
  if (e != hipSuccess) fprintf(stderr, "cooperative launch failed: %s (grid %d)\n", hipGetErrorString(e), grid_blocks);
}
```

```cpp
#include <hip/hip_runtime.h>
#include <hip/hip_cooperative_groups.h>
#include <cstdio>
#include <cstdint>
namespace cg = cooperative_groups;

__device__ __forceinline__ int lane_id() { return (int)__builtin_amdgcn_mbcnt_hi(~0u, __builtin_amdgcn_mbcnt_lo(~0u, 0u)); }

namespace pg8 {
#define PG8_LAS __attribute__((address_space(3)))
typedef unsigned short bf16_t;
typedef short bf16x8 __attribute__((ext_vector_type(8)));
typedef float f32x4 __attribute__((ext_vector_type(4)));
typedef unsigned u32x4 __attribute__((ext_vector_type(4)));
constexpr int BM = 256, BK = 64, HALF = 128, HTB = HALF * BK * 2  , STAGE_BYTES = 8 * HTB, NXCD = 8, WGM = 8;

__host__ __device__ __forceinline__ int lds_byte(int r, int c) { const int st = (r >> 4) * 2 + (c >> 5), rr = r & 15, cc = c & 31, ob = rr * 64 + cc * 2; return st * 1024 + (ob ^ (((ob >> 9) & 1) << 5)); }
__host__ __device__ __forceinline__ void stage_rc(int b, int& R, int& C) { const int st = b / 1024, sb = b % 1024, swz = sb ^ (((sb >> 9) & 1) << 5); R = (st >> 1) * 16 + swz / 64; C = (st & 1) * 32 + (swz % 64) / 2; }
__host__ __device__ __forceinline__ int perm32(int rho) { const int n = rho >> 4, i = rho & 15; return 8 * (i >> 2) + 4 * n + (i & 3); }

struct Unit { int pm, pn; };
struct Gemm { const bf16_t* A; const bf16_t* Bt; int M, N, K; };

struct StaticOrder {
    int nM, nN, nwg, G, c;
    __host__ __device__ void init(int M, int N, int G_, int c_) { nM = M / BM; nN = N / BM; nwg = nM * nN; G = G_; c = c_; }
    __host__ __device__ bool next(int i, Unit& u) const {
        const long L = (long)i * G + c; if (L >= nwg) return false;
        int wgid = (int)L; { const int q = nwg / NXCD, r = nwg % NXCD, xcd = wgid % NXCD, off = wgid / NXCD; wgid = (xcd < r ? xcd * (q + 1) : r * (q + 1) + (xcd - r) * q) + off; }
        const int nig = WGM * nN, gid = wgid / nig, fm = gid * WGM, gsz = (nM - fm) < WGM ? (nM - fm) : WGM;
        u.pm = fm + ((wgid % nig) % gsz); u.pn = (wgid % nig) / gsz; return true;
    }
    __device__ __forceinline__ void a_ready(const Unit&) const {}
    __device__ __forceinline__ void done(const Unit&) const {}
};
template <class Epi, class Sched, bool ALIGN_EPI = false, bool SP2 = false>
__device__ __forceinline__ void gemm_phase(PG8_LAS unsigned char* lds, const Gemm g, const Sched& S, const Epi& E, const int wvp) {
    const int wid = wvp, lane = lane_id(), tid = wid * 64 + lane, wr = wid >> 2, wc = wid & 3, fr = lane & 15, fq = lane >> 4;
    const int K = g.K, nt = K / BK;
    unsigned voffA[2], voffB[2];
#pragma unroll
    for (int i = 0; i < 2; ++i) { int R, C; stage_rc(tid * 16 + i * 8192, R, C); const int Rb = Epi::PERM ? ((R & ~31) + perm32(R & 31)) : R;
        voffA[i] = (unsigned)(R * K + C) * 2u; voffB[i] = (unsigned)(Rb * K + C) * 2u; }
    const size_t kstep = (size_t)(BK * 2);
    const size_t hstep = (size_t)HALF * K * 2;
    const size_t tstep = 2 * hstep;
    const unsigned ldsw = (unsigned)wid * 1024u;
    const int aoff = lds_byte(wr * 64 + fr, fq * 8), boff = lds_byte(wc * 32 + fr, fq * 8);
#define PG8_SA(b, h) (((b) * 2 + (h)) * HTB)
#define PG8_SB(b, h) ((4 + (b) * 2 + (h)) * HTB)
#define PG8_STAGE(bufoff, gbase, voff) do { _Pragma("unroll") for (int _i = 0; _i < 2; ++_i) \
        __builtin_amdgcn_global_load_lds((const unsigned*)((const char*)(gbase) + (voff)[_i]), (PG8_LAS unsigned*)(lds + (bufoff) + ldsw + _i * 8192), 16, 0, 0); } while (0)
#define PG8_LDA(dst, b, h) do { _Pragma("unroll") for (int m = 0; m < 4; ++m) _Pragma("unroll") for (int k = 0; k < 2; ++k) dst[m][k] = *(const PG8_LAS bf16x8*)(lds + PG8_SA(b, h) + aoff + m * 2048 + k * 1024); } while (0)
#define PG8_LDB(dst, b, h) do { _Pragma("unroll") for (int n = 0; n < 2; ++n) _Pragma("unroll") for (int k = 0; k < 2; ++k) dst[n][k] = *(const PG8_LAS bf16x8*)(lds + PG8_SB(b, h) + boff + n * 2048 + k * 1024); } while (0)
#define PG8_MMA(ai, bj, At, Bt) do { __builtin_amdgcn_s_setprio(1); _Pragma("unroll") for (int m = 0; m < 4; ++m) _Pragma("unroll") for (int n = 0; n < 2; ++n) _Pragma("unroll") for (int k = 0; k < 2; ++k) \
        acc[ai][bj][m][n] = __builtin_amdgcn_mfma_f32_16x16x32_bf16(Bt[n][k], At[m][k], acc[ai][bj][m][n], 0, 0, 0); __builtin_amdgcn_s_setprio(0); } while (0)
#define PG8_WAIT_V(n) asm volatile("s_waitcnt vmcnt(" #n ")" ::: "memory")
#define PG8_WAIT_L(n) asm volatile("s_waitcnt lgkmcnt(" #n ")" ::: "memory")
#define PG8_BAR __builtin_amdgcn_s_barrier()
#define PG8_SCHED __builtin_amdgcn_sched_barrier(0)
    Unit cur, nxt; int ui = 0;
    if (!S.next(0, cur)) return;
    f32x4 acc[2][2][4][2];
#pragma unroll
    for (int a = 0; a < 2; ++a)
#pragma unroll
        for (int b = 0; b < 2; ++b)
#pragma unroll
            for (int m = 0; m < 4; ++m)
#pragma unroll
                for (int n = 0; n < 2; ++n) acc[a][b][m][n] = (f32x4){0.f, 0.f, 0.f, 0.f};
    bf16x8 At[4][2], B0[2][2], B1[2][2];
    const char* cA = (const char*)g.A + (size_t)cur.pm * tstep; const char* cB = (const char*)g.Bt + (size_t)cur.pn * tstep;
    S.a_ready(cur);
    if constexpr (SP2) {
        PG8_STAGE(PG8_SB(0, 0), cB, voffB); PG8_STAGE(PG8_SB(0, 1), cB + hstep, voffB); PG8_STAGE(PG8_SA(0, 0), cA, voffA); PG8_STAGE(PG8_SA(0, 1), cA + hstep, voffA);
        if (wr == 1) PG8_BAR;
        PG8_WAIT_V(2); PG8_BAR;
        PG8_STAGE(PG8_SB(1, 0), cB + kstep, voffB); PG8_STAGE(PG8_SA(1, 0), cA + kstep, voffA); PG8_STAGE(PG8_SB(1, 1), cB + hstep + kstep, voffB);
        PG8_WAIT_V(6); PG8_BAR;
    } else {
        PG8_STAGE(PG8_SB(0, 0), cB, voffB); PG8_STAGE(PG8_SA(0, 0), cA, voffA); PG8_STAGE(PG8_SB(0, 1), cB + hstep, voffB); PG8_STAGE(PG8_SA(0, 1), cA + hstep, voffA);
        if (wr == 1) PG8_BAR;
        PG8_WAIT_V(4); PG8_BAR;
        PG8_STAGE(PG8_SB(1, 0), cB + kstep, voffB); PG8_STAGE(PG8_SA(1, 0), cA + kstep, voffA); PG8_STAGE(PG8_SB(1, 1), cB + hstep + kstep, voffB);
        PG8_WAIT_V(6); PG8_BAR;
    }
    for (;;) {
        const bool has_next = S.next(ui + 1, nxt);
        const char* nA = has_next ? (const char*)g.A + (size_t)nxt.pm * tstep : cA; const char* nB = has_next ? (const char*)g.Bt + (size_t)nxt.pn * tstep : cB;
        for (int t = 0; t < nt; t += 2) {
            const bool last = (t == nt - 2);
            const char* a1 = cA + (size_t)(t + 1) * kstep;
            const char* a2 = last ? nA : cA + (size_t)(t + 2) * kstep; const char* b2 = last ? nB : cB + (size_t)(t + 2) * kstep;
            const char* a3 = a2 + kstep; const char* b3 = b2 + kstep;
            if (last && has_next) S.a_ready(nxt);
            if constexpr (SP2) {
            PG8_LDB(B0, 0, 0); PG8_LDB(B1, 0, 1); PG8_SCHED; PG8_LDA(At, 0, 0); PG8_STAGE(PG8_SA(1, 1), a1 + hstep, voffA);
            PG8_WAIT_V(8); PG8_WAIT_L(0); PG8_BAR; PG8_MMA(0, 0, At, B0); PG8_MMA(0, 1, At, B1); PG8_BAR; PG8_SCHED;
            PG8_LDA(At, 0, 1); PG8_STAGE(PG8_SB(0, 0), b2, voffB); PG8_STAGE(PG8_SB(0, 1), b2 + hstep, voffB); PG8_STAGE(PG8_SA(0, 0), a2, voffA);
            PG8_WAIT_V(8); PG8_WAIT_L(0); PG8_BAR; PG8_MMA(1, 0, At, B0); PG8_MMA(1, 1, At, B1); PG8_BAR; PG8_SCHED;
            PG8_LDB(B0, 1, 0); PG8_LDB(B1, 1, 1); PG8_SCHED; PG8_LDA(At, 1, 0); PG8_STAGE(PG8_SA(0, 1), a2 + hstep, voffA);
            PG8_WAIT_V(8); PG8_WAIT_L(0); PG8_BAR; PG8_MMA(0, 0, At, B0); PG8_MMA(0, 1, At, B1); PG8_BAR; PG8_SCHED;
            PG8_LDA(At, 1, 1); PG8_STAGE(PG8_SB(1, 0), b3, voffB); PG8_STAGE(PG8_SB(1, 1), b3 + hstep, voffB); PG8_STAGE(PG8_SA(1, 0), a3, voffA);
            PG8_WAIT_V(8); PG8_WAIT_L(0); PG8_BAR; PG8_MMA(1, 0, At, B0); PG8_MMA(1, 1, At, B1); PG8_BAR; PG8_SCHED;
            } else {
            PG8_LDB(B0, 0, 0); PG8_SCHED; PG8_LDA(At, 0, 0); PG8_STAGE(PG8_SA(1, 1), a1 + hstep, voffA);
            PG8_WAIT_L(8); PG8_BAR; PG8_WAIT_L(0); PG8_MMA(0, 0, At, B0); PG8_BAR; PG8_SCHED;
            PG8_LDB(B1, 0, 1); PG8_STAGE(PG8_SB(0, 0), b2, voffB);
            PG8_BAR; PG8_WAIT_L(0); PG8_MMA(0, 1, At, B1); PG8_BAR;
            PG8_LDA(At, 0, 1); PG8_STAGE(PG8_SA(0, 0), a2, voffA);
            PG8_BAR; PG8_WAIT_L(0); PG8_MMA(1, 0, At, B0); PG8_BAR; PG8_SCHED;
            PG8_STAGE(PG8_SB(0, 1), b2 + hstep, voffB);
            PG8_WAIT_V(6); PG8_BAR; PG8_MMA(1, 1, At, B1); PG8_BAR;
            PG8_LDB(B0, 1, 0); PG8_SCHED; PG8_LDA(At, 1, 0); PG8_STAGE(PG8_SA(0, 1), a2 + hstep, voffA);
            PG8_WAIT_L(8); PG8_BAR; PG8_WAIT_L(0); PG8_MMA(0, 0, At, B0); PG8_BAR; PG8_SCHED;
            PG8_LDB(B1, 1, 1); PG8_STAGE(PG8_SB(1, 0), b3, voffB);
            PG8_BAR; PG8_WAIT_L(0); PG8_MMA(0, 1, At, B1); PG8_BAR;
            PG8_LDA(At, 1, 1); PG8_STAGE(PG8_SA(1, 0), a3, voffA);
            PG8_BAR; PG8_WAIT_L(0); PG8_MMA(1, 0, At, B0); PG8_BAR; PG8_SCHED;
            PG8_STAGE(PG8_SB(1, 1), b3 + hstep, voffB);
            PG8_WAIT_V(6); PG8_BAR; PG8_MMA(1, 1, At, B1); PG8_BAR;
            }
        }
        if constexpr (ALIGN_EPI) { if (wr == 0) PG8_BAR; }
        if constexpr (!Epi::AFTER_DRAIN) { E(acc, cur, wr, wc, fr, fq); S.done(cur); }
        if (!has_next) break;
#pragma unroll
        for (int a = 0; a < 2; ++a)
#pragma unroll
            for (int b = 0; b < 2; ++b)
#pragma unroll
                for (int m = 0; m < 4; ++m)
#pragma unroll
                    for (int n = 0; n < 2; ++n) acc[a][b][m][n] = (f32x4){0.f, 0.f, 0.f, 0.f};
        cur = nxt; cA = nA; cB = nB; ++ui;
        if constexpr (ALIGN_EPI) { if (wr == 1) PG8_BAR; }
    }
    PG8_WAIT_V(0);
    if constexpr (!ALIGN_EPI) { if (wr == 0) PG8_BAR; }
    PG8_BAR;
    if constexpr (Epi::AFTER_DRAIN) { E.fused(acc, cur, wr, wc, fr, fq, lds, wid, lane); S.done(cur); }
#undef PG8_SA
#undef PG8_SB
#undef PG8_STAGE
#undef PG8_LDA
#undef PG8_LDB
#undef PG8_MMA
#undef PG8_WAIT_V
#undef PG8_WAIT_L
#undef PG8_BAR
#undef PG8_SCHED
}
}


typedef unsigned short bf16_t;
typedef short bf16x8 __attribute__((ext_vector_type(8)));
typedef float f32x16 __attribute__((ext_vector_type(16)));
typedef pg8::f32x4 f32x4;
using pg8::Unit;

constexpr int NTHR = 512, NWV = 8;
constexpr int NTOK = 16384, NCTX = 8192, DM = 1024, DIN = 2336, DINP = 2560, DFF = 4096;
constexpr int LDS_RED = 131072;
constexpr int LDS_ROPEW = 131072 + 4096, LDS_ROPEM = LDS_ROPEW + 64 * 32 * 4;
constexpr int LDS_BYTES = LDS_ROPEM + 64 * 16 * 4;
constexpr float LOG2E = 1.4426950408889634f;
constexpr float L2_10000 = 13.287712379549449f;

#define AL256(x) (((x) + 255) & ~(size_t)255)
constexpr size_t OFF_mod = 0;
constexpr size_t OFF_ropeW = OFF_mod + AL256((size_t)2 * 9 * 6144 * 4);
constexpr size_t OFF_ropeM = OFF_ropeW + AL256((size_t)64 * 32 * 4);
constexpr size_t OFF_ctl = OFF_ropeM + AL256((size_t)64 * 16 * 4);
constexpr size_t OFF_rssA = OFF_ctl + AL256((size_t)256 * 4);
constexpr size_t OFF_rssB = OFF_rssA + AL256((size_t)NTOK * 16 * 4);
constexpr size_t OFF_sWin = OFF_rssB + AL256((size_t)NTOK * 16 * 4);
constexpr size_t OFF_sWup = OFF_sWin + AL256((size_t)2 * 9 * DINP * 4);
constexpr size_t OFF_WinT = OFF_sWup + AL256((size_t)2 * 9 * DFF * 4);
constexpr size_t OFF_WoutT = OFF_WinT + AL256((size_t)2 * DINP * DM * 2);
constexpr size_t OFF_WupT = OFF_WoutT + AL256((size_t)2 * DM * DM * 2);
constexpr size_t OFF_WdownT = OFF_WupT + AL256((size_t)2 * DFF * DM * 2);
constexpr size_t OFF_WkvbT = OFF_WdownT + AL256((size_t)2 * DM * DFF * 2);
constexpr size_t OFF_hbuf = OFF_WkvbT + AL256((size_t)2 * 512 * 128 * 2);
constexpr size_t OFF_Kwin_l = OFF_hbuf + AL256((size_t)NTOK * DM * 2);
constexpr size_t OFF_Vtwin_l = OFF_Kwin_l + AL256((size_t)2 * 8 * 1280 * 128 * 2);
constexpr size_t OFF_S0t = OFF_Vtwin_l + AL256((size_t)2 * 8 * 2 * 64 * 1280 * 2);
constexpr size_t OFF_ckvn = OFF_S0t + AL256((size_t)2 * 8 * 2 * 4 * 4096 * 2);
constexpr size_t OFF_Kmla_l = OFF_ckvn + AL256((size_t)2 * 18432 * 128 * 2);
constexpr size_t OFF_Vtmla_l = OFF_Kmla_l + AL256((size_t)2 * 8 * 4 * 1280 * 96 * 2);
constexpr size_t OFF_ubuf = OFF_Vtmla_l + AL256((size_t)2 * 8 * 4 * 64 * 1280 * 2);
constexpr size_t WS_END = OFF_ubuf + AL256((size_t)NTOK * DFF * 2);
constexpr size_t OFF_mix = OFF_ubuf + (size_t)96 * 1024 * 1024;
constexpr size_t OFF_Qwin = OFF_ubuf;
constexpr size_t OFF_Kwin_c = OFF_Qwin + AL256((size_t)NTOK * 512 * 2);
constexpr size_t OFF_Vtwin_c = OFF_Kwin_c + AL256((size_t)NCTX * 128 * 2);
constexpr size_t OFF_Qret = OFF_Vtwin_c + AL256((size_t)32 * 2 * 64 * 256 * 2);
constexpr size_t OFF_Kret = OFF_Qret + AL256((size_t)NTOK * 256 * 2);
constexpr size_t OFF_Gret = OFF_Kret + AL256((size_t)NTOK * 256 * 2);
constexpr size_t OFF_Vtret_c = OFF_Gret + AL256((size_t)NTOK * 256 * 2);
constexpr size_t OFF_Vtret_l = OFF_Vtret_c + AL256((size_t)32 * 4 * 64 * 256 * 2);
constexpr size_t OFF_Qmla = OFF_Vtret_l + AL256((size_t)8 * 4 * 64 * 1024 * 2);
constexpr size_t OFF_Kmla_c = OFF_Qmla + AL256((size_t)NTOK * 384 * 2);
constexpr size_t OFF_Vtmla_c = OFF_Kmla_c + AL256((size_t)32 * 4 * 256 * 96 * 2);
static_assert(OFF_Vtmla_c + (size_t)32 * 4 * 64 * 256 * 2 <= OFF_mix && OFF_mix + (size_t)NTOK * DM * 2 <= WS_END, "attention temporaries + mix must fit in the ubuf region");
static_assert(WS_END <= (size_t)256 * 1024 * 1024, "workspace must fit 256 MiB");

struct P {
  const float *x_prompt, *x_sample, *cache_win_k, *cache_win_v, *cache_mla_ckv, *cache_mla_krope, *state_ret,
      *c, *c_ctx, *w_mod, *b_mod, *norm1, *norm2, *w_in, *win_sink, *ret_decay, *ret_gn, *mla_kv_norm,
      *w_kv_b, *w_out, *w_up, *w_down, *final_norm;
  float* out;
  unsigned char* ws;
#define WSBUF(ty, name) __device__ __forceinline__ ty* name() const { return (ty*)(ws + OFF_##name); }
  WSBUF(unsigned, ctl) WSBUF(float, mod) WSBUF(float, ropeW) WSBUF(float, ropeM) WSBUF(float, rssA) WSBUF(float, rssB) WSBUF(float, sWin) WSBUF(float, sWup) WSBUF(bf16_t, WinT) WSBUF(bf16_t, WoutT) WSBUF(bf16_t, WupT) WSBUF(bf16_t, WdownT) WSBUF(bf16_t, WkvbT)
  WSBUF(bf16_t, hbuf) WSBUF(bf16_t, mix) WSBUF(bf16_t, Qwin) WSBUF(bf16_t, Kwin_c) WSBUF(bf16_t, Vtwin_c) WSBUF(bf16_t, Kwin_l)
  WSBUF(bf16_t, Vtwin_l) WSBUF(bf16_t, Qret) WSBUF(bf16_t, Kret) WSBUF(bf16_t, Gret) WSBUF(bf16_t, Vtret_c) WSBUF(bf16_t, Vtret_l)
  WSBUF(bf16_t, S0t) WSBUF(bf16_t, Qmla) WSBUF(bf16_t, ckvn) WSBUF(bf16_t, Kmla_c) WSBUF(bf16_t, Vtmla_c) WSBUF(bf16_t, Kmla_l)
  WSBUF(bf16_t, Vtmla_l) WSBUF(bf16_t, ubuf)
  __device__ __forceinline__ float* xw() const { return out; }
};

typedef float f32x2_t __attribute__((ext_vector_type(2)));
typedef __bf16 bf16x2_t __attribute__((ext_vector_type(2)));
__device__ __forceinline__ unsigned pk2(float lo, float hi) {
  const f32x2_t v = {lo, hi};
  const bf16x2_t b = __builtin_convertvector(v, bf16x2_t);
  return __builtin_bit_cast(unsigned, b);
}
__device__ __forceinline__ bf16_t f2bf(float f) { return (bf16_t)(pk2(f, 0.f) & 0xffffu); }
__device__ __forceinline__ float bf2f(bf16_t b) { return __uint_as_float(((unsigned)b) << 16); }
__device__ __forceinline__ float shx(float v, int mask, int ln) { return __int_as_float(__builtin_amdgcn_ds_bpermute((ln ^ mask) << 2, __float_as_int(v))); }
__device__ __forceinline__ float wave_sum(float v, int ln) {
#pragma unroll
  for (int o = 1; o < 64; o <<= 1) v += shx(v, o, ln);
  return v;
}
typedef const __attribute__((address_space(4))) unsigned char* kargp_t;
__device__ __forceinline__ P load_params(kargp_t kp) {
  asm volatile("" : "+s"(kp));
  P p;
  __builtin_memcpy(&p, kp, sizeof(P));
  return p;
}
__device__ __forceinline__ int my_tid(int wv) { int w = wv; asm volatile("" : "+s"(w)); int t = w * 64 + lane_id(); asm volatile("" : "+v"(t)); return t; }
__device__ __forceinline__ int my_bid() { int b = blockIdx.x; asm volatile("" : "+s"(b)); return b; }
__device__ __forceinline__ float fexp2(float x) { return __builtin_amdgcn_exp2f(x); }
__device__ __forceinline__ int mod_row(int m) { return m < NCTX ? 0 : 1 + ((m - NCTX) >> 10); }

__device__ __forceinline__ void st_rm_bf16(bf16_t* rp, int h, const f32x16& o) {
#pragma unroll
  for (int g = 0; g < 4; ++g) {
    uint2 u;
    u.x = pk2(o[4 * g], o[4 * g + 1]);
    u.y = pk2(o[4 * g + 2], o[4 * g + 3]);
    *(uint2*)(rp + 8 * g + 4 * h) = u;
  }
}
__device__ __forceinline__ void st_tr_bf16(bf16_t* bp, int stride, int h, const f32x16& o) {
#pragma unroll
  for (int i = 0; i < 16; ++i) bp[(size_t)((i & 3) + 8 * (i >> 2) + 4 * h) * stride] = f2bf(o[i]);
}

__device__ __forceinline__ void st8_bf16(bf16_t* rp, int fq, const f32x4& a, const f32x4& b) {
  *(uint2*)(rp + 4 * fq) = make_uint2(pk2(a[0], a[1]), pk2(a[2], a[3]));
  *(uint2*)(rp + 16 + 4 * fq) = make_uint2(pk2(b[0], b[1]), pk2(b[2], b[3]));
}
__device__ __forceinline__ void st8_f32(float* rp, int fq, const f32x4& a, const f32x4& b) {
  *(f32x4*)(rp + 4 * fq) = a;
  *(f32x4*)(rp + 16 + 4 * fq) = b;
}
__device__ __forceinline__ void st8_tr(bf16_t* bp, int stride, int fq, const f32x4& a, const f32x4& b) {
#pragma unroll
  for (int j = 0; j < 4; ++j) {
    bp[(size_t)(4 * fq + j) * stride] = f2bf(a[j]);
    bp[(size_t)(16 + 4 * fq + j) * stride] = f2bf(b[j]);
  }
}
__device__ __forceinline__ void rope8_win(f32x4& a, f32x4& b, int fq, const float* tab) {
  const f32x4 cs = *(const f32x4*)(tab + 4 * fq), sn = *(const f32x4*)(tab + 16 + 4 * fq);
  const f32x4 x = a, y = b;
  a = x * cs - y * sn;
  b = x * sn + y * cs;
}
__device__ __forceinline__ void rope8_mla(f32x4& a, f32x4& b, int fq, int ln, const float* tabr, const float* tabc) {
  const int fo = 4 * (fq & 1);
  {
    const f32x4 cs = *(const f32x4*)(tabr + fo), sn = *(const f32x4*)(tabr + 8 + fo);
#pragma unroll
    for (int j = 0; j < 4; ++j) { const float pa = shx(a[j], 32, ln); a[j] = fq < 2 ? a[j] * cs[j] - pa * sn[j] : pa * sn[j] + a[j] * cs[j]; }
  }
  asm volatile("" ::: "memory");
  {
    const f32x4 cs = *(const f32x4*)(tabc + fo), sn = *(const f32x4*)(tabc + 8 + fo);
#pragma unroll
    for (int j = 0; j < 4; ++j) { const float pb = shx(b[j], 32, ln); b[j] = fq < 2 ? b[j] * cs[j] - pb * sn[j] : pb * sn[j] + b[j] * cs[j]; }
  }
}


__device__ __forceinline__ void st8p_bf16(bf16_t* rp, int fq, const f32x4& a, const f32x4& b) {
  *(uint4*)(rp + 8 * fq) = make_uint4(pk2(a[0], a[1]), pk2(a[2], a[3]), pk2(b[0], b[1]), pk2(b[2], b[3]));
}
__device__ __forceinline__ void st8p_f32(float* rp, int fq, const f32x4& a, const f32x4& b) {
  *(f32x4*)(rp + 8 * fq) = a;
  *(f32x4*)(rp + 8 * fq + 4) = b;
}
__device__ __forceinline__ void st8p_tr(bf16_t* bp, int stride, int fq, const f32x4& a, const f32x4& b) {
#pragma unroll
  for (int j = 0; j < 4; ++j) {
    bp[(size_t)(8 * fq + j) * stride] = f2bf(a[j]);
    bp[(size_t)(8 * fq + 4 + j) * stride] = f2bf(b[j]);
  }
}
__device__ __forceinline__ void rope8p_win(f32x4& a, f32x4& b, int fq, int ln, const float* tab) {
  const int f0 = 8 * (fq & 1);
  const f32x4 ca = *(const f32x4*)(tab + f0), cb4 = *(const f32x4*)(tab + f0 + 4), sa = *(const f32x4*)(tab + 16 + f0), sb = *(const f32x4*)(tab + 16 + f0 + 4);
#pragma unroll
  for (int j = 0; j < 4; ++j) {
    const float pa = shx(a[j], 32, ln), pb = shx(b[j], 32, ln);
    a[j] = fq < 2 ? a[j] * ca[j] - pa * sa[j] : pa * sa[j] + a[j] * ca[j];
    b[j] = fq < 2 ? b[j] * cb4[j] - pb * sb[j] : pb * sb[j] + b[j] * cb4[j];
  }
}
__device__ __forceinline__ void rope8p_mla(f32x4& a, f32x4& b, int fq, int ln, const float* tabr, const float* tabc) {
  const float* tab = fq < 2 ? tabr : tabc;
  const f32x4 ca = *(const f32x4*)(tab), cb4 = *(const f32x4*)(tab + 4), sa = *(const f32x4*)(tab + 8), sb = *(const f32x4*)(tab + 12);
#pragma unroll
  for (int j = 0; j < 4; ++j) {
    const float pa = shx(a[j], 16, ln), pb = shx(b[j], 16, ln);
    a[j] = (fq & 1) == 0 ? a[j] * ca[j] - pa * sa[j] : pa * sa[j] + a[j] * ca[j];
    b[j] = (fq & 1) == 0 ? b[j] * cb4[j] - pb * sb[j] : pb * sb[j] + b[j] * cb4[j];
  }
}

__device__ __forceinline__ float row_rstd(const float* rss, int m) {
  const f32x4 a = *(const f32x4*)(rss + (size_t)m * 16), b = *(const f32x4*)(rss + (size_t)m * 16 + 4);
  const f32x4 c = *(const f32x4*)(rss + (size_t)m * 16 + 8), d = *(const f32x4*)(rss + (size_t)m * 16 + 12);
  const f32x4 s = (a + b) + (c + d);
  return rsqrtf(((s[0] + s[1]) + (s[2] + s[3])) * (1.f / 1024.f) + 1e-6f);
}

typedef f32x4 acc_t[2][2][4][2];
template <int V> struct IC { static constexpr int value = V; };
extern __shared__ __attribute__((aligned(16))) unsigned char smem[];
struct EpiIn8 {
  static constexpr bool PERM = true, AFTER_DRAIN = false;
  P p0; int l; kargp_t kp;
  __device__ __forceinline__ void operator()(const acc_t& acc, const Unit& u, int wr, int wc, int fr_in, int fq_in) const {
    int fr = fr_in; asm volatile("" : "+v"(fr));
    int fq = fq_in; asm volatile("" : "+v"(fq));
    const int ln = fq * 16 + fr; (void)ln;
    P p = p0; asm volatile("" : "+s"(p.ws), "+s"(p.out));
    const bool lat = u.pm >= 32;
    const int rbase = u.pm * 256 + wr * 64 + fr;
#define ROWS_BEGIN _Pragma("unroll") for (int ai = 0; ai < 2; ++ai) _Pragma("unroll") for (int mm = 0; mm < 4; ++mm) { \
      int m = rbase + ai * 128 + mm * 16; asm volatile("" : "+v"(m)); int b, s; \
      if (!lat) { b = m >> 8; s = m & 255; } else { b = (m - NCTX) >> 10; s = (m - NCTX) & 1023; } \
      const float rsd = rsdv[ai][mm]; \
      f32x4 v0 = acc[ai][bj][mm][0] * rsd + sw0, v1 = acc[ai][bj][mm][1] * rsd + sw1; (void)b; (void)s;
#define ROWS_END }
    float rsdv[2][4];
    {
      const float* rss = p.rssA();
#pragma unroll
      for (int ai = 0; ai < 2; ++ai)
#pragma unroll
        for (int mm = 0; mm < 4; ++mm) rsdv[ai][mm] = row_rstd(rss, rbase + ai * 128 + mm * 16);
    }
    auto do_half = [&](auto BJ) {
      constexpr int bj = decltype(BJ)::value;
      const int nb = u.pn * 256 + bj * 128 + wc * 32;
      if (nb >= DIN) return;
      const float* swp = p.sWin() + ((size_t)(l * 9 + (lat ? 1 + ((u.pm - 32) >> 2) : 0))) * DINP + nb;
      const f32x4 sw0 = *(const f32x4*)(swp + 8 * fq), sw1 = *(const f32x4*)(swp + 8 * fq + 4);
      if (nb < 512) {
        ROWS_BEGIN
          if (lat) rope8p_win(v0, v1, fq, ln, (const float*)(smem + LDS_ROPEW) + ((nb & 32) ? (s & 63) : (s >> 6)) * 32);
          st8p_bf16(p.Qwin() + (size_t)m * 512 + nb, fq, v0, v1);
        ROWS_END
      } else if (nb < 640) {
        const int c = nb - 512;
        ROWS_BEGIN
          if (!lat) {
            st8p_f32(p.out + 16777216 + ((size_t)((b * 2 + l) * 256 + s)) * 128 + c, fq, v0, v1);
            st8p_bf16(p.Kwin_c() + (size_t)m * 128 + c, fq, v0, v1);
          } else {
            rope8p_win(v0, v1, fq, ln, (const float*)(smem + LDS_ROPEW) + ((nb & 32) ? (s & 63) : (s >> 6)) * 32);
            st8p_bf16(p.Kwin_l() + ((size_t)((l * 8 + b) * 1280 + s)) * 128 + c, fq, v0, v1);
          }
        ROWS_END
      } else if (nb < 768) {
        const int c = nb - 640, kv = c >> 6, d0 = c & 63;
        ROWS_BEGIN
          if (!lat) {
            st8p_f32(p.out + 18874368 + ((size_t)((b * 2 + l) * 256 + s)) * 128 + c, fq, v0, v1);
            st8p_tr(p.Vtwin_c() + ((size_t)((b * 2 + kv) * 64 + d0)) * 256 + s, 256, fq, v0, v1);
          } else {
            st8p_tr(p.Vtwin_l() + ((size_t)(((l * 8 + b) * 2 + kv) * 64 + d0)) * 1280 + s, 1280, fq, v0, v1);
          }
        ROWS_END
      } else if (nb < 1024) {
        ROWS_BEGIN
          st8p_bf16(p.Qret() + (size_t)m * 256 + (nb - 768), fq, v0, v1);
        ROWS_END
      } else if (nb < 1280) {
        ROWS_BEGIN
          st8p_bf16(p.Kret() + (size_t)m * 256 + (nb - 1024), fq, v0, v1);
        ROWS_END
      } else if (nb < 1536) {
        const int c = nb - 1280, hh = c >> 6, d0 = c & 63;
        ROWS_BEGIN
          if (!lat) st8p_tr(p.Vtret_c() + ((size_t)((b * 4 + hh) * 64 + d0)) * 256 + s, 256, fq, v0, v1);
          else st8p_tr(p.Vtret_l() + ((size_t)((b * 4 + hh) * 64 + d0)) * 1024 + s, 1024, fq, v0, v1);
        ROWS_END
      } else if (nb < 1792) {
        ROWS_BEGIN
          st8p_bf16(p.Gret() + (size_t)m * 256 + (nb - 1536), fq, v0, v1);
        ROWS_END
      } else if (nb < 2176) {
        const int c = nb - 1792;
        const bool rp = lat && (c % 96) == 64;
        ROWS_BEGIN
          if (rp) rope8p_mla(v0, v1, fq, ln, (const float*)(smem + LDS_ROPEM) + (s >> 6) * 16, (const float*)(smem + LDS_ROPEM) + (s & 63) * 16);
          st8p_bf16(p.Qmla() + (size_t)m * 384 + c, fq, v0, v1);
        ROWS_END
      } else if (nb < 2304) {
        const int c = nb - 2176;
        float* red = (float*)(smem + LDS_RED);
        kargp_t k2 = kp; asm volatile("" : "+s"(k2));
        const float* g = ((const __attribute__((address_space(4))) P*)k2)->mla_kv_norm + l * 128 + c;
        const f32x4 g0 = *(const f32x4*)(g + 8 * fq), g1 = *(const f32x4*)(g + 8 * fq + 4);
#pragma unroll
        for (int ai = 0; ai < 2; ++ai)
#pragma unroll
          for (int mm = 0; mm < 4; ++mm) {
            const float rsd0 = rsdv[ai][mm];
            const f32x4 a = acc[ai][bj][mm][0] * rsd0 + sw0, b4 = acc[ai][bj][mm][1] * rsd0 + sw1;
            float ss = a[0] * a[0] + a[1] * a[1] + a[2] * a[2] + a[3] * a[3] + b4[0] * b4[0] + b4[1] * b4[1] + b4[2] * b4[2] + b4[3] * b4[3];
            ss += shx(ss, 16, ln);
            ss += shx(ss, 32, ln);
            if (fq == 0) red[wc * 256 + ai * 128 + wr * 64 + mm * 16 + fr] = ss;
          }
        asm volatile("s_waitcnt lgkmcnt(0)" ::: "memory");
        __builtin_amdgcn_s_barrier();
        ROWS_BEGIN
          const int rt = ai * 128 + wr * 64 + mm * 16 + fr;
          const float rsv = rsqrtf((red[rt] + red[256 + rt] + red[512 + rt] + red[768 + rt]) * (1.f / 128.f) + 1e-6f);
          v0 = v0 * rsv * g0;
          v1 = v1 * rsv * g1;
          st8p_bf16(p.ckvn() + ((size_t)l * 18432 + m) * 128 + c, fq, v0, v1);
          if (!lat) st8p_f32(p.out + 20971520 + ((size_t)((b * 2 + l) * 256 + s)) * 128 + c, fq, v0, v1);
        ROWS_END
        asm volatile("s_waitcnt vmcnt(0) lgkmcnt(0)" ::: "memory");
        __builtin_amdgcn_s_barrier();
        if (wr == 0 && wc == 0 && ln == 0) {
          __builtin_amdgcn_fence(__ATOMIC_RELEASE, "agent");
          asm volatile("s_waitcnt vmcnt(0)" ::: "memory");
          __hip_atomic_fetch_add(p.ctl() + 64 * l, 1u, __ATOMIC_RELAXED, __HIP_MEMORY_SCOPE_AGENT);
        }
      } else {
        ROWS_BEGIN
          if (!lat) {
            st8p_f32(p.out + 23068672 + ((size_t)((b * 2 + l) * 256 + s)) * 32, fq, v0, v1);
#pragma unroll
            for (int hh = 0; hh < 4; ++hh) st8p_bf16(p.Kmla_c() + ((size_t)((b * 4 + hh) * 256 + s)) * 96 + 64, fq, v0, v1);
          } else {
            rope8p_mla(v0, v1, fq, ln, (const float*)(smem + LDS_ROPEM) + (s >> 6) * 16, (const float*)(smem + LDS_ROPEM) + (s & 63) * 16);
#pragma unroll
            for (int hh = 0; hh < 4; ++hh) st8p_bf16(p.Kmla_l() + ((size_t)(((l * 8 + b) * 4 + hh) * 1280 + s)) * 96 + 64, fq, v0, v1);
          }
        ROWS_END
      }
    };
    do_half(IC<0>{});
    do_half(IC<1>{});
#undef ROWS_BEGIN
#undef ROWS_END
  }
};

struct EpiOut8 {
  static constexpr bool PERM = true, AFTER_DRAIN = false;
  P p0; int l;
  __device__ __forceinline__ void operator()(const acc_t& acc, const Unit& u, int wr, int wc, int fr_in, int fq_in) const {
    int fr = fr_in; asm volatile("" : "+v"(fr));
    int fq = fq_in; asm volatile("" : "+v"(fq));
    const int ln = fq * 16 + fr; (void)ln;
    P p = p0; asm volatile("" : "+s"(p.ws), "+s"(p.out));
    const int rbase = u.pm * 256 + wr * 64 + fr;
    const int cb = u.pn * 256 + wc * 32 + 8 * fq;
    const float* md = p.mod() + ((size_t)(l * 9 + mod_row(u.pm * 256))) * 6144;
    const float* gate = md + 2 * 1024; const float* sc2 = md + 4 * 1024; const float* g2 = p.norm2 + l * DM;
#pragma unroll
    for (int ap = 0; ap < 4; ++ap) {
      constexpr int dummy = 0; (void)dummy;
      const int ai = ap >> 1, m2 = (ap & 1) * 2;
      int mb = rbase + ai * 128 + m2 * 16; asm volatile("" : "+v"(mb));
      f32x4 xv[2][2][2];
#pragma unroll
      for (int mq = 0; mq < 2; ++mq) {
        const int mm = m2 + mq;
        const int m = mb + mq * 16;
        if (l == 0) {
          const float* xr = m < NCTX ? p.x_prompt + (size_t)m * DM : p.x_sample + (size_t)(m - NCTX) * DM;
#pragma unroll
          for (int bj = 0; bj < 2; ++bj)
#pragma unroll
            for (int n = 0; n < 2; ++n) xv[mq][bj][n] = *(const f32x4*)(xr + cb + bj * 128 + n * 4);
        } else {
          const bf16_t* hr = p.hbuf() + (size_t)m * DM;
#pragma unroll
          for (int bj = 0; bj < 2; ++bj)
#pragma unroll
            for (int n = 0; n < 2; ++n) {
              const int c = cb + bj * 128 + n * 4;
              const uint2 hq = *(const uint2*)(hr + c);
              const f32x4 q1 = *(const f32x4*)(p.norm1 + DM + c) * (*(const f32x4*)(md + 1 * 1024 + c) + 1.f);
              f32x4 xm;
              xm[0] = __uint_as_float(hq.x << 16) * __builtin_amdgcn_rcpf(q1[0]); xm[1] = __uint_as_float(hq.x & 0xffff0000u) * __builtin_amdgcn_rcpf(q1[1]);
              xm[2] = __uint_as_float(hq.y << 16) * __builtin_amdgcn_rcpf(q1[2]); xm[3] = __uint_as_float(hq.y & 0xffff0000u) * __builtin_amdgcn_rcpf(q1[3]);
              xv[mq][bj][n] = xm;
            }
        }
      }
#pragma unroll
      for (int mq = 0; mq < 2; ++mq) {
        const int mm = m2 + mq;
        const int m = mb + mq * 16;
        bf16_t* ho = p.hbuf() + (size_t)m * DM;
        float ss = 0.f;
#pragma unroll
        for (int bj = 0; bj < 2; ++bj) {
          unsigned pw[4];
#pragma unroll
          for (int n = 0; n < 2; ++n) {
            const int c = cb + bj * 128 + n * 4;
            const f32x4 xn = xv[mq][bj][n] + *(const f32x4*)(gate + c) * acc[ai][bj][mm][n];
            const f32x4 hv = xn * (*(const f32x4*)(g2 + c) * (*(const f32x4*)(sc2 + c) + 1.f));
            pw[2 * n] = pk2(hv[0], hv[1]); pw[2 * n + 1] = pk2(hv[2], hv[3]);
            ss += (xn[0] * xn[0] + xn[1] * xn[1]) + (xn[2] * xn[2] + xn[3] * xn[3]);
          }
          *(uint4*)(ho + cb + bj * 128) = make_uint4(pw[0], pw[1], pw[2], pw[3]);
        }
        ss += shx(ss, 16, ln);
        ss += shx(ss, 32, ln);
        if (fq == 0) p.rssB()[(size_t)m * 16 + u.pn * 4 + wc] = ss;
      }
      asm volatile("" ::: "memory");
    }
  }
};
struct EpiUp8 {
  static constexpr bool PERM = true, AFTER_DRAIN = false;
  P p0; int l;
  __device__ __forceinline__ void operator()(const acc_t& acc, const Unit& u, int wr, int wc, int fr_in, int fq_in) const {
    int fr = fr_in; asm volatile("" : "+v"(fr));
    int fq = fq_in; asm volatile("" : "+v"(fq));
    const int ln = fq * 16 + fr; (void)ln;
    P p = p0; asm volatile("" : "+s"(p.ws), "+s"(p.out));
    const int rbase = u.pm * 256 + wr * 64 + fr;
    const int cb = u.pn * 256 + wc * 32 + 8 * fq;
    const float* swp = p.sWup() + ((size_t)(l * 9 + mod_row(u.pm * 256))) * DFF;
    float rsdv[2][4];
#pragma unroll
    for (int ai = 0; ai < 2; ++ai)
#pragma unroll
      for (int mm = 0; mm < 4; ++mm) rsdv[ai][mm] = row_rstd(p.rssB(), rbase + ai * 128 + mm * 16);
    f32x4 swv[2][2];
#pragma unroll
    for (int bj = 0; bj < 2; ++bj)
#pragma unroll
      for (int n = 0; n < 2; ++n) swv[bj][n] = *(const f32x4*)(swp + cb + bj * 128 + n * 4);
#pragma unroll
    for (int ai = 0; ai < 2; ++ai)
#pragma unroll
      for (int mm = 0; mm < 4; ++mm) {
        int m = rbase + ai * 128 + mm * 16; asm volatile("" : "+v"(m));
        bf16_t* uo = p.ubuf() + (size_t)m * DFF;
        const float rsd = rsdv[ai][mm];
#pragma unroll
        for (int bj = 0; bj < 2; ++bj) {
          f32x4 t0 = acc[ai][bj][mm][0] * rsd + swv[bj][0], t1 = acc[ai][bj][mm][1] * rsd + swv[bj][1];
#pragma unroll
          for (int j = 0; j < 4; ++j) { const float a = fmaxf(t0[j], 0.f), b = fmaxf(t1[j], 0.f); t0[j] = a * a; t1[j] = b * b; }
          *(uint4*)(uo + cb + bj * 128) = make_uint4(pk2(t0[0], t0[1]), pk2(t0[2], t0[3]), pk2(t1[0], t1[1]), pk2(t1[2], t1[3]));
        }
      }
  }
};
struct EpiDown8 {
  static constexpr bool PERM = true, AFTER_DRAIN = false;
  P p0; int l;
  __device__ __forceinline__ void operator()(const acc_t& acc, const Unit& u, int wr, int wc, int fr_in, int fq_in) const {
    int fr = fr_in; asm volatile("" : "+v"(fr));
    int fq = fq_in; asm volatile("" : "+v"(fq));
    const int ln = fq * 16 + fr; (void)ln;
    P p = p0; asm volatile("" : "+s"(p.ws), "+s"(p.out));
    const int rbase = u.pm * 256 + wr * 64 + fr;
    const int cb = u.pn * 256 + wc * 32 + 8 * fq;
    const int r = mod_row(u.pm * 256);
    const float* md = p.mod() + ((size_t)(l * 9 + r)) * 6144;
    const float* gate = md + 5 * 1024; const float* sc2 = md + 4 * 1024; const float* g2 = p.norm2 + l * DM;
    const float* sc1 = p.mod() + ((size_t)(9 + r)) * 6144 + 1 * 1024;
    const float* g1 = p.norm1 + DM;
    f32x4 riv[2][2];
#pragma unroll
    for (int bj = 0; bj < 2; ++bj)
#pragma unroll
      for (int n = 0; n < 2; ++n) {
        const int c = cb + bj * 128 + n * 4;
        const f32x4 q2 = *(const f32x4*)(g2 + c) * (*(const f32x4*)(sc2 + c) + 1.f);
#pragma unroll
        for (int j = 0; j < 4; ++j) riv[bj][n][j] = __builtin_amdgcn_rcpf(q2[j]);
      }
#pragma unroll
    for (int ap = 0; ap < 4; ++ap) {
      const int ai = ap >> 1, m2 = (ap & 1) * 2;
      int mb = rbase + ai * 128 + m2 * 16; asm volatile("" : "+v"(mb));
      uint4 hvv[2][2];
#pragma unroll
      for (int mq = 0; mq < 2; ++mq) {
        const bf16_t* hr = p.hbuf() + (size_t)(mb + mq * 16) * DM;
#pragma unroll
        for (int bj = 0; bj < 2; ++bj) hvv[mq][bj] = *(const uint4*)(hr + cb + bj * 128);
      }
#pragma unroll
      for (int mq = 0; mq < 2; ++mq) {
        const int mm = m2 + mq;
        const int m = mb + mq * 16;
        float* xo = p.xw() + (size_t)m * DM;
        bf16_t* ho = p.hbuf() + (size_t)m * DM;
        float ss = 0.f;
#pragma unroll
        for (int bj = 0; bj < 2; ++bj) {
          unsigned pw[4] = {0u, 0u, 0u, 0u};
#pragma unroll
          for (int n = 0; n < 2; ++n) {
            const int c = cb + bj * 128 + n * 4;
            uint2 hq; hq.x = n ? hvv[mq][bj].z : hvv[mq][bj].x; hq.y = n ? hvv[mq][bj].w : hvv[mq][bj].y;
            f32x4 xm;
            xm[0] = __uint_as_float(hq.x << 16); xm[1] = __uint_as_float(hq.x & 0xffff0000u);
            xm[2] = __uint_as_float(hq.y << 16); xm[3] = __uint_as_float(hq.y & 0xffff0000u);
            const f32x4 xn = xm * riv[bj][n] + *(const f32x4*)(gate + c) * acc[ai][bj][mm][n];
            if (l != 0) *(f32x4*)(xo + c) = xn;
            if (l == 0) {
              const f32x4 hv = xn * (*(const f32x4*)(g1 + c) * (*(const f32x4*)(sc1 + c) + 1.f));
              pw[2 * n] = pk2(hv[0], hv[1]); pw[2 * n + 1] = pk2(hv[2], hv[3]);
              ss += (xn[0] * xn[0] + xn[1] * xn[1]) + (xn[2] * xn[2] + xn[3] * xn[3]);
            }
          }
          if (l == 0) *(uint4*)(ho + cb + bj * 128) = make_uint4(pw[0], pw[1], pw[2], pw[3]);
        }
        if (l == 0) {
          ss += shx(ss, 16, ln);
          ss += shx(ss, 32, ln);
          if (fq == 0) p.rssA()[(size_t)m * 16 + u.pn * 4 + wc] = ss;
        }
      }
      asm volatile("" ::: "memory");
    }
  }
};

struct EpiKvb {
  P p; int l;
  __device__ __forceinline__ void operator()(int m, int nb, int h, const f32x16& v) const {
    const int hh = nb >> 7, j0 = nb & 127;
    bf16_t* Kb; bf16_t* Vb; int S, key;
    if (m < NCTX) {
      const int b = m >> 8; key = m & 255; S = 256;
      Kb = p.Kmla_c() + ((size_t)((b * 4 + hh) * 256)) * 96;
      Vb = p.Vtmla_c() + ((size_t)((b * 4 + hh) * 64)) * 256;
    } else {
      int b;
      if (m < NTOK) { b = (m - NCTX) >> 10; key = (m - NCTX) & 1023; }
      else { b = (m - NTOK) >> 8; key = 1024 + ((m - NTOK) & 255); }
      S = 1280;
      Kb = p.Kmla_l() + ((size_t)(((l * 8 + b) * 4 + hh) * 1280)) * 96;
      Vb = p.Vtmla_l() + ((size_t)(((l * 8 + b) * 4 + hh) * 64)) * 1280;
    }
    if (j0 < 64) st_rm_bf16(Kb + (size_t)key * 96 + j0, h, v);
    else st_tr_bf16(Vb + (size_t)(j0 - 64) * S + key, S, h, v);
  }
};

template <class Epi>
__device__ __forceinline__ void gemm_small(const bf16_t* __restrict__ A, int lda, const bf16_t* __restrict__ W, int ldw,
                                           int M, int N, int K, unsigned char* smem, const Epi& epi, const int wv, unsigned* ready, unsigned* ticket) {
  constexpr int TA = 256 * 72, TW = 128 * 72;
  bf16_t* sb = (bf16_t*)smem;
  const int tid = my_tid(wv), bid = my_bid(), lane = tid & 63, wave = tid >> 6;
  const int wm = wave >> 1, wn = wave & 1, r = lane & 31, h = lane >> 5;
  const int MT = M >> 8, NT = N >> 7, ntiles = MT * NT, nk = K >> 6;
  const int lc = tid & 7, lr = tid >> 3;
  (void)bid;
  if (tid == 0) {
    unsigned polls = 0;
    while (__hip_atomic_load(ready, __ATOMIC_RELAXED, __HIP_MEMORY_SCOPE_AGENT) < 64u && ++polls < (1u << 22)) __builtin_amdgcn_s_sleep(8);
    __builtin_amdgcn_fence(__ATOMIC_ACQUIRE, "agent");
    asm volatile("s_waitcnt vmcnt(0)" ::: "memory");
  }
  __syncthreads();
  volatile int* tks = (volatile int*)(smem + LDS_RED + 2048);
  for (;;) {
    __syncthreads();
    if (tid == 0) *tks = (int)__hip_atomic_fetch_add(ticket, 1u, __ATOMIC_RELAXED, __HIP_MEMORY_SCOPE_AGENT);
    __syncthreads();
    const int tile = *tks;
    if (tile >= ntiles) break;
    const int m0 = (tile % MT) << 8, n0 = (tile / MT) << 7;
    f32x16 acc[2][2];
#pragma unroll
    for (int a = 0; a < 2; ++a)
#pragma unroll
      for (int b = 0; b < 2; ++b)
#pragma unroll
        for (int i = 0; i < 16; ++i) acc[a][b][i] = 0.f;
    uint4 ra[4], rw[2];
    const bf16_t* Ap = A + (size_t)(m0 + lr) * lda + lc * 8;
    const bf16_t* Wp = W + (size_t)(n0 + lr) * ldw + lc * 8;
    auto gload = [&](int kt) {
#pragma unroll
      for (int i = 0; i < 4; ++i) ra[i] = *(const uint4*)(Ap + (size_t)(64 * i) * lda + kt * 64);
#pragma unroll
      for (int i = 0; i < 2; ++i) rw[i] = *(const uint4*)(Wp + (size_t)(64 * i) * ldw + kt * 64);
    };
    auto swrite = [&](int bsel) {
      bf16_t* sA = sb + bsel * (TA + TW); bf16_t* sW = sA + TA;
#pragma unroll
      for (int i = 0; i < 4; ++i) *(uint4*)(sA + (lr + 64 * i) * 72 + lc * 8) = ra[i];
#pragma unroll
      for (int i = 0; i < 2; ++i) *(uint4*)(sW + (lr + 64 * i) * 72 + lc * 8) = rw[i];
    };
    __syncthreads();
    gload(0); swrite(0);
    __syncthreads();
    for (int kt = 0; kt < nk; ++kt) {
      if (kt + 1 < nk) gload(kt + 1);
      const bf16_t* sA = sb + (kt & 1) * (TA + TW); const bf16_t* sW = sA + TA;
#pragma unroll
      for (int ks = 0; ks < 4; ++ks) {
        bf16x8 wf[2], af[2];
#pragma unroll
        for (int i = 0; i < 2; ++i) {
          wf[i] = *(const bf16x8*)(sW + (wn * 64 + i * 32 + r) * 72 + ks * 16 + h * 8);
          af[i] = *(const bf16x8*)(sA + (wm * 64 + i * 32 + r) * 72 + ks * 16 + h * 8);
        }
#pragma unroll
        for (int a = 0; a < 2; ++a)
#pragma unroll
          for (int b = 0; b < 2; ++b) acc[a][b] = __builtin_amdgcn_mfma_f32_32x32x16_bf16(wf[a], af[b], acc[a][b], 0, 0, 0);
      }
      if (kt + 1 < nk) swrite((kt + 1) & 1);
      __syncthreads();
    }
#pragma unroll
    for (int a = 0; a < 2; ++a)
#pragma unroll
      for (int b = 0; b < 2; ++b) epi(m0 + wm * 64 + b * 32 + r, n0 + wn * 64 + a * 32, h, acc[a][b]);
  }
}

struct AttnItem {
  const bf16_t* Q; int qs;
  const bf16_t* K; int ks;
  const bf16_t* Vt; int vs;
  int t0, t1, t2, t3;
  int qpos0, T;
  float scale, sink_l2; int has_sink;
  float lgf, lgb;
  const bf16_t *S0f, *S0b;
  const bf16_t* G; const float* gn;
  bf16_t* out;
  float* sout;
};

template <int DQK, int MODE>
__device__ __forceinline__ void attn_item(const AttnItem& it, unsigned char* smem, const int wv) {
  constexpr int KSTR = DQK + 8, NKS = DQK / 16, VSTR = 68, KCH = DQK / 8;
  bf16_t* Ks = (bf16_t*)smem;
  bf16_t* Vs = Ks + 64 * KSTR;
  const int tid = my_tid(wv), lane = tid & 63, wave = tid >> 6, r = lane & 31, h = lane >> 5;
  const int qrow = wave * 32 + r;
  bf16x8 qf[NKS];
  if constexpr (MODE == 3) {
    const int dq = (wave & 1) * 32 + r;
#pragma unroll
    for (int ks = 0; ks < NKS; ++ks) {
      const int e = dq - (ks * 16 + h * 8);
      uint4 v;
      v.x = e == 0 ? 0x3F80u : (e == 1 ? 0x3F800000u : 0u);
      v.y = e == 2 ? 0x3F80u : (e == 3 ? 0x3F800000u : 0u);
      v.z = e == 4 ? 0x3F80u : (e == 5 ? 0x3F800000u : 0u);
      v.w = e == 6 ? 0x3F80u : (e == 7 ? 0x3F800000u : 0u);
      qf[ks] = __builtin_bit_cast(bf16x8, v);
    }
  } else {
#pragma unroll
    for (int ks = 0; ks < NKS; ++ks) qf[ks] = *(const bf16x8*)(it.Q + (size_t)qrow * it.qs + ks * 16 + h * 8);
  }
  f32x16 o0, o1;
#pragma unroll
  for (int i = 0; i < 16; ++i) { o0[i] = 0.f; o1[i] = 0.f; }
  float mrun = it.has_sink ? it.sink_l2 : -1e30f, lrun = 0.f;
  const int qp = it.qpos0 + qrow;
  const int n1 = it.t1 - it.t0, ntl = n1 + (it.t3 - it.t2);
  constexpr int BUFE = 64 * KSTR + 64 * VSTR;
  const int krow0 = tid / KCH, kch0 = tid % KCH, krow1 = (tid + NTHR) / KCH, kch1 = (tid + NTHR) % KCH;
  const bool k2 = (KCH == 12) && (tid + NTHR < 64 * KCH);
  const int vrow = tid >> 3, vch = tid & 7;
  uint4 rk0, rk1, rv;
  auto tile_of = [&](int ti) { return ti < n1 ? it.t0 + ti : it.t2 + (ti - n1); };
  auto gload = [&](int t) {
    const bool stt = (MODE == 2) && (t >= 16);
    if (!stt) {
      const int key0 = t * 64;
      rk0 = *(const uint4*)(it.K + (size_t)(key0 + krow0) * it.ks + kch0 * 8);
      if (k2) rk1 = *(const uint4*)(it.K + (size_t)(key0 + krow1) * it.ks + kch1 * 8);
      rv = *(const uint4*)(it.Vt + (size_t)vrow * it.vs + key0 + vch * 8);
    } else {
      const bf16_t* S = (t == 16) ? it.S0f : it.S0b;
      const int e = krow0 - kch0 * 8;
      rk0.x = e == 0 ? 0x3F80u : (e == 1 ? 0x3F800000u : 0u);
      rk0.y = e == 2 ? 0x3F80u : (e == 3 ? 0x3F800000u : 0u);
      rk0.z = e == 4 ? 0x3F80u : (e == 5 ? 0x3F800000u : 0u);
      rk0.w = e == 6 ? 0x3F80u : (e == 7 ? 0x3F800000u : 0u);
      rv = *(const uint4*)(S + (size_t)vrow * 64 + vch * 8);
    }
  };
  auto swrite = [&](int bsel) {
    bf16_t* Kb = Ks + bsel * BUFE; bf16_t* Vb = Kb + 64 * KSTR;
    *(uint4*)(Kb + krow0 * KSTR + kch0 * 8) = rk0;
    if (k2) *(uint4*)(Kb + krow1 * KSTR + kch1 * 8) = rk1;
    uint2* d = (uint2*)(Vb + vrow * VSTR + vch * 8);
    d[0] = make_uint2(rv.x, rv.y); d[1] = make_uint2(rv.z, rv.w);
  };
  __syncthreads();
  gload(tile_of(0)); swrite(0);
  __syncthreads();
  for (int ti = 0; ti < ntl; ++ti) {
    const int t = tile_of(ti);
    const bool st_tile = (MODE == 2) && (t >= 16);
    const int key0 = t * 64;
    const bool more = ti + 1 < ntl;
    if (more) gload(tile_of(ti + 1));
    const bf16_t* Kc = Ks + (ti & 1) * BUFE; const bf16_t* Vc = Kc + 64 * KSTR;
    bool skip = (MODE == 3) && (wave >= 4);
    if (MODE == 1 && t < 16) {
      const int qlo = it.qpos0 + wave * 32;
      skip = (key0 > qlo + 31 + 128 || key0 + 63 < qlo - 128);
    }
    if (!skip) {
    f32x16 s0, s1;
#pragma unroll
    for (int i = 0; i < 16; ++i) { s0[i] = 0.f; s1[i] = 0.f; }
#pragma unroll
    for (int ks = 0; ks < NKS; ++ks) {
      const bf16x8 k0 = *(const bf16x8*)(Kc + r * KSTR + ks * 16 + h * 8);
      const bf16x8 k1 = *(const bf16x8*)(Kc + (32 + r) * KSTR + ks * 16 + h * 8);
      s0 = __builtin_amdgcn_mfma_f32_32x32x16_bf16(k0, qf[ks], s0, 0, 0, 0);
      s1 = __builtin_amdgcn_mfma_f32_32x32x16_bf16(k1, qf[ks], s1, 0, 0, 0);
    }
    if constexpr (MODE == 3) {
      if (wave < 2) {
        const float base = (float)(it.T - 1 - key0 - 4 * h) * it.lgf - 3.f;
#pragma unroll
        for (int i = 0; i < 16; ++i) {
          s0[i] *= fexp2(fmaf(-(float)((i & 3) + 8 * (i >> 2)), it.lgf, base));
          s1[i] *= fexp2(fmaf(-(float)(32 + (i & 3) + 8 * (i >> 2)), it.lgf, base));
        }
      } else {
        const float base = (float)(key0 + 4 * h) * it.lgb - 3.f;
#pragma unroll
        for (int i = 0; i < 16; ++i) {
          s0[i] *= fexp2(fmaf((float)((i & 3) + 8 * (i >> 2)), it.lgb, base));
          s1[i] *= fexp2(fmaf((float)(32 + (i & 3) + 8 * (i >> 2)), it.lgb, base));
        }
      }
    } else if constexpr (MODE == 2) {
      if (!st_tile) {
        const int qlo = it.qpos0 + wave * 32;
        if (key0 + 63 < qlo) {
          const float base = (float)(qp - key0 - 4 * h) * it.lgf - 3.f;
#pragma unroll
          for (int i = 0; i < 16; ++i) {
            s0[i] *= fexp2(fmaf(-(float)((i & 3) + 8 * (i >> 2)), it.lgf, base));
            s1[i] *= fexp2(fmaf(-(float)(32 + (i & 3) + 8 * (i >> 2)), it.lgf, base));
          }
        } else if (key0 > qlo + 31) {
          const float base = (float)(key0 + 4 * h - qp) * it.lgb - 3.f;
#pragma unroll
          for (int i = 0; i < 16; ++i) {
            s0[i] *= fexp2(fmaf((float)((i & 3) + 8 * (i >> 2)), it.lgb, base));
            s1[i] *= fexp2(fmaf((float)(32 + (i & 3) + 8 * (i >> 2)), it.lgb, base));
          }
        } else {
#pragma unroll
        for (int i = 0; i < 16; ++i) {
          const int key = key0 + (i & 3) + 8 * (i >> 2) + 4 * h;
          const int e0 = qp - key, e1 = e0 - 32;
          float d0 = fexp2((float)(e0 < 0 ? -e0 : e0) * (e0 > 0 ? it.lgf : it.lgb));
          float d1 = fexp2((float)(e1 < 0 ? -e1 : e1) * (e1 > 0 ? it.lgf : it.lgb));
          d0 = e0 == 0 ? 2.f : d0;
          d1 = e1 == 0 ? 2.f : d1;
          s0[i] *= it.scale * d0;
          s1[i] *= it.scale * d1;
        }
        }
      } else {
        const float dec = (t == 16) ? fexp2((float)(qp + 1) * it.lgf) : fexp2((float)(it.T - qp) * it.lgb);
#pragma unroll
        for (int i = 0; i < 16; ++i) { s0[i] *= dec; s1[i] *= dec; }
      }
    } else {
      float mx = -INFINITY;
      const int qlo1 = it.qpos0 + wave * 32;
      const bool need_mask = (MODE == 1) && (t < 16) && !(key0 >= qlo1 + 31 - 128 && key0 + 63 <= qlo1 + 128);
#pragma unroll
      for (int i = 0; i < 16; ++i) {
        float a = s0[i] * it.scale, b = s1[i] * it.scale;
        if (MODE == 1 && need_mask) {
          const int key = key0 + (i & 3) + 8 * (i >> 2) + 4 * h;
          const int e0 = key - qp, e1 = e0 + 32;
          if (e0 > 128 || e0 < -128) a = -INFINITY;
          if (e1 > 128 || e1 < -128) b = -INFINITY;
        }
        s0[i] = a; s1[i] = b;
        mx = fmaxf(mx, fmaxf(a, b));
      }
      mx = fmaxf(mx, shx(mx, 32, lane));
      const float mnew = fmaxf(mrun, mx);
      const float alpha = fexp2(mrun - mnew);
      float sum = 0.f;
#pragma unroll
      for (int i = 0; i < 16; ++i) {
        s0[i] = fexp2(s0[i] - mnew);
        s1[i] = fexp2(s1[i] - mnew);
        sum += s0[i] + s1[i];
      }
      lrun = lrun * alpha + sum;
      mrun = mnew;
#pragma unroll
      for (int i = 0; i < 16; ++i) { o0[i] *= alpha; o1[i] *= alpha; }
    }
#pragma unroll
    for (int kt = 0; kt < 2; ++kt) {
#pragma unroll
      for (int sbk = 0; sbk < 2; ++sbk) {
        uint4 pw;
        if (kt == 0) {
          pw.x = pk2(s0[8 * sbk + 0], s0[8 * sbk + 1]); pw.y = pk2(s0[8 * sbk + 2], s0[8 * sbk + 3]);
          pw.z = pk2(s0[8 * sbk + 4], s0[8 * sbk + 5]); pw.w = pk2(s0[8 * sbk + 6], s0[8 * sbk + 7]);
        } else {
          pw.x = pk2(s1[8 * sbk + 0], s1[8 * sbk + 1]); pw.y = pk2(s1[8 * sbk + 2], s1[8 * sbk + 3]);
          pw.z = pk2(s1[8 * sbk + 4], s1[8 * sbk + 5]); pw.w = pk2(s1[8 * sbk + 6], s1[8 * sbk + 7]);
        }
        const bf16x8 pf = __builtin_bit_cast(bf16x8, pw);
        const int koff = kt * 32 + sbk * 16 + 4 * h;
        const uint2 a0 = *(const uint2*)(Vc + r * VSTR + koff), a1 = *(const uint2*)(Vc + r * VSTR + koff + 8);
        const uint2 b0 = *(const uint2*)(Vc + (32 + r) * VSTR + koff), b1 = *(const uint2*)(Vc + (32 + r) * VSTR + koff + 8);
        const bf16x8 v0 = __builtin_bit_cast(bf16x8, make_uint4(a0.x, a0.y, a1.x, a1.y));
        const bf16x8 v1 = __builtin_bit_cast(bf16x8, make_uint4(b0.x, b0.y, b1.x, b1.y));
        o0 = __builtin_amdgcn_mfma_f32_32x32x16_bf16(v0, pf, o0, 0, 0, 0);
        o1 = __builtin_amdgcn_mfma_f32_32x32x16_bf16(v1, pf, o1, 0, 0, 0);
      }
    }
    }
    if (more) swrite((ti + 1) & 1);
    __syncthreads();
  }
  if constexpr (MODE == 3) {
    if (wave < 4) {
      float* rowp = it.sout + (size_t)(wave >> 1) * 16384 + (size_t)((wave & 1) * 32 + r) * 64;
#pragma unroll
      for (int g = 0; g < 4; ++g) {
        *(float4*)(rowp + 8 * g + 4 * h) = make_float4(o0[4 * g], o0[4 * g + 1], o0[4 * g + 2], o0[4 * g + 3]);
        *(float4*)(rowp + 32 + 8 * g + 4 * h) = make_float4(o1[4 * g], o1[4 * g + 1], o1[4 * g + 2], o1[4 * g + 3]);
      }
    }
    return;
  }
  bf16_t* orow = it.out + (size_t)qrow * DM;
  if constexpr (MODE == 2) {
    float sm = 0.f;
#pragma unroll
    for (int i = 0; i < 16; ++i) sm += o0[i] + o1[i];
    sm += shx(sm, 32, lane);
    const float mu = sm * (1.f / 64.f);
    float vr = 0.f;
#pragma unroll
    for (int i = 0; i < 16; ++i) { o0[i] -= mu; o1[i] -= mu; vr += o0[i] * o0[i] + o1[i] * o1[i]; }
    vr += shx(vr, 32, lane);
    const float rstd = rsqrtf(vr * (1.f / 64.f) + 1e-6f);
    const bf16_t* grow = it.G + (size_t)qrow * 256;
#pragma unroll
    for (int g = 0; g < 4; ++g) {
      const int d = 8 * g + 4 * h;
      const uint2 ga = *(const uint2*)(grow + d), gb = *(const uint2*)(grow + 32 + d);
      const float gav[4] = {__uint_as_float(ga.x << 16), __uint_as_float(ga.x & 0xffff0000u), __uint_as_float(ga.y << 16), __uint_as_float(ga.y & 0xffff0000u)};
      const float gbv[4] = {__uint_as_float(gb.x << 16), __uint_as_float(gb.x & 0xffff0000u), __uint_as_float(gb.y << 16), __uint_as_float(gb.y & 0xffff0000u)};
#pragma unroll
      for (int j = 0; j < 4; ++j) {
        const float x0 = gav[j], x1 = gbv[j];
        o0[4 * g + j] = o0[4 * g + j] * rstd * it.gn[d + j] * (x0 / (1.f + __expf(-x0)));
        o1[4 * g + j] = o1[4 * g + j] * rstd * it.gn[32 + d + j] * (x1 / (1.f + __expf(-x1)));
      }
    }
  } else {
    float lt = lrun + shx(lrun, 32, lane);
    if (it.has_sink) lt += fexp2(it.sink_l2 - mrun);
    const float inv = 1.f / lt;
#pragma unroll
    for (int i = 0; i < 16; ++i) { o0[i] *= inv; o1[i] *= inv; }
  }
  st_rm_bf16(orow, h, o0);
  st_rm_bf16(orow + 32, h, o1);
}

__device__ __forceinline__ float log2_sigmoid(float x) { return -log1pf(expf(-x)) * LOG2E; }

__device__ __forceinline__ void state_item(const P& p, int l, int idx, unsigned char* smem, const int wv) {
  const int b = idx >> 3, hh = (idx >> 1) & 3, dir = idx & 1;
  float* Ksm = (float*)smem;
  float* Vsm = Ksm + 4096;
  const int tid = my_tid(wv);
  const float lg = log2_sigmoid(p.ret_decay[(l * 2 + dir) * 4 + hh]);
  float acc[8];
#pragma unroll
  for (int i = 0; i < 8; ++i) acc[i] = 0.f;
  const int d = tid >> 3, e0 = (tid & 7) * 8;
  for (int c = 0; c < 4; ++c) {
    __syncthreads();
    for (int i = tid; i < 4096; i += NTHR) {
      const int j = i >> 6, dd = i & 63, tok = c * 64 + j;
      const float dec = dir == 0 ? fexp2((float)(255 - tok) * lg) : fexp2((float)tok * lg);
      Ksm[j * 64 + dd] = bf2f(p.Kret()[(size_t)(b * 256 + tok) * 256 + hh * 64 + dd]) * 0.125f * dec;
      const int e = i >> 6, jj = i & 63;
      Vsm[e * 65 + jj] = bf2f(p.Vtret_c()[((size_t)((b * 4 + hh) * 64 + e)) * 256 + c * 64 + jj]);
    }
    __syncthreads();
    for (int j = 0; j < 64; ++j) {
      const float kd = Ksm[j * 64 + d];
#pragma unroll
      for (int i = 0; i < 8; ++i) acc[i] += kd * Vsm[(e0 + i) * 65 + j];
    }
  }
  float* op = p.out + 23592960 + ((size_t)((((b * 2 + l) * 2 + dir) * 4 + hh) * 64 + d)) * 64 + e0;
  *(float4*)(op) = make_float4(acc[0], acc[1], acc[2], acc[3]);
  *(float4*)(op + 4) = make_float4(acc[4], acc[5], acc[6], acc[7]);
}

__device__ __forceinline__ void attn_phase(const P& p, int l, unsigned char* smem, const int wv) {
  constexpr int NA = 128, NB = 128, NC = 256, ND = 256, NE = 128, NF = 128, NG = 128;
  constexpr int TOT = NA + NB + NC + ND + NE + NF + NG;
  unsigned* ticket = p.ctl() + 32 + 64 * l;
  volatile int* tks = (volatile int*)(smem + LDS_RED + 2048);
  const int tid0 = my_tid(wv);
  for (;;) {
    __syncthreads();
    if (tid0 == 0) *tks = (int)__hip_atomic_fetch_add(ticket, 1u, __ATOMIC_RELAXED, __HIP_MEMORY_SCOPE_AGENT);
    __syncthreads();
    const int item = *tks;
    if (item >= TOT) break;
    int idx = item;
    AttnItem it;
    it.t2 = 0; it.t3 = 0; it.qpos0 = 0; it.T = 0; it.sink_l2 = 0.f; it.has_sink = 0; it.lgf = 0.f; it.lgb = 0.f;
    it.S0f = nullptr; it.S0b = nullptr; it.G = nullptr; it.gn = nullptr; it.sout = nullptr;
    if (idx < NA) {
      const int b = idx >> 4, hh = (idx >> 2) & 3, qb = idx & 3, row0 = NCTX + b * 1024 + qb * 256;
      it.Q = p.Qmla() + (size_t)row0 * 384 + hh * 96; it.qs = 384;
      it.K = p.Kmla_l() + ((size_t)(((l * 8 + b) * 4 + hh) * 1280)) * 96; it.ks = 96;
      it.Vt = p.Vtmla_l() + ((size_t)(((l * 8 + b) * 4 + hh) * 64)) * 1280; it.vs = 1280;
      it.t0 = 0; it.t1 = 20;
      it.scale = 0.10206207261596575f * LOG2E;
      it.out = p.mix() + (size_t)row0 * DM + 768 + hh * 64;
      attn_item<96, 0>(it, smem, wv);
      continue;
    }
    idx -= NA;
    if (idx < NB) {
      const int b = idx >> 4, hh = (idx >> 2) & 3, qb = idx & 3, row0 = NCTX + b * 1024 + qb * 256;
      it.Q = p.Qret() + (size_t)row0 * 256 + hh * 64; it.qs = 256;
      it.K = p.Kret() + (size_t)(NCTX + b * 1024) * 256 + hh * 64; it.ks = 256;
      it.Vt = p.Vtret_l() + ((size_t)((b * 4 + hh) * 64)) * 1024; it.vs = 1024;
      it.t0 = 0; it.t1 = 16; it.t2 = 16; it.t3 = 18;
      it.qpos0 = qb * 256; it.T = 1024; it.scale = 0.125f;
      it.lgf = log2_sigmoid(p.ret_decay[(l * 2 + 0) * 4 + hh]);
      it.lgb = log2_sigmoid(p.ret_decay[(l * 2 + 1) * 4 + hh]);
      it.S0f = p.S0t() + ((size_t)((((l * 8 + b) * 2 + 0) * 4 + hh))) * 4096;
      it.S0b = p.S0t() + ((size_t)((((l * 8 + b) * 2 + 1) * 4 + hh))) * 4096;
      it.G = p.Gret() + (size_t)row0 * 256 + hh * 64; it.gn = p.ret_gn + l * 256 + hh * 64;
      it.out = p.mix() + (size_t)row0 * DM + 512 + hh * 64;
      attn_item<64, 2>(it, smem, wv);
      continue;
    }
    idx -= NB;
    if (idx < NC) {
      const int b = idx >> 5, head = (idx >> 2) & 7, qb = idx & 3, kv = head >> 2, row0 = NCTX + b * 1024 + qb * 256;
      it.Q = p.Qwin() + (size_t)row0 * 512 + head * 64; it.qs = 512;
      it.K = p.Kwin_l() + ((size_t)((l * 8 + b) * 1280)) * 128 + kv * 64; it.ks = 128;
      it.Vt = p.Vtwin_l() + ((size_t)(((l * 8 + b) * 2 + kv) * 64)) * 1280; it.vs = 1280;
      it.t0 = max(0, qb * 4 - 2); it.t1 = min(16, qb * 4 + 6); it.t2 = 16; it.t3 = 20;
      it.qpos0 = qb * 256;
      it.scale = 0.125f * LOG2E; it.sink_l2 = p.win_sink[l * 8 + head] * LOG2E; it.has_sink = 1;
      it.out = p.mix() + (size_t)row0 * DM + head * 64;
      attn_item<64, 1>(it, smem, wv);
      continue;
    }
    idx -= NC;
    if (idx < ND) {
      const int b = idx >> 3, head = idx & 7, kv = head >> 2, row0 = b * 256;
      it.Q = p.Qwin() + (size_t)row0 * 512 + head * 64; it.qs = 512;
      it.K = p.Kwin_c() + (size_t)(b * 256) * 128 + kv * 64; it.ks = 128;
      it.Vt = p.Vtwin_c() + ((size_t)((b * 2 + kv) * 64)) * 256; it.vs = 256;
      it.t0 = 0; it.t1 = 4;
      it.scale = 0.125f * LOG2E; it.sink_l2 = p.win_sink[l * 8 + head] * LOG2E; it.has_sink = 1;
      it.out = p.mix() + (size_t)row0 * DM + head * 64;
      attn_item<64, 0>(it, smem, wv);
      continue;
    }
    idx -= ND;
    if (idx < NE) {
      const int b = idx >> 2, hh = idx & 3, row0 = b * 256;
      it.Q = p.Qmla() + (size_t)row0 * 384 + hh * 96; it.qs = 384;
      it.K = p.Kmla_c() + ((size_t)((b * 4 + hh) * 256)) * 96; it.ks = 96;
      it.Vt = p.Vtmla_c() + ((size_t)((b * 4 + hh) * 64)) * 256; it.vs = 256;
      it.t0 = 0; it.t1 = 4;
      it.scale = 0.10206207261596575f * LOG2E;
      it.out = p.mix() + (size_t)row0 * DM + 768 + hh * 64;
      attn_item<96, 0>(it, smem, wv);
      continue;
    }
    idx -= NE;
    if (idx < NF) {
      const int b = idx >> 2, hh = idx & 3, row0 = b * 256;
      it.Q = p.Qret() + (size_t)row0 * 256 + hh * 64; it.qs = 256;
      it.K = p.Kret() + (size_t)(b * 256) * 256 + hh * 64; it.ks = 256;
      it.Vt = p.Vtret_c() + ((size_t)((b * 4 + hh) * 64)) * 256; it.vs = 256;
      it.t0 = 0; it.t1 = 4;
      it.qpos0 = 0; it.T = 256; it.scale = 0.125f;
      it.lgf = log2_sigmoid(p.ret_decay[(l * 2 + 0) * 4 + hh]);
      it.lgb = log2_sigmoid(p.ret_decay[(l * 2 + 1) * 4 + hh]);
      it.G = p.Gret() + (size_t)row0 * 256 + hh * 64; it.gn = p.ret_gn + l * 256 + hh * 64;
      it.out = p.mix() + (size_t)row0 * DM + 512 + hh * 64;
      attn_item<64, 2>(it, smem, wv);
      continue;
    }
    idx -= NF;
    {
      const int b = idx >> 2, hh = idx & 3;
      it.Q = nullptr; it.qs = 0;
      it.K = p.Kret() + (size_t)(b * 256) * 256 + hh * 64; it.ks = 256;
      it.Vt = p.Vtret_c() + ((size_t)((b * 4 + hh) * 64)) * 256; it.vs = 256;
      it.t0 = 0; it.t1 = 4;
      it.T = 256; it.scale = 0.125f;
      it.lgf = log2_sigmoid(p.ret_decay[(l * 2 + 0) * 4 + hh]);
      it.lgb = log2_sigmoid(p.ret_decay[(l * 2 + 1) * 4 + hh]);
      it.out = nullptr;
      it.sout = p.out + 23592960 + ((size_t)((b * 2 + l) * 2 * 4 + hh)) * 4096;
      attn_item<64, 3>(it, smem, wv);
    }
  }
}

__device__ __forceinline__ void gemv9_item(const float* sc, float* red, const float* __restrict__ W, int N, int n0, float* outp, int ldo,
                                           const float* bias, const int tid) {
  const int j4 = (tid & 7) * 4, kq = tid >> 3;
  f32x4 acc[9];
#pragma unroll
  for (int r = 0; r < 9; ++r) acc[r] = (f32x4){0.f, 0.f, 0.f, 0.f};
  const float* w = W + (size_t)(kq * 16) * N + n0 + j4;
  const float* s = sc + kq * 16;
#pragma unroll
  for (int kk = 0; kk < 16; ++kk) {
    const f32x4 wv = *(const f32x4*)(w + (size_t)kk * N);
#pragma unroll
    for (int r = 0; r < 9; ++r) acc[r] += wv * s[r * 1024 + kk];
  }
#pragma unroll
  for (int r = 0; r < 9; ++r) *(f32x4*)(red + (kq * 9 + r) * 32 + j4) = acc[r];
  __syncthreads();
  for (int oo = tid; oo < 288; oo += NTHR) {
    const int r = oo >> 5, jj = oo & 31;
    float sum = 0.f;
#pragma unroll 16
    for (int q = 0; q < 64; ++q) sum += red[(q * 9 + r) * 32 + jj];
    outp[(size_t)r * ldo + n0 + jj] = sum + (bias ? bias[n0 + jj] : 0.f);
  }
  __syncthreads();
}

__device__ __forceinline__ void norm0_phase(const P& p, unsigned char* smem, const int wv) {
  const int tid = my_tid(wv), lane = tid & 63, gw = my_bid() * NWV + (tid >> 6), ngw = gridDim.x * NWV;
  const float* gain = p.norm1;
  for (int m0 = gw; m0 < NTOK; m0 += 2 * ngw) {
    float4 v[2][4];
    float ss[2] = {0.f, 0.f};
#pragma unroll
    for (int q = 0; q < 2; ++q) {
      const int m = m0 + q * ngw;
      const float* xr = m < NCTX ? p.x_prompt + (size_t)m * DM : p.x_sample + (size_t)(m - NCTX) * DM;
#pragma unroll
      for (int j = 0; j < 4; ++j) v[q][j] = ((const float4*)xr)[lane + 64 * j];
    }
#pragma unroll
    for (int q = 0; q < 2; ++q) {
#pragma unroll
      for (int j = 0; j < 4; ++j) ss[q] += v[q][j].x * v[q][j].x + v[q][j].y * v[q][j].y + v[q][j].z * v[q][j].z + v[q][j].w * v[q][j].w;
      ss[q] = wave_sum(ss[q], lane);
    }
#pragma unroll
    for (int q = 0; q < 2; ++q) {
      const int m = m0 + q * ngw;
      const float* scale = p.mod() + ((size_t)mod_row(m)) * 6144 + 1 * 1024;
#pragma unroll
      for (int j = 0; j < 4; ++j) {
        const int c = (lane + 64 * j) * 4;
        const float4 g = *(const float4*)(gain + c), sc = *(const float4*)(scale + c);
        uint2 u;
        u.x = pk2(v[q][j].x * g.x * (1.f + sc.x), v[q][j].y * g.y * (1.f + sc.y));
        u.y = pk2(v[q][j].z * g.z * (1.f + sc.z), v[q][j].w * g.w * (1.f + sc.w));
        *(uint2*)(p.hbuf() + (size_t)m * DM + c) = u;
      }
      if (lane < 16) p.rssA()[(size_t)m * 16 + lane] = lane == 0 ? ss[q] : 0.f;
    }
  }
  float* sc = (float*)smem;
  float* red = sc + 9216;
  constexpr int G_IN = DIN / 32, G_UP = DFF / 32, NIT = 2 * G_IN + 2 * G_UP;
  for (int item = my_bid(); item < NIT; item += gridDim.x) {
    int l, grp; const float* W; int N; float* outp; int ldo; int which;
    if (item < 2 * G_IN) { l = item / G_IN; grp = item % G_IN; W = p.w_in + (size_t)l * DM * DIN; N = DIN; outp = p.sWin() + (size_t)l * 9 * DINP; ldo = DINP; which = 0; }
    else { const int i2 = item - 2 * G_IN; l = i2 / G_UP; grp = i2 % G_UP; W = p.w_up + (size_t)l * DM * DFF; N = DFF; outp = p.sWup() + (size_t)l * 9 * DFF; ldo = DFF; which = 3; }
    __syncthreads();
    for (int i = tid; i < 9216; i += NTHR) sc[i] = p.mod()[((size_t)(l * 9 + (i >> 10))) * 6144 + which * 1024 + (i & 1023)];
    __syncthreads();
    gemv9_item(sc, red, W, N, grp * 32, outp, ldo, nullptr, tid);
  }
}
__device__ __forceinline__ void final_norm_phase(const P& p, const int wv) {
  const int tid = my_tid(wv), lane = tid & 63, gw = my_bid() * NWV + (tid >> 6), ngw = gridDim.x * NWV;
  for (int m = gw; m < NTOK; m += ngw) {
    const float* xr = p.xw() + (size_t)m * DM;
    float4 v[4];
    float ss = 0.f;
#pragma unroll
    for (int j = 0; j < 4; ++j) {
      v[j] = ((const float4*)xr)[lane + 64 * j];
      ss += v[j].x * v[j].x + v[j].y * v[j].y + v[j].z * v[j].z + v[j].w * v[j].w;
    }
    ss = wave_sum(ss, lane);
    const float rstd = rsqrtf(ss * (1.f / 1024.f) + 1e-6f);
#pragma unroll
    for (int j = 0; j < 4; ++j) {
      const int c = (lane + 64 * j) * 4;
      const float4 g = *(const float4*)(p.final_norm + c);
      *(float4*)(p.out + (size_t)m * DM + c) = make_float4(v[j].x * rstd * g.x, v[j].y * rstd * g.y, v[j].z * rstd * g.z, v[j].w * rstd * g.w);
    }
  }
}

__device__ __forceinline__ void transpose_tile(const float* __restrict__ W, int K, int N, bf16_t* __restrict__ WT, int item, float* tile, const int tid) {
  const int ntn = (N + 63) >> 6, kt = item / ntn, nt = item % ntn, k0 = kt * 64, n0 = nt * 64;
  const int n4 = (tid & 15) * 4, kr = tid >> 4;
#pragma unroll
  for (int q = 0; q < 2; ++q) {
    const int k = q * 32 + kr;
    float4 v = make_float4(0.f, 0.f, 0.f, 0.f);
    if (n0 + n4 < N) v = *(const float4*)(W + (size_t)(k0 + k) * N + n0 + n4);
    float* t = tile + k * 65 + n4;
    t[0] = v.x; t[1] = v.y; t[2] = v.z; t[3] = v.w;
  }
  __syncthreads();
  {
    const int n = tid >> 3, kc = (tid & 7) * 8;
    const float* t = tile + kc * 65 + n;
    uint4 o;
    o.x = pk2(t[0 * 65], t[1 * 65]); o.y = pk2(t[2 * 65], t[3 * 65]); o.z = pk2(t[4 * 65], t[5 * 65]); o.w = pk2(t[6 * 65], t[7 * 65]);
    if (n0 + n < N) *(uint4*)(WT + (size_t)(n0 + n) * K + k0 + kc) = o;
  }
  __syncthreads();
}

__device__ __forceinline__ void prep_phase(const P& p, unsigned char* smem, const int wv) {
  const int tid = my_tid(wv);
  {
    float* sc = (float*)smem;
    float* red = sc + 9216;
    for (int i = tid; i < 9216; i += NTHR) {
      const int r = i >> 10, k = i & 1023;
      const float x = r == 0 ? p.c_ctx[k] : p.c[(r - 1) * 1024 + k];
      sc[i] = x / (1.f + expf(-x));
    }
    __syncthreads();
    for (int item = blockIdx.x; item < 384; item += gridDim.x) {
      const int l = item / 192, n0 = (item % 192) * 32;
      gemv9_item(sc, red, p.w_mod + (size_t)l * 1024 * 6144, 6144, n0, p.mod() + (size_t)l * 9 * 6144, 6144, p.b_mod + l * 6144, tid);
    }
  }
  __syncthreads();
  {
    float* tile = (float*)smem;
    constexpr int I_IN = 16 * 37, I_OUT = 16 * 16, I_UP = 16 * 64, I_DN = 64 * 16, I_KV = 2 * 8;
    constexpr int PER = I_IN + I_OUT + I_UP + I_DN + I_KV;
    for (int item = blockIdx.x; item < 2 * PER; item += gridDim.x) {
      const int l = item / PER;
      int r = item % PER;
      if (r < I_IN) { transpose_tile(p.w_in + (size_t)l * DM * DIN, DM, DIN, p.WinT() + (size_t)l * DINP * DM, r, tile, tid); continue; }
      r -= I_IN;
      if (r < I_OUT) { transpose_tile(p.w_out + (size_t)l * DM * DM, DM, DM, p.WoutT() + (size_t)l * DM * DM, r, tile, tid); continue; }
      r -= I_OUT;
      if (r < I_UP) { transpose_tile(p.w_up + (size_t)l * DM * DFF, DM, DFF, p.WupT() + (size_t)l * DFF * DM, r, tile, tid); continue; }
      r -= I_UP;
      if (r < I_DN) { transpose_tile(p.w_down + (size_t)l * DFF * DM, DFF, DM, p.WdownT() + (size_t)l * DM * DFF, r, tile, tid); continue; }
      r -= I_DN;
      transpose_tile(p.w_kv_b + (size_t)l * 128 * 512, 128, 512, p.WkvbT() + (size_t)l * 512 * 128, r, tile, tid);
    }
  }
  const int gt = blockIdx.x * NTHR + tid, gs = gridDim.x * NTHR;
  if (gt < 256) p.ctl()[gt] = 0u;
  for (int i = gt; i < 64 * 16; i += gs) {
    const int pos = i >> 4, f = i & 15;
    const float ang = (float)pos * exp2f(-(float)f * (L2_10000 / 16.f));
    p.ropeW()[pos * 32 + f] = __cosf(ang);
    p.ropeW()[pos * 32 + 16 + f] = __sinf(ang);
  }
  for (int i = gt; i < 64 * 8; i += gs) {
    const int pos = i >> 3, f = i & 7;
    const float ang = (float)pos * exp2f(-(float)f * (L2_10000 / 8.f));
    p.ropeM()[pos * 16 + f] = __cosf(ang);
    p.ropeM()[pos * 16 + 8 + f] = __sinf(ang);
  }
  for (int i = gt; i < 2 * (DINP - DIN) * DM / 8; i += gs) {
    const int l = i / ((DINP - DIN) * DM / 8), o = i % ((DINP - DIN) * DM / 8);
    *(uint4*)(p.WinT() + ((size_t)l * DINP + DIN) * DM + (size_t)o * 8) = make_uint4(0, 0, 0, 0);
  }
  for (int i = gt; i < 524288 / 8; i += gs) {
    const int d8 = i & 7, kv = (i >> 3) & 1, s = (i >> 4) & 255, l = (i >> 12) & 1, b = i >> 13;
    const float4 a = *(const float4*)(p.cache_win_k + (size_t)i * 8), c = *(const float4*)(p.cache_win_k + (size_t)i * 8 + 4);
    *(uint4*)(p.Kwin_l() + ((size_t)((l * 8 + b) * 1280 + 1024 + s)) * 128 + kv * 64 + d8 * 8) = make_uint4(pk2(a.x, a.y), pk2(a.z, a.w), pk2(c.x, c.y), pk2(c.z, c.w));
  }
  for (int i = gt; i < 524288 / 8; i += gs) {
    const int d = i & 63, kv = (i >> 6) & 1, s8 = (i >> 7) & 31, l = (i >> 12) & 1, b = i >> 13;
    const float* src = p.cache_win_v + ((size_t)((b * 2 + l) * 256 + s8 * 8) * 2 + kv) * 64 + d;
    float v[8];
#pragma unroll
    for (int j = 0; j < 8; ++j) v[j] = src[(size_t)j * 128];
    *(uint4*)(p.Vtwin_l() + ((size_t)(((l * 8 + b) * 2 + kv) * 64 + d)) * 1280 + 1024 + s8 * 8) = make_uint4(pk2(v[0], v[1]), pk2(v[2], v[3]), pk2(v[4], v[5]), pk2(v[6], v[7]));
  }
  for (int i = gt; i < 524288 / 8; i += gs) {
    const int j8 = i & 15, s = (i >> 4) & 255, l = (i >> 12) & 1, b = i >> 13;
    const float4 a = *(const float4*)(p.cache_mla_ckv + (size_t)i * 8), c = *(const float4*)(p.cache_mla_ckv + (size_t)i * 8 + 4);
    *(uint4*)(p.ckvn() + ((size_t)l * 18432 + 16384 + b * 256 + s) * 128 + j8 * 8) = make_uint4(pk2(a.x, a.y), pk2(a.z, a.w), pk2(c.x, c.y), pk2(c.z, c.w));
  }
  for (int i = gt; i < 131072 / 8; i += gs) {
    const int j8 = i & 3, s = (i >> 2) & 255, l = (i >> 10) & 1, b = i >> 11;
    const float4 a = *(const float4*)(p.cache_mla_krope + (size_t)i * 8), c = *(const float4*)(p.cache_mla_krope + (size_t)i * 8 + 4);
    const uint4 o = make_uint4(pk2(a.x, a.y), pk2(a.z, a.w), pk2(c.x, c.y), pk2(c.z, c.w));
#pragma unroll
    for (int hh = 0; hh < 4; ++hh) *(uint4*)(p.Kmla_l() + ((size_t)(((l * 8 + b) * 4 + hh) * 1280 + 1024 + s)) * 96 + 64 + j8 * 8) = o;
  }
  for (int i = gt; i < 524288 / 8; i += gs) {
    const int e = i & 63, d8 = (i >> 6) & 7, blk = i >> 9;
    const int hh = blk & 3, dir = (blk >> 2) & 1, l = (blk >> 3) & 1, b = blk >> 4;
    const float* src = p.state_ret + (size_t)blk * 4096 + (size_t)(d8 * 8) * 64 + e;
    float v[8];
#pragma unroll
    for (int j = 0; j < 8; ++j) v[j] = src[(size_t)j * 64];
    *(uint4*)(p.S0t() + ((size_t)((((l * 8 + b) * 2 + dir) * 4 + hh) * 64 + e)) * 64 + d8 * 8) = make_uint4(pk2(v[0], v[1]), pk2(v[2], v[3]), pk2(v[4], v[5]), pk2(v[6], v[7]));
  }
}

struct RotOrder : pg8::StaticOrder {
  int rot;
  __device__ __forceinline__ bool next(int i, Unit& u) const {
    if (!pg8::StaticOrder::next(i, u)) return false;
    u.pn += rot; if (u.pn >= nN) u.pn -= nN;
    return true;
  }
};
template <class Epi>
__device__ __forceinline__ void big_gemm(unsigned char* smem, const bf16_t* A, const bf16_t* Bt, int N, int K, const Epi& E, const int wv, int rot = 0) {
  pg8::Gemm g{A, Bt, NTOK, N, K};
  RotOrder S;
  S.init(NTOK, N, (int)gridDim.x, my_bid());
  S.rot = rot;
  pg8::gemm_phase<Epi, RotOrder, true, true>((PG8_LAS unsigned char*)smem, g, S, E, wv);
}

#define GSYNC() grid.sync()
__global__ void __launch_bounds__(NTHR, 2) hybrid_fwd(P p_arg) {
  cg::grid_group grid = cg::this_grid();
  const kargp_t kp = (kargp_t)__builtin_amdgcn_kernarg_segment_ptr();
  const int wv = __builtin_amdgcn_readfirstlane((int)threadIdx.x >> 6);
  { const P p = load_params(kp); prep_phase(p, smem, wv); }
  GSYNC();
  { const P p = load_params(kp); norm0_phase(p, smem, wv); }
  GSYNC();
#pragma unroll
  for (int l = 0; l < 2; ++l) {
    { const P pc = load_params(kp); const int t0 = my_tid(wv);
      for (int i = t0; i < 64 * 32; i += NTHR) ((float*)(smem + LDS_ROPEW))[i] = pc.ropeW()[i];
      for (int i = t0; i < 64 * 16; i += NTHR) ((float*)(smem + LDS_ROPEM))[i] = pc.ropeM()[i];
      __syncthreads(); }
    { const P p = load_params(kp);
      big_gemm(smem, p.hbuf(), p.WinT() + (size_t)l * DINP * DM, DINP, DM, EpiIn8{p, l, kp}, wv, 8); }
    { const P p = load_params(kp); gemm_small(p.ckvn() + (size_t)l * 18432 * 128, 128, p.WkvbT() + (size_t)l * 512 * 128, 128, 18432, 512, 128, smem, EpiKvb{p, l}, wv, p.ctl() + 64 * l, p.ctl() + 128 + 64 * l); }
    GSYNC();
    { const P p = load_params(kp); attn_phase(p, l, smem, wv); }
    GSYNC();
    { const P p = load_params(kp); big_gemm(smem, p.mix(), p.WoutT() + (size_t)l * DM * DM, DM, DM, EpiOut8{p, l}, wv); }
    GSYNC();
    { const P p = load_params(kp); big_gemm(smem, p.hbuf(), p.WupT() + (size_t)l * DFF * DM, DFF, DM, EpiUp8{p, l}, wv); }
    GSYNC();
    { const P p = load_params(kp); big_gemm(smem, p.ubuf(), p.WdownT() + (size_t)l * DM * DFF, DM, DFF, EpiDown8{p, l}, wv); }
    GSYNC();
  }
  { const P p = load_params(kp); final_norm_phase(p, wv); }
}

extern "C" void kernel_launch(void* const* d_in, const int* in_sizes, int n_in, void* d_out, int out_size, void* d_ws, size_t ws_size,
                              hipStream_t stream) {
  static int grid_blocks = 0;
  if (grid_blocks == 0) {
    int dev = 0, cus = 0, per_cu = 0;
    (void)hipGetDevice(&dev);
    (void)hipDeviceGetAttribute(&cus, hipDeviceAttributeMultiprocessorCount, dev);
    (void)hipFuncSetAttribute((const void*)hybrid_fwd, hipFuncAttributeMaxDynamicSharedMemorySize, LDS_BYTES);
    (void)hipOccupancyMaxActiveBlocksPerMultiprocessor(&per_cu, (const void*)hybrid_fwd, NTHR, LDS_BYTES);
    if (per_cu < 1) { fprintf(stderr, "occupancy query returned %d\n", per_cu); per_cu = 1; }
    per_cu = 1;
    grid_blocks = cus * per_cu;
  }
  P p{};
  const float* const* in = (const float* const*)d_in;
  p.x_prompt = in[0]; p.x_sample = in[1]; p.cache_win_k = in[2]; p.cache_win_v = in[3]; p.cache_mla_ckv = in[4];
  p.cache_mla_krope = in[5]; p.state_ret = in[6]; p.c = in[7]; p.c_ctx = in[8]; p.w_mod = in[9]; p.b_mod = in[10];
  p.norm1 = in[11]; p.norm2 = in[12]; p.w_in = in[13]; p.win_sink = in[14]; p.ret_decay = in[15]; p.ret_gn = in[16];
  p.mla_kv_norm = in[17]; p.w_kv_b = in[18]; p.w_out = in[19]; p.w_up = in[20]; p.w_down = in[21]; p.final_norm = in[22];
  p.out = (float*)d_out;
  p.ws = (unsigned char*)d_ws;
  if (WS_END > ws_size) { fprintf(stderr, "kernel_launch: workspace too small: need %zu, have %zu\n", (size_t)WS_END, ws_size); return; }
  void* args[] = {&p};
  hipError_t e = hipLaunchCooperativeKernel((const void*)hybrid_fwd, dim3(grid_blocks), dim3(NTHR), args, LDS_BYTES, stream);
  if (e != hipSuccess) fprintf(stderr, "cooperative launch failed: %s (grid %d)\n", hipGetErrorString(e), grid_blocks);
}
```

```cpp
#include <hip/hip_runtime.h>
#include <hip/hip_cooperative_groups.h>
#include <cstdio>
#include <cstdint>
namespace cg = cooperative_groups;

__device__ __forceinline__ int lane_id() { return (int)__builtin_amdgcn_mbcnt_hi(~0u, __builtin_amdgcn_mbcnt_lo(~0u, 0u)); }

namespace pg8 {
#define PG8_LAS __attribute__((address_space(3)))
typedef unsigned short bf16_t;
typedef short bf16x8 __attribute__((ext_vector_type(8)));
typedef float f32x4 __attribute__((ext_vector_type(4)));
typedef unsigned u32x4 __attribute__((ext_vector_type(4)));
constexpr int BM = 256, BK = 64, HALF = 128, HTB = HALF * BK * 2  , STAGE_BYTES = 8 * HTB, NXCD = 8, WGM = 8;

__host__ __device__ __forceinline__ int lds_byte(int r, int c) { const int st = (r >> 4) * 2 + (c >> 5), rr = r & 15, cc = c & 31, ob = rr * 64 + cc * 2; return st * 1024 + (ob ^ (((ob >> 9) & 1) << 5)); }
__host__ __device__ __forceinline__ void stage_rc(int b, int& R, int& C) { const int st = b / 1024, sb = b % 1024, swz = sb ^ (((sb >> 9) & 1) << 5); R = (st >> 1) * 16 + swz / 64; C = (st & 1) * 32 + (swz % 64) / 2; }
__host__ __device__ __forceinline__ int perm32(int rho) { const int n = rho >> 4, i = rho & 15; return 8 * (i >> 2) + 4 * n + (i & 3); }

struct Unit { int pm, pn; };
struct Gemm { const bf16_t* A; const bf16_t* Bt; int M, N, K; };

struct StaticOrder {
    int nM, nN, nwg, G, c;
    __host__ __device__ void init(int M, int N, int G_, int c_) { nM = M / BM; nN = N / BM; nwg = nM * nN; G = G_; c = c_; }
    __host__ __device__ bool next(int i, Unit& u) const {
        const long L = (long)i * G + c; if (L >= nwg) return false;
        int wgid = (int)L; { const int q = nwg / NXCD, r = nwg % NXCD, xcd = wgid % NXCD, off = wgid / NXCD; wgid = (xcd < r ? xcd * (q + 1) : r * (q + 1) + (xcd - r) * q) + off; }
        const int nig = WGM * nN, gid = wgid / nig, fm = gid * WGM, gsz = (nM - fm) < WGM ? (nM - fm) : WGM;
        u.pm = fm + ((wgid % nig) % gsz); u.pn = (wgid % nig) / gsz; return true;
    }
    __device__ __forceinline__ void a_ready(const Unit&) const {}
    __device__ __forceinline__ void done(const Unit&) const {}
};
template <class Epi, class Sched, bool ALIGN_EPI = false, bool SP2 = false>
__device__ __forceinline__ void gemm_phase(PG8_LAS unsigned char* lds, const Gemm g, const Sched& S, const Epi& E, const int wvp) {
    const int wid = wvp, lane = lane_id(), tid = wid * 64 + lane, wr = wid >> 2, wc = wid & 3, fr = lane & 15, fq = lane >> 4;
    const int K = g.K, nt = K / BK;
    unsigned voffA[2], voffB[2];
#pragma unroll
    for (int i = 0; i < 2; ++i) { int R, C; stage_rc(tid * 16 + i * 8192, R, C); const int Rb = Epi::PERM ? ((R & ~31) + perm32(R & 31)) : R;
        voffA[i] = (unsigned)(R * K + C) * 2u; voffB[i] = (unsigned)(Rb * K + C) * 2u; }
    const size_t kstep = (size_t)(BK * 2);
    const size_t hstep = (size_t)HALF * K * 2;
    const size_t tstep = 2 * hstep;
    const unsigned ldsw = (unsigned)wid * 1024u;
    const int aoff = lds_byte(wr * 64 + fr, fq * 8), boff = lds_byte(wc * 32 + fr, fq * 8);
#define PG8_SA(b, h) (((b) * 2 + (h)) * HTB)
#define PG8_SB(b, h) ((4 + (b) * 2 + (h)) * HTB)
#define PG8_STAGE(bufoff, gbase, voff) do { _Pragma("unroll") for (int _i = 0; _i < 2; ++_i) \
        __builtin_amdgcn_global_load_lds((const unsigned*)((const char*)(gbase) + (voff)[_i]), (PG8_LAS unsigned*)(lds + (bufoff) + ldsw + _i * 8192), 16, 0, 0); } while (0)
#define PG8_LDA(dst, b, h) do { _Pragma("unroll") for (int m = 0; m < 4; ++m) _Pragma("unroll") for (int k = 0; k < 2; ++k) dst[m][k] = *(const PG8_LAS bf16x8*)(lds + PG8_SA(b, h) + aoff + m * 2048 + k * 1024); } while (0)
#define PG8_LDB(dst, b, h) do { _Pragma("unroll") for (int n = 0; n < 2; ++n) _Pragma("unroll") for (int k = 0; k < 2; ++k) dst[n][k] = *(const PG8_LAS bf16x8*)(lds + PG8_SB(b, h) + boff + n * 2048 + k * 1024); } while (0)
#define PG8_MMA(ai, bj, At, Bt) do { __builtin_amdgcn_s_setprio(1); _Pragma("unroll") for (int m = 0; m < 4; ++m) _Pragma("unroll") for (int n = 0; n < 2; ++n) _Pragma("unroll") for (int k = 0; k < 2; ++k) \
        acc[ai][bj][m][n] = __builtin_amdgcn_mfma_f32_16x16x32_bf16(Bt[n][k], At[m][k], acc[ai][bj][m][n], 0, 0, 0); __builtin_amdgcn_s_setprio(0); } while (0)
#define PG8_WAIT_V(n) asm volatile("s_waitcnt vmcnt(" #n ")" ::: "memory")
#define PG8_WAIT_L(n) asm volatile("s_waitcnt lgkmcnt(" #n ")" ::: "memory")
#define PG8_BAR __builtin_amdgcn_s_barrier()
#define PG8_SCHED __builtin_amdgcn_sched_barrier(0)
    Unit cur, nxt; int ui = 0;
    if (!S.next(0, cur)) return;
    f32x4 acc[2][2][4][2];
#pragma unroll
    for (int a = 0; a < 2; ++a)
#pragma unroll
        for (int b = 0; b < 2; ++b)
#pragma unroll
            for (int m = 0; m < 4; ++m)
#pragma unroll
                for (int n = 0; n < 2; ++n) acc[a][b][m][n] = (f32x4){0.f, 0.f, 0.f, 0.f};
    bf16x8 At[4][2], B0[2][2], B1[2][2];
    const char* cA = (const char*)g.A + (size_t)cur.pm * tstep; const char* cB = (const char*)g.Bt + (size_t)cur.pn * tstep;
    S.a_ready(cur);
    if constexpr (SP2) {
        PG8_STAGE(PG8_SB(0, 0), cB, voffB); PG8_STAGE(PG8_SB(0, 1), cB + hstep, voffB); PG8_STAGE(PG8_SA(0, 0), cA, voffA); PG8_STAGE(PG8_SA(0, 1), cA + hstep, voffA);
        if (wr == 1) PG8_BAR;
        PG8_WAIT_V(2); PG8_BAR;
        PG8_STAGE(PG8_SB(1, 0), cB + kstep, voffB); PG8_STAGE(PG8_SA(1, 0), cA + kstep, voffA); PG8_STAGE(PG8_SB(1, 1), cB + hstep + kstep, voffB);
        PG8_WAIT_V(6); PG8_BAR;
    } else {
        PG8_STAGE(PG8_SB(0, 0), cB, voffB); PG8_STAGE(PG8_SA(0, 0), cA, voffA); PG8_STAGE(PG8_SB(0, 1), cB + hstep, voffB); PG8_STAGE(PG8_SA(0, 1), cA + hstep, voffA);
        if (wr == 1) PG8_BAR;
        PG8_WAIT_V(4); PG8_BAR;
        PG8_STAGE(PG8_SB(1, 0), cB + kstep, voffB); PG8_STAGE(PG8_SA(1, 0), cA + kstep, voffA); PG8_STAGE(PG8_SB(1, 1), cB + hstep + kstep, voffB);
        PG8_WAIT_V(6); PG8_BAR;
    }
    for (;;) {
        const bool has_next = S.next(ui + 1, nxt);
        const char* nA = has_next ? (const char*)g.A + (size_t)nxt.pm * tstep : cA; const char* nB = has_next ? (const char*)g.Bt + (size_t)nxt.pn * tstep : cB;
        for (int t = 0; t < nt; t += 2) {
            const bool last = (t == nt - 2);
            const char* a1 = cA + (size_t)(t + 1) * kstep;
            const char* a2 = last ? nA : cA + (size_t)(t + 2) * kstep; const char* b2 = last ? nB : cB + (size_t)(t + 2) * kstep;
            const char* a3 = a2 + kstep; const char* b3 = b2 + kstep;
            if (last && has_next) S.a_ready(nxt);
            if constexpr (SP2) {
            PG8_LDB(B0, 0, 0); PG8_LDB(B1, 0, 1); PG8_SCHED; PG8_LDA(At, 0, 0); PG8_STAGE(PG8_SA(1, 1), a1 + hstep, voffA);
            PG8_WAIT_V(8); PG8_WAIT_L(0); PG8_BAR; PG8_MMA(0, 0, At, B0); PG8_MMA(0, 1, At, B1); PG8_BAR; PG8_SCHED;
            PG8_LDA(At, 0, 1); PG8_STAGE(PG8_SB(0, 0), b2, voffB); PG8_STAGE(PG8_SB(0, 1), b2 + hstep, voffB); PG8_STAGE(PG8_SA(0, 0), a2, voffA);
            PG8_WAIT_V(8); PG8_WAIT_L(0); PG8_BAR; PG8_MMA(1, 0, At, B0); PG8_MMA(1, 1, At, B1); PG8_BAR; PG8_SCHED;
            PG8_LDB(B0, 1, 0); PG8_LDB(B1, 1, 1); PG8_SCHED; PG8_LDA(At, 1, 0); PG8_STAGE(PG8_SA(0, 1), a2 + hstep, voffA);
            PG8_WAIT_V(8); PG8_WAIT_L(0); PG8_BAR; PG8_MMA(0, 0, At, B0); PG8_MMA(0, 1, At, B1); PG8_BAR; PG8_SCHED;
            PG8_LDA(At, 1, 1); PG8_STAGE(PG8_SB(1, 0), b3, voffB); PG8_STAGE(PG8_SB(1, 1), b3 + hstep, voffB); PG8_STAGE(PG8_SA(1, 0), a3, voffA);
            PG8_WAIT_V(8); PG8_WAIT_L(0); PG8_BAR; PG8_MMA(1, 0, At, B0); PG8_MMA(1, 1, At, B1); PG8_BAR; PG8_SCHED;
            } else {
            PG8_LDB(B0, 0, 0); PG8_SCHED; PG8_LDA(At, 0, 0); PG8_STAGE(PG8_SA(1, 1), a1 + hstep, voffA);
            PG8_WAIT_L(8); PG8_BAR; PG8_WAIT_L(0); PG8_MMA(0, 0, At, B0); PG8_BAR; PG8_SCHED;
            PG8_LDB(B1, 0, 1); PG8_STAGE(PG8_SB(0, 0), b2, voffB);
            PG8_BAR; PG8_WAIT_L(0); PG8_MMA(0, 1, At, B1); PG8_BAR;
            PG8_LDA(At, 0, 1); PG8_STAGE(PG8_SA(0, 0), a2, voffA);
            PG8_BAR; PG8_WAIT_L(0); PG8_MMA(1, 0, At, B0); PG8_BAR; PG8_SCHED;
            PG8_STAGE(PG8_SB(0, 1), b2 + hstep, voffB);
            PG8_WAIT_V(6); PG8_BAR; PG8_MMA(1, 1, At, B1); PG8_BAR;
            PG8_LDB(B0, 1, 0); PG8_SCHED; PG8_LDA(At, 1, 0); PG8_STAGE(PG8_SA(0, 1), a2 + hstep, voffA);
            PG8_WAIT_L(8); PG8_BAR; PG8_WAIT_L(0); PG8_MMA(0, 0, At, B0); PG8_BAR; PG8_SCHED;
            PG8_LDB(B1, 1, 1); PG8_STAGE(PG8_SB(1, 0), b3, voffB);
            PG8_BAR; PG8_WAIT_L(0); PG8_MMA(0, 1, At, B1); PG8_BAR;
            PG8_LDA(At, 1, 1); PG8_STAGE(PG8_SA(1, 0), a3, voffA);
            PG8_BAR; PG8_WAIT_L(0); PG8_MMA(1, 0, At, B0); PG8_BAR; PG8_SCHED;
            PG8_STAGE(PG8_SB(1, 1), b3 + hstep, voffB);
            PG8_WAIT_V(6); PG8_BAR; PG8_MMA(1, 1, At, B1); PG8_BAR;
            }
        }
        if constexpr (ALIGN_EPI) { if (wr == 0) PG8_BAR; }
        if constexpr (!Epi::AFTER_DRAIN) { E(acc, cur, wr, wc, fr, fq); S.done(cur); }
        if (!has_next) break;
#pragma unroll
        for (int a = 0; a < 2; ++a)
#pragma unroll
            for (int b = 0; b < 2; ++b)
#pragma unroll
                for (int m = 0; m < 4; ++m)
#pragma unroll
                    for (int n = 0; n < 2; ++n) acc[a][b][m][n] = (f32x4){0.f, 0.f, 0.f, 0.f};
        cur = nxt; cA = nA; cB = nB; ++ui;
        if constexpr (ALIGN_EPI) { if (wr == 1) PG8_BAR; }
    }
    PG8_WAIT_V(0);
    if constexpr (!ALIGN_EPI) { if (wr == 0) PG8_BAR; }
    PG8_BAR;
    if constexpr (Epi::AFTER_DRAIN) { E.fused(acc, cur, wr, wc, fr, fq, lds, wid, lane); S.done(cur); }
#undef PG8_SA
#undef PG8_SB
#undef PG8_STAGE
#undef PG8_LDA
#undef PG8_LDB
#undef PG8_MMA
#undef PG8_WAIT_V
#undef PG8_WAIT_L
#undef PG8_BAR
#undef PG8_SCHED
}
}


typedef unsigned short bf16_t;
typedef short bf16x8 __attribute__((ext_vector_type(8)));
typedef float f32x16 __attribute__((ext_vector_type(16)));
typedef pg8::f32x4 f32x4;
using pg8::Unit;

constexpr int NTHR = 512, NWV = 8;
constexpr int NTOK = 16384, NCTX = 8192, DM = 1024, DIN = 2336, DINP = 2560, DFF = 4096;
constexpr int LDS_RED = 131072;
constexpr int LDS_ROPEW = 131072 + 4096, LDS_ROPEM = LDS_ROPEW + 64 * 32 * 4;
constexpr int LDS_BYTES = LDS_ROPEM + 64 * 16 * 4;
constexpr float LOG2E = 1.4426950408889634f;
constexpr float L2_10000 = 13.287712379549449f;

#define AL256(x) (((x) + 255) & ~(size_t)255)
constexpr size_t OFF_mod = 0;
constexpr size_t OFF_ropeW = OFF_mod + AL256((size_t)2 * 9 * 6144 * 4);
constexpr size_t OFF_ropeM = OFF_ropeW + AL256((size_t)64 * 32 * 4);
constexpr size_t OFF_ctl = OFF_ropeM + AL256((size_t)64 * 16 * 4);
constexpr size_t OFF_rssA = OFF_ctl + AL256((size_t)256 * 4);
constexpr size_t OFF_rssB = OFF_rssA + AL256((size_t)NTOK * 16 * 4);
constexpr size_t OFF_sWin = OFF_rssB + AL256((size_t)NTOK * 16 * 4);
constexpr size_t OFF_sWup = OFF_sWin + AL256((size_t)2 * 9 * DINP * 4);
constexpr size_t OFF_WinT = OFF_sWup + AL256((size_t)2 * 9 * DFF * 4);
constexpr size_t OFF_WoutT = OFF_WinT + AL256((size_t)2 * DINP * DM * 2);
constexpr size_t OFF_WupT = OFF_WoutT + AL256((size_t)2 * DM * DM * 2);
constexpr size_t OFF_WdownT = OFF_WupT + AL256((size_t)2 * DFF * DM * 2);
constexpr size_t OFF_WkvbT = OFF_WdownT + AL256((size_t)2 * DM * DFF * 2);
constexpr size_t OFF_hbuf = OFF_WkvbT + AL256((size_t)2 * 512 * 128 * 2);
constexpr size_t OFF_Kwin_l = OFF_hbuf + AL256((size_t)NTOK * DM * 2);
constexpr size_t OFF_Vtwin_l = OFF_Kwin_l + AL256((size_t)2 * 8 * 1280 * 128 * 2);
constexpr size_t OFF_S0t = OFF_Vtwin_l + AL256((size_t)2 * 8 * 2 * 64 * 1280 * 2);
constexpr size_t OFF_ckvn = OFF_S0t + AL256((size_t)2 * 8 * 2 * 4 * 4096 * 2);
constexpr size_t OFF_Kmla_l = OFF_ckvn + AL256((size_t)2 * 18432 * 128 * 2);
constexpr size_t OFF_Vtmla_l = OFF_Kmla_l + AL256((size_t)2 * 8 * 4 * 1280 * 96 * 2);
constexpr size_t OFF_ubuf = OFF_Vtmla_l + AL256((size_t)2 * 8 * 4 * 64 * 1280 * 2);
constexpr size_t WS_END = OFF_ubuf + AL256((size_t)NTOK * DFF * 2);
constexpr size_t OFF_mix = OFF_ubuf + (size_t)96 * 1024 * 1024;
constexpr size_t OFF_Qwin = OFF_ubuf;
constexpr size_t OFF_Kwin_c = OFF_Qwin + AL256((size_t)NTOK * 512 * 2);
constexpr size_t OFF_Vtwin_c = OFF_Kwin_c + AL256((size_t)NCTX * 128 * 2);
constexpr size_t OFF_Qret = OFF_Vtwin_c + AL256((size_t)32 * 2 * 64 * 256 * 2);
constexpr size_t OFF_Kret = OFF_Qret + AL256((size_t)NTOK * 256 * 2);
constexpr size_t OFF_Gret = OFF_Kret + AL256((size_t)NTOK * 256 * 2);
constexpr size_t OFF_Vtret_c = OFF_Gret + AL256((size_t)NTOK * 256 * 2);
constexpr size_t OFF_Vtret_l = OFF_Vtret_c + AL256((size_t)32 * 4 * 64 * 256 * 2);
constexpr size_t OFF_Qmla = OFF_Vtret_l + AL256((size_t)8 * 4 * 64 * 1024 * 2);
constexpr size_t OFF_Kmla_c = OFF_Qmla + AL256((size_t)NTOK * 384 * 2);
constexpr size_t OFF_Vtmla_c = OFF_Kmla_c + AL256((size_t)32 * 4 * 256 * 96 * 2);
static_assert(OFF_Vtmla_c + (size_t)32 * 4 * 64 * 256 * 2 <= OFF_mix && OFF_mix + (size_t)NTOK * DM * 2 <= WS_END, "attention temporaries + mix must fit in the ubuf region");
static_assert(WS_END <= (size_t)256 * 1024 * 1024, "workspace must fit 256 MiB");

struct P {
  const float *x_prompt, *x_sample, *cache_win_k, *cache_win_v, *cache_mla_ckv, *cache_mla_krope, *state_ret,
      *c, *c_ctx, *w_mod, *b_mod, *norm1, *norm2, *w_in, *win_sink, *ret_decay, *ret_gn, *mla_kv_norm,
      *w_kv_b, *w_out, *w_up, *w_down, *final_norm;
  float* out;
  unsigned char* ws;
#define WSBUF(ty, name) __device__ __forceinline__ ty* name() const { return (ty*)(ws + OFF_##name); }
  WSBUF(unsigned, ctl) WSBUF(float, mod) WSBUF(float, ropeW) WSBUF(float, ropeM) WSBUF(float, rssA) WSBUF(float, rssB) WSBUF(float, sWin) WSBUF(float, sWup) WSBUF(bf16_t, WinT) WSBUF(bf16_t, WoutT) WSBUF(bf16_t, WupT) WSBUF(bf16_t, WdownT) WSBUF(bf16_t, WkvbT)
  WSBUF(bf16_t, hbuf) WSBUF(bf16_t, mix) WSBUF(bf16_t, Qwin) WSBUF(bf16_t, Kwin_c) WSBUF(bf16_t, Vtwin_c) WSBUF(bf16_t, Kwin_l)
  WSBUF(bf16_t, Vtwin_l) WSBUF(bf16_t, Qret) WSBUF(bf16_t, Kret) WSBUF(bf16_t, Gret) WSBUF(bf16_t, Vtret_c) WSBUF(bf16_t, Vtret_l)
  WSBUF(bf16_t, S0t) WSBUF(bf16_t, Qmla) WSBUF(bf16_t, ckvn) WSBUF(bf16_t, Kmla_c) WSBUF(bf16_t, Vtmla_c) WSBUF(bf16_t, Kmla_l)
  WSBUF(bf16_t, Vtmla_l) WSBUF(bf16_t, ubuf)
  __device__ __forceinline__ float* xw() const { return out; }
};

typedef float f32x2_t __attribute__((ext_vector_type(2)));
typedef __bf16 bf16x2_t __attribute__((ext_vector_type(2)));
__device__ __forceinline__ unsigned pk2(float lo, float hi) {
  const f32x2_t v = {lo, hi};
  const bf16x2_t b = __builtin_convertvector(v, bf16x2_t);
  return __builtin_bit_cast(unsigned, b);
}
__device__ __forceinline__ bf16_t f2bf(float f) { return (bf16_t)(pk2(f, 0.f) & 0xffffu); }
__device__ __forceinline__ float bf2f(bf16_t b) { return __uint_as_float(((unsigned)b) << 16); }
__device__ __forceinline__ float shx(float v, int mask, int ln) { return __int_as_float(__builtin_amdgcn_ds_bpermute((ln ^ mask) << 2, __float_as_int(v))); }
__device__ __forceinline__ float wave_sum(float v, int ln) {
#pragma unroll
  for (int o = 1; o < 64; o <<= 1) v += shx(v, o, ln);
  return v;
}
typedef const __attribute__((address_space(4))) unsigned char* kargp_t;
__device__ __forceinline__ P load_params(kargp_t kp) {
  asm volatile("" : "+s"(kp));
  P p;
  __builtin_memcpy(&p, kp, sizeof(P));
  return p;
}
__device__ __forceinline__ int my_tid(int wv) { int w = wv; asm volatile("" : "+s"(w)); int t = w * 64 + lane_id(); asm volatile("" : "+v"(t)); return t; }
__device__ __forceinline__ int my_bid() { int b = blockIdx.x; asm volatile("" : "+s"(b)); return b; }
__device__ __forceinline__ float fexp2(float x) { return __builtin_amdgcn_exp2f(x); }
__device__ __forceinline__ int mod_row(int m) { return m < NCTX ? 0 : 1 + ((m - NCTX) >> 10); }

__device__ __forceinline__ void st_rm_bf16(bf16_t* rp, int h, const f32x16& o) {
#pragma unroll
  for (int g = 0; g < 4; ++g) {
    uint2 u;
    u.x = pk2(o[4 * g], o[4 * g + 1]);
    u.y = pk2(o[4 * g + 2], o[4 * g + 3]);
    *(uint2*)(rp + 8 * g + 4 * h) = u;
  }
}
__device__ __forceinline__ void st_tr_bf16(bf16_t* bp, int stride, int h, const f32x16& o) {
#pragma unroll
  for (int i = 0; i < 16; ++i) bp[(size_t)((i & 3) + 8 * (i >> 2) + 4 * h) * stride] = f2bf(o[i]);
}

__device__ __forceinline__ void st8_bf16(bf16_t* rp, int fq, const f32x4& a, const f32x4& b) {
  *(uint2*)(rp + 4 * fq) = make_uint2(pk2(a[0], a[1]), pk2(a[2], a[3]));
  *(uint2*)(rp + 16 + 4 * fq) = make_uint2(pk2(b[0], b[1]), pk2(b[2], b[3]));
}
__device__ __forceinline__ void st8_f32(float* rp, int fq, const f32x4& a, const f32x4& b) {
  *(f32x4*)(rp + 4 * fq) = a;
  *(f32x4*)(rp + 16 + 4 * fq) = b;
}
__device__ __forceinline__ void st8_tr(bf16_t* bp, int stride, int fq, const f32x4& a, const f32x4& b) {
#pragma unroll
  for (int j = 0; j < 4; ++j) {
    bp[(size_t)(4 * fq + j) * stride] = f2bf(a[j]);
    bp[(size_t)(16 + 4 * fq + j) * stride] = f2bf(b[j]);
  }
}
__device__ __forceinline__ void rope8_win(f32x4& a, f32x4& b, int fq, const float* tab) {
  const f32x4 cs = *(const f32x4*)(tab + 4 * fq), sn = *(const f32x4*)(tab + 16 + 4 * fq);
  const f32x4 x = a, y = b;
  a = x * cs - y * sn;
  b = x * sn + y * cs;
}
__device__ __forceinline__ void rope8_mla(f32x4& a, f32x4& b, int fq, int ln, const float* tabr, const float* tabc) {
  const int fo = 4 * (fq & 1);
  {
    const f32x4 cs = *(const f32x4*)(tabr + fo), sn = *(const f32x4*)(tabr + 8 + fo);
#pragma unroll
    for (int j = 0; j < 4; ++j) { const float pa = shx(a[j], 32, ln); a[j] = fq < 2 ? a[j] * cs[j] - pa * sn[j] : pa * sn[j] + a[j] * cs[j]; }
  }
  asm volatile("" ::: "memory");
  {
    const f32x4 cs = *(const f32x4*)(tabc + fo), sn = *(const f32x4*)(tabc + 8 + fo);
#pragma unroll
    for (int j = 0; j < 4; ++j) { const float pb = shx(b[j], 32, ln); b[j] = fq < 2 ? b[j] * cs[j] - pb * sn[j] : pb * sn[j] + b[j] * cs[j]; }
  }
}


__device__ __forceinline__ void st8p_bf16(bf16_t* rp, int fq, const f32x4& a, const f32x4& b) {
  *(uint4*)(rp + 8 * fq) = make_uint4(pk2(a[0], a[1]), pk2(a[2], a[3]), pk2(b[0], b[1]), pk2(b[2], b[3]));
}
__device__ __forceinline__ void st8p_f32(float* rp, int fq, const f32x4& a, const f32x4& b) {
  *(f32x4*)(rp + 8 * fq) = a;
  *(f32x4*)(rp + 8 * fq + 4) = b;
}
__device__ __forceinline__ void st8p_tr(bf16_t* bp, int stride, int fq, const f32x4& a, const f32x4& b) {
#pragma unroll
  for (int j = 0; j < 4; ++j) {
    bp[(size_t)(8 * fq + j) * stride] = f2bf(a[j]);
    bp[(size_t)(8 * fq + 4 + j) * stride] = f2bf(b[j]);
  }
}
__device__ __forceinline__ void rope8p_win(f32x4& a, f32x4& b, int fq, int ln, const float* tab) {
  const int f0 = 8 * (fq & 1);
  const f32x4 ca = *(const f32x4*)(tab + f0), cb4 = *(const f32x4*)(tab + f0 + 4), sa = *(const f32x4*)(tab + 16 + f0), sb = *(const f32x4*)(tab + 16 + f0 + 4);
#pragma unroll
  for (int j = 0; j < 4; ++j) {
    const float pa = shx(a[j], 32, ln), pb = shx(b[j], 32, ln);
    a[j] = fq < 2 ? a[j] * ca[j] - pa * sa[j] : pa * sa[j] + a[j] * ca[j];
    b[j] = fq < 2 ? b[j] * cb4[j] - pb * sb[j] : pb * sb[j] + b[j] * cb4[j];
  }
}
__device__ __forceinline__ void rope8p_mla(f32x4& a, f32x4& b, int fq, int ln, const float* tabr, const float* tabc) {
  const float* tab = fq < 2 ? tabr : tabc;
  const f32x4 ca = *(const f32x4*)(tab), cb4 = *(const f32x4*)(tab + 4), sa = *(const f32x4*)(tab + 8), sb = *(const f32x4*)(tab + 12);
#pragma unroll
  for (int j = 0; j < 4; ++j) {
    const float pa = shx(a[j], 16, ln), pb = shx(b[j], 16, ln);
    a[j] = (fq & 1) == 0 ? a[j] * ca[j] - pa * sa[j] : pa * sa[j] + a[j] * ca[j];
    b[j] = (fq & 1) == 0 ? b[j] * cb4[j] - pb * sb[j] : pb * sb[j] + b[j] * cb4[j];
  }
}

__device__ __forceinline__ float row_rstd(const float* rss, int m) {
  const f32x4 a = *(const f32x4*)(rss + (size_t)m * 16), b = *(const f32x4*)(rss + (size_t)m * 16 + 4);
  const f32x4 c = *(const f32x4*)(rss + (size_t)m * 16 + 8), d = *(const f32x4*)(rss + (size_t)m * 16 + 12);
  const f32x4 s = (a + b) + (c + d);
  return rsqrtf(((s[0] + s[1]) + (s[2] + s[3])) * (1.f / 1024.f) + 1e-6f);
}

typedef f32x4 acc_t[2][2][4][2];
template <int V> struct IC { static constexpr int value = V; };
extern __shared__ __attribute__((aligned(16))) unsigned char smem[];
struct EpiIn8 {
  static constexpr bool PERM = true, AFTER_DRAIN = false;
  P p0; int l; kargp_t kp;
  __device__ __forceinline__ void operator()(const acc_t& acc, const Unit& u, int wr, int wc, int fr_in, int fq_in) const {
    int fr = fr_in; asm volatile("" : "+v"(fr));
    int fq = fq_in; asm volatile("" : "+v"(fq));
    const int ln = fq * 16 + fr; (void)ln;
    P p = p0; asm volatile("" : "+s"(p.ws), "+s"(p.out));
    const bool lat = u.pm >= 32;
    const int rbase = u.pm * 256 + wr * 64 + fr;
#define ROWS_BEGIN _Pragma("unroll") for (int ai = 0; ai < 2; ++ai) _Pragma("unroll") for (int mm = 0; mm < 4; ++mm) { \
      int m = rbase + ai * 128 + mm * 16; asm volatile("" : "+v"(m)); int b, s; \
      if (!lat) { b = m >> 8; s = m & 255; } else { b = (m - NCTX) >> 10; s = (m - NCTX) & 1023; } \
      const float rsd = rsdv[ai][mm]; \
      f32x4 v0 = acc[ai][bj][mm][0] * rsd + sw0, v1 = acc[ai][bj][mm][1] * rsd + sw1; (void)b; (void)s;
#define ROWS_END }
    float rsdv[2][4];
    {
      const float* rss = p.rssA();
#pragma unroll
      for (int ai = 0; ai < 2; ++ai)
#pragma unroll
        for (int mm = 0; mm < 4; ++mm) rsdv[ai][mm] = row_rstd(rss, rbase + ai * 128 + mm * 16);
    }
    auto do_half = [&](auto BJ) {
      constexpr int bj = decltype(BJ)::value;
      const int nb = u.pn * 256 + bj * 128 + wc * 32;
      if (nb >= DIN) return;
      const float* swp = p.sWin() + ((size_t)(l * 9 + (lat ? 1 + ((u.pm - 32) >> 2) : 0))) * DINP + nb;
      const f32x4 sw0 = *(const f32x4*)(swp + 8 * fq), sw1 = *(const f32x4*)(swp + 8 * fq + 4);
      if (nb < 512) {
        ROWS_BEGIN
          if (lat) rope8p_win(v0, v1, fq, ln, (const float*)(smem + LDS_ROPEW) + ((nb & 32) ? (s & 63) : (s >> 6)) * 32);
          st8p_bf16(p.Qwin() + (size_t)m * 512 + nb, fq, v0, v1);
        ROWS_END
      } else if (nb < 640) {
        const int c = nb - 512;
        ROWS_BEGIN
          if (!lat) {
            st8p_f32(p.out + 16777216 + ((size_t)((b * 2 + l) * 256 + s)) * 128 + c, fq, v0, v1);
            st8p_bf16(p.Kwin_c() + (size_t)m * 128 + c, fq, v0, v1);
          } else {
            rope8p_win(v0, v1, fq, ln, (const float*)(smem + LDS_ROPEW) + ((nb & 32) ? (s & 63) : (s >> 6)) * 32);
            st8p_bf16(p.Kwin_l() + ((size_t)((l * 8 + b) * 1280 + s)) * 128 + c, fq, v0, v1);
          }
        ROWS_END
      } else if (nb < 768) {
        const int c = nb - 640, kv = c >> 6, d0 = c & 63;
        ROWS_BEGIN
          if (!lat) {
            st8p_f32(p.out + 18874368 + ((size_t)((b * 2 + l) * 256 + s)) * 128 + c, fq, v0, v1);
            st8p_tr(p.Vtwin_c() + ((size_t)((b * 2 + kv) * 64 + d0)) * 256 + s, 256, fq, v0, v1);
          } else {
            st8p_tr(p.Vtwin_l() + ((size_t)(((l * 8 + b) * 2 + kv) * 64 + d0)) * 1280 + s, 1280, fq, v0, v1);
          }
        ROWS_END
      } else if (nb < 1024) {
        ROWS_BEGIN
          st8p_bf16(p.Qret() + (size_t)m * 256 + (nb - 768), fq, v0, v1);
        ROWS_END
      } else if (nb < 1280) {
        ROWS_BEGIN
          st8p_bf16(p.Kret() + (size_t)m * 256 + (nb - 1024), fq, v0, v1);
        ROWS_END
      } else if (nb < 1536) {
        const int c = nb - 1280, hh = c >> 6, d0 = c & 63;
        ROWS_BEGIN
          if (!lat) st8p_tr(p.Vtret_c() + ((size_t)((b * 4 + hh) * 64 + d0)) * 256 + s, 256, fq, v0, v1);
          else st8p_tr(p.Vtret_l() + ((size_t)((b * 4 + hh) * 64 + d0)) * 1024 + s, 1024, fq, v0, v1);
        ROWS_END
      } else if (nb < 1792) {
        ROWS_BEGIN
          st8p_bf16(p.Gret() + (size_t)m * 256 + (nb - 1536), fq, v0, v1);
        ROWS_END
      } else if (nb < 2176) {
        const int c = nb - 1792;
        const bool rp = lat && (c % 96) == 64;
        ROWS_BEGIN
          if (rp) rope8p_mla(v0, v1, fq, ln, (const float*)(smem + LDS_ROPEM) + (s >> 6) * 16, (const float*)(smem + LDS_ROPEM) + (s & 63) * 16);
          st8p_bf16(p.Qmla() + (size_t)m * 384 + c, fq, v0, v1);
        ROWS_END
      } else if (nb < 2304) {
        const int c = nb - 2176;
        float* red = (float*)(smem + LDS_RED);
        kargp_t k2 = kp; asm volatile("" : "+s"(k2));
        const float* g = ((const __attribute__((address_space(4))) P*)k2)->mla_kv_norm + l * 128 + c;
        const f32x4 g0 = *(const f32x4*)(g + 8 * fq), g1 = *(const f32x4*)(g + 8 * fq + 4);
#pragma unroll
        for (int ai = 0; ai < 2; ++ai)
#pragma unroll
          for (int mm = 0; mm < 4; ++mm) {
            const float rsd0 = rsdv[ai][mm];
            const f32x4 a = acc[ai][bj][mm][0] * rsd0 + sw0, b4 = acc[ai][bj][mm][1] * rsd0 + sw1;
            float ss = a[0] * a[0] + a[1] * a[1] + a[2] * a[2] + a[3] * a[3] + b4[0] * b4[0] + b4[1] * b4[1] + b4[2] * b4[2] + b4[3] * b4[3];
            ss += shx(ss, 16, ln);
            ss += shx(ss, 32, ln);
            if (fq == 0) red[wc * 256 + ai * 128 + wr * 64 + mm * 16 + fr] = ss;
          }
        asm volatile("s_waitcnt lgkmcnt(0)" ::: "memory");
        __builtin_amdgcn_s_barrier();
        ROWS_BEGIN
          const int rt = ai * 128 + wr * 64 + mm * 16 + fr;
          const float rsv = rsqrtf((red[rt] + red[256 + rt] + red[512 + rt] + red[768 + rt]) * (1.f / 128.f) + 1e-6f);
          v0 = v0 * rsv * g0;
          v1 = v1 * rsv * g1;
          st8p_bf16(p.ckvn() + ((size_t)l * 18432 + m) * 128 + c, fq, v0, v1);
          if (!lat) st8p_f32(p.out + 20971520 + ((size_t)((b * 2 + l) * 256 + s)) * 128 + c, fq, v0, v1);
        ROWS_END
        asm volatile("s_waitcnt vmcnt(0) lgkmcnt(0)" ::: "memory");
        __builtin_amdgcn_s_barrier();
        if (wr == 0 && wc == 0 && ln == 0) {
          __builtin_amdgcn_fence(__ATOMIC_RELEASE, "agent");
          asm volatile("s_waitcnt vmcnt(0)" ::: "memory");
          __hip_atomic_fetch_add(p.ctl() + 64 * l, 1u, __ATOMIC_RELAXED, __HIP_MEMORY_SCOPE_AGENT);
        }
      } else {
        ROWS_BEGIN
          if (!lat) {
            st8p_f32(p.out + 23068672 + ((size_t)((b * 2 + l) * 256 + s)) * 32, fq, v0, v1);
#pragma unroll
            for (int hh = 0; hh < 4; ++hh) st8p_bf16(p.Kmla_c() + ((size_t)((b * 4 + hh) * 256 + s)) * 96 + 64, fq, v0, v1);
          } else {
            rope8p_mla(v0, v1, fq, ln, (const float*)(smem + LDS_ROPEM) + (s >> 6) * 16, (const float*)(smem + LDS_ROPEM) + (s & 63) * 16);
#pragma unroll
            for (int hh = 0; hh < 4; ++hh) st8p_bf16(p.Kmla_l() + ((size_t)(((l * 8 + b) * 4 + hh) * 1280 + s)) * 96 + 64, fq, v0, v1);
          }
        ROWS_END
      }
    };
    do_half(IC<0>{});
    do_half(IC<1>{});
#undef ROWS_BEGIN
#undef ROWS_END
  }
};

struct EpiOut8 {
  static constexpr bool PERM = true, AFTER_DRAIN = false;
  P p0; int l;
  __device__ __forceinline__ void operator()(const acc_t& acc, const Unit& u, int wr, int wc, int fr_in, int fq_in) const {
    int fr = fr_in; asm volatile("" : "+v"(fr));
    int fq = fq_in; asm volatile("" : "+v"(fq));
    const int ln = fq * 16 + fr; (void)ln;
    P p = p0; asm volatile("" : "+s"(p.ws), "+s"(p.out));
    const int rbase = u.pm * 256 + wr * 64 + fr;
    const int cb = u.pn * 256 + wc * 32 + 8 * fq;
    const float* md = p.mod() + ((size_t)(l * 9 + mod_row(u.pm * 256))) * 6144;
    const float* gate = md + 2 * 1024; const float* sc2 = md + 4 * 1024; const float* g2 = p.norm2 + l * DM;
#pragma unroll
    for (int ap = 0; ap < 4; ++ap) {
      constexpr int dummy = 0; (void)dummy;
      const int ai = ap >> 1, m2 = (ap & 1) * 2;
      int mb = rbase + ai * 128 + m2 * 16; asm volatile("" : "+v"(mb));
      f32x4 xv[2][2][2];
#pragma unroll
      for (int mq = 0; mq < 2; ++mq) {
        const int mm = m2 + mq;
        const int m = mb + mq * 16;
        if (l == 0) {
          const float* xr = m < NCTX ? p.x_prompt + (size_t)m * DM : p.x_sample + (size_t)(m - NCTX) * DM;
#pragma unroll
          for (int bj = 0; bj < 2; ++bj)
#pragma unroll
            for (int n = 0; n < 2; ++n) xv[mq][bj][n] = *(const f32x4*)(xr + cb + bj * 128 + n * 4);
        } else {
          const bf16_t* hr = p.hbuf() + (size_t)m * DM;
#pragma unroll
          for (int bj = 0; bj < 2; ++bj) {
            const uint4 h8 = *(const uint4*)(hr + cb + bj * 128);
#pragma unroll
            for (int n = 0; n < 2; ++n) {
              const int c = cb + bj * 128 + n * 4;
              uint2 hq; hq.x = n ? h8.z : h8.x; hq.y = n ? h8.w : h8.y;
              const f32x4 q1 = *(const f32x4*)(p.norm1 + DM + c) * (*(const f32x4*)(md + 1 * 1024 + c) + 1.f);
              f32x4 xm;
              xm[0] = __uint_as_float(hq.x << 16) * __builtin_amdgcn_rcpf(q1[0]); xm[1] = __uint_as_float(hq.x & 0xffff0000u) * __builtin_amdgcn_rcpf(q1[1]);
              xm[2] = __uint_as_float(hq.y << 16) * __builtin_amdgcn_rcpf(q1[2]); xm[3] = __uint_as_float(hq.y & 0xffff0000u) * __builtin_amdgcn_rcpf(q1[3]);
              xv[mq][bj][n] = xm;
            }
          }
        }
      }
#pragma unroll
      for (int mq = 0; mq < 2; ++mq) {
        const int mm = m2 + mq;
        const int m = mb + mq * 16;
        bf16_t* ho = p.hbuf() + (size_t)m * DM;
        float ss = 0.f;
#pragma unroll
        for (int bj = 0; bj < 2; ++bj) {
          unsigned pw[4];
#pragma unroll
          for (int n = 0; n < 2; ++n) {
            const int c = cb + bj * 128 + n * 4;
            const f32x4 xn = xv[mq][bj][n] + *(const f32x4*)(gate + c) * acc[ai][bj][mm][n];
            const f32x4 hv = xn * (*(const f32x4*)(g2 + c) * (*(const f32x4*)(sc2 + c) + 1.f));
            pw[2 * n] = pk2(hv[0], hv[1]); pw[2 * n + 1] = pk2(hv[2], hv[3]);
            ss += (xn[0] * xn[0] + xn[1] * xn[1]) + (xn[2] * xn[2] + xn[3] * xn[3]);
          }
          *(uint4*)(ho + cb + bj * 128) = make_uint4(pw[0], pw[1], pw[2], pw[3]);
        }
        ss += shx(ss, 16, ln);
        ss += shx(ss, 32, ln);
        if (fq == 0) p.rssB()[(size_t)m * 16 + u.pn * 4 + wc] = ss;
      }
      asm volatile("" ::: "memory");
    }
  }
};
struct EpiUp8 {
  static constexpr bool PERM = true, AFTER_DRAIN = false;
  P p0; int l;
  __device__ __forceinline__ void operator()(const acc_t& acc, const Unit& u, int wr, int wc, int fr_in, int fq_in) const {
    int fr = fr_in; asm volatile("" : "+v"(fr));
    int fq = fq_in; asm volatile("" : "+v"(fq));
    const int ln = fq * 16 + fr; (void)ln;
    P p = p0; asm volatile("" : "+s"(p.ws), "+s"(p.out));
    const int rbase = u.pm * 256 + wr * 64 + fr;
    const int cb = u.pn * 256 + wc * 32 + 8 * fq;
    const float* swp = p.sWup() + ((size_t)(l * 9 + mod_row(u.pm * 256))) * DFF;
    float rsdv[2][4];
#pragma unroll
    for (int ai = 0; ai < 2; ++ai)
#pragma unroll
      for (int mm = 0; mm < 4; ++mm) rsdv[ai][mm] = row_rstd(p.rssB(), rbase + ai * 128 + mm * 16);
    f32x4 swv[2][2];
#pragma unroll
    for (int bj = 0; bj < 2; ++bj)
#pragma unroll
      for (int n = 0; n < 2; ++n) swv[bj][n] = *(const f32x4*)(swp + cb + bj * 128 + n * 4);
#pragma unroll
    for (int ai = 0; ai < 2; ++ai)
#pragma unroll
      for (int mm = 0; mm < 4; ++mm) {
        int m = rbase + ai * 128 + mm * 16; asm volatile("" : "+v"(m));
        bf16_t* uo = p.ubuf() + (size_t)m * DFF;
        const float rsd = rsdv[ai][mm];
#pragma unroll
        for (int bj = 0; bj < 2; ++bj) {
          f32x4 t0 = acc[ai][bj][mm][0] * rsd + swv[bj][0], t1 = acc[ai][bj][mm][1] * rsd + swv[bj][1];
#pragma unroll
          for (int j = 0; j < 4; ++j) { const float a = fmaxf(t0[j], 0.f), b = fmaxf(t1[j], 0.f); t0[j] = a * a; t1[j] = b * b; }
          *(uint4*)(uo + cb + bj * 128) = make_uint4(pk2(t0[0], t0[1]), pk2(t0[2], t0[3]), pk2(t1[0], t1[1]), pk2(t1[2], t1[3]));
        }
      }
  }
};
struct EpiDown8 {
  static constexpr bool PERM = true, AFTER_DRAIN = false;
  P p0; int l;
  __device__ __forceinline__ void operator()(const acc_t& acc, const Unit& u, int wr, int wc, int fr_in, int fq_in) const {
    int fr = fr_in; asm volatile("" : "+v"(fr));
    int fq = fq_in; asm volatile("" : "+v"(fq));
    const int ln = fq * 16 + fr; (void)ln;
    P p = p0; asm volatile("" : "+s"(p.ws), "+s"(p.out));
    const int rbase = u.pm * 256 + wr * 64 + fr;
    const int cb = u.pn * 256 + wc * 32 + 8 * fq;
    const int r = mod_row(u.pm * 256);
    const float* md = p.mod() + ((size_t)(l * 9 + r)) * 6144;
    const float* gate = md + 5 * 1024; const float* sc2 = md + 4 * 1024; const float* g2 = p.norm2 + l * DM;
    const float* sc1 = p.mod() + ((size_t)(9 + r)) * 6144 + 1 * 1024;
    const float* g1 = p.norm1 + DM;
    f32x4 riv[2][2];
#pragma unroll
    for (int bj = 0; bj < 2; ++bj)
#pragma unroll
      for (int n = 0; n < 2; ++n) {
        const int c = cb + bj * 128 + n * 4;
        const f32x4 q2 = *(const f32x4*)(g2 + c) * (*(const f32x4*)(sc2 + c) + 1.f);
#pragma unroll
        for (int j = 0; j < 4; ++j) riv[bj][n][j] = __builtin_amdgcn_rcpf(q2[j]);
      }
#pragma unroll
    for (int ap = 0; ap < 4; ++ap) {
      const int ai = ap >> 1, m2 = (ap & 1) * 2;
      int mb = rbase + ai * 128 + m2 * 16; asm volatile("" : "+v"(mb));
      uint4 hvv[2][2];
#pragma unroll
      for (int mq = 0; mq < 2; ++mq) {
        const bf16_t* hr = p.hbuf() + (size_t)(mb + mq * 16) * DM;
#pragma unroll
        for (int bj = 0; bj < 2; ++bj) hvv[mq][bj] = *(const uint4*)(hr + cb + bj * 128);
      }
#pragma unroll
      for (int mq = 0; mq < 2; ++mq) {
        const int mm = m2 + mq;
        const int m = mb + mq * 16;
        float* xo = p.xw() + (size_t)m * DM;
        bf16_t* ho = p.hbuf() + (size_t)m * DM;
        float ss = 0.f;
#pragma unroll
        for (int bj = 0; bj < 2; ++bj) {
          unsigned pw[4] = {0u, 0u, 0u, 0u};
#pragma unroll
          for (int n = 0; n < 2; ++n) {
            const int c = cb + bj * 128 + n * 4;
            uint2 hq; hq.x = n ? hvv[mq][bj].z : hvv[mq][bj].x; hq.y = n ? hvv[mq][bj].w : hvv[mq][bj].y;
            f32x4 xm;
            xm[0] = __uint_as_float(hq.x << 16); xm[1] = __uint_as_float(hq.x & 0xffff0000u);
            xm[2] = __uint_as_float(hq.y << 16); xm[3] = __uint_as_float(hq.y & 0xffff0000u);
            const f32x4 xn = xm * riv[bj][n] + *(const f32x4*)(gate + c) * acc[ai][bj][mm][n];
            if (l != 0) *(f32x4*)(xo + c) = xn;
            if (l == 0) {
              const f32x4 hv = xn * (*(const f32x4*)(g1 + c) * (*(const f32x4*)(sc1 + c) + 1.f));
              pw[2 * n] = pk2(hv[0], hv[1]); pw[2 * n + 1] = pk2(hv[2], hv[3]);
              ss += (xn[0] * xn[0] + xn[1] * xn[1]) + (xn[2] * xn[2] + xn[3] * xn[3]);
            }
          }
          if (l == 0) *(uint4*)(ho + cb + bj * 128) = make_uint4(pw[0], pw[1], pw[2], pw[3]);
        }
        if (l == 0) {
          ss += shx(ss, 16, ln);
          ss += shx(ss, 32, ln);
          if (fq == 0) p.rssA()[(size_t)m * 16 + u.pn * 4 + wc] = ss;
        }
      }
      asm volatile("" ::: "memory");
    }
  }
};

struct EpiKvb {
  P p; int l;
  __device__ __forceinline__ void operator()(int m, int nb, int h, const f32x16& v) const {
    const int hh = nb >> 7, j0 = nb & 127;
    bf16_t* Kb; bf16_t* Vb; int S, key;
    if (m < NCTX) {
      const int b = m >> 8; key = m & 255; S = 256;
      Kb = p.Kmla_c() + ((size_t)((b * 4 + hh) * 256)) * 96;
      Vb = p.Vtmla_c() + ((size_t)((b * 4 + hh) * 64)) * 256;
    } else {
      int b;
      if (m < NTOK) { b = (m - NCTX) >> 10; key = (m - NCTX) & 1023; }
      else { b = (m - NTOK) >> 8; key = 1024 + ((m - NTOK) & 255); }
      S = 1280;
      Kb = p.Kmla_l() + ((size_t)(((l * 8 + b) * 4 + hh) * 1280)) * 96;
      Vb = p.Vtmla_l() + ((size_t)(((l * 8 + b) * 4 + hh) * 64)) * 1280;
    }
    if (j0 < 64) st_rm_bf16(Kb + (size_t)key * 96 + j0, h, v);
    else st_tr_bf16(Vb + (size_t)(j0 - 64) * S + key, S, h, v);
  }
};

template <class Epi>
__device__ __forceinline__ void gemm_small(const bf16_t* __restrict__ A, int lda, const bf16_t* __restrict__ W, int ldw,
                                           int M, int N, int K, unsigned char* smem, const Epi& epi, const int wv, unsigned* ready, unsigned* ticket) {
  constexpr int TA = 256 * 72, TW = 128 * 72;
  bf16_t* sb = (bf16_t*)smem;
  const int tid = my_tid(wv), bid = my_bid(), lane = tid & 63, wave = tid >> 6;
  const int wm = wave >> 1, wn = wave & 1, r = lane & 31, h = lane >> 5;
  const int MT = M >> 8, NT = N >> 7, ntiles = MT * NT, nk = K >> 6;
  const int lc = tid & 7, lr = tid >> 3;
  (void)bid;
  if (tid == 0) {
    unsigned polls = 0;
    while (__hip_atomic_load(ready, __ATOMIC_RELAXED, __HIP_MEMORY_SCOPE_AGENT) < 64u && ++polls < (1u << 22)) __builtin_amdgcn_s_sleep(8);
    __builtin_amdgcn_fence(__ATOMIC_ACQUIRE, "agent");
    asm volatile("s_waitcnt vmcnt(0)" ::: "memory");
  }
  __syncthreads();
  volatile int* tks = (volatile int*)(smem + LDS_RED + 2048);
  for (;;) {
    __syncthreads();
    if (tid == 0) *tks = (int)__hip_atomic_fetch_add(ticket, 1u, __ATOMIC_RELAXED, __HIP_MEMORY_SCOPE_AGENT);
    __syncthreads();
    const int tile = *tks;
    if (tile >= ntiles) break;
    const int m0 = (tile % MT) << 8, n0 = (tile / MT) << 7;
    f32x16 acc[2][2];
#pragma unroll
    for (int a = 0; a < 2; ++a)
#pragma unroll
      for (int b = 0; b < 2; ++b)
#pragma unroll
        for (int i = 0; i < 16; ++i) acc[a][b][i] = 0.f;
    uint4 ra[4], rw[2];
    const bf16_t* Ap = A + (size_t)(m0 + lr) * lda + lc * 8;
    const bf16_t* Wp = W + (size_t)(n0 + lr) * ldw + lc * 8;
    auto gload = [&](int kt) {
#pragma unroll
      for (int i = 0; i < 4; ++i) ra[i] = *(const uint4*)(Ap + (size_t)(64 * i) * lda + kt * 64);
#pragma unroll
      for (int i = 0; i < 2; ++i) rw[i] = *(const uint4*)(Wp + (size_t)(64 * i) * ldw + kt * 64);
    };
    auto swrite = [&](int bsel) {
      bf16_t* sA = sb + bsel * (TA + TW); bf16_t* sW = sA + TA;
#pragma unroll
      for (int i = 0; i < 4; ++i) *(uint4*)(sA + (lr + 64 * i) * 72 + lc * 8) = ra[i];
#pragma unroll
      for (int i = 0; i < 2; ++i) *(uint4*)(sW + (lr + 64 * i) * 72 + lc * 8) = rw[i];
    };
    __syncthreads();
    gload(0); swrite(0);
    __syncthreads();
    for (int kt = 0; kt < nk; ++kt) {
      if (kt + 1 < nk) gload(kt + 1);
      const bf16_t* sA = sb + (kt & 1) * (TA + TW); const bf16_t* sW = sA + TA;
#pragma unroll
      for (int ks = 0; ks < 4; ++ks) {
        bf16x8 wf[2], af[2];
#pragma unroll
        for (int i = 0; i < 2; ++i) {
          wf[i] = *(const bf16x8*)(sW + (wn * 64 + i * 32 + r) * 72 + ks * 16 + h * 8);
          af[i] = *(const bf16x8*)(sA + (wm * 64 + i * 32 + r) * 72 + ks * 16 + h * 8);
        }
#pragma unroll
        for (int a = 0; a < 2; ++a)
#pragma unroll
          for (int b = 0; b < 2; ++b) acc[a][b] = __builtin_amdgcn_mfma_f32_32x32x16_bf16(wf[a], af[b], acc[a][b], 0, 0, 0);
      }
      if (kt + 1 < nk) swrite((kt + 1) & 1);
      __syncthreads();
    }
#pragma unroll
    for (int a = 0; a < 2; ++a)
#pragma unroll
      for (int b = 0; b < 2; ++b) epi(m0 + wm * 64 + b * 32 + r, n0 + wn * 64 + a * 32, h, acc[a][b]);
  }
}

struct AttnItem {
  const bf16_t* Q; int qs;
  const bf16_t* K; int ks;
  const bf16_t* Vt; int vs;
  int t0, t1, t2, t3;
  int qpos0, T;
  float scale, sink_l2; int has_sink;
  float lgf, lgb;
  const bf16_t *S0f, *S0b;
  const bf16_t* G; const float* gn;
  bf16_t* out;
  float* sout;
};

template <int DQK, int MODE>
__device__ __forceinline__ void attn_item(const AttnItem& it, unsigned char* smem, const int wv) {
  constexpr int KSTR = DQK + 8, NKS = DQK / 16, VSTR = 68, KCH = DQK / 8;
  bf16_t* Ks = (bf16_t*)smem;
  bf16_t* Vs = Ks + 64 * KSTR;
  const int tid = my_tid(wv), lane = tid & 63, wave = tid >> 6, r = lane & 31, h = lane >> 5;
  const int qrow = wave * 32 + r;
  bf16x8 qf[NKS];
  if constexpr (MODE == 3) {
    const int dq = (wave & 1) * 32 + r;
#pragma unroll
    for (int ks = 0; ks < NKS; ++ks) {
      const int e = dq - (ks * 16 + h * 8);
      uint4 v;
      v.x = e == 0 ? 0x3F80u : (e == 1 ? 0x3F800000u : 0u);
      v.y = e == 2 ? 0x3F80u : (e == 3 ? 0x3F800000u : 0u);
      v.z = e == 4 ? 0x3F80u : (e == 5 ? 0x3F800000u : 0u);
      v.w = e == 6 ? 0x3F80u : (e == 7 ? 0x3F800000u : 0u);
      qf[ks] = __builtin_bit_cast(bf16x8, v);
    }
  } else {
#pragma unroll
    for (int ks = 0; ks < NKS; ++ks) qf[ks] = *(const bf16x8*)(it.Q + (size_t)qrow * it.qs + ks * 16 + h * 8);
  }
  f32x16 o0, o1;
#pragma unroll
  for (int i = 0; i < 16; ++i) { o0[i] = 0.f; o1[i] = 0.f; }
  float mrun = it.has_sink ? it.sink_l2 : -1e30f, lrun = 0.f;
  const int qp = it.qpos0 + qrow;
  const int n1 = it.t1 - it.t0, ntl = n1 + (it.t3 - it.t2);
  constexpr int BUFE = 64 * KSTR + 64 * VSTR;
  const int krow0 = tid / KCH, kch0 = tid % KCH, krow1 = (tid + NTHR) / KCH, kch1 = (tid + NTHR) % KCH;
  const bool k2 = (KCH == 12) && (tid + NTHR < 64 * KCH);
  const int vrow = tid >> 3, vch = tid & 7;
  uint4 rk0, rk1, rv;
  auto tile_of = [&](int ti) { return ti < n1 ? it.t0 + ti : it.t2 + (ti - n1); };
  auto gload = [&](int t) {
    const bool stt = (MODE == 2) && (t >= 16);
    if (!stt) {
      const int key0 = t * 64;
      rk0 = *(const uint4*)(it.K + (size_t)(key0 + krow0) * it.ks + kch0 * 8);
      if (k2) rk1 = *(const uint4*)(it.K + (size_t)(key0 + krow1) * it.ks + kch1 * 8);
      rv = *(const uint4*)(it.Vt + (size_t)vrow * it.vs + key0 + vch * 8);
    } else {
      const bf16_t* S = (t == 16) ? it.S0f : it.S0b;
      const int e = krow0 - kch0 * 8;
      rk0.x = e == 0 ? 0x3F80u : (e == 1 ? 0x3F800000u : 0u);
      rk0.y = e == 2 ? 0x3F80u : (e == 3 ? 0x3F800000u : 0u);
      rk0.z = e == 4 ? 0x3F80u : (e == 5 ? 0x3F800000u : 0u);
      rk0.w = e == 6 ? 0x3F80u : (e == 7 ? 0x3F800000u : 0u);
      rv = *(const uint4*)(S + (size_t)vrow * 64 + vch * 8);
    }
  };
  auto swrite = [&](int bsel) {
    bf16_t* Kb = Ks + bsel * BUFE; bf16_t* Vb = Kb + 64 * KSTR;
    *(uint4*)(Kb + krow0 * KSTR + kch0 * 8) = rk0;
    if (k2) *(uint4*)(Kb + krow1 * KSTR + kch1 * 8) = rk1;
    uint2* d = (uint2*)(Vb + vrow * VSTR + vch * 8);
    d[0] = make_uint2(rv.x, rv.y); d[1] = make_uint2(rv.z, rv.w);
  };
  __syncthreads();
  gload(tile_of(0)); swrite(0);
  __syncthreads();
  for (int ti = 0; ti < ntl; ++ti) {
    const int t = tile_of(ti);
    const bool st_tile = (MODE == 2) && (t >= 16);
    const int key0 = t * 64;
    const bool more = ti + 1 < ntl;
    if (more) gload(tile_of(ti + 1));
    const bf16_t* Kc = Ks + (ti & 1) * BUFE; const bf16_t* Vc = Kc + 64 * KSTR;
    bool skip = (MODE == 3) && (wave >= 4);
    if (MODE == 1 && t < 16) {
      const int qlo = it.qpos0 + wave * 32;
      skip = (key0 > qlo + 31 + 128 || key0 + 63 < qlo - 128);
    }
    if (!skip) {
    f32x16 s0, s1;
#pragma unroll
    for (int i = 0; i < 16; ++i) { s0[i] = 0.f; s1[i] = 0.f; }
#pragma unroll
    for (int ks = 0; ks < NKS; ++ks) {
      const bf16x8 k0 = *(const bf16x8*)(Kc + r * KSTR + ks * 16 + h * 8);
      const bf16x8 k1 = *(const bf16x8*)(Kc + (32 + r) * KSTR + ks * 16 + h * 8);
      s0 = __builtin_amdgcn_mfma_f32_32x32x16_bf16(k0, qf[ks], s0, 0, 0, 0);
      s1 = __builtin_amdgcn_mfma_f32_32x32x16_bf16(k1, qf[ks], s1, 0, 0, 0);
    }
    if constexpr (MODE == 3) {
      if (wave < 2) {
        const float base = (float)(it.T - 1 - key0 - 4 * h) * it.lgf - 3.f;
#pragma unroll
        for (int i = 0; i < 16; ++i) {
          s0[i] *= fexp2(fmaf(-(float)((i & 3) + 8 * (i >> 2)), it.lgf, base));
          s1[i] *= fexp2(fmaf(-(float)(32 + (i & 3) + 8 * (i >> 2)), it.lgf, base));
        }
      } else {
        const float base = (float)(key0 + 4 * h) * it.lgb - 3.f;
#pragma unroll
        for (int i = 0; i < 16; ++i) {
          s0[i] *= fexp2(fmaf((float)((i & 3) + 8 * (i >> 2)), it.lgb, base));
          s1[i] *= fexp2(fmaf((float)(32 + (i & 3) + 8 * (i >> 2)), it.lgb, base));
        }
      }
    } else if constexpr (MODE == 2) {
      if (!st_tile) {
        const int qlo = it.qpos0 + wave * 32;
        if (key0 + 63 < qlo) {
          const float base = (float)(qp - key0 - 4 * h) * it.lgf - 3.f;
#pragma unroll
          for (int i = 0; i < 16; ++i) {
            s0[i] *= fexp2(fmaf(-(float)((i & 3) + 8 * (i >> 2)), it.lgf, base));
            s1[i] *= fexp2(fmaf(-(float)(32 + (i & 3) + 8 * (i >> 2)), it.lgf, base));
          }
        } else if (key0 > qlo + 31) {
          const float base = (float)(key0 + 4 * h - qp) * it.lgb - 3.f;
#pragma unroll
          for (int i = 0; i < 16; ++i) {
            s0[i] *= fexp2(fmaf((float)((i & 3) + 8 * (i >> 2)), it.lgb, base));
            s1[i] *= fexp2(fmaf((float)(32 + (i & 3) + 8 * (i >> 2)), it.lgb, base));
          }
        } else {
#pragma unroll
        for (int i = 0; i < 16; ++i) {
          const int key = key0 + (i & 3) + 8 * (i >> 2) + 4 * h;
          const int e0 = qp - key, e1 = e0 - 32;
          float d0 = fexp2((float)(e0 < 0 ? -e0 : e0) * (e0 > 0 ? it.lgf : it.lgb));
          float d1 = fexp2((float)(e1 < 0 ? -e1 : e1) * (e1 > 0 ? it.lgf : it.lgb));
          d0 = e0 == 0 ? 2.f : d0;
          d1 = e1 == 0 ? 2.f : d1;
          s0[i] *= it.scale * d0;
          s1[i] *= it.scale * d1;
        }
        }
      } else {
        const float dec = (t == 16) ? fexp2((float)(qp + 1) * it.lgf) : fexp2((float)(it.T - qp) * it.lgb);
#pragma unroll
        for (int i = 0; i < 16; ++i) { s0[i] *= dec; s1[i] *= dec; }
      }
    } else {
      float mx = -INFINITY;
      const int qlo1 = it.qpos0 + wave * 32;
      const bool need_mask = (MODE == 1) && (t < 16) && !(key0 >= qlo1 + 31 - 128 && key0 + 63 <= qlo1 + 128);
#pragma unroll
      for (int i = 0; i < 16; ++i) {
        float a = s0[i] * it.scale, b = s1[i] * it.scale;
        if (MODE == 1 && need_mask) {
          const int key = key0 + (i & 3) + 8 * (i >> 2) + 4 * h;
          const int e0 = key - qp, e1 = e0 + 32;
          if (e0 > 128 || e0 < -128) a = -INFINITY;
          if (e1 > 128 || e1 < -128) b = -INFINITY;
        }
        s0[i] = a; s1[i] = b;
        mx = fmaxf(mx, fmaxf(a, b));
      }
      mx = fmaxf(mx, shx(mx, 32, lane));
      const float mnew = fmaxf(mrun, mx);
      const float alpha = fexp2(mrun - mnew);
      float sum = 0.f;
#pragma unroll
      for (int i = 0; i < 16; ++i) {
        s0[i] = fexp2(s0[i] - mnew);
        s1[i] = fexp2(s1[i] - mnew);
        sum += s0[i] + s1[i];
      }
      lrun = lrun * alpha + sum;
      mrun = mnew;
#pragma unroll
      for (int i = 0; i < 16; ++i) { o0[i] *= alpha; o1[i] *= alpha; }
    }
#pragma unroll
    for (int kt = 0; kt < 2; ++kt) {
#pragma unroll
      for (int sbk = 0; sbk < 2; ++sbk) {
        uint4 pw;
        if (kt == 0) {
          pw.x = pk2(s0[8 * sbk + 0], s0[8 * sbk + 1]); pw.y = pk2(s0[8 * sbk + 2], s0[8 * sbk + 3]);
          pw.z = pk2(s0[8 * sbk + 4], s0[8 * sbk + 5]); pw.w = pk2(s0[8 * sbk + 6], s0[8 * sbk + 7]);
        } else {
          pw.x = pk2(s1[8 * sbk + 0], s1[8 * sbk + 1]); pw.y = pk2(s1[8 * sbk + 2], s1[8 * sbk + 3]);
          pw.z = pk2(s1[8 * sbk + 4], s1[8 * sbk + 5]); pw.w = pk2(s1[8 * sbk + 6], s1[8 * sbk + 7]);
        }
        const bf16x8 pf = __builtin_bit_cast(bf16x8, pw);
        const int koff = kt * 32 + sbk * 16 + 4 * h;
        const uint2 a0 = *(const uint2*)(Vc + r * VSTR + koff), a1 = *(const uint2*)(Vc + r * VSTR + koff + 8);
        const uint2 b0 = *(const uint2*)(Vc + (32 + r) * VSTR + koff), b1 = *(const uint2*)(Vc + (32 + r) * VSTR + koff + 8);
        const bf16x8 v0 = __builtin_bit_cast(bf16x8, make_uint4(a0.x, a0.y, a1.x, a1.y));
        const bf16x8 v1 = __builtin_bit_cast(bf16x8, make_uint4(b0.x, b0.y, b1.x, b1.y));
        o0 = __builtin_amdgcn_mfma_f32_32x32x16_bf16(v0, pf, o0, 0, 0, 0);
        o1 = __builtin_amdgcn_mfma_f32_32x32x16_bf16(v1, pf, o1, 0, 0, 0);
      }
    }
    }
    if (more) swrite((ti + 1) & 1);
    __syncthreads();
  }
  if constexpr (MODE == 3) {
    if (wave < 4) {
      float* rowp = it.sout + (size_t)(wave >> 1) * 16384 + (size_t)((wave & 1) * 32 + r) * 64;
#pragma unroll
      for (int g = 0; g < 4; ++g) {
        *(float4*)(rowp + 8 * g + 4 * h) = make_float4(o0[4 * g], o0[4 * g + 1], o0[4 * g + 2], o0[4 * g + 3]);
        *(float4*)(rowp + 32 + 8 * g + 4 * h) = make_float4(o1[4 * g], o1[4 * g + 1], o1[4 * g + 2], o1[4 * g + 3]);
      }
    }
    return;
  }
  bf16_t* orow = it.out + (size_t)qrow * DM;
  if constexpr (MODE == 2) {
    float sm = 0.f;
#pragma unroll
    for (int i = 0; i < 16; ++i) sm += o0[i] + o1[i];
    sm += shx(sm, 32, lane);
    const float mu = sm * (1.f / 64.f);
    float vr = 0.f;
#pragma unroll
    for (int i = 0; i < 16; ++i) { o0[i] -= mu; o1[i] -= mu; vr += o0[i] * o0[i] + o1[i] * o1[i]; }
    vr += shx(vr, 32, lane);
    const float rstd = rsqrtf(vr * (1.f / 64.f) + 1e-6f);
    const bf16_t* grow = it.G + (size_t)qrow * 256;
#pragma unroll
    for (int g = 0; g < 4; ++g) {
      const int d = 8 * g + 4 * h;
      const uint2 ga = *(const uint2*)(grow + d), gb = *(const uint2*)(grow + 32 + d);
      const float gav[4] = {__uint_as_float(ga.x << 16), __uint_as_float(ga.x & 0xffff0000u), __uint_as_float(ga.y << 16), __uint_as_float(ga.y & 0xffff0000u)};
      const float gbv[4] = {__uint_as_float(gb.x << 16), __uint_as_float(gb.x & 0xffff0000u), __uint_as_float(gb.y << 16), __uint_as_float(gb.y & 0xffff0000u)};
#pragma unroll
      for (int j = 0; j < 4; ++j) {
        const float x0 = gav[j], x1 = gbv[j];
        o0[4 * g + j] = o0[4 * g + j] * rstd * it.gn[d + j] * (x0 / (1.f + __expf(-x0)));
        o1[4 * g + j] = o1[4 * g + j] * rstd * it.gn[32 + d + j] * (x1 / (1.f + __expf(-x1)));
      }
    }
  } else {
    float lt = lrun + shx(lrun, 32, lane);
    if (it.has_sink) lt += fexp2(it.sink_l2 - mrun);
    const float inv = 1.f / lt;
#pragma unroll
    for (int i = 0; i < 16; ++i) { o0[i] *= inv; o1[i] *= inv; }
  }
  st_rm_bf16(orow, h, o0);
  st_rm_bf16(orow + 32, h, o1);
}

__device__ __forceinline__ float log2_sigmoid(float x) { return -log1pf(expf(-x)) * LOG2E; }

__device__ __forceinline__ void state_item(const P& p, int l, int idx, unsigned char* smem, const int wv) {
  const int b = idx >> 3, hh = (idx >> 1) & 3, dir = idx & 1;
  float* Ksm = (float*)smem;
  float* Vsm = Ksm + 4096;
  const int tid = my_tid(wv);
  const float lg = log2_sigmoid(p.ret_decay[(l * 2 + dir) * 4 + hh]);
  float acc[8];
#pragma unroll
  for (int i = 0; i < 8; ++i) acc[i] = 0.f;
  const int d = tid >> 3, e0 = (tid & 7) * 8;
  for (int c = 0; c < 4; ++c) {
    __syncthreads();
    for (int i = tid; i < 4096; i += NTHR) {
      const int j = i >> 6, dd = i & 63, tok = c * 64 + j;
      const float dec = dir == 0 ? fexp2((float)(255 - tok) * lg) : fexp2((float)tok * lg);
      Ksm[j * 64 + dd] = bf2f(p.Kret()[(size_t)(b * 256 + tok) * 256 + hh * 64 + dd]) * 0.125f * dec;
      const int e = i >> 6, jj = i & 63;
      Vsm[e * 65 + jj] = bf2f(p.Vtret_c()[((size_t)((b * 4 + hh) * 64 + e)) * 256 + c * 64 + jj]);
    }
    __syncthreads();
    for (int j = 0; j < 64; ++j) {
      const float kd = Ksm[j * 64 + d];
#pragma unroll
      for (int i = 0; i < 8; ++i) acc[i] += kd * Vsm[(e0 + i) * 65 + j];
    }
  }
  float* op = p.out + 23592960 + ((size_t)((((b * 2 + l) * 2 + dir) * 4 + hh) * 64 + d)) * 64 + e0;
  *(float4*)(op) = make_float4(acc[0], acc[1], acc[2], acc[3]);
  *(float4*)(op + 4) = make_float4(acc[4], acc[5], acc[6], acc[7]);
}

__device__ __forceinline__ void attn_phase(const P& p, int l, unsigned char* smem, const int wv) {
  constexpr int NA = 128, NB = 128, NC = 256, ND = 256, NE = 128, NF = 128, NG = 128;
  constexpr int TOT = NA + NB + NC + ND + NE + NF + NG;
  unsigned* ticket = p.ctl() + 32 + 64 * l;
  volatile int* tks = (volatile int*)(smem + LDS_RED + 2048);
  const int tid0 = my_tid(wv);
  for (;;) {
    __syncthreads();
    if (tid0 == 0) *tks = (int)__hip_atomic_fetch_add(ticket, 1u, __ATOMIC_RELAXED, __HIP_MEMORY_SCOPE_AGENT);
    __syncthreads();
    const int item = *tks;
    if (item >= TOT) break;
    int idx = item;
    AttnItem it;
    it.t2 = 0; it.t3 = 0; it.qpos0 = 0; it.T = 0; it.sink_l2 = 0.f; it.has_sink = 0; it.lgf = 0.f; it.lgb = 0.f;
    it.S0f = nullptr; it.S0b = nullptr; it.G = nullptr; it.gn = nullptr; it.sout = nullptr;
    if (idx < NA) {
      const int b = idx >> 4, hh = (idx >> 2) & 3, qb = idx & 3, row0 = NCTX + b * 1024 + qb * 256;
      it.Q = p.Qmla() + (size_t)row0 * 384 + hh * 96; it.qs = 384;
      it.K = p.Kmla_l() + ((size_t)(((l * 8 + b) * 4 + hh) * 1280)) * 96; it.ks = 96;
      it.Vt = p.Vtmla_l() + ((size_t)(((l * 8 + b) * 4 + hh) * 64)) * 1280; it.vs = 1280;
      it.t0 = 0; it.t1 = 20;
      it.scale = 0.10206207261596575f * LOG2E;
      it.out = p.mix() + (size_t)row0 * DM + 768 + hh * 64;
      attn_item<96, 0>(it, smem, wv);
      continue;
    }
    idx -= NA;
    if (idx < NB) {
      const int b = idx >> 4, hh = (idx >> 2) & 3, qb = idx & 3, row0 = NCTX + b * 1024 + qb * 256;
      it.Q = p.Qret() + (size_t)row0 * 256 + hh * 64; it.qs = 256;
      it.K = p.Kret() + (size_t)(NCTX + b * 1024) * 256 + hh * 64; it.ks = 256;
      it.Vt = p.Vtret_l() + ((size_t)((b * 4 + hh) * 64)) * 1024; it.vs = 1024;
      it.t0 = 0; it.t1 = 16; it.t2 = 16; it.t3 = 18;
      it.qpos0 = qb * 256; it.T = 1024; it.scale = 0.125f;
      it.lgf = log2_sigmoid(p.ret_decay[(l * 2 + 0) * 4 + hh]);
      it.lgb = log2_sigmoid(p.ret_decay[(l * 2 + 1) * 4 + hh]);
      it.S0f = p.S0t() + ((size_t)((((l * 8 + b) * 2 + 0) * 4 + hh))) * 4096;
      it.S0b = p.S0t() + ((size_t)((((l * 8 + b) * 2 + 1) * 4 + hh))) * 4096;
      it.G = p.Gret() + (size_t)row0 * 256 + hh * 64; it.gn = p.ret_gn + l * 256 + hh * 64;
      it.out = p.mix() + (size_t)row0 * DM + 512 + hh * 64;
      attn_item<64, 2>(it, smem, wv);
      continue;
    }
    idx -= NB;
    if (idx < NC) {
      const int b = idx >> 5, head = (idx >> 2) & 7, qb = idx & 3, kv = head >> 2, row0 = NCTX + b * 1024 + qb * 256;
      it.Q = p.Qwin() + (size_t)row0 * 512 + head * 64; it.qs = 512;
      it.K = p.Kwin_l() + ((size_t)((l * 8 + b) * 1280)) * 128 + kv * 64; it.ks = 128;
      it.Vt = p.Vtwin_l() + ((size_t)(((l * 8 + b) * 2 + kv) * 64)) * 1280; it.vs = 1280;
      it.t0 = max(0, qb * 4 - 2); it.t1 = min(16, qb * 4 + 6); it.t2 = 16; it.t3 = 20;
      it.qpos0 = qb * 256;
      it.scale = 0.125f * LOG2E; it.sink_l2 = p.win_sink[l * 8 + head] * LOG2E; it.has_sink = 1;
      it.out = p.mix() + (size_t)row0 * DM + head * 64;
      attn_item<64, 1>(it, smem, wv);
      continue;
    }
    idx -= NC;
    if (idx < ND) {
      const int b = idx >> 3, head = idx & 7, kv = head >> 2, row0 = b * 256;
      it.Q = p.Qwin() + (size_t)row0 * 512 + head * 64; it.qs = 512;
      it.K = p.Kwin_c() + (size_t)(b * 256) * 128 + kv * 64; it.ks = 128;
      it.Vt = p.Vtwin_c() + ((size_t)((b * 2 + kv) * 64)) * 256; it.vs = 256;
      it.t0 = 0; it.t1 = 4;
      it.scale = 0.125f * LOG2E; it.sink_l2 = p.win_sink[l * 8 + head] * LOG2E; it.has_sink = 1;
      it.out = p.mix() + (size_t)row0 * DM + head * 64;
      attn_item<64, 0>(it, smem, wv);
      continue;
    }
    idx -= ND;
    if (idx < NE) {
      const int b = idx >> 2, hh = idx & 3, row0 = b * 256;
      it.Q = p.Qmla() + (size_t)row0 * 384 + hh * 96; it.qs = 384;
      it.K = p.Kmla_c() + ((size_t)((b * 4 + hh) * 256)) * 96; it.ks = 96;
      it.Vt = p.Vtmla_c() + ((size_t)((b * 4 + hh) * 64)) * 256; it.vs = 256;
      it.t0 = 0; it.t1 = 4;
      it.scale = 0.10206207261596575f * LOG2E;
      it.out = p.mix() + (size_t)row0 * DM + 768 + hh * 64;
      attn_item<96, 0>(it, smem, wv);
      continue;
    }
    idx -= NE;
    if (idx < NF) {
      const int b = idx >> 2, hh = idx & 3, row0 = b * 256;
      it.Q = p.Qret() + (size_t)row0 * 256 + hh * 64; it.qs = 256;
      it.K = p.Kret() + (size_t)(b * 256) * 256 + hh * 64; it.ks = 256;
      it.Vt = p.Vtret_c() + ((size_t)((b * 4 + hh) * 64)) * 256; it.vs = 256;
      it.t0 = 0; it.t1 = 4;
      it.qpos0 = 0; it.T = 256; it.scale = 0.125f;
      it.lgf = log2_sigmoid(p.ret_decay[(l * 2 + 0) * 4 + hh]);
      it.lgb = log2_sigmoid(p.ret_decay[(l * 2 + 1) * 4 + hh]);
      it.G = p.Gret() + (size_t)row0 * 256 + hh * 64; it.gn = p.ret_gn + l * 256 + hh * 64;
      it.out = p.mix() + (size_t)row0 * DM + 512 + hh * 64;
      attn_item<64, 2>(it, smem, wv);
      continue;
    }
    idx -= NF;
    {
      const int b = idx >> 2, hh = idx & 3;
      it.Q = nullptr; it.qs = 0;
      it.K = p.Kret() + (size_t)(b * 256) * 256 + hh * 64; it.ks = 256;
      it.Vt = p.Vtret_c() + ((size_t)((b * 4 + hh) * 64)) * 256; it.vs = 256;
      it.t0 = 0; it.t1 = 4;
      it.T = 256; it.scale = 0.125f;
      it.lgf = log2_sigmoid(p.ret_decay[(l * 2 + 0) * 4 + hh]);
      it.lgb = log2_sigmoid(p.ret_decay[(l * 2 + 1) * 4 + hh]);
      it.out = nullptr;
      it.sout = p.out + 23592960 + ((size_t)((b * 2 + l) * 2 * 4 + hh)) * 4096;
      attn_item<64, 3>(it, smem, wv);
    }
  }
}

__device__ __forceinline__ void gemv9_item(const float* sc, float* red, const float* __restrict__ W, int N, int n0, float* outp, int ldo,
                                           const float* bias, const int tid) {
  const int j4 = (tid & 7) * 4, kq = tid >> 3;
  f32x4 acc[9];
#pragma unroll
  for (int r = 0; r < 9; ++r) acc[r] = (f32x4){0.f, 0.f, 0.f, 0.f};
  const float* w = W + (size_t)(kq * 16) * N + n0 + j4;
  const float* s = sc + kq * 16;
#pragma unroll
  for (int kk = 0; kk < 16; ++kk) {
    const f32x4 wv = *(const f32x4*)(w + (size_t)kk * N);
#pragma unroll
    for (int r = 0; r < 9; ++r) acc[r] += wv * s[r * 1024 + kk];
  }
#pragma unroll
  for (int r = 0; r < 9; ++r) *(f32x4*)(red + (kq * 9 + r) * 32 + j4) = acc[r];
  __syncthreads();
  for (int oo = tid; oo < 288; oo += NTHR) {
    const int r = oo >> 5, jj = oo & 31;
    float sum = 0.f;
#pragma unroll 16
    for (int q = 0; q < 64; ++q) sum += red[(q * 9 + r) * 32 + jj];
    outp[(size_t)r * ldo + n0 + jj] = sum + (bias ? bias[n0 + jj] : 0.f);
  }
  __syncthreads();
}

__device__ __forceinline__ void norm0_phase(const P& p, unsigned char* smem, const int wv) {
  const int tid = my_tid(wv), lane = tid & 63, gw = my_bid() * NWV + (tid >> 6), ngw = gridDim.x * NWV;
  const float* gain = p.norm1;
  for (int m0 = gw; m0 < NTOK; m0 += 2 * ngw) {
    float4 v[2][4];
    float ss[2] = {0.f, 0.f};
#pragma unroll
    for (int q = 0; q < 2; ++q) {
      const int m = m0 + q * ngw;
      const float* xr = m < NCTX ? p.x_prompt + (size_t)m * DM : p.x_sample + (size_t)(m - NCTX) * DM;
#pragma unroll
      for (int t = 0; t < 2; ++t) {
        v[q][2 * t] = *(const float4*)(xr + t * 512 + lane * 8);
        v[q][2 * t + 1] = *(const float4*)(xr + t * 512 + lane * 8 + 4);
      }
    }
#pragma unroll
    for (int q = 0; q < 2; ++q) {
#pragma unroll
      for (int j = 0; j < 4; ++j) ss[q] += v[q][j].x * v[q][j].x + v[q][j].y * v[q][j].y + v[q][j].z * v[q][j].z + v[q][j].w * v[q][j].w;
      ss[q] = wave_sum(ss[q], lane);
    }
#pragma unroll
    for (int q = 0; q < 2; ++q) {
      const int m = m0 + q * ngw;
      const float* scale = p.mod() + ((size_t)mod_row(m)) * 6144 + 1 * 1024;
#pragma unroll
      for (int t = 0; t < 2; ++t) {
        const int c = t * 512 + lane * 8;
        const float4 g0 = *(const float4*)(gain + c), g1 = *(const float4*)(gain + c + 4), s0 = *(const float4*)(scale + c), s1 = *(const float4*)(scale + c + 4);
        const float4 a = v[q][2 * t], b = v[q][2 * t + 1];
        uint4 u;
        u.x = pk2(a.x * g0.x * (1.f + s0.x), a.y * g0.y * (1.f + s0.y));
        u.y = pk2(a.z * g0.z * (1.f + s0.z), a.w * g0.w * (1.f + s0.w));
        u.z = pk2(b.x * g1.x * (1.f + s1.x), b.y * g1.y * (1.f + s1.y));
        u.w = pk2(b.z * g1.z * (1.f + s1.z), b.w * g1.w * (1.f + s1.w));
        *(uint4*)(p.hbuf() + (size_t)m * DM + c) = u;
      }
      if (lane < 16) p.rssA()[(size_t)m * 16 + lane] = lane == 0 ? ss[q] : 0.f;
    }
  }
  float* sc = (float*)smem;
  float* red = sc + 9216;
  constexpr int G_IN = DIN / 32, G_UP = DFF / 32, NIT = 2 * G_IN + 2 * G_UP;
  for (int item = my_bid(); item < NIT; item += gridDim.x) {
    int l, grp; const float* W; int N; float* outp; int ldo; int which;
    if (item < 2 * G_IN) { l = item / G_IN; grp = item % G_IN; W = p.w_in + (size_t)l * DM * DIN; N = DIN; outp = p.sWin() + (size_t)l * 9 * DINP; ldo = DINP; which = 0; }
    else { const int i2 = item - 2 * G_IN; l = i2 / G_UP; grp = i2 % G_UP; W = p.w_up + (size_t)l * DM * DFF; N = DFF; outp = p.sWup() + (size_t)l * 9 * DFF; ldo = DFF; which = 3; }
    __syncthreads();
    for (int i = tid; i < 9216; i += NTHR) sc[i] = p.mod()[((size_t)(l * 9 + (i >> 10))) * 6144 + which * 1024 + (i & 1023)];
    __syncthreads();
    gemv9_item(sc, red, W, N, grp * 32, outp, ldo, nullptr, tid);
  }
}
__device__ __forceinline__ void final_norm_phase(const P& p, const int wv) {
  const int tid = my_tid(wv), lane = tid & 63, gw = my_bid() * NWV + (tid >> 6), ngw = gridDim.x * NWV;
  for (int m = gw; m < NTOK; m += ngw) {
    const float* xr = p.xw() + (size_t)m * DM;
    float4 v[4];
    float ss = 0.f;
#pragma unroll
    for (int j = 0; j < 4; ++j) {
      v[j] = ((const float4*)xr)[lane + 64 * j];
      ss += v[j].x * v[j].x + v[j].y * v[j].y + v[j].z * v[j].z + v[j].w * v[j].w;
    }
    ss = wave_sum(ss, lane);
    const float rstd = rsqrtf(ss * (1.f / 1024.f) + 1e-6f);
#pragma unroll
    for (int j = 0; j < 4; ++j) {
      const int c = (lane + 64 * j) * 4;
      const float4 g = *(const float4*)(p.final_norm + c);
      *(float4*)(p.out + (size_t)m * DM + c) = make_float4(v[j].x * rstd * g.x, v[j].y * rstd * g.y, v[j].z * rstd * g.z, v[j].w * rstd * g.w);
    }
  }
}

__device__ __forceinline__ void transpose_tile(const float* __restrict__ W, int K, int N, bf16_t* __restrict__ WT, int item, float* tile, const int tid) {
  const int ntn = (N + 63) >> 6, kt = item / ntn, nt = item % ntn, k0 = kt * 64, n0 = nt * 64;
  const int n4 = (tid & 15) * 4, kr = tid >> 4;
#pragma unroll
  for (int q = 0; q < 2; ++q) {
    const int k = q * 32 + kr;
    float4 v = make_float4(0.f, 0.f, 0.f, 0.f);
    if (n0 + n4 < N) v = *(const float4*)(W + (size_t)(k0 + k) * N + n0 + n4);
    float* t = tile + k * 65 + n4;
    t[0] = v.x; t[1] = v.y; t[2] = v.z; t[3] = v.w;
  }
  __syncthreads();
  {
    const int n = tid >> 3, kc = (tid & 7) * 8;
    const float* t = tile + kc * 65 + n;
    uint4 o;
    o.x = pk2(t[0 * 65], t[1 * 65]); o.y = pk2(t[2 * 65], t[3 * 65]); o.z = pk2(t[4 * 65], t[5 * 65]); o.w = pk2(t[6 * 65], t[7 * 65]);
    if (n0 + n < N) *(uint4*)(WT + (size_t)(n0 + n) * K + k0 + kc) = o;
  }
  __syncthreads();
}

__device__ __forceinline__ void prep_phase(const P& p, unsigned char* smem, const int wv) {
  const int tid = my_tid(wv);
  {
    float* sc = (float*)smem;
    float* red = sc + 9216;
    for (int i = tid; i < 9216; i += NTHR) {
      const int r = i >> 10, k = i & 1023;
      const float x = r == 0 ? p.c_ctx[k] : p.c[(r - 1) * 1024 + k];
      sc[i] = x / (1.f + expf(-x));
    }
    __syncthreads();
    for (int item = blockIdx.x; item < 384; item += gridDim.x) {
      const int l = item / 192, n0 = (item % 192) * 32;
      gemv9_item(sc, red, p.w_mod + (size_t)l * 1024 * 6144, 6144, n0, p.mod() + (size_t)l * 9 * 6144, 6144, p.b_mod + l * 6144, tid);
    }
  }
  __syncthreads();
  {
    float* tile = (float*)smem;
    constexpr int I_IN = 16 * 37, I_OUT = 16 * 16, I_UP = 16 * 64, I_DN = 64 * 16, I_KV = 2 * 8;
    constexpr int PER = I_IN + I_OUT + I_UP + I_DN + I_KV;
    for (int item = blockIdx.x; item < 2 * PER; item += gridDim.x) {
      const int l = item / PER;
      int r = item % PER;
      if (r < I_IN) { transpose_tile(p.w_in + (size_t)l * DM * DIN, DM, DIN, p.WinT() + (size_t)l * DINP * DM, r, tile, tid); continue; }
      r -= I_IN;
      if (r < I_OUT) { transpose_tile(p.w_out + (size_t)l * DM * DM, DM, DM, p.WoutT() + (size_t)l * DM * DM, r, tile, tid); continue; }
      r -= I_OUT;
      if (r < I_UP) { transpose_tile(p.w_up + (size_t)l * DM * DFF, DM, DFF, p.WupT() + (size_t)l * DFF * DM, r, tile, tid); continue; }
      r -= I_UP;
      if (r < I_DN) { transpose_tile(p.w_down + (size_t)l * DFF * DM, DFF, DM, p.WdownT() + (size_t)l * DM * DFF, r, tile, tid); continue; }
      r -= I_DN;
      transpose_tile(p.w_kv_b + (size_t)l * 128 * 512, 128, 512, p.WkvbT() + (size_t)l * 512 * 128, r, tile, tid);
    }
  }
  const int gt = blockIdx.x * NTHR + tid, gs = gridDim.x * NTHR;
  if (gt < 256) p.ctl()[gt] = 0u;
  for (int i = gt; i < 64 * 16; i += gs) {
    const int pos = i >> 4, f = i & 15;
    const float ang = (float)pos * exp2f(-(float)f * (L2_10000 / 16.f));
    p.ropeW()[pos * 32 + f] = __cosf(ang);
    p.ropeW()[pos * 32 + 16 + f] = __sinf(ang);
  }
  for (int i = gt; i < 64 * 8; i += gs) {
    const int pos = i >> 3, f = i & 7;
    const float ang = (float)pos * exp2f(-(float)f * (L2_10000 / 8.f));
    p.ropeM()[pos * 16 + f] = __cosf(ang);
    p.ropeM()[pos * 16 + 8 + f] = __sinf(ang);
  }
  for (int i = gt; i < 2 * (DINP - DIN) * DM / 8; i += gs) {
    const int l = i / ((DINP - DIN) * DM / 8), o = i % ((DINP - DIN) * DM / 8);
    *(uint4*)(p.WinT() + ((size_t)l * DINP + DIN) * DM + (size_t)o * 8) = make_uint4(0, 0, 0, 0);
  }
  for (int i = gt; i < 524288 / 8; i += gs) {
    const int d8 = i & 7, kv = (i >> 3) & 1, s = (i >> 4) & 255, l = (i >> 12) & 1, b = i >> 13;
    const float4 a = *(const float4*)(p.cache_win_k + (size_t)i * 8), c = *(const float4*)(p.cache_win_k + (size_t)i * 8 + 4);
    *(uint4*)(p.Kwin_l() + ((size_t)((l * 8 + b) * 1280 + 1024 + s)) * 128 + kv * 64 + d8 * 8) = make_uint4(pk2(a.x, a.y), pk2(a.z, a.w), pk2(c.x, c.y), pk2(c.z, c.w));
  }
  for (int i = gt; i < 524288 / 8; i += gs) {
    const int d = i & 63, kv = (i >> 6) & 1, s8 = (i >> 7) & 31, l = (i >> 12) & 1, b = i >> 13;
    const float* src = p.cache_win_v + ((size_t)((b * 2 + l) * 256 + s8 * 8) * 2 + kv) * 64 + d;
    float v[8];
#pragma unroll
    for (int j = 0; j < 8; ++j) v[j] = src[(size_t)j * 128];
    *(uint4*)(p.Vtwin_l() + ((size_t)(((l * 8 + b) * 2 + kv) * 64 + d)) * 1280 + 1024 + s8 * 8) = make_uint4(pk2(v[0], v[1]), pk2(v[2], v[3]), pk2(v[4], v[5]), pk2(v[6], v[7]));
  }
  for (int i = gt; i < 524288 / 8; i += gs) {
    const int j8 = i & 15, s = (i >> 4) & 255, l = (i >> 12) & 1, b = i >> 13;
    const float4 a = *(const float4*)(p.cache_mla_ckv + (size_t)i * 8), c = *(const float4*)(p.cache_mla_ckv + (size_t)i * 8 + 4);
    *(uint4*)(p.ckvn() + ((size_t)l * 18432 + 16384 + b * 256 + s) * 128 + j8 * 8) = make_uint4(pk2(a.x, a.y), pk2(a.z, a.w), pk2(c.x, c.y), pk2(c.z, c.w));
  }
  for (int i = gt; i < 131072 / 8; i += gs) {
    const int j8 = i & 3, s = (i >> 2) & 255, l = (i >> 10) & 1, b = i >> 11;
    const float4 a = *(const float4*)(p.cache_mla_krope + (size_t)i * 8), c = *(const float4*)(p.cache_mla_krope + (size_t)i * 8 + 4);
    const uint4 o = make_uint4(pk2(a.x, a.y), pk2(a.z, a.w), pk2(c.x, c.y), pk2(c.z, c.w));
#pragma unroll
    for (int hh = 0; hh < 4; ++hh) *(uint4*)(p.Kmla_l() + ((size_t)(((l * 8 + b) * 4 + hh) * 1280 + 1024 + s)) * 96 + 64 + j8 * 8) = o;
  }
  for (int i = gt; i < 524288 / 8; i += gs) {
    const int e = i & 63, d8 = (i >> 6) & 7, blk = i >> 9;
    const int hh = blk & 3, dir = (blk >> 2) & 1, l = (blk >> 3) & 1, b = blk >> 4;
    const float* src = p.state_ret + (size_t)blk * 4096 + (size_t)(d8 * 8) * 64 + e;
    float v[8];
#pragma unroll
    for (int j = 0; j < 8; ++j) v[j] = src[(size_t)j * 64];
    *(uint4*)(p.S0t() + ((size_t)((((l * 8 + b) * 2 + dir) * 4 + hh) * 64 + e)) * 64 + d8 * 8) = make_uint4(pk2(v[0], v[1]), pk2(v[2], v[3]), pk2(v[4], v[5]), pk2(v[6], v[7]));
  }
}

struct RotOrder : pg8::StaticOrder {
  int rot;
  __device__ __forceinline__ bool next(int i, Unit& u) const {
    if (!pg8::StaticOrder::next(i, u)) return false;
    u.pn += rot; if (u.pn >= nN) u.pn -= nN;
    return true;
  }
};
template <class Epi>
__device__ __forceinline__ void big_gemm(unsigned char* smem, const bf16_t* A, const bf16_t* Bt, int N, int K, const Epi& E, const int wv, int rot = 0) {
  pg8::Gemm g{A, Bt, NTOK, N, K};
  RotOrder S;
  S.init(NTOK, N, (int)gridDim.x, my_bid());
  S.rot = rot;
  pg8::gemm_phase<Epi, RotOrder, true, true>((PG8_LAS unsigned char*)smem, g, S, E, wv);
}

#define GSYNC() grid.sync()
__global__ void __launch_bounds__(NTHR, 2) hybrid_fwd(P p_arg) {
  cg::grid_group grid = cg::this_grid();
  const kargp_t kp = (kargp_t)__builtin_amdgcn_kernarg_segment_ptr();
  const int wv = __builtin_amdgcn_readfirstlane((int)threadIdx.x >> 6);
  { const P p = load_params(kp); prep_phase(p, smem, wv); }
  GSYNC();
  { const P p = load_params(kp); norm0_phase(p, smem, wv); }
  GSYNC();
#pragma unroll
  for (int l = 0; l < 2; ++l) {
    { const P pc = load_params(kp); const int t0 = my_tid(wv);
      for (int i = t0; i < 64 * 32; i += NTHR) ((float*)(smem + LDS_ROPEW))[i] = pc.ropeW()[i];
      for (int i = t0; i < 64 * 16; i += NTHR) ((float*)(smem + LDS_ROPEM))[i] = pc.ropeM()[i];
      __syncthreads(); }
    { const P p = load_params(kp);
      big_gemm(smem, p.hbuf(), p.WinT() + (size_t)l * DINP * DM, DINP, DM, EpiIn8{p, l, kp}, wv, 8); }
    { const P p = load_params(kp); gemm_small(p.ckvn() + (size_t)l * 18432 * 128, 128, p.WkvbT() + (size_t)l * 512 * 128, 128, 18432, 512, 128, smem, EpiKvb{p, l}, wv, p.ctl() + 64 * l, p.ctl() + 128 + 64 * l); }
    GSYNC();
    { const P p = load_params(kp); attn_phase(p, l, smem, wv); }
    GSYNC();
    { const P p = load_params(kp); big_gemm(smem, p.mix(), p.WoutT() + (size_t)l * DM * DM, DM, DM, EpiOut8{p, l}, wv); }
    GSYNC();
    { const P p = load_params(kp); big_gemm(smem, p.hbuf(), p.WupT() + (size_t)l * DFF * DM, DFF, DM, EpiUp8{p, l}, wv); }
    GSYNC();
    { const P p = load_params(kp); big_gemm(smem, p.ubuf(), p.WdownT() + (size_t)l * DM * DFF, DM, DFF, EpiDown8{p, l}, wv); }
    GSYNC();
  }
  { const P p = load_params(kp); final_norm_phase(p, wv); }
}

extern "C" void kernel_launch(void* const* d_in, const int* in_sizes, int n_in, void* d_out, int out_size, void* d_ws, size_t ws_size,
                              hipStream_t stream) {
  static int grid_blocks = 0;
  if (grid_blocks == 0) {
    int dev = 0, cus = 0, per_cu = 0;
    (void)hipGetDevice(&dev);
    (void)hipDeviceGetAttribute(&cus, hipDeviceAttributeMultiprocessorCount, dev);
    (void)hipFuncSetAttribute((const void*)hybrid_fwd, hipFuncAttributeMaxDynamicSharedMemorySize, LDS_BYTES);
    (void)hipOccupancyMaxActiveBlocksPerMultiprocessor(&per_cu, (const void*)hybrid_fwd, NTHR, LDS_BYTES);
    if (per_cu < 1) { fprintf(stderr, "occupancy query returned %d\n", per_cu); per_cu = 1; }
    per_cu = 1;
    grid_blocks = cus * per_cu;
  }
  P p{};
  const float* const* in = (const float* const*)d_in;
  p.x_prompt = in[0]; p.x_sample = in[1]; p.cache_win_k = in[2]; p.cache_win_v = in[3]; p.cache_mla_ckv = in[4];
  p.cache_mla_krope = in[5]; p.state_ret = in[6]; p.c = in[7]; p.c_ctx = in[8]; p.w_mod = in[9]; p.b_mod = in[10];
  p.norm1 = in[11]; p.norm2 = in[12]; p.w_in = in[13]; p.win_sink = in[14]; p.ret_decay = in[15]; p.ret_gn = in[16];
  p.mla_kv_norm = in[17]; p.w_kv_b = in[18]; p.w_out = in[19]; p.w_up = in[20]; p.w_down = in[21]; p.final_norm = in[22];
  p.out = (float*)d_out;
  p.ws = (unsigned char*)d_ws;
  if (WS_END > ws_size) { fprintf(stderr, "kernel_launch: workspace too small: need %zu, have %zu\n", (size_t)WS_END, ws_size); return; }
  void* args[] = {&p};
  hipError_t e = hipLaunchCooperativeKernel((const void*)hybrid_fwd, dim3(grid_blocks), dim3(NTHR), args, LDS_BYTES, stream);
  if (e != hipSuccess) fprintf(stderr, "cooperative launch failed: %s (grid %d)\n", hipGetErrorString(e), grid_blocks);
}
```

```cpp
#include <hip/hip_runtime.h>
#include <hip/hip_cooperative_groups.h>
#include <cstdio>
#include <cstdint>
namespace cg = cooperative_groups;

__device__ __forceinline__ int lane_id() { return (int)__builtin_amdgcn_mbcnt_hi(~0u, __builtin_amdgcn_mbcnt_lo(~0u, 0u)); }

namespace pg8 {
#define PG8_LAS __attribute__((address_space(3)))
typedef unsigned short bf16_t;
typedef short bf16x8 __attribute__((ext_vector_type(8)));
typedef float f32x4 __attribute__((ext_vector_type(4)));
typedef unsigned u32x4 __attribute__((ext_vector_type(4)));
constexpr int BM = 256, BK = 64, HALF = 128, HTB = HALF * BK * 2  , STAGE_BYTES = 8 * HTB, NXCD = 8, WGM = 8;

__host__ __device__ __forceinline__ int lds_byte(int r, int c) { const int st = (r >> 4) * 2 + (c >> 5), rr = r & 15, cc = c & 31, ob = rr * 64 + cc * 2; return st * 1024 + (ob ^ (((ob >> 9) & 1) << 5)); }
__host__ __device__ __forceinline__ void stage_rc(int b, int& R, int& C) { const int st = b / 1024, sb = b % 1024, swz = sb ^ (((sb >> 9) & 1) << 5); R = (st >> 1) * 16 + swz / 64; C = (st & 1) * 32 + (swz % 64) / 2; }
__host__ __device__ __forceinline__ int perm32(int rho) { const int n = rho >> 4, i = rho & 15; return 8 * (i >> 2) + 4 * n + (i & 3); }

struct Unit { int pm, pn; };
struct Gemm { const bf16_t* A; const bf16_t* Bt; int M, N, K; };

struct StaticOrder {
    int nM, nN, nwg, G, c;
    __host__ __device__ void init(int M, int N, int G_, int c_) { nM = M / BM; nN = N / BM; nwg = nM * nN; G = G_; c = c_; }
    __host__ __device__ bool next(int i, Unit& u) const {
        const long L = (long)i * G + c; if (L >= nwg) return false;
        int wgid = (int)L; { const int q = nwg / NXCD, r = nwg % NXCD, xcd = wgid % NXCD, off = wgid / NXCD; wgid = (xcd < r ? xcd * (q + 1) : r * (q + 1) + (xcd - r) * q) + off; }
        const int nig = WGM * nN, gid = wgid / nig, fm = gid * WGM, gsz = (nM - fm) < WGM ? (nM - fm) : WGM;
        u.pm = fm + ((wgid % nig) % gsz); u.pn = (wgid % nig) / gsz; return true;
    }
    __device__ __forceinline__ void a_ready(const Unit&) const {}
    __device__ __forceinline__ void done(const Unit&) const {}
};
template <class Epi, class Sched, bool ALIGN_EPI = false, bool SP2 = false>
__device__ __forceinline__ void gemm_phase(PG8_LAS unsigned char* lds, const Gemm g, const Sched& S, const Epi& E, const int wvp) {
    const int wid = wvp, lane = lane_id(), tid = wid * 64 + lane, wr = wid >> 2, wc = wid & 3, fr = lane & 15, fq = lane >> 4;
    const int K = g.K, nt = K / BK;
    unsigned voffA[2], voffB[2];
#pragma unroll
    for (int i = 0; i < 2; ++i) { int R, C; stage_rc(tid * 16 + i * 8192, R, C); const int Rb = Epi::PERM ? ((R & ~31) + perm32(R & 31)) : R;
        voffA[i] = (unsigned)(R * K + C) * 2u; voffB[i] = (unsigned)(Rb * K + C) * 2u; }
    const size_t kstep = (size_t)(BK * 2);
    const size_t hstep = (size_t)HALF * K * 2;
    const size_t tstep = 2 * hstep;
    const unsigned ldsw = (unsigned)wid * 1024u;
    const int aoff = lds_byte(wr * 64 + fr, fq * 8), boff = lds_byte(wc * 32 + fr, fq * 8);
#define PG8_SA(b, h) (((b) * 2 + (h)) * HTB)
#define PG8_SB(b, h) ((4 + (b) * 2 + (h)) * HTB)
#define PG8_STAGE(bufoff, gbase, voff) do { _Pragma("unroll") for (int _i = 0; _i < 2; ++_i) \
        __builtin_amdgcn_global_load_lds((const unsigned*)((const char*)(gbase) + (voff)[_i]), (PG8_LAS unsigned*)(lds + (bufoff) + ldsw + _i * 8192), 16, 0, 0); } while (0)
#define PG8_LDA(dst, b, h) do { _Pragma("unroll") for (int m = 0; m < 4; ++m) _Pragma("unroll") for (int k = 0; k < 2; ++k) dst[m][k] = *(const PG8_LAS bf16x8*)(lds + PG8_SA(b, h) + aoff + m * 2048 + k * 1024); } while (0)
#define PG8_LDB(dst, b, h) do { _Pragma("unroll") for (int n = 0; n < 2; ++n) _Pragma("unroll") for (int k = 0; k < 2; ++k) dst[n][k] = *(const PG8_LAS bf16x8*)(lds + PG8_SB(b, h) + boff + n * 2048 + k * 1024); } while (0)
#define PG8_MMA(ai, bj, At, Bt) do { __builtin_amdgcn_s_setprio(1); _Pragma("unroll") for (int m = 0; m < 4; ++m) _Pragma("unroll") for (int n = 0; n < 2; ++n) _Pragma("unroll") for (int k = 0; k < 2; ++k) \
        acc[ai][bj][m][n] = __builtin_amdgcn_mfma_f32_16x16x32_bf16(Bt[n][k], At[m][k], acc[ai][bj][m][n], 0, 0, 0); __builtin_amdgcn_s_setprio(0); } while (0)
#define PG8_WAIT_V(n) asm volatile("s_waitcnt vmcnt(" #n ")" ::: "memory")
#define PG8_WAIT_L(n) asm volatile("s_waitcnt lgkmcnt(" #n ")" ::: "memory")
#define PG8_BAR __builtin_amdgcn_s_barrier()
#define PG8_SCHED __builtin_amdgcn_sched_barrier(0)
    Unit cur, nxt; int ui = 0;
    if (!S.next(0, cur)) return;
    f32x4 acc[2][2][4][2];
#pragma unroll
    for (int a = 0; a < 2; ++a)
#pragma unroll
        for (int b = 0; b < 2; ++b)
#pragma unroll
            for (int m = 0; m < 4; ++m)
#pragma unroll
                for (int n = 0; n < 2; ++n) acc[a][b][m][n] = (f32x4){0.f, 0.f, 0.f, 0.f};
    bf16x8 At[4][2], B0[2][2], B1[2][2];
    const char* cA = (const char*)g.A + (size_t)cur.pm * tstep; const char* cB = (const char*)g.Bt + (size_t)cur.pn * tstep;
    S.a_ready(cur);
    if constexpr (SP2) {
        PG8_STAGE(PG8_SB(0, 0), cB, voffB); PG8_STAGE(PG8_SB(0, 1), cB + hstep, voffB); PG8_STAGE(PG8_SA(0, 0), cA, voffA); PG8_STAGE(PG8_SA(0, 1), cA + hstep, voffA);
        if (wr == 1) PG8_BAR;
        PG8_WAIT_V(2); PG8_BAR;
        PG8_STAGE(PG8_SB(1, 0), cB + kstep, voffB); PG8_STAGE(PG8_SA(1, 0), cA + kstep, voffA); PG8_STAGE(PG8_SB(1, 1), cB + hstep + kstep, voffB);
        PG8_WAIT_V(6); PG8_BAR;
    } else {
        PG8_STAGE(PG8_SB(0, 0), cB, voffB); PG8_STAGE(PG8_SA(0, 0), cA, voffA); PG8_STAGE(PG8_SB(0, 1), cB + hstep, voffB); PG8_STAGE(PG8_SA(0, 1), cA + hstep, voffA);
        if (wr == 1) PG8_BAR;
        PG8_WAIT_V(4); PG8_BAR;
        PG8_STAGE(PG8_SB(1, 0), cB + kstep, voffB); PG8_STAGE(PG8_SA(1, 0), cA + kstep, voffA); PG8_STAGE(PG8_SB(1, 1), cB + hstep + kstep, voffB);
        PG8_WAIT_V(6); PG8_BAR;
    }
    for (;;) {
        const bool has_next = S.next(ui + 1, nxt);
        const char* nA = has_next ? (const char*)g.A + (size_t)nxt.pm * tstep : cA; const char* nB = has_next ? (const char*)g.Bt + (size_t)nxt.pn * tstep : cB;
        for (int t = 0; t < nt; t += 2) {
            const bool last = (t == nt - 2);
            const char* a1 = cA + (size_t)(t + 1) * kstep;
            const char* a2 = last ? nA : cA + (size_t)(t + 2) * kstep; const char* b2 = last ? nB : cB + (size_t)(t + 2) * kstep;
            const char* a3 = a2 + kstep; const char* b3 = b2 + kstep;
            if (last && has_next) S.a_ready(nxt);
            if constexpr (SP2) {
            PG8_LDB(B0, 0, 0); PG8_LDB(B1, 0, 1); PG8_SCHED; PG8_LDA(At, 0, 0); PG8_STAGE(PG8_SA(1, 1), a1 + hstep, voffA);
            PG8_WAIT_V(8); PG8_WAIT_L(0); PG8_BAR; PG8_MMA(0, 0, At, B0); PG8_MMA(0, 1, At, B1); PG8_BAR; PG8_SCHED;
            PG8_LDA(At, 0, 1); PG8_STAGE(PG8_SB(0, 0), b2, voffB); PG8_STAGE(PG8_SB(0, 1), b2 + hstep, voffB); PG8_STAGE(PG8_SA(0, 0), a2, voffA);
            PG8_WAIT_V(8); PG8_WAIT_L(0); PG8_BAR; PG8_MMA(1, 0, At, B0); PG8_MMA(1, 1, At, B1); PG8_BAR; PG8_SCHED;
            PG8_LDB(B0, 1, 0); PG8_LDB(B1, 1, 1); PG8_SCHED; PG8_LDA(At, 1, 0); PG8_STAGE(PG8_SA(0, 1), a2 + hstep, voffA);
            PG8_WAIT_V(8); PG8_WAIT_L(0); PG8_BAR; PG8_MMA(0, 0, At, B0); PG8_MMA(0, 1, At, B1); PG8_BAR; PG8_SCHED;
            PG8_LDA(At, 1, 1); PG8_STAGE(PG8_SB(1, 0), b3, voffB); PG8_STAGE(PG8_SB(1, 1), b3 + hstep, voffB); PG8_STAGE(PG8_SA(1, 0), a3, voffA);
            PG8_WAIT_V(8); PG8_WAIT_L(0); PG8_BAR; PG8_MMA(1, 0, At, B0); PG8_MMA(1, 1, At, B1); PG8_BAR; PG8_SCHED;
            } else {
            PG8_LDB(B0, 0, 0); PG8_SCHED; PG8_LDA(At, 0, 0); PG8_STAGE(PG8_SA(1, 1), a1 + hstep, voffA);
            PG8_WAIT_L(8); PG8_BAR; PG8_WAIT_L(0); PG8_MMA(0, 0, At, B0); PG8_BAR; PG8_SCHED;
            PG8_LDB(B1, 0, 1); PG8_STAGE(PG8_SB(0, 0), b2, voffB);
            PG8_BAR; PG8_WAIT_L(0); PG8_MMA(0, 1, At, B1); PG8_BAR;
            PG8_LDA(At, 0, 1); PG8_STAGE(PG8_SA(0, 0), a2, voffA);
            PG8_BAR; PG8_WAIT_L(0); PG8_MMA(1, 0, At, B0); PG8_BAR; PG8_SCHED;
            PG8_STAGE(PG8_SB(0, 1), b2 + hstep, voffB);
            PG8_WAIT_V(6); PG8_BAR; PG8_MMA(1, 1, At, B1); PG8_BAR;
            PG8_LDB(B0, 1, 0); PG8_SCHED; PG8_LDA(At, 1, 0); PG8_STAGE(PG8_SA(0, 1), a2 + hstep, voffA);
            PG8_WAIT_L(8); PG8_BAR; PG8_WAIT_L(0); PG8_MMA(0, 0, At, B0); PG8_BAR; PG8_SCHED;
            PG8_LDB(B1, 1, 1); PG8_STAGE(PG8_SB(1, 0), b3, voffB);
            PG8_BAR; PG8_WAIT_L(0); PG8_MMA(0, 1, At, B1); PG8_BAR;
            PG8_LDA(At, 1, 1); PG8_STAGE(PG8_SA(1, 0), a3, voffA);
            PG8_BAR; PG8_WAIT_L(0); PG8_MMA(1, 0, At, B0); PG8_BAR; PG8_SCHED;
            PG8_STAGE(PG8_SB(1, 1), b3 + hstep, voffB);
            PG8_WAIT_V(6); PG8_BAR; PG8_MMA(1, 1, At, B1); PG8_BAR;
            }
        }
        if constexpr (ALIGN_EPI) { if (wr == 0) PG8_BAR; }
        if constexpr (!Epi::AFTER_DRAIN) { E(acc, cur, wr, wc, fr, fq); S.done(cur); }
        if (!has_next) break;
#pragma unroll
        for (int a = 0; a < 2; ++a)
#pragma unroll
            for (int b = 0; b < 2; ++b)
#pragma unroll
                for (int m = 0; m < 4; ++m)
#pragma unroll
                    for (int n = 0; n < 2; ++n) acc[a][b][m][n] = (f32x4){0.f, 0.f, 0.f, 0.f};
        cur = nxt; cA = nA; cB = nB; ++ui;
        if constexpr (ALIGN_EPI) { if (wr == 1) PG8_BAR; }
    }
    PG8_WAIT_V(0);
    if constexpr (!ALIGN_EPI) { if (wr == 0) PG8_BAR; }
    PG8_BAR;
    if constexpr (Epi::AFTER_DRAIN) { E.fused(acc, cur, wr, wc, fr, fq, lds, wid, lane); S.done(cur); }
#undef PG8_SA
#undef PG8_SB
#undef PG8_STAGE
#undef PG8_LDA
#undef PG8_LDB
#undef PG8_MMA
#undef PG8_WAIT_V
#undef PG8_WAIT_L
#undef PG8_BAR
#undef PG8_SCHED
}
}


typedef unsigned short bf16_t;
typedef short bf16x8 __attribute__((ext_vector_type(8)));
typedef float f32x16 __attribute__((ext_vector_type(16)));
typedef pg8::f32x4 f32x4;
typedef unsigned u32x4v __attribute__((ext_vector_type(4)));
using pg8::Unit;

constexpr int NTHR = 512, NWV = 8;
constexpr int NTOK = 16384, NCTX = 8192, DM = 1024, DIN = 2336, DINP = 2560, DFF = 4096;
constexpr int LDS_RED = 131072;
constexpr int LDS_ROPEW = 131072 + 4096, LDS_ROPEM = LDS_ROPEW + 64 * 32 * 4;
constexpr int LDS_BYTES = LDS_ROPEM + 64 * 16 * 4;
constexpr float LOG2E = 1.4426950408889634f;
constexpr float L2_10000 = 13.287712379549449f;

#define AL256(x) (((x) + 255) & ~(size_t)255)
constexpr size_t OFF_mod = 0;
constexpr size_t OFF_ropeW = OFF_mod + AL256((size_t)2 * 9 * 6144 * 4);
constexpr size_t OFF_ropeM = OFF_ropeW + AL256((size_t)64 * 32 * 4);
constexpr size_t OFF_ctl = OFF_ropeM + AL256((size_t)64 * 16 * 4);
constexpr size_t OFF_rssA = OFF_ctl + AL256((size_t)256 * 4);
constexpr size_t OFF_rssB = OFF_rssA + AL256((size_t)NTOK * 16 * 4);
constexpr size_t OFF_sWin = OFF_rssB + AL256((size_t)NTOK * 16 * 4);
constexpr size_t OFF_sWup = OFF_sWin + AL256((size_t)2 * 9 * DINP * 4);
constexpr size_t OFF_WinT = OFF_sWup + AL256((size_t)2 * 9 * DFF * 4);
constexpr size_t OFF_WoutT = OFF_WinT + AL256((size_t)2 * DINP * DM * 2);
constexpr size_t OFF_WupT = OFF_WoutT + AL256((size_t)2 * DM * DM * 2);
constexpr size_t OFF_WdownT = OFF_WupT + AL256((size_t)2 * DFF * DM * 2);
constexpr size_t OFF_WkvbT = OFF_WdownT + AL256((size_t)2 * DM * DFF * 2);
constexpr size_t OFF_hbuf = OFF_WkvbT + AL256((size_t)2 * 512 * 128 * 2);
constexpr size_t OFF_Kwin_l = OFF_hbuf + AL256((size_t)NTOK * DM * 2);
constexpr size_t OFF_Vtwin_l = OFF_Kwin_l + AL256((size_t)2 * 8 * 1280 * 128 * 2);
constexpr size_t OFF_S0t = OFF_Vtwin_l + AL256((size_t)2 * 8 * 2 * 64 * 1280 * 2);
constexpr size_t OFF_ckvn = OFF_S0t + AL256((size_t)2 * 8 * 2 * 4 * 4096 * 2);
constexpr size_t OFF_Kmla_l = OFF_ckvn + AL256((size_t)2 * 18432 * 128 * 2);
constexpr size_t OFF_Vtmla_l = OFF_Kmla_l + AL256((size_t)2 * 8 * 4 * 1280 * 96 * 2);
constexpr size_t OFF_ubuf = OFF_Vtmla_l + AL256((size_t)2 * 8 * 4 * 64 * 1280 * 2);
constexpr size_t WS_END = OFF_ubuf + AL256((size_t)NTOK * DFF * 2);
constexpr size_t OFF_mix = OFF_ubuf + (size_t)96 * 1024 * 1024;
constexpr size_t OFF_Qwin = OFF_ubuf;
constexpr size_t OFF_Kwin_c = OFF_Qwin + AL256((size_t)NTOK * 512 * 2);
constexpr size_t OFF_Vtwin_c = OFF_Kwin_c + AL256((size_t)NCTX * 128 * 2);
constexpr size_t OFF_Qret = OFF_Vtwin_c + AL256((size_t)32 * 2 * 64 * 256 * 2);
constexpr size_t OFF_Kret = OFF_Qret + AL256((size_t)NTOK * 256 * 2);
constexpr size_t OFF_Gret = OFF_Kret + AL256((size_t)NTOK * 256 * 2);
constexpr size_t OFF_Vtret_c = OFF_Gret + AL256((size_t)NTOK * 256 * 2);
constexpr size_t OFF_Vtret_l = OFF_Vtret_c + AL256((size_t)32 * 4 * 64 * 256 * 2);
constexpr size_t OFF_Qmla = OFF_Vtret_l + AL256((size_t)8 * 4 * 64 * 1024 * 2);
constexpr size_t OFF_Kmla_c = OFF_Qmla + AL256((size_t)NTOK * 384 * 2);
constexpr size_t OFF_Vtmla_c = OFF_Kmla_c + AL256((size_t)32 * 4 * 256 * 96 * 2);
static_assert(OFF_Vtmla_c + (size_t)32 * 4 * 64 * 256 * 2 <= OFF_mix && OFF_mix + (size_t)NTOK * DM * 2 <= WS_END, "attention temporaries + mix must fit in the ubuf region");
static_assert(WS_END <= (size_t)256 * 1024 * 1024, "workspace must fit 256 MiB");

struct P {
  const float *x_prompt, *x_sample, *cache_win_k, *cache_win_v, *cache_mla_ckv, *cache_mla_krope, *state_ret,
      *c, *c_ctx, *w_mod, *b_mod, *norm1, *norm2, *w_in, *win_sink, *ret_decay, *ret_gn, *mla_kv_norm,
      *w_kv_b, *w_out, *w_up, *w_down, *final_norm;
  float* out;
  unsigned char* ws;
#define WSBUF(ty, name) __device__ __forceinline__ ty* name() const { return (ty*)(ws + OFF_##name); }
  WSBUF(unsigned, ctl) WSBUF(float, mod) WSBUF(float, ropeW) WSBUF(float, ropeM) WSBUF(float, rssA) WSBUF(float, rssB) WSBUF(float, sWin) WSBUF(float, sWup) WSBUF(bf16_t, WinT) WSBUF(bf16_t, WoutT) WSBUF(bf16_t, WupT) WSBUF(bf16_t, WdownT) WSBUF(bf16_t, WkvbT)
  WSBUF(bf16_t, hbuf) WSBUF(bf16_t, mix) WSBUF(bf16_t, Qwin) WSBUF(bf16_t, Kwin_c) WSBUF(bf16_t, Vtwin_c) WSBUF(bf16_t, Kwin_l)
  WSBUF(bf16_t, Vtwin_l) WSBUF(bf16_t, Qret) WSBUF(bf16_t, Kret) WSBUF(bf16_t, Gret) WSBUF(bf16_t, Vtret_c) WSBUF(bf16_t, Vtret_l)
  WSBUF(bf16_t, S0t) WSBUF(bf16_t, Qmla) WSBUF(bf16_t, ckvn) WSBUF(bf16_t, Kmla_c) WSBUF(bf16_t, Vtmla_c) WSBUF(bf16_t, Kmla_l)
  WSBUF(bf16_t, Vtmla_l) WSBUF(bf16_t, ubuf)
  __device__ __forceinline__ float* xw() const { return out; }
};

typedef float f32x2_t __attribute__((ext_vector_type(2)));
typedef __bf16 bf16x2_t __attribute__((ext_vector_type(2)));
__device__ __forceinline__ unsigned pk2(float lo, float hi) {
  const f32x2_t v = {lo, hi};
  const bf16x2_t b = __builtin_convertvector(v, bf16x2_t);
  return __builtin_bit_cast(unsigned, b);
}
__device__ __forceinline__ bf16_t f2bf(float f) { return (bf16_t)(pk2(f, 0.f) & 0xffffu); }
__device__ __forceinline__ float bf2f(bf16_t b) { return __uint_as_float(((unsigned)b) << 16); }
__device__ __forceinline__ float shx(float v, int mask, int ln) { return __int_as_float(__builtin_amdgcn_ds_bpermute((ln ^ mask) << 2, __float_as_int(v))); }
__device__ __forceinline__ float wave_sum(float v, int ln) {
#pragma unroll
  for (int o = 1; o < 64; o <<= 1) v += shx(v, o, ln);
  return v;
}
typedef const __attribute__((address_space(4))) unsigned char* kargp_t;
__device__ __forceinline__ P load_params(kargp_t kp) {
  asm volatile("" : "+s"(kp));
  P p;
  __builtin_memcpy(&p, kp, sizeof(P));
  return p;
}
__device__ __forceinline__ int my_tid(int wv) { int w = wv; asm volatile("" : "+s"(w)); int t = w * 64 + lane_id(); asm volatile("" : "+v"(t)); return t; }
__device__ __forceinline__ int my_bid() { int b = blockIdx.x; asm volatile("" : "+s"(b)); return b; }
__device__ __forceinline__ float fexp2(float x) { return __builtin_amdgcn_exp2f(x); }
__device__ __forceinline__ int mod_row(int m) { return m < NCTX ? 0 : 1 + ((m - NCTX) >> 10); }

__device__ __forceinline__ void st_rm_bf16(bf16_t* rp, int h, const f32x16& o) {
#pragma unroll
  for (int g = 0; g < 4; ++g) {
    uint2 u;
    u.x = pk2(o[4 * g], o[4 * g + 1]);
    u.y = pk2(o[4 * g + 2], o[4 * g + 3]);
    *(uint2*)(rp + 8 * g + 4 * h) = u;
  }
}
__device__ __forceinline__ void st_tr_bf16(bf16_t* bp, int stride, int h, const f32x16& o) {
#pragma unroll
  for (int i = 0; i < 16; ++i) bp[(size_t)((i & 3) + 8 * (i >> 2) + 4 * h) * stride] = f2bf(o[i]);
}

__device__ __forceinline__ void st8_bf16(bf16_t* rp, int fq, const f32x4& a, const f32x4& b) {
  *(uint2*)(rp + 4 * fq) = make_uint2(pk2(a[0], a[1]), pk2(a[2], a[3]));
  *(uint2*)(rp + 16 + 4 * fq) = make_uint2(pk2(b[0], b[1]), pk2(b[2], b[3]));
}
__device__ __forceinline__ void st8_f32(float* rp, int fq, const f32x4& a, const f32x4& b) {
  *(f32x4*)(rp + 4 * fq) = a;
  *(f32x4*)(rp + 16 + 4 * fq) = b;
}
__device__ __forceinline__ void st8_tr(bf16_t* bp, int stride, int fq, const f32x4& a, const f32x4& b) {
#pragma unroll
  for (int j = 0; j < 4; ++j) {
    bp[(size_t)(4 * fq + j) * stride] = f2bf(a[j]);
    bp[(size_t)(16 + 4 * fq + j) * stride] = f2bf(b[j]);
  }
}
__device__ __forceinline__ void rope8_win(f32x4& a, f32x4& b, int fq, const float* tab) {
  const f32x4 cs = *(const f32x4*)(tab + 4 * fq), sn = *(const f32x4*)(tab + 16 + 4 * fq);
  const f32x4 x = a, y = b;
  a = x * cs - y * sn;
  b = x * sn + y * cs;
}
__device__ __forceinline__ void rope8_mla(f32x4& a, f32x4& b, int fq, int ln, const float* tabr, const float* tabc) {
  const int fo = 4 * (fq & 1);
  {
    const f32x4 cs = *(const f32x4*)(tabr + fo), sn = *(const f32x4*)(tabr + 8 + fo);
#pragma unroll
    for (int j = 0; j < 4; ++j) { const float pa = shx(a[j], 32, ln); a[j] = fq < 2 ? a[j] * cs[j] - pa * sn[j] : pa * sn[j] + a[j] * cs[j]; }
  }
  asm volatile("" ::: "memory");
  {
    const f32x4 cs = *(const f32x4*)(tabc + fo), sn = *(const f32x4*)(tabc + 8 + fo);
#pragma unroll
    for (int j = 0; j < 4; ++j) { const float pb = shx(b[j], 32, ln); b[j] = fq < 2 ? b[j] * cs[j] - pb * sn[j] : pb * sn[j] + b[j] * cs[j]; }
  }
}


__device__ __forceinline__ void st8p_bf16(bf16_t* rp, int fq, const f32x4& a, const f32x4& b) {
  *(uint4*)(rp + 8 * fq) = make_uint4(pk2(a[0], a[1]), pk2(a[2], a[3]), pk2(b[0], b[1]), pk2(b[2], b[3]));
}
__device__ __forceinline__ void st8p_f32(float* rp, int fq, const f32x4& a, const f32x4& b) {
  __builtin_nontemporal_store(a, (f32x4*)(rp + 8 * fq));
  __builtin_nontemporal_store(b, (f32x4*)(rp + 8 * fq + 4));
}
__device__ __forceinline__ void st8p_tr(bf16_t* bp, int stride, int fq, const f32x4& a, const f32x4& b) {
#pragma unroll
  for (int j = 0; j < 4; ++j) {
    bp[(size_t)(8 * fq + j) * stride] = f2bf(a[j]);
    bp[(size_t)(8 * fq + 4 + j) * stride] = f2bf(b[j]);
  }
}
__device__ __forceinline__ void rope8p_win(f32x4& a, f32x4& b, int fq, int ln, const float* tab) {
  const int f0 = 8 * (fq & 1);
  const f32x4 ca = *(const f32x4*)(tab + f0), cb4 = *(const f32x4*)(tab + f0 + 4), sa = *(const f32x4*)(tab + 16 + f0), sb = *(const f32x4*)(tab + 16 + f0 + 4);
#pragma unroll
  for (int j = 0; j < 4; ++j) {
    const float pa = shx(a[j], 32, ln), pb = shx(b[j], 32, ln);
    a[j] = fq < 2 ? a[j] * ca[j] - pa * sa[j] : pa * sa[j] + a[j] * ca[j];
    b[j] = fq < 2 ? b[j] * cb4[j] - pb * sb[j] : pb * sb[j] + b[j] * cb4[j];
  }
}
__device__ __forceinline__ void rope8p_mla(f32x4& a, f32x4& b, int fq, int ln, const float* tabr, const float* tabc) {
  const float* tab = fq < 2 ? tabr : tabc;
  const f32x4 ca = *(const f32x4*)(tab), cb4 = *(const f32x4*)(tab + 4), sa = *(const f32x4*)(tab + 8), sb = *(const f32x4*)(tab + 12);
#pragma unroll
  for (int j = 0; j < 4; ++j) {
    const float pa = shx(a[j], 16, ln), pb = shx(b[j], 16, ln);
    a[j] = (fq & 1) == 0 ? a[j] * ca[j] - pa * sa[j] : pa * sa[j] + a[j] * ca[j];
    b[j] = (fq & 1) == 0 ? b[j] * cb4[j] - pb * sb[j] : pb * sb[j] + b[j] * cb4[j];
  }
}

__device__ __forceinline__ float row_rstd(const float* rss, int m) {
  const f32x4 a = *(const f32x4*)(rss + (size_t)m * 16), b = *(const f32x4*)(rss + (size_t)m * 16 + 4);
  const f32x4 c = *(const f32x4*)(rss + (size_t)m * 16 + 8), d = *(const f32x4*)(rss + (size_t)m * 16 + 12);
  const f32x4 s = (a + b) + (c + d);
  return rsqrtf(((s[0] + s[1]) + (s[2] + s[3])) * (1.f / 1024.f) + 1e-6f);
}

typedef f32x4 acc_t[2][2][4][2];
template <int V> struct IC { static constexpr int value = V; };
extern __shared__ __attribute__((aligned(16))) unsigned char smem[];
struct EpiIn8 {
  static constexpr bool PERM = true, AFTER_DRAIN = false;
  P p0; int l; kargp_t kp;
  __device__ __forceinline__ void operator()(const acc_t& acc, const Unit& u, int wr, int wc, int fr_in, int fq_in) const {
    int fr = fr_in; asm volatile("" : "+v"(fr));
    int fq = fq_in; asm volatile("" : "+v"(fq));
    const int ln = fq * 16 + fr; (void)ln;
    P p = p0; asm volatile("" : "+s"(p.ws), "+s"(p.out));
    const bool lat = u.pm >= 32;
    const int rbase = u.pm * 256 + wr * 64 + fr;
#define ROWS_BEGIN _Pragma("unroll") for (int ai = 0; ai < 2; ++ai) _Pragma("unroll") for (int mm = 0; mm < 4; ++mm) { \
      int m = rbase + ai * 128 + mm * 16; asm volatile("" : "+v"(m)); int b, s; \
      if (!lat) { b = m >> 8; s = m & 255; } else { b = (m - NCTX) >> 10; s = (m - NCTX) & 1023; } \
      const float rsd = rsdv[ai][mm]; \
      f32x4 v0 = acc[ai][bj][mm][0] * rsd + sw0, v1 = acc[ai][bj][mm][1] * rsd + sw1; (void)b; (void)s;
#define ROWS_END }
    float rsdv[2][4];
    {
      const float* rss = p.rssA();
#pragma unroll
      for (int ai = 0; ai < 2; ++ai)
#pragma unroll
        for (int mm = 0; mm < 4; ++mm) rsdv[ai][mm] = row_rstd(rss, rbase + ai * 128 + mm * 16);
    }
    auto do_half = [&](auto BJ) {
      constexpr int bj = decltype(BJ)::value;
      const int nb = u.pn * 256 + bj * 128 + wc * 32;
      if (nb >= DIN) return;
      const float* swp = p.sWin() + ((size_t)(l * 9 + (lat ? 1 + ((u.pm - 32) >> 2) : 0))) * DINP + nb;
      const f32x4 sw0 = *(const f32x4*)(swp + 8 * fq), sw1 = *(const f32x4*)(swp + 8 * fq + 4);
      if (nb < 512) {
        ROWS_BEGIN
          if (lat) rope8p_win(v0, v1, fq, ln, (const float*)(smem + LDS_ROPEW) + ((nb & 32) ? (s & 63) : (s >> 6)) * 32);
          st8p_bf16(p.Qwin() + (size_t)m * 512 + nb, fq, v0, v1);
        ROWS_END
      } else if (nb < 640) {
        const int c = nb - 512;
        ROWS_BEGIN
          if (!lat) {
            st8p_f32(p.out + 16777216 + ((size_t)((b * 2 + l) * 256 + s)) * 128 + c, fq, v0, v1);
            st8p_bf16(p.Kwin_c() + (size_t)m * 128 + c, fq, v0, v1);
          } else {
            rope8p_win(v0, v1, fq, ln, (const float*)(smem + LDS_ROPEW) + ((nb & 32) ? (s & 63) : (s >> 6)) * 32);
            st8p_bf16(p.Kwin_l() + ((size_t)((l * 8 + b) * 1280 + s)) * 128 + c, fq, v0, v1);
          }
        ROWS_END
      } else if (nb < 768) {
        const int c = nb - 640, kv = c >> 6, d0 = c & 63;
        ROWS_BEGIN
          if (!lat) {
            st8p_f32(p.out + 18874368 + ((size_t)((b * 2 + l) * 256 + s)) * 128 + c, fq, v0, v1);
            st8p_tr(p.Vtwin_c() + ((size_t)((b * 2 + kv) * 64 + d0)) * 256 + s, 256, fq, v0, v1);
          } else {
            st8p_tr(p.Vtwin_l() + ((size_t)(((l * 8 + b) * 2 + kv) * 64 + d0)) * 1280 + s, 1280, fq, v0, v1);
          }
        ROWS_END
      } else if (nb < 1024) {
        ROWS_BEGIN
          st8p_bf16(p.Qret() + (size_t)m * 256 + (nb - 768), fq, v0, v1);
        ROWS_END
      } else if (nb < 1280) {
        ROWS_BEGIN
          st8p_bf16(p.Kret() + (size_t)m * 256 + (nb - 1024), fq, v0, v1);
        ROWS_END
      } else if (nb < 1536) {
        const int c = nb - 1280, hh = c >> 6, d0 = c & 63;
        ROWS_BEGIN
          if (!lat) st8p_tr(p.Vtret_c() + ((size_t)((b * 4 + hh) * 64 + d0)) * 256 + s, 256, fq, v0, v1);
          else st8p_tr(p.Vtret_l() + ((size_t)((b * 4 + hh) * 64 + d0)) * 1024 + s, 1024, fq, v0, v1);
        ROWS_END
      } else if (nb < 1792) {
        ROWS_BEGIN
          st8p_bf16(p.Gret() + (size_t)m * 256 + (nb - 1536), fq, v0, v1);
        ROWS_END
      } else if (nb < 2176) {
        const int c = nb - 1792;
        const bool rp = lat && (c % 96) == 64;
        ROWS_BEGIN
          if (rp) rope8p_mla(v0, v1, fq, ln, (const float*)(smem + LDS_ROPEM) + (s >> 6) * 16, (const float*)(smem + LDS_ROPEM) + (s & 63) * 16);
          st8p_bf16(p.Qmla() + (size_t)m * 384 + c, fq, v0, v1);
        ROWS_END
      } else if (nb < 2304) {
        const int c = nb - 2176;
        float* red = (float*)(smem + LDS_RED);
        kargp_t k2 = kp; asm volatile("" : "+s"(k2));
        const float* g = ((const __attribute__((address_space(4))) P*)k2)->mla_kv_norm + l * 128 + c;
        const f32x4 g0 = *(const f32x4*)(g + 8 * fq), g1 = *(const f32x4*)(g + 8 * fq + 4);
#pragma unroll
        for (int ai = 0; ai < 2; ++ai)
#pragma unroll
          for (int mm = 0; mm < 4; ++mm) {
            const float rsd0 = rsdv[ai][mm];
            const f32x4 a = acc[ai][bj][mm][0] * rsd0 + sw0, b4 = acc[ai][bj][mm][1] * rsd0 + sw1;
            float ss = a[0] * a[0] + a[1] * a[1] + a[2] * a[2] + a[3] * a[3] + b4[0] * b4[0] + b4[1] * b4[1] + b4[2] * b4[2] + b4[3] * b4[3];
            ss += shx(ss, 16, ln);
            ss += shx(ss, 32, ln);
            if (fq == 0) red[wc * 256 + ai * 128 + wr * 64 + mm * 16 + fr] = ss;
          }
        asm volatile("s_waitcnt lgkmcnt(0)" ::: "memory");
        __builtin_amdgcn_s_barrier();
        ROWS_BEGIN
          const int rt = ai * 128 + wr * 64 + mm * 16 + fr;
          const float rsv = rsqrtf((red[rt] + red[256 + rt] + red[512 + rt] + red[768 + rt]) * (1.f / 128.f) + 1e-6f);
          v0 = v0 * rsv * g0;
          v1 = v1 * rsv * g1;
          st8p_bf16(p.ckvn() + ((size_t)l * 18432 + m) * 128 + c, fq, v0, v1);
          if (!lat) st8p_f32(p.out + 20971520 + ((size_t)((b * 2 + l) * 256 + s)) * 128 + c, fq, v0, v1);
        ROWS_END
        asm volatile("s_waitcnt vmcnt(0) lgkmcnt(0)" ::: "memory");
        __builtin_amdgcn_s_barrier();
        if (wr == 0 && wc == 0 && ln == 0) {
          __builtin_amdgcn_fence(__ATOMIC_RELEASE, "agent");
          asm volatile("s_waitcnt vmcnt(0)" ::: "memory");
          __hip_atomic_fetch_add(p.ctl() + 64 * l, 1u, __ATOMIC_RELAXED, __HIP_MEMORY_SCOPE_AGENT);
        }
      } else {
        ROWS_BEGIN
          if (!lat) {
            st8p_f32(p.out + 23068672 + ((size_t)((b * 2 + l) * 256 + s)) * 32, fq, v0, v1);
#pragma unroll
            for (int hh = 0; hh < 4; ++hh) st8p_bf16(p.Kmla_c() + ((size_t)((b * 4 + hh) * 256 + s)) * 96 + 64, fq, v0, v1);
          } else {
            rope8p_mla(v0, v1, fq, ln, (const float*)(smem + LDS_ROPEM) + (s >> 6) * 16, (const float*)(smem + LDS_ROPEM) + (s & 63) * 16);
#pragma unroll
            for (int hh = 0; hh < 4; ++hh) st8p_bf16(p.Kmla_l() + ((size_t)(((l * 8 + b) * 4 + hh) * 1280 + s)) * 96 + 64, fq, v0, v1);
          }
        ROWS_END
      }
    };
    do_half(IC<0>{});
    do_half(IC<1>{});
#undef ROWS_BEGIN
#undef ROWS_END
  }
};

struct EpiOut8 {
  static constexpr bool PERM = true, AFTER_DRAIN = false;
  P p0; int l;
  __device__ __forceinline__ void operator()(const acc_t& acc, const Unit& u, int wr, int wc, int fr_in, int fq_in) const {
    int fr = fr_in; asm volatile("" : "+v"(fr));
    int fq = fq_in; asm volatile("" : "+v"(fq));
    const int ln = fq * 16 + fr; (void)ln;
    P p = p0; asm volatile("" : "+s"(p.ws), "+s"(p.out));
    const int rbase = u.pm * 256 + wr * 64 + fr;
    const int cb = u.pn * 256 + wc * 32 + 8 * fq;
    const float* md = p.mod() + ((size_t)(l * 9 + mod_row(u.pm * 256))) * 6144;
    const float* gate = md + 2 * 1024; const float* sc2 = md + 4 * 1024; const float* g2 = p.norm2 + l * DM;
#pragma unroll
    for (int ap = 0; ap < 4; ++ap) {
      constexpr int dummy = 0; (void)dummy;
      const int ai = ap >> 1, m2 = (ap & 1) * 2;
      int mb = rbase + ai * 128 + m2 * 16; asm volatile("" : "+v"(mb));
      f32x4 xv[2][2][2];
#pragma unroll
      for (int mq = 0; mq < 2; ++mq) {
        const int mm = m2 + mq;
        const int m = mb + mq * 16;
        if (l == 0) {
          const float* xr = m < NCTX ? p.x_prompt + (size_t)m * DM : p.x_sample + (size_t)(m - NCTX) * DM;
#pragma unroll
          for (int bj = 0; bj < 2; ++bj)
#pragma unroll
            for (int n = 0; n < 2; ++n) xv[mq][bj][n] = *(const f32x4*)(xr + cb + bj * 128 + n * 4);
        } else {
          const bf16_t* hr = p.hbuf() + (size_t)m * DM;
#pragma unroll
          for (int bj = 0; bj < 2; ++bj) {
            const uint4 h8 = *(const uint4*)(hr + cb + bj * 128);
#pragma unroll
            for (int n = 0; n < 2; ++n) {
              const int c = cb + bj * 128 + n * 4;
              uint2 hq; hq.x = n ? h8.z : h8.x; hq.y = n ? h8.w : h8.y;
              const f32x4 q1 = *(const f32x4*)(p.norm1 + DM + c) * (*(const f32x4*)(md + 1 * 1024 + c) + 1.f);
              f32x4 xm;
              xm[0] = __uint_as_float(hq.x << 16) * __builtin_amdgcn_rcpf(q1[0]); xm[1] = __uint_as_float(hq.x & 0xffff0000u) * __builtin_amdgcn_rcpf(q1[1]);
              xm[2] = __uint_as_float(hq.y << 16) * __builtin_amdgcn_rcpf(q1[2]); xm[3] = __uint_as_float(hq.y & 0xffff0000u) * __builtin_amdgcn_rcpf(q1[3]);
              xv[mq][bj][n] = xm;
            }
          }
        }
      }
#pragma unroll
      for (int mq = 0; mq < 2; ++mq) {
        const int mm = m2 + mq;
        const int m = mb + mq * 16;
        bf16_t* ho = p.hbuf() + (size_t)m * DM;
        float ss = 0.f;
#pragma unroll
        for (int bj = 0; bj < 2; ++bj) {
          unsigned pw[4];
#pragma unroll
          for (int n = 0; n < 2; ++n) {
            const int c = cb + bj * 128 + n * 4;
            const f32x4 xn = xv[mq][bj][n] + *(const f32x4*)(gate + c) * acc[ai][bj][mm][n];
            const f32x4 hv = xn * (*(const f32x4*)(g2 + c) * (*(const f32x4*)(sc2 + c) + 1.f));
            pw[2 * n] = pk2(hv[0], hv[1]); pw[2 * n + 1] = pk2(hv[2], hv[3]);
            ss += (xn[0] * xn[0] + xn[1] * xn[1]) + (xn[2] * xn[2] + xn[3] * xn[3]);
          }
          *(uint4*)(ho + cb + bj * 128) = make_uint4(pw[0], pw[1], pw[2], pw[3]);
        }
        ss += shx(ss, 16, ln);
        ss += shx(ss, 32, ln);
        if (fq == 0) p.rssB()[(size_t)m * 16 + u.pn * 4 + wc] = ss;
      }
      asm volatile("" ::: "memory");
    }
  }
};
struct EpiUp8 {
  static constexpr bool PERM = true, AFTER_DRAIN = false;
  P p0; int l;
  __device__ __forceinline__ void operator()(const acc_t& acc, const Unit& u, int wr, int wc, int fr_in, int fq_in) const {
    int fr = fr_in; asm volatile("" : "+v"(fr));
    int fq = fq_in; asm volatile("" : "+v"(fq));
    const int ln = fq * 16 + fr; (void)ln;
    P p = p0; asm volatile("" : "+s"(p.ws), "+s"(p.out));
    const int rbase = u.pm * 256 + wr * 64 + fr;
    const int cb = u.pn * 256 + wc * 32 + 8 * fq;
    const float* swp = p.sWup() + ((size_t)(l * 9 + mod_row(u.pm * 256))) * DFF;
    float rsdv[2][4];
#pragma unroll
    for (int ai = 0; ai < 2; ++ai)
#pragma unroll
      for (int mm = 0; mm < 4; ++mm) rsdv[ai][mm] = row_rstd(p.rssB(), rbase + ai * 128 + mm * 16);
    f32x4 swv[2][2];
#pragma unroll
    for (int bj = 0; bj < 2; ++bj)
#pragma unroll
      for (int n = 0; n < 2; ++n) swv[bj][n] = *(const f32x4*)(swp + cb + bj * 128 + n * 4);
#pragma unroll
    for (int ai = 0; ai < 2; ++ai)
#pragma unroll
      for (int mm = 0; mm < 4; ++mm) {
        int m = rbase + ai * 128 + mm * 16; asm volatile("" : "+v"(m));
        bf16_t* uo = p.ubuf() + (size_t)m * DFF;
        const float rsd = rsdv[ai][mm];
#pragma unroll
        for (int bj = 0; bj < 2; ++bj) {
          f32x4 t0 = acc[ai][bj][mm][0] * rsd + swv[bj][0], t1 = acc[ai][bj][mm][1] * rsd + swv[bj][1];
#pragma unroll
          for (int j = 0; j < 4; ++j) { const float a = fmaxf(t0[j], 0.f), b = fmaxf(t1[j], 0.f); t0[j] = a * a; t1[j] = b * b; }
          __builtin_nontemporal_store((u32x4v){pk2(t0[0], t0[1]), pk2(t0[2], t0[3]), pk2(t1[0], t1[1]), pk2(t1[2], t1[3])}, (u32x4v*)(uo + cb + bj * 128));
        }
      }
  }
};
struct EpiDown8 {
  static constexpr bool PERM = true, AFTER_DRAIN = false;
  P p0; int l;
  __device__ __forceinline__ void operator()(const acc_t& acc, const Unit& u, int wr, int wc, int fr_in, int fq_in) const {
    int fr = fr_in; asm volatile("" : "+v"(fr));
    int fq = fq_in; asm volatile("" : "+v"(fq));
    const int ln = fq * 16 + fr; (void)ln;
    P p = p0; asm volatile("" : "+s"(p.ws), "+s"(p.out));
    const int rbase = u.pm * 256 + wr * 64 + fr;
    const int cb = u.pn * 256 + wc * 32 + 8 * fq;
    const int r = mod_row(u.pm * 256);
    const float* md = p.mod() + ((size_t)(l * 9 + r)) * 6144;
    const float* gate = md + 5 * 1024; const float* sc2 = md + 4 * 1024; const float* g2 = p.norm2 + l * DM;
    const float* sc1 = p.mod() + ((size_t)(9 + r)) * 6144 + 1 * 1024;
    const float* g1 = p.norm1 + DM;
    f32x4 riv[2][2];
#pragma unroll
    for (int bj = 0; bj < 2; ++bj)
#pragma unroll
      for (int n = 0; n < 2; ++n) {
        const int c = cb + bj * 128 + n * 4;
        const f32x4 q2 = *(const f32x4*)(g2 + c) * (*(const f32x4*)(sc2 + c) + 1.f);
#pragma unroll
        for (int j = 0; j < 4; ++j) riv[bj][n][j] = __builtin_amdgcn_rcpf(q2[j]);
      }
#pragma unroll
    for (int ap = 0; ap < 4; ++ap) {
      const int ai = ap >> 1, m2 = (ap & 1) * 2;
      int mb = rbase + ai * 128 + m2 * 16; asm volatile("" : "+v"(mb));
      uint4 hvv[2][2];
#pragma unroll
      for (int mq = 0; mq < 2; ++mq) {
        const bf16_t* hr = p.hbuf() + (size_t)(mb + mq * 16) * DM;
#pragma unroll
        for (int bj = 0; bj < 2; ++bj) hvv[mq][bj] = *(const uint4*)(hr + cb + bj * 128);
      }
#pragma unroll
      for (int mq = 0; mq < 2; ++mq) {
        const int mm = m2 + mq;
        const int m = mb + mq * 16;
        float* xo = p.xw() + (size_t)m * DM;
        bf16_t* ho = p.hbuf() + (size_t)m * DM;
        float ss = 0.f;
#pragma unroll
        for (int bj = 0; bj < 2; ++bj) {
          unsigned pw[4] = {0u, 0u, 0u, 0u};
#pragma unroll
          for (int n = 0; n < 2; ++n) {
            const int c = cb + bj * 128 + n * 4;
            uint2 hq; hq.x = n ? hvv[mq][bj].z : hvv[mq][bj].x; hq.y = n ? hvv[mq][bj].w : hvv[mq][bj].y;
            f32x4 xm;
            xm[0] = __uint_as_float(hq.x << 16); xm[1] = __uint_as_float(hq.x & 0xffff0000u);
            xm[2] = __uint_as_float(hq.y << 16); xm[3] = __uint_as_float(hq.y & 0xffff0000u);
            const f32x4 xn = xm * riv[bj][n] + *(const f32x4*)(gate + c) * acc[ai][bj][mm][n];
            if (l != 0) *(f32x4*)(xo + c) = xn;
            if (l == 0) {
              const f32x4 hv = xn * (*(const f32x4*)(g1 + c) * (*(const f32x4*)(sc1 + c) + 1.f));
              pw[2 * n] = pk2(hv[0], hv[1]); pw[2 * n + 1] = pk2(hv[2], hv[3]);
              ss += (xn[0] * xn[0] + xn[1] * xn[1]) + (xn[2] * xn[2] + xn[3] * xn[3]);
            }
          }
          if (l == 0) *(uint4*)(ho + cb + bj * 128) = make_uint4(pw[0], pw[1], pw[2], pw[3]);
        }
        if (l == 0) {
          ss += shx(ss, 16, ln);
          ss += shx(ss, 32, ln);
          if (fq == 0) p.rssA()[(size_t)m * 16 + u.pn * 4 + wc] = ss;
        }
      }
      asm volatile("" ::: "memory");
    }
  }
};

struct EpiKvb {
  P p; int l;
  __device__ __forceinline__ void operator()(int m, int nb, int h, const f32x16& v) const {
    const int hh = nb >> 7, j0 = nb & 127;
    bf16_t* Kb; bf16_t* Vb; int S, key;
    if (m < NCTX) {
      const int b = m >> 8; key = m & 255; S = 256;
      Kb = p.Kmla_c() + ((size_t)((b * 4 + hh) * 256)) * 96;
      Vb = p.Vtmla_c() + ((size_t)((b * 4 + hh) * 64)) * 256;
    } else {
      int b;
      if (m < NTOK) { b = (m - NCTX) >> 10; key = (m - NCTX) & 1023; }
      else { b = (m - NTOK) >> 8; key = 1024 + ((m - NTOK) & 255); }
      S = 1280;
      Kb = p.Kmla_l() + ((size_t)(((l * 8 + b) * 4 + hh) * 1280)) * 96;
      Vb = p.Vtmla_l() + ((size_t)(((l * 8 + b) * 4 + hh) * 64)) * 1280;
    }
    if (j0 < 64) st_rm_bf16(Kb + (size_t)key * 96 + j0, h, v);
    else st_tr_bf16(Vb + (size_t)(j0 - 64) * S + key, S, h, v);
  }
};

template <class Epi>
__device__ __forceinline__ void gemm_small(const bf16_t* __restrict__ A, int lda, const bf16_t* __restrict__ W, int ldw,
                                           int M, int N, int K, unsigned char* smem, const Epi& epi, const int wv, unsigned* ready, unsigned* ticket) {
  constexpr int TA = 256 * 72, TW = 128 * 72;
  bf16_t* sb = (bf16_t*)smem;
  const int tid = my_tid(wv), bid = my_bid(), lane = tid & 63, wave = tid >> 6;
  const int wm = wave >> 1, wn = wave & 1, r = lane & 31, h = lane >> 5;
  const int MT = M >> 8, NT = N >> 7, ntiles = MT * NT, nk = K >> 6;
  const int lc = tid & 7, lr = tid >> 3;
  (void)bid;
  if (tid == 0) {
    unsigned polls = 0;
    while (__hip_atomic_load(ready, __ATOMIC_RELAXED, __HIP_MEMORY_SCOPE_AGENT) < 64u && ++polls < (1u << 22)) __builtin_amdgcn_s_sleep(8);
    __builtin_amdgcn_fence(__ATOMIC_ACQUIRE, "agent");
    asm volatile("s_waitcnt vmcnt(0)" ::: "memory");
  }
  __syncthreads();
  volatile int* tks = (volatile int*)(smem + LDS_RED + 2048);
  for (;;) {
    __syncthreads();
    if (tid == 0) *tks = (int)__hip_atomic_fetch_add(ticket, 1u, __ATOMIC_RELAXED, __HIP_MEMORY_SCOPE_AGENT);
    __syncthreads();
    const int tile = *tks;
    if (tile >= ntiles) break;
    const int m0 = (tile % MT) << 8, n0 = (tile / MT) << 7;
    f32x16 acc[2][2];
#pragma unroll
    for (int a = 0; a < 2; ++a)
#pragma unroll
      for (int b = 0; b < 2; ++b)
#pragma unroll
        for (int i = 0; i < 16; ++i) acc[a][b][i] = 0.f;
    uint4 ra[4], rw[2];
    const bf16_t* Ap = A + (size_t)(m0 + lr) * lda + lc * 8;
    const bf16_t* Wp = W + (size_t)(n0 + lr) * ldw + lc * 8;
    auto gload = [&](int kt) {
#pragma unroll
      for (int i = 0; i < 4; ++i) ra[i] = *(const uint4*)(Ap + (size_t)(64 * i) * lda + kt * 64);
#pragma unroll
      for (int i = 0; i < 2; ++i) rw[i] = *(const uint4*)(Wp + (size_t)(64 * i) * ldw + kt * 64);
    };
    auto swrite = [&](int bsel) {
      bf16_t* sA = sb + bsel * (TA + TW); bf16_t* sW = sA + TA;
#pragma unroll
      for (int i = 0; i < 4; ++i) *(uint4*)(sA + (lr + 64 * i) * 72 + lc * 8) = ra[i];
#pragma unroll
      for (int i = 0; i < 2; ++i) *(uint4*)(sW + (lr + 64 * i) * 72 + lc * 8) = rw[i];
    };
    __syncthreads();
    gload(0); swrite(0);
    __syncthreads();
    for (int kt = 0; kt < nk; ++kt) {
      if (kt + 1 < nk) gload(kt + 1);
      const bf16_t* sA = sb + (kt & 1) * (TA + TW); const bf16_t* sW = sA + TA;
#pragma unroll
      for (int ks = 0; ks < 4; ++ks) {
        bf16x8 wf[2], af[2];
#pragma unroll
        for (int i = 0; i < 2; ++i) {
          wf[i] = *(const bf16x8*)(sW + (wn * 64 + i * 32 + r) * 72 + ks * 16 + h * 8);
          af[i] = *(const bf16x8*)(sA + (wm * 64 + i * 32 + r) * 72 + ks * 16 + h * 8);
        }
#pragma unroll
        for (int a = 0; a < 2; ++a)
#pragma unroll
          for (int b = 0; b < 2; ++b) acc[a][b] = __builtin_amdgcn_mfma_f32_32x32x16_bf16(wf[a], af[b], acc[a][b], 0, 0, 0);
      }
      if (kt + 1 < nk) swrite((kt + 1) & 1);
      __syncthreads();
    }
#pragma unroll
    for (int a = 0; a < 2; ++a)
#pragma unroll
      for (int b = 0; b < 2; ++b) epi(m0 + wm * 64 + b * 32 + r, n0 + wn * 64 + a * 32, h, acc[a][b]);
  }
}

struct AttnItem {
  const bf16_t* Q; int qs;
  const bf16_t* K; int ks;
  const bf16_t* Vt; int vs;
  int t0, t1, t2, t3;
  int qpos0, T;
  float scale, sink_l2; int has_sink;
  float lgf, lgb;
  const bf16_t *S0f, *S0b;
  const bf16_t* G; const float* gn;
  bf16_t* out;
  float* sout;
};

template <int DQK, int MODE>
__device__ __forceinline__ void attn_item(const AttnItem& it, unsigned char* smem, const int wv) {
  constexpr int KSTR = DQK + 8, NKS = DQK / 16, VSTR = 68, KCH = DQK / 8;
  bf16_t* Ks = (bf16_t*)smem;
  bf16_t* Vs = Ks + 64 * KSTR;
  const int tid = my_tid(wv), lane = tid & 63, wave = tid >> 6, r = lane & 31, h = lane >> 5;
  const int qrow = wave * 32 + r;
  bf16x8 qf[NKS];
  if constexpr (MODE == 3) {
    const int dq = (wave & 1) * 32 + r;
#pragma unroll
    for (int ks = 0; ks < NKS; ++ks) {
      const int e = dq - (ks * 16 + h * 8);
      uint4 v;
      v.x = e == 0 ? 0x3F80u : (e == 1 ? 0x3F800000u : 0u);
      v.y = e == 2 ? 0x3F80u : (e == 3 ? 0x3F800000u : 0u);
      v.z = e == 4 ? 0x3F80u : (e == 5 ? 0x3F800000u : 0u);
      v.w = e == 6 ? 0x3F80u : (e == 7 ? 0x3F800000u : 0u);
      qf[ks] = __builtin_bit_cast(bf16x8, v);
    }
  } else {
#pragma unroll
    for (int ks = 0; ks < NKS; ++ks) qf[ks] = *(const bf16x8*)(it.Q + (size_t)qrow * it.qs + ks * 16 + h * 8);
  }
  f32x16 o0, o1;
#pragma unroll
  for (int i = 0; i < 16; ++i) { o0[i] = 0.f; o1[i] = 0.f; }
  float mrun = it.has_sink ? it.sink_l2 : -1e30f, lrun = 0.f;
  const int qp = it.qpos0 + qrow;
  const int n1 = it.t1 - it.t0, ntl = n1 + (it.t3 - it.t2);
  constexpr int BUFE = 64 * KSTR + 64 * VSTR;
  const int krow0 = tid / KCH, kch0 = tid % KCH, krow1 = (tid + NTHR) / KCH, kch1 = (tid + NTHR) % KCH;
  const bool k2 = (KCH == 12) && (tid + NTHR < 64 * KCH);
  const int vrow = tid >> 3, vch = tid & 7;
  uint4 rk0, rk1, rv;
  auto tile_of = [&](int ti) { return ti < n1 ? it.t0 + ti : it.t2 + (ti - n1); };
  auto gload = [&](int t) {
    const bool stt = (MODE == 2) && (t >= 16);
    if (!stt) {
      const int key0 = t * 64;
      rk0 = *(const uint4*)(it.K + (size_t)(key0 + krow0) * it.ks + kch0 * 8);
      if (k2) rk1 = *(const uint4*)(it.K + (size_t)(key0 + krow1) * it.ks + kch1 * 8);
      rv = *(const uint4*)(it.Vt + (size_t)vrow * it.vs + key0 + vch * 8);
    } else {
      const bf16_t* S = (t == 16) ? it.S0f : it.S0b;
      const int e = krow0 - kch0 * 8;
      rk0.x = e == 0 ? 0x3F80u : (e == 1 ? 0x3F800000u : 0u);
      rk0.y = e == 2 ? 0x3F80u : (e == 3 ? 0x3F800000u : 0u);
      rk0.z = e == 4 ? 0x3F80u : (e == 5 ? 0x3F800000u : 0u);
      rk0.w = e == 6 ? 0x3F80u : (e == 7 ? 0x3F800000u : 0u);
      rv = *(const uint4*)(S + (size_t)vrow * 64 + vch * 8);
    }
  };
  auto swrite = [&](int bsel) {
    bf16_t* Kb = Ks + bsel * BUFE; bf16_t* Vb = Kb + 64 * KSTR;
    *(uint4*)(Kb + krow0 * KSTR + kch0 * 8) = rk0;
    if (k2) *(uint4*)(Kb + krow1 * KSTR + kch1 * 8) = rk1;
    uint2* d = (uint2*)(Vb + vrow * VSTR + vch * 8);
    d[0] = make_uint2(rv.x, rv.y); d[1] = make_uint2(rv.z, rv.w);
  };
  __syncthreads();
  gload(tile_of(0)); swrite(0);
  __syncthreads();
  for (int ti = 0; ti < ntl; ++ti) {
    const int t = tile_of(ti);
    const bool st_tile = (MODE == 2) && (t >= 16);
    const int key0 = t * 64;
    const bool more = ti + 1 < ntl;
    if (more) gload(tile_of(ti + 1));
    const bf16_t* Kc = Ks + (ti & 1) * BUFE; const bf16_t* Vc = Kc + 64 * KSTR;
    bool skip = (MODE == 3) && (wave >= 4);
    if (MODE == 1 && t < 16) {
      const int qlo = it.qpos0 + wave * 32;
      skip = (key0 > qlo + 31 + 128 || key0 + 63 < qlo - 128);
    }
    if (!skip) {
    f32x16 s0, s1;
#pragma unroll
    for (int i = 0; i < 16; ++i) { s0[i] = 0.f; s1[i] = 0.f; }
#pragma unroll
    for (int ks = 0; ks < NKS; ++ks) {
      const bf16x8 k0 = *(const bf16x8*)(Kc + r * KSTR + ks * 16 + h * 8);
      const bf16x8 k1 = *(const bf16x8*)(Kc + (32 + r) * KSTR + ks * 16 + h * 8);
      s0 = __builtin_amdgcn_mfma_f32_32x32x16_bf16(k0, qf[ks], s0, 0, 0, 0);
      s1 = __builtin_amdgcn_mfma_f32_32x32x16_bf16(k1, qf[ks], s1, 0, 0, 0);
    }
    if constexpr (MODE == 3) {
      if (wave < 2) {
        const float base = (float)(it.T - 1 - key0 - 4 * h) * it.lgf - 3.f;
#pragma unroll
        for (int i = 0; i < 16; ++i) {
          s0[i] *= fexp2(fmaf(-(float)((i & 3) + 8 * (i >> 2)), it.lgf, base));
          s1[i] *= fexp2(fmaf(-(float)(32 + (i & 3) + 8 * (i >> 2)), it.lgf, base));
        }
      } else {
        const float base = (float)(key0 + 4 * h) * it.lgb - 3.f;
#pragma unroll
        for (int i = 0; i < 16; ++i) {
          s0[i] *= fexp2(fmaf((float)((i & 3) + 8 * (i >> 2)), it.lgb, base));
          s1[i] *= fexp2(fmaf((float)(32 + (i & 3) + 8 * (i >> 2)), it.lgb, base));
        }
      }
    } else if constexpr (MODE == 2) {
      if (!st_tile) {
        const int qlo = it.qpos0 + wave * 32;
        if (key0 + 63 < qlo) {
          const float base = (float)(qp - key0 - 4 * h) * it.lgf - 3.f;
#pragma unroll
          for (int i = 0; i < 16; ++i) {
            s0[i] *= fexp2(fmaf(-(float)((i & 3) + 8 * (i >> 2)), it.lgf, base));
            s1[i] *= fexp2(fmaf(-(float)(32 + (i & 3) + 8 * (i >> 2)), it.lgf, base));
          }
        } else if (key0 > qlo + 31) {
          const float base = (float)(key0 + 4 * h - qp) * it.lgb - 3.f;
#pragma unroll
          for (int i = 0; i < 16; ++i) {
            s0[i] *= fexp2(fmaf((float)((i & 3) + 8 * (i >> 2)), it.lgb, base));
            s1[i] *= fexp2(fmaf((float)(32 + (i & 3) + 8 * (i >> 2)), it.lgb, base));
          }
        } else {
#pragma unroll
        for (int i = 0; i < 16; ++i) {
          const int key = key0 + (i & 3) + 8 * (i >> 2) + 4 * h;
          const int e0 = qp - key, e1 = e0 - 32;
          float d0 = fexp2((float)(e0 < 0 ? -e0 : e0) * (e0 > 0 ? it.lgf : it.lgb));
          float d1 = fexp2((float)(e1 < 0 ? -e1 : e1) * (e1 > 0 ? it.lgf : it.lgb));
          d0 = e0 == 0 ? 2.f : d0;
          d1 = e1 == 0 ? 2.f : d1;
          s0[i] *= it.scale * d0;
          s1[i] *= it.scale * d1;
        }
        }
      } else {
        const float dec = (t == 16) ? fexp2((float)(qp + 1) * it.lgf) : fexp2((float)(it.T - qp) * it.lgb);
#pragma unroll
        for (int i = 0; i < 16; ++i) { s0[i] *= dec; s1[i] *= dec; }
      }
    } else {
      float mx = -INFINITY;
      const int qlo1 = it.qpos0 + wave * 32;
      const bool need_mask = (MODE == 1) && (t < 16) && !(key0 >= qlo1 + 31 - 128 && key0 + 63 <= qlo1 + 128);
#pragma unroll
      for (int i = 0; i < 16; ++i) {
        float a = s0[i] * it.scale, b = s1[i] * it.scale;
        if (MODE == 1 && need_mask) {
          const int key = key0 + (i & 3) + 8 * (i >> 2) + 4 * h;
          const int e0 = key - qp, e1 = e0 + 32;
          if (e0 > 128 || e0 < -128) a = -INFINITY;
          if (e1 > 128 || e1 < -128) b = -INFINITY;
        }
        s0[i] = a; s1[i] = b;
        mx = fmaxf(mx, fmaxf(a, b));
      }
      mx = fmaxf(mx, shx(mx, 32, lane));
      const float mnew = fmaxf(mrun, mx);
      const float alpha = fexp2(mrun - mnew);
      float sum = 0.f;
#pragma unroll
      for (int i = 0; i < 16; ++i) {
        s0[i] = fexp2(s0[i] - mnew);
        s1[i] = fexp2(s1[i] - mnew);
        sum += s0[i] + s1[i];
      }
      lrun = lrun * alpha + sum;
      mrun = mnew;
#pragma unroll
      for (int i = 0; i < 16; ++i) { o0[i] *= alpha; o1[i] *= alpha; }
    }
#pragma unroll
    for (int kt = 0; kt < 2; ++kt) {
#pragma unroll
      for (int sbk = 0; sbk < 2; ++sbk) {
        uint4 pw;
        if (kt == 0) {
          pw.x = pk2(s0[8 * sbk + 0], s0[8 * sbk + 1]); pw.y = pk2(s0[8 * sbk + 2], s0[8 * sbk + 3]);
          pw.z = pk2(s0[8 * sbk + 4], s0[8 * sbk + 5]); pw.w = pk2(s0[8 * sbk + 6], s0[8 * sbk + 7]);
        } else {
          pw.x = pk2(s1[8 * sbk + 0], s1[8 * sbk + 1]); pw.y = pk2(s1[8 * sbk + 2], s1[8 * sbk + 3]);
          pw.z = pk2(s1[8 * sbk + 4], s1[8 * sbk + 5]); pw.w = pk2(s1[8 * sbk + 6], s1[8 * sbk + 7]);
        }
        const bf16x8 pf = __builtin_bit_cast(bf16x8, pw);
        const int koff = kt * 32 + sbk * 16 + 4 * h;
        const uint2 a0 = *(const uint2*)(Vc + r * VSTR + koff), a1 = *(const uint2*)(Vc + r * VSTR + koff + 8);
        const uint2 b0 = *(const uint2*)(Vc + (32 + r) * VSTR + koff), b1 = *(const uint2*)(Vc + (32 + r) * VSTR + koff + 8);
        const bf16x8 v0 = __builtin_bit_cast(bf16x8, make_uint4(a0.x, a0.y, a1.x, a1.y));
        const bf16x8 v1 = __builtin_bit_cast(bf16x8, make_uint4(b0.x, b0.y, b1.x, b1.y));
        o0 = __builtin_amdgcn_mfma_f32_32x32x16_bf16(v0, pf, o0, 0, 0, 0);
        o1 = __builtin_amdgcn_mfma_f32_32x32x16_bf16(v1, pf, o1, 0, 0, 0);
      }
    }
    }
    if (more) swrite((ti + 1) & 1);
    __syncthreads();
  }
  if constexpr (MODE == 3) {
    if (wave < 4) {
      float* rowp = it.sout + (size_t)(wave >> 1) * 16384 + (size_t)((wave & 1) * 32 + r) * 64;
#pragma unroll
      for (int g = 0; g < 4; ++g) {
        *(float4*)(rowp + 8 * g + 4 * h) = make_float4(o0[4 * g], o0[4 * g + 1], o0[4 * g + 2], o0[4 * g + 3]);
        *(float4*)(rowp + 32 + 8 * g + 4 * h) = make_float4(o1[4 * g], o1[4 * g + 1], o1[4 * g + 2], o1[4 * g + 3]);
      }
    }
    return;
  }
  bf16_t* orow = it.out + (size_t)qrow * DM;
  if constexpr (MODE == 2) {
    float sm = 0.f;
#pragma unroll
    for (int i = 0; i < 16; ++i) sm += o0[i] + o1[i];
    sm += shx(sm, 32, lane);
    const float mu = sm * (1.f / 64.f);
    float vr = 0.f;
#pragma unroll
    for (int i = 0; i < 16; ++i) { o0[i] -= mu; o1[i] -= mu; vr += o0[i] * o0[i] + o1[i] * o1[i]; }
    vr += shx(vr, 32, lane);
    const float rstd = rsqrtf(vr * (1.f / 64.f) + 1e-6f);
    const bf16_t* grow = it.G + (size_t)qrow * 256;
#pragma unroll
    for (int g = 0; g < 4; ++g) {
      const int d = 8 * g + 4 * h;
      const uint2 ga = *(const uint2*)(grow + d), gb = *(const uint2*)(grow + 32 + d);
      const float gav[4] = {__uint_as_float(ga.x << 16), __uint_as_float(ga.x & 0xffff0000u), __uint_as_float(ga.y << 16), __uint_as_float(ga.y & 0xffff0000u)};
      const float gbv[4] = {__uint_as_float(gb.x << 16), __uint_as_float(gb.x & 0xffff0000u), __uint_as_float(gb.y << 16), __uint_as_float(gb.y & 0xffff0000u)};
#pragma unroll
      for (int j = 0; j < 4; ++j) {
        const float x0 = gav[j], x1 = gbv[j];
        o0[4 * g + j] = o0[4 * g + j] * rstd * it.gn[d + j] * (x0 / (1.f + __expf(-x0)));
        o1[4 * g + j] = o1[4 * g + j] * rstd * it.gn[32 + d + j] * (x1 / (1.f + __expf(-x1)));
      }
    }
  } else {
    float lt = lrun + shx(lrun, 32, lane);
    if (it.has_sink) lt += fexp2(it.sink_l2 - mrun);
    const float inv = 1.f / lt;
#pragma unroll
    for (int i = 0; i < 16; ++i) { o0[i] *= inv; o1[i] *= inv; }
  }
  st_rm_bf16(orow, h, o0);
  st_rm_bf16(orow + 32, h, o1);
}

__device__ __forceinline__ float log2_sigmoid(float x) { return -log1pf(expf(-x)) * LOG2E; }

__device__ __forceinline__ void state_item(const P& p, int l, int idx, unsigned char* smem, const int wv) {
  const int b = idx >> 3, hh = (idx >> 1) & 3, dir = idx & 1;
  float* Ksm = (float*)smem;
  float* Vsm = Ksm + 4096;
  const int tid = my_tid(wv);
  const float lg = log2_sigmoid(p.ret_decay[(l * 2 + dir) * 4 + hh]);
  float acc[8];
#pragma unroll
  for (int i = 0; i < 8; ++i) acc[i] = 0.f;
  const int d = tid >> 3, e0 = (tid & 7) * 8;
  for (int c = 0; c < 4; ++c) {
    __syncthreads();
    for (int i = tid; i < 4096; i += NTHR) {
      const int j = i >> 6, dd = i & 63, tok = c * 64 + j;
      const float dec = dir == 0 ? fexp2((float)(255 - tok) * lg) : fexp2((float)tok * lg);
      Ksm[j * 64 + dd] = bf2f(p.Kret()[(size_t)(b * 256 + tok) * 256 + hh * 64 + dd]) * 0.125f * dec;
      const int e = i >> 6, jj = i & 63;
      Vsm[e * 65 + jj] = bf2f(p.Vtret_c()[((size_t)((b * 4 + hh) * 64 + e)) * 256 + c * 64 + jj]);
    }
    __syncthreads();
    for (int j = 0; j < 64; ++j) {
      const float kd = Ksm[j * 64 + d];
#pragma unroll
      for (int i = 0; i < 8; ++i) acc[i] += kd * Vsm[(e0 + i) * 65 + j];
    }
  }
  float* op = p.out + 23592960 + ((size_t)((((b * 2 + l) * 2 + dir) * 4 + hh) * 64 + d)) * 64 + e0;
  *(float4*)(op) = make_float4(acc[0], acc[1], acc[2], acc[3]);
  *(float4*)(op + 4) = make_float4(acc[4], acc[5], acc[6], acc[7]);
}

__device__ __forceinline__ void attn_phase(const P& p, int l, unsigned char* smem, const int wv) {
  constexpr int NA = 128, NB = 128, NC = 256, ND = 256, NE = 128, NF = 128, NG = 128;
  constexpr int TOT = NA + NB + NC + ND + NE + NF + NG;
  unsigned* ticket = p.ctl() + 32 + 64 * l;
  volatile int* tks = (volatile int*)(smem + LDS_RED + 2048);
  const int tid0 = my_tid(wv);
  for (;;) {
    __syncthreads();
    if (tid0 == 0) *tks = (int)__hip_atomic_fetch_add(ticket, 1u, __ATOMIC_RELAXED, __HIP_MEMORY_SCOPE_AGENT);
    __syncthreads();
    const int item = *tks;
    if (item >= TOT) break;
    int idx = item;
    AttnItem it;
    it.t2 = 0; it.t3 = 0; it.qpos0 = 0; it.T = 0; it.sink_l2 = 0.f; it.has_sink = 0; it.lgf = 0.f; it.lgb = 0.f;
    it.S0f = nullptr; it.S0b = nullptr; it.G = nullptr; it.gn = nullptr; it.sout = nullptr;
    if (idx < NA) {
      const int b = idx >> 4, hh = (idx >> 2) & 3, qb = idx & 3, row0 = NCTX + b * 1024 + qb * 256;
      it.Q = p.Qmla() + (size_t)row0 * 384 + hh * 96; it.qs = 384;
      it.K = p.Kmla_l() + ((size_t)(((l * 8 + b) * 4 + hh) * 1280)) * 96; it.ks = 96;
      it.Vt = p.Vtmla_l() + ((size_t)(((l * 8 + b) * 4 + hh) * 64)) * 1280; it.vs = 1280;
      it.t0 = 0; it.t1 = 20;
      it.scale = 0.10206207261596575f * LOG2E;
      it.out = p.mix() + (size_t)row0 * DM + 768 + hh * 64;
      attn_item<96, 0>(it, smem, wv);
      continue;
    }
    idx -= NA;
    if (idx < NB) {
      const int b = idx >> 4, hh = (idx >> 2) & 3, qb = idx & 3, row0 = NCTX + b * 1024 + qb * 256;
      it.Q = p.Qret() + (size_t)row0 * 256 + hh * 64; it.qs = 256;
      it.K = p.Kret() + (size_t)(NCTX + b * 1024) * 256 + hh * 64; it.ks = 256;
      it.Vt = p.Vtret_l() + ((size_t)((b * 4 + hh) * 64)) * 1024; it.vs = 1024;
      it.t0 = 0; it.t1 = 16; it.t2 = 16; it.t3 = 18;
      it.qpos0 = qb * 256; it.T = 1024; it.scale = 0.125f;
      it.lgf = log2_sigmoid(p.ret_decay[(l * 2 + 0) * 4 + hh]);
      it.lgb = log2_sigmoid(p.ret_decay[(l * 2 + 1) * 4 + hh]);
      it.S0f = p.S0t() + ((size_t)((((l * 8 + b) * 2 + 0) * 4 + hh))) * 4096;
      it.S0b = p.S0t() + ((size_t)((((l * 8 + b) * 2 + 1) * 4 + hh))) * 4096;
      it.G = p.Gret() + (size_t)row0 * 256 + hh * 64; it.gn = p.ret_gn + l * 256 + hh * 64;
      it.out = p.mix() + (size_t)row0 * DM + 512 + hh * 64;
      attn_item<64, 2>(it, smem, wv);
      continue;
    }
    idx -= NB;
    if (idx < NC) {
      const int b = idx >> 5, head = (idx >> 2) & 7, qb = idx & 3, kv = head >> 2, row0 = NCTX + b * 1024 + qb * 256;
      it.Q = p.Qwin() + (size_t)row0 * 512 + head * 64; it.qs = 512;
      it.K = p.Kwin_l() + ((size_t)((l * 8 + b) * 1280)) * 128 + kv * 64; it.ks = 128;
      it.Vt = p.Vtwin_l() + ((size_t)(((l * 8 + b) * 2 + kv) * 64)) * 1280; it.vs = 1280;
      it.t0 = max(0, qb * 4 - 2); it.t1 = min(16, qb * 4 + 6); it.t2 = 16; it.t3 = 20;
      it.qpos0 = qb * 256;
      it.scale = 0.125f * LOG2E; it.sink_l2 = p.win_sink[l * 8 + head] * LOG2E; it.has_sink = 1;
      it.out = p.mix() + (size_t)row0 * DM + head * 64;
      attn_item<64, 1>(it, smem, wv);
      continue;
    }
    idx -= NC;
    if (idx < ND) {
      const int b = idx >> 3, head = idx & 7, kv = head >> 2, row0 = b * 256;
      it.Q = p.Qwin() + (size_t)row0 * 512 + head * 64; it.qs = 512;
      it.K = p.Kwin_c() + (size_t)(b * 256) * 128 + kv * 64; it.ks = 128;
      it.Vt = p.Vtwin_c() + ((size_t)((b * 2 + kv) * 64)) * 256; it.vs = 256;
      it.t0 = 0; it.t1 = 4;
      it.scale = 0.125f * LOG2E; it.sink_l2 = p.win_sink[l * 8 + head] * LOG2E; it.has_sink = 1;
      it.out = p.mix() + (size_t)row0 * DM + head * 64;
      attn_item<64, 0>(it, smem, wv);
      continue;
    }
    idx -= ND;
    if (idx < NE) {
      const int b = idx >> 2, hh = idx & 3, row0 = b * 256;
      it.Q = p.Qmla() + (size_t)row0 * 384 + hh * 96; it.qs = 384;
      it.K = p.Kmla_c() + ((size_t)((b * 4 + hh) * 256)) * 96; it.ks = 96;
      it.Vt = p.Vtmla_c() + ((size_t)((b * 4 + hh) * 64)) * 256; it.vs = 256;
      it.t0 = 0; it.t1 = 4;
      it.scale = 0.10206207261596575f * LOG2E;
      it.out = p.mix() + (size_t)row0 * DM + 768 + hh * 64;
      attn_item<96, 0>(it, smem, wv);
      continue;
    }
    idx -= NE;
    if (idx < NF) {
      const int b = idx >> 2, hh = idx & 3, row0 = b * 256;
      it.Q = p.Qret() + (size_t)row0 * 256 + hh * 64; it.qs = 256;
      it.K = p.Kret() + (size_t)(b * 256) * 256 + hh * 64; it.ks = 256;
      it.Vt = p.Vtret_c() + ((size_t)((b * 4 + hh) * 64)) * 256; it.vs = 256;
      it.t0 = 0; it.t1 = 4;
      it.qpos0 = 0; it.T = 256; it.scale = 0.125f;
      it.lgf = log2_sigmoid(p.ret_decay[(l * 2 + 0) * 4 + hh]);
      it.lgb = log2_sigmoid(p.ret_decay[(l * 2 + 1) * 4 + hh]);
      it.G = p.Gret() + (size_t)row0 * 256 + hh * 64; it.gn = p.ret_gn + l * 256 + hh * 64;
      it.out = p.mix() + (size_t)row0 * DM + 512 + hh * 64;
      attn_item<64, 2>(it, smem, wv);
      continue;
    }
    idx -= NF;
    {
      const int b = idx >> 2, hh = idx & 3;
      it.Q = nullptr; it.qs = 0;
      it.K = p.Kret() + (size_t)(b * 256) * 256 + hh * 64; it.ks = 256;
      it.Vt = p.Vtret_c() + ((size_t)((b * 4 + hh) * 64)) * 256; it.vs = 256;
      it.t0 = 0; it.t1 = 4;
      it.T = 256; it.scale = 0.125f;
      it.lgf = log2_sigmoid(p.ret_decay[(l * 2 + 0) * 4 + hh]);
      it.lgb = log2_sigmoid(p.ret_decay[(l * 2 + 1) * 4 + hh]);
      it.out = nullptr;
      it.sout = p.out + 23592960 + ((size_t)((b * 2 + l) * 2 * 4 + hh)) * 4096;
      attn_item<64, 3>(it, smem, wv);
    }
  }
}

__device__ __forceinline__ void gemv9_item(const float* sc, float* red, const float* __restrict__ W, int N, int n0, float* outp, int ldo,
                                           const float* bias, const int tid) {
  const int j4 = (tid & 7) * 4, kq = tid >> 3;
  f32x4 acc[9];
#pragma unroll
  for (int r = 0; r < 9; ++r) acc[r] = (f32x4){0.f, 0.f, 0.f, 0.f};
  const float* w = W + (size_t)(kq * 16) * N + n0 + j4;
  const float* s = sc + kq * 16;
#pragma unroll
  for (int kk = 0; kk < 16; ++kk) {
    const f32x4 wv = *(const f32x4*)(w + (size_t)kk * N);
#pragma unroll
    for (int r = 0; r < 9; ++r) acc[r] += wv * s[r * 1024 + kk];
  }
#pragma unroll
  for (int r = 0; r < 9; ++r) *(f32x4*)(red + (kq * 9 + r) * 32 + j4) = acc[r];
  __syncthreads();
  for (int oo = tid; oo < 288; oo += NTHR) {
    const int r = oo >> 5, jj = oo & 31;
    float sum = 0.f;
#pragma unroll 16
    for (int q = 0; q < 64; ++q) sum += red[(q * 9 + r) * 32 + jj];
    outp[(size_t)r * ldo + n0 + jj] = sum + (bias ? bias[n0 + jj] : 0.f);
  }
  __syncthreads();
}

__device__ __forceinline__ void norm0_phase(const P& p, unsigned char* smem, const int wv) {
  const int tid = my_tid(wv), lane = tid & 63, gw = my_bid() * NWV + (tid >> 6), ngw = gridDim.x * NWV;
  const float* gain = p.norm1;
  for (int m0 = gw; m0 < NTOK; m0 += 2 * ngw) {
    float4 v[2][4];
    float ss[2] = {0.f, 0.f};
#pragma unroll
    for (int q = 0; q < 2; ++q) {
      const int m = m0 + q * ngw;
      const float* xr = m < NCTX ? p.x_prompt + (size_t)m * DM : p.x_sample + (size_t)(m - NCTX) * DM;
#pragma unroll
      for (int t = 0; t < 2; ++t) {
        v[q][2 * t] = *(const float4*)(xr + t * 512 + lane * 8);
        v[q][2 * t + 1] = *(const float4*)(xr + t * 512 + lane * 8 + 4);
      }
    }
#pragma unroll
    for (int q = 0; q < 2; ++q) {
#pragma unroll
      for (int j = 0; j < 4; ++j) ss[q] += v[q][j].x * v[q][j].x + v[q][j].y * v[q][j].y + v[q][j].z * v[q][j].z + v[q][j].w * v[q][j].w;
      ss[q] = wave_sum(ss[q], lane);
    }
#pragma unroll
    for (int q = 0; q < 2; ++q) {
      const int m = m0 + q * ngw;
      const float* scale = p.mod() + ((size_t)mod_row(m)) * 6144 + 1 * 1024;
#pragma unroll
      for (int t = 0; t < 2; ++t) {
        const int c = t * 512 + lane * 8;
        const float4 g0 = *(const float4*)(gain + c), g1 = *(const float4*)(gain + c + 4), s0 = *(const float4*)(scale + c), s1 = *(const float4*)(scale + c + 4);
        const float4 a = v[q][2 * t], b = v[q][2 * t + 1];
        uint4 u;
        u.x = pk2(a.x * g0.x * (1.f + s0.x), a.y * g0.y * (1.f + s0.y));
        u.y = pk2(a.z * g0.z * (1.f + s0.z), a.w * g0.w * (1.f + s0.w));
        u.z = pk2(b.x * g1.x * (1.f + s1.x), b.y * g1.y * (1.f + s1.y));
        u.w = pk2(b.z * g1.z * (1.f + s1.z), b.w * g1.w * (1.f + s1.w));
        *(uint4*)(p.hbuf() + (size_t)m * DM + c) = u;
      }
      if (lane < 16) p.rssA()[(size_t)m * 16 + lane] = lane == 0 ? ss[q] : 0.f;
    }
  }
  float* sc = (float*)smem;
  float* red = sc + 9216;
  constexpr int G_IN = DIN / 32, G_UP = DFF / 32, NIT = 2 * G_IN + 2 * G_UP;
  for (int item = my_bid(); item < NIT; item += gridDim.x) {
    int l, grp; const float* W; int N; float* outp; int ldo; int which;
    if (item < 2 * G_IN) { l = item / G_IN; grp = item % G_IN; W = p.w_in + (size_t)l * DM * DIN; N = DIN; outp = p.sWin() + (size_t)l * 9 * DINP; ldo = DINP; which = 0; }
    else { const int i2 = item - 2 * G_IN; l = i2 / G_UP; grp = i2 % G_UP; W = p.w_up + (size_t)l * DM * DFF; N = DFF; outp = p.sWup() + (size_t)l * 9 * DFF; ldo = DFF; which = 3; }
    __syncthreads();
    for (int i = tid; i < 9216; i += NTHR) sc[i] = p.mod()[((size_t)(l * 9 + (i >> 10))) * 6144 + which * 1024 + (i & 1023)];
    __syncthreads();
    gemv9_item(sc, red, W, N, grp * 32, outp, ldo, nullptr, tid);
  }
}
__device__ __forceinline__ void final_norm_phase(const P& p, const int wv) {
  const int tid = my_tid(wv), lane = tid & 63, gw = my_bid() * NWV + (tid >> 6), ngw = gridDim.x * NWV;
  for (int m = gw; m < NTOK; m += ngw) {
    const float* xr = p.xw() + (size_t)m * DM;
    float4 v[4];
    float ss = 0.f;
#pragma unroll
    for (int j = 0; j < 4; ++j) {
      v[j] = ((const float4*)xr)[lane + 64 * j];
      ss += v[j].x * v[j].x + v[j].y * v[j].y + v[j].z * v[j].z + v[j].w * v[j].w;
    }
    ss = wave_sum(ss, lane);
    const float rstd = rsqrtf(ss * (1.f / 1024.f) + 1e-6f);
#pragma unroll
    for (int j = 0; j < 4; ++j) {
      const int c = (lane + 64 * j) * 4;
      const float4 g = *(const float4*)(p.final_norm + c);
      __builtin_nontemporal_store((f32x4){v[j].x * rstd * g.x, v[j].y * rstd * g.y, v[j].z * rstd * g.z, v[j].w * rstd * g.w}, (f32x4*)(p.out + (size_t)m * DM + c));
    }
  }
}

__device__ __forceinline__ void transpose_tile(const float* __restrict__ W, int K, int N, bf16_t* __restrict__ WT, int item, float* tile, const int tid) {
  const int ntn = (N + 63) >> 6, kt = item / ntn, nt = item % ntn, k0 = kt * 64, n0 = nt * 64;
  const int n4 = (tid & 15) * 4, kr = tid >> 4;
#pragma unroll
  for (int q = 0; q < 2; ++q) {
    const int k = q * 32 + kr;
    float4 v = make_float4(0.f, 0.f, 0.f, 0.f);
    if (n0 + n4 < N) v = *(const float4*)(W + (size_t)(k0 + k) * N + n0 + n4);
    float* t = tile + k * 65 + n4;
    t[0] = v.x; t[1] = v.y; t[2] = v.z; t[3] = v.w;
  }
  __syncthreads();
  {
    const int n = tid >> 3, kc = (tid & 7) * 8;
    const float* t = tile + kc * 65 + n;
    uint4 o;
    o.x = pk2(t[0 * 65], t[1 * 65]); o.y = pk2(t[2 * 65], t[3 * 65]); o.z = pk2(t[4 * 65], t[5 * 65]); o.w = pk2(t[6 * 65], t[7 * 65]);
    if (n0 + n < N) *(uint4*)(WT + (size_t)(n0 + n) * K + k0 + kc) = o;
  }
  __syncthreads();
}

__device__ __forceinline__ void prep_phase(const P& p, unsigned char* smem, const int wv) {
  const int tid = my_tid(wv);
  {
    float* sc = (float*)smem;
    float* red = sc + 9216;
    for (int i = tid; i < 9216; i += NTHR) {
      const int r = i >> 10, k = i & 1023;
      const float x = r == 0 ? p.c_ctx[k] : p.c[(r - 1) * 1024 + k];
      sc[i] = x / (1.f + expf(-x));
    }
    __syncthreads();
    for (int item = blockIdx.x; item < 384; item += gridDim.x) {
      const int l = item / 192, n0 = (item % 192) * 32;
      gemv9_item(sc, red, p.w_mod + (size_t)l * 1024 * 6144, 6144, n0, p.mod() + (size_t)l * 9 * 6144, 6144, p.b_mod + l * 6144, tid);
    }
  }
  __syncthreads();
  {
    float* tile = (float*)smem;
    constexpr int I_IN = 16 * 37, I_OUT = 16 * 16, I_UP = 16 * 64, I_DN = 64 * 16, I_KV = 2 * 8;
    constexpr int PER = I_IN + I_OUT + I_UP + I_DN + I_KV;
    for (int item = blockIdx.x; item < 2 * PER; item += gridDim.x) {
      const int l = item / PER;
      int r = item % PER;
      if (r < I_IN) { transpose_tile(p.w_in + (size_t)l * DM * DIN, DM, DIN, p.WinT() + (size_t)l * DINP * DM, r, tile, tid); continue; }
      r -= I_IN;
      if (r < I_OUT) { transpose_tile(p.w_out + (size_t)l * DM * DM, DM, DM, p.WoutT() + (size_t)l * DM * DM, r, tile, tid); continue; }
      r -= I_OUT;
      if (r < I_UP) { transpose_tile(p.w_up + (size_t)l * DM * DFF, DM, DFF, p.WupT() + (size_t)l * DFF * DM, r, tile, tid); continue; }
      r -= I_UP;
      if (r < I_DN) { transpose_tile(p.w_down + (size_t)l * DFF * DM, DFF, DM, p.WdownT() + (size_t)l * DM * DFF, r, tile, tid); continue; }
      r -= I_DN;
      transpose_tile(p.w_kv_b + (size_t)l * 128 * 512, 128, 512, p.WkvbT() + (size_t)l * 512 * 128, r, tile, tid);
    }
  }
  const int gt = blockIdx.x * NTHR + tid, gs = gridDim.x * NTHR;
  if (gt < 256) p.ctl()[gt] = 0u;
  for (int i = gt; i < 64 * 16; i += gs) {
    const int pos = i >> 4, f = i & 15;
    const float ang = (float)pos * exp2f(-(float)f * (L2_10000 / 16.f));
    p.ropeW()[pos * 32 + f] = __cosf(ang);
    p.ropeW()[pos * 32 + 16 + f] = __sinf(ang);
  }
  for (int i = gt; i < 64 * 8; i += gs) {
    const int pos = i >> 3, f = i & 7;
    const float ang = (float)pos * exp2f(-(float)f * (L2_10000 / 8.f));
    p.ropeM()[pos * 16 + f] = __cosf(ang);
    p.ropeM()[pos * 16 + 8 + f] = __sinf(ang);
  }
  for (int i = gt; i < 2 * (DINP - DIN) * DM / 8; i += gs) {
    const int l = i / ((DINP - DIN) * DM / 8), o = i % ((DINP - DIN) * DM / 8);
    *(uint4*)(p.WinT() + ((size_t)l * DINP + DIN) * DM + (size_t)o * 8) = make_uint4(0, 0, 0, 0);
  }
  for (int i = gt; i < 524288 / 8; i += gs) {
    const int d8 = i & 7, kv = (i >> 3) & 1, s = (i >> 4) & 255, l = (i >> 12) & 1, b = i >> 13;
    const float4 a = *(const float4*)(p.cache_win_k + (size_t)i * 8), c = *(const float4*)(p.cache_win_k + (size_t)i * 8 + 4);
    *(uint4*)(p.Kwin_l() + ((size_t)((l * 8 + b) * 1280 + 1024 + s)) * 128 + kv * 64 + d8 * 8) = make_uint4(pk2(a.x, a.y), pk2(a.z, a.w), pk2(c.x, c.y), pk2(c.z, c.w));
  }
  for (int i = gt; i < 524288 / 8; i += gs) {
    const int d = i & 63, kv = (i >> 6) & 1, s8 = (i >> 7) & 31, l = (i >> 12) & 1, b = i >> 13;
    const float* src = p.cache_win_v + ((size_t)((b * 2 + l) * 256 + s8 * 8) * 2 + kv) * 64 + d;
    float v[8];
#pragma unroll
    for (int j = 0; j < 8; ++j) v[j] = src[(size_t)j * 128];
    *(uint4*)(p.Vtwin_l() + ((size_t)(((l * 8 + b) * 2 + kv) * 64 + d)) * 1280 + 1024 + s8 * 8) = make_uint4(pk2(v[0], v[1]), pk2(v[2], v[3]), pk2(v[4], v[5]), pk2(v[6], v[7]));
  }
  for (int i = gt; i < 524288 / 8; i += gs) {
    const int j8 = i & 15, s = (i >> 4) & 255, l = (i >> 12) & 1, b = i >> 13;
    const float4 a = *(const float4*)(p.cache_mla_ckv + (size_t)i * 8), c = *(const float4*)(p.cache_mla_ckv + (size_t)i * 8 + 4);
    *(uint4*)(p.ckvn() + ((size_t)l * 18432 + 16384 + b * 256 + s) * 128 + j8 * 8) = make_uint4(pk2(a.x, a.y), pk2(a.z, a.w), pk2(c.x, c.y), pk2(c.z, c.w));
  }
  for (int i = gt; i < 131072 / 8; i += gs) {
    const int j8 = i & 3, s = (i >> 2) & 255, l = (i >> 10) & 1, b = i >> 11;
    const float4 a = *(const float4*)(p.cache_mla_krope + (size_t)i * 8), c = *(const float4*)(p.cache_mla_krope + (size_t)i * 8 + 4);
    const uint4 o = make_uint4(pk2(a.x, a.y), pk2(a.z, a.w), pk2(c.x, c.y), pk2(c.z, c.w));
#pragma unroll
    for (int hh = 0; hh < 4; ++hh) *(uint4*)(p.Kmla_l() + ((size_t)(((l * 8 + b) * 4 + hh) * 1280 + 1024 + s)) * 96 + 64 + j8 * 8) = o;
  }
  for (int i = gt; i < 524288 / 8; i += gs) {
    const int e = i & 63, d8 = (i >> 6) & 7, blk = i >> 9;
    const int hh = blk & 3, dir = (blk >> 2) & 1, l = (blk >> 3) & 1, b = blk >> 4;
    const float* src = p.state_ret + (size_t)blk * 4096 + (size_t)(d8 * 8) * 64 + e;
    float v[8];
#pragma unroll
    for (int j = 0; j < 8; ++j) v[j] = src[(size_t)j * 64];
    *(uint4*)(p.S0t() + ((size_t)((((l * 8 + b) * 2 + dir) * 4 + hh) * 64 + e)) * 64 + d8 * 8) = make_uint4(pk2(v[0], v[1]), pk2(v[2], v[3]), pk2(v[4], v[5]), pk2(v[6], v[7]));
  }
}

struct RotOrder : pg8::StaticOrder {
  int rot;
  __device__ __forceinline__ bool next(int i, Unit& u) const {
    if (!pg8::StaticOrder::next(i, u)) return false;
    u.pn += rot; if (u.pn >= nN) u.pn -= nN;
    return true;
  }
};
template <class Epi>
__device__ __forceinline__ void big_gemm(unsigned char* smem, const bf16_t* A, const bf16_t* Bt, int N, int K, const Epi& E, const int wv, int rot = 0) {
  pg8::Gemm g{A, Bt, NTOK, N, K};
  RotOrder S;
  S.init(NTOK, N, (int)gridDim.x, my_bid());
  S.rot = rot;
  pg8::gemm_phase<Epi, RotOrder, true, true>((PG8_LAS unsigned char*)smem, g, S, E, wv);
}

#define GSYNC() grid.sync()
__global__ void __launch_bounds__(NTHR, 2) hybrid_fwd(P p_arg) {
  cg::grid_group grid = cg::this_grid();
  const kargp_t kp = (kargp_t)__builtin_amdgcn_kernarg_segment_ptr();
  const int wv = __builtin_amdgcn_readfirstlane((int)threadIdx.x >> 6);
  { const P p = load_params(kp); prep_phase(p, smem, wv); }
  GSYNC();
  { const P p = load_params(kp); norm0_phase(p, smem, wv); }
  GSYNC();
#pragma unroll
  for (int l = 0; l < 2; ++l) {
    { const P pc = load_params(kp); const int t0 = my_tid(wv);
      for (int i = t0; i < 64 * 32; i += NTHR) ((float*)(smem + LDS_ROPEW))[i] = pc.ropeW()[i];
      for (int i = t0; i < 64 * 16; i += NTHR) ((float*)(smem + LDS_ROPEM))[i] = pc.ropeM()[i];
      __syncthreads(); }
    { const P p = load_params(kp);
      big_gemm(smem, p.hbuf(), p.WinT() + (size_t)l * DINP * DM, DINP, DM, EpiIn8{p, l, kp}, wv, 8); }
    { const P p = load_params(kp); gemm_small(p.ckvn() + (size_t)l * 18432 * 128, 128, p.WkvbT() + (size_t)l * 512 * 128, 128, 18432, 512, 128, smem, EpiKvb{p, l}, wv, p.ctl() + 64 * l, p.ctl() + 128 + 64 * l); }
    GSYNC();
    { const P p = load_params(kp); attn_phase(p, l, smem, wv); }
    GSYNC();
    { const P p = load_params(kp); big_gemm(smem, p.mix(), p.WoutT() + (size_t)l * DM * DM, DM, DM, EpiOut8{p, l}, wv); }
    GSYNC();
    { const P p = load_params(kp); big_gemm(smem, p.hbuf(), p.WupT() + (size_t)l * DFF * DM, DFF, DM, EpiUp8{p, l}, wv); }
    GSYNC();
    { const P p = load_params(kp); big_gemm(smem, p.ubuf(), p.WdownT() + (size_t)l * DM * DFF, DM, DFF, EpiDown8{p, l}, wv); }
    GSYNC();
  }
  { const P p = load_params(kp); final_norm_phase(p, wv); }
}

extern "C" void kernel_launch(void* const* d_in, const int* in_sizes, int n_in, void* d_out, int out_size, void* d_ws, size_t ws_size,
                              hipStream_t stream) {
  static int grid_blocks = 0;
  if (grid_blocks == 0) {
    int dev = 0, cus = 0, per_cu = 0;
    (void)hipGetDevice(&dev);
    (void)hipDeviceGetAttribute(&cus, hipDeviceAttributeMultiprocessorCount, dev);
    (void)hipFuncSetAttribute((const void*)hybrid_fwd, hipFuncAttributeMaxDynamicSharedMemorySize, LDS_BYTES);
    (void)hipOccupancyMaxActiveBlocksPerMultiprocessor(&per_cu, (const void*)hybrid_fwd, NTHR, LDS_BYTES);
    if (per_cu < 1) { fprintf(stderr, "occupancy query returned %d\n", per_cu); per_cu = 1; }
    per_cu = 1;
    grid_blocks = cus * per_cu;
  }
  P p{};
  const float* const* in = (const float* const*)d_in;
  p.x_prompt = in[0]; p.x_sample = in[1]; p.cache_win_k = in[2]; p.cache_win_v = in[3]; p.cache_mla_ckv = in[4];
  p.cache_mla_krope = in[5]; p.state_ret = in[6]; p.c = in[7]; p.c_ctx = in[8]; p.w_mod = in[9]; p.b_mod = in[10];
  p.norm1 = in[11]; p.norm2 = in[12]; p.w_in = in[13]; p.win_sink = in[14]; p.ret_decay = in[15]; p.ret_gn = in[16];
  p.mla_kv_norm = in[17]; p.w_kv_b = in[18]; p.w_out = in[19]; p.w_up = in[20]; p.w_down = in[21]; p.final_norm = in[22];
  p.out = (float*)d_out;
  p.ws = (unsigned char*)d_ws;
  if (WS_END > ws_size) { fprintf(stderr, "kernel_launch: workspace too small: need %zu, have %zu\n", (size_t)WS_END, ws_size); return; }
  void* args[] = {&p};
  hipError_t e = hipLaunchCooperativeKernel((const void*)hybrid_fwd, dim3(grid_blocks), dim3(NTHR), args, LDS_BYTES, stream);
  if (e != hipSuccess) fprintf(stderr, "cooperative launch failed: %s (grid %d)\n", hipGetErrorString(e), grid_blocks);
}
```

```cpp
#include <hip/hip_runtime.h>
#include <hip/hip_cooperative_groups.h>
#include <cstdio>
#include <cstdint>
namespace cg = cooperative_groups;

__device__ __forceinline__ int lane_id() { return (int)__builtin_amdgcn_mbcnt_hi(~0u, __builtin_amdgcn_mbcnt_lo(~0u, 0u)); }

namespace pg8 {
#define PG8_LAS __attribute__((address_space(3)))
typedef unsigned short bf16_t;
typedef short bf16x8 __attribute__((ext_vector_type(8)));
typedef float f32x4 __attribute__((ext_vector_type(4)));
typedef unsigned u32x4 __attribute__((ext_vector_type(4)));
constexpr int BM = 256, BK = 64, HALF = 128, HTB = HALF * BK * 2  , STAGE_BYTES = 8 * HTB, NXCD = 8, WGM = 8;

__host__ __device__ __forceinline__ int lds_byte(int r, int c) { const int st = (r >> 4) * 2 + (c >> 5), rr = r & 15, cc = c & 31, ob = rr * 64 + cc * 2; return st * 1024 + (ob ^ (((ob >> 9) & 1) << 5)); }
__host__ __device__ __forceinline__ void stage_rc(int b, int& R, int& C) { const int st = b / 1024, sb = b % 1024, swz = sb ^ (((sb >> 9) & 1) << 5); R = (st >> 1) * 16 + swz / 64; C = (st & 1) * 32 + (swz % 64) / 2; }
__host__ __device__ __forceinline__ int perm32(int rho) { const int n = rho >> 4, i = rho & 15; return 8 * (i >> 2) + 4 * n + (i & 3); }

struct Unit { int pm, pn; };
struct Gemm { const bf16_t* A; const bf16_t* Bt; int M, N, K; };

struct StaticOrder {
    int nM, nN, nwg, G, c;
    __host__ __device__ void init(int M, int N, int G_, int c_) { nM = M / BM; nN = N / BM; nwg = nM * nN; G = G_; c = c_; }
    __host__ __device__ bool next(int i, Unit& u) const {
        const long L = (long)i * G + c; if (L >= nwg) return false;
        int wgid = (int)L; { const int q = nwg / NXCD, r = nwg % NXCD, xcd = wgid % NXCD, off = wgid / NXCD; wgid = (xcd < r ? xcd * (q + 1) : r * (q + 1) + (xcd - r) * q) + off; }
        const int nig = WGM * nN, gid = wgid / nig, fm = gid * WGM, gsz = (nM - fm) < WGM ? (nM - fm) : WGM;
        u.pm = fm + ((wgid % nig) % gsz); u.pn = (wgid % nig) / gsz; return true;
    }
    __device__ __forceinline__ void a_ready(const Unit&) const {}
    __device__ __forceinline__ void done(const Unit&) const {}
};
template <class Epi, class Sched, bool ALIGN_EPI = false, bool SP2 = false>
__device__ __forceinline__ void gemm_phase(PG8_LAS unsigned char* lds, const Gemm g, const Sched& S, const Epi& E, const int wvp) {
    const int wid = wvp, lane = lane_id(), tid = wid * 64 + lane, wr = wid >> 2, wc = wid & 3, fr = lane & 15, fq = lane >> 4;
    const int K = g.K, nt = K / BK;
    unsigned voffA[2], voffB[2];
#pragma unroll
    for (int i = 0; i < 2; ++i) { int R, C; stage_rc(tid * 16 + i * 8192, R, C); const int Rb = Epi::PERM ? ((R & ~31) + perm32(R & 31)) : R;
        voffA[i] = (unsigned)(R * K + C) * 2u; voffB[i] = (unsigned)(Rb * K + C) * 2u; }
    const size_t kstep = (size_t)(BK * 2);
    const size_t hstep = (size_t)HALF * K * 2;
    const size_t tstep = 2 * hstep;
    const unsigned ldsw = (unsigned)wid * 1024u;
    const int aoff = lds_byte(wr * 64 + fr, fq * 8), boff = lds_byte(wc * 32 + fr, fq * 8);
#define PG8_SA(b, h) (((b) * 2 + (h)) * HTB)
#define PG8_SB(b, h) ((4 + (b) * 2 + (h)) * HTB)
#define PG8_STAGE(bufoff, gbase, voff) do { _Pragma("unroll") for (int _i = 0; _i < 2; ++_i) \
        __builtin_amdgcn_global_load_lds((const unsigned*)((const char*)(gbase) + (voff)[_i]), (PG8_LAS unsigned*)(lds + (bufoff) + ldsw + _i * 8192), 16, 0, 0); } while (0)
#define PG8_LDA(dst, b, h) do { _Pragma("unroll") for (int m = 0; m < 4; ++m) _Pragma("unroll") for (int k = 0; k < 2; ++k) dst[m][k] = *(const PG8_LAS bf16x8*)(lds + PG8_SA(b, h) + aoff + m * 2048 + k * 1024); } while (0)
#define PG8_LDB(dst, b, h) do { _Pragma("unroll") for (int n = 0; n < 2; ++n) _Pragma("unroll") for (int k = 0; k < 2; ++k) dst[n][k] = *(const PG8_LAS bf16x8*)(lds + PG8_SB(b, h) + boff + n * 2048 + k * 1024); } while (0)
#define PG8_MMA(ai, bj, At, Bt) do { __builtin_amdgcn_s_setprio(1); _Pragma("unroll") for (int m = 0; m < 4; ++m) _Pragma("unroll") for (int n = 0; n < 2; ++n) _Pragma("unroll") for (int k = 0; k < 2; ++k) \
        acc[ai][bj][m][n] = __builtin_amdgcn_mfma_f32_16x16x32_bf16(Bt[n][k], At[m][k], acc[ai][bj][m][n], 0, 0, 0); __builtin_amdgcn_s_setprio(0); } while (0)
#define PG8_WAIT_V(n) asm volatile("s_waitcnt vmcnt(" #n ")" ::: "memory")
#define PG8_WAIT_L(n) asm volatile("s_waitcnt lgkmcnt(" #n ")" ::: "memory")
#define PG8_BAR __builtin_amdgcn_s_barrier()
#define PG8_SCHED __builtin_amdgcn_sched_barrier(0)
    Unit cur, nxt; int ui = 0;
    if (!S.next(0, cur)) return;
    f32x4 acc[2][2][4][2];
#pragma unroll
    for (int a = 0; a < 2; ++a)
#pragma unroll
        for (int b = 0; b < 2; ++b)
#pragma unroll
            for (int m = 0; m < 4; ++m)
#pragma unroll
                for (int n = 0; n < 2; ++n) acc[a][b][m][n] = (f32x4){0.f, 0.f, 0.f, 0.f};
    bf16x8 At[4][2], B0[2][2], B1[2][2];
    const char* cA = (const char*)g.A + (size_t)cur.pm * tstep; const char* cB = (const char*)g.Bt + (size_t)cur.pn * tstep;
    S.a_ready(cur);
    if constexpr (SP2) {
        PG8_STAGE(PG8_SB(0, 0), cB, voffB); PG8_STAGE(PG8_SB(0, 1), cB + hstep, voffB); PG8_STAGE(PG8_SA(0, 0), cA, voffA); PG8_STAGE(PG8_SA(0, 1), cA + hstep, voffA);
        if (wr == 1) PG8_BAR;
        PG8_WAIT_V(2); PG8_BAR;
        PG8_STAGE(PG8_SB(1, 0), cB + kstep, voffB); PG8_STAGE(PG8_SA(1, 0), cA + kstep, voffA); PG8_STAGE(PG8_SB(1, 1), cB + hstep + kstep, voffB);
        PG8_WAIT_V(6); PG8_BAR;
    } else {
        PG8_STAGE(PG8_SB(0, 0), cB, voffB); PG8_STAGE(PG8_SA(0, 0), cA, voffA); PG8_STAGE(PG8_SB(0, 1), cB + hstep, voffB); PG8_STAGE(PG8_SA(0, 1), cA + hstep, voffA);
        if (wr == 1) PG8_BAR;
        PG8_WAIT_V(4); PG8_BAR;
        PG8_STAGE(PG8_SB(1, 0), cB + kstep, voffB); PG8_STAGE(PG8_SA(1, 0), cA + kstep, voffA); PG8_STAGE(PG8_SB(1, 1), cB + hstep + kstep, voffB);
        PG8_WAIT_V(6); PG8_BAR;
    }
    for (;;) {
        const bool has_next = S.next(ui + 1, nxt);
        const char* nA = has_next ? (const char*)g.A + (size_t)nxt.pm * tstep : cA; const char* nB = has_next ? (const char*)g.Bt + (size_t)nxt.pn * tstep : cB;
        for (int t = 0; t < nt; t += 2) {
            const bool last = (t == nt - 2);
            const char* a1 = cA + (size_t)(t + 1) * kstep;
            const char* a2 = last ? nA : cA + (size_t)(t + 2) * kstep; const char* b2 = last ? nB : cB + (size_t)(t + 2) * kstep;
            const char* a3 = a2 + kstep; const char* b3 = b2 + kstep;
            if (last && has_next) S.a_ready(nxt);
            if constexpr (SP2) {
            PG8_LDB(B0, 0, 0); PG8_LDB(B1, 0, 1); PG8_SCHED; PG8_LDA(At, 0, 0); PG8_STAGE(PG8_SA(1, 1), a1 + hstep, voffA);
            PG8_WAIT_V(8); PG8_WAIT_L(0); PG8_BAR; PG8_MMA(0, 0, At, B0); PG8_MMA(0, 1, At, B1); PG8_BAR; PG8_SCHED;
            PG8_LDA(At, 0, 1); PG8_STAGE(PG8_SB(0, 0), b2, voffB); PG8_STAGE(PG8_SB(0, 1), b2 + hstep, voffB); PG8_STAGE(PG8_SA(0, 0), a2, voffA);
            PG8_WAIT_V(8); PG8_WAIT_L(0); PG8_BAR; PG8_MMA(1, 0, At, B0); PG8_MMA(1, 1, At, B1); PG8_BAR; PG8_SCHED;
            PG8_LDB(B0, 1, 0); PG8_LDB(B1, 1, 1); PG8_SCHED; PG8_LDA(At, 1, 0); PG8_STAGE(PG8_SA(0, 1), a2 + hstep, voffA);
            PG8_WAIT_V(8); PG8_WAIT_L(0); PG8_BAR; PG8_MMA(0, 0, At, B0); PG8_MMA(0, 1, At, B1); PG8_BAR; PG8_SCHED;
            PG8_LDA(At, 1, 1); PG8_STAGE(PG8_SB(1, 0), b3, voffB); PG8_STAGE(PG8_SB(1, 1), b3 + hstep, voffB); PG8_STAGE(PG8_SA(1, 0), a3, voffA);
            PG8_WAIT_V(8); PG8_WAIT_L(0); PG8_BAR; PG8_MMA(1, 0, At, B0); PG8_MMA(1, 1, At, B1); PG8_BAR; PG8_SCHED;
            } else {
            PG8_LDB(B0, 0, 0); PG8_SCHED; PG8_LDA(At, 0, 0); PG8_STAGE(PG8_SA(1, 1), a1 + hstep, voffA);
            PG8_WAIT_L(8); PG8_BAR; PG8_WAIT_L(0); PG8_MMA(0, 0, At, B0); PG8_BAR; PG8_SCHED;
            PG8_LDB(B1, 0, 1); PG8_STAGE(PG8_SB(0, 0), b2, voffB);
            PG8_BAR; PG8_WAIT_L(0); PG8_MMA(0, 1, At, B1); PG8_BAR;
            PG8_LDA(At, 0, 1); PG8_STAGE(PG8_SA(0, 0), a2, voffA);
            PG8_BAR; PG8_WAIT_L(0); PG8_MMA(1, 0, At, B0); PG8_BAR; PG8_SCHED;
            PG8_STAGE(PG8_SB(0, 1), b2 + hstep, voffB);
            PG8_WAIT_V(6); PG8_BAR; PG8_MMA(1, 1, At, B1); PG8_BAR;
            PG8_LDB(B0, 1, 0); PG8_SCHED; PG8_LDA(At, 1, 0); PG8_STAGE(PG8_SA(0, 1), a2 + hstep, voffA);
            PG8_WAIT_L(8); PG8_BAR; PG8_WAIT_L(0); PG8_MMA(0, 0, At, B0); PG8_BAR; PG8_SCHED;
            PG8_LDB(B1, 1, 1); PG8_STAGE(PG8_SB(1, 0), b3, voffB);
            PG8_BAR; PG8_WAIT_L(0); PG8_MMA(0, 1, At, B1); PG8_BAR;
            PG8_LDA(At, 1, 1); PG8_STAGE(PG8_SA(1, 0), a3, voffA);
            PG8_BAR; PG8_WAIT_L(0); PG8_MMA(1, 0, At, B0); PG8_BAR; PG8_SCHED;
            PG8_STAGE(PG8_SB(1, 1), b3 + hstep, voffB);
            PG8_WAIT_V(6); PG8_BAR; PG8_MMA(1, 1, At, B1); PG8_BAR;
            }
        }
        if constexpr (ALIGN_EPI) { if (wr == 0) PG8_BAR; }
        if constexpr (!Epi::AFTER_DRAIN) { E(acc, cur, wr, wc, fr, fq); S.done(cur); }
        if (!has_next) break;
#pragma unroll
        for (int a = 0; a < 2; ++a)
#pragma unroll
            for (int b = 0; b < 2; ++b)
#pragma unroll
                for (int m = 0; m < 4; ++m)
#pragma unroll
                    for (int n = 0; n < 2; ++n) acc[a][b][m][n] = (f32x4){0.f, 0.f, 0.f, 0.f};
        cur = nxt; cA = nA; cB = nB; ++ui;
        if constexpr (ALIGN_EPI) { if (wr == 1) PG8_BAR; }
    }
    PG8_WAIT_V(0);
    if constexpr (!ALIGN_EPI) { if (wr == 0) PG8_BAR; }
    PG8_BAR;
    if constexpr (Epi::AFTER_DRAIN) { E.fused(acc, cur, wr, wc, fr, fq, lds, wid, lane); S.done(cur); }
#undef PG8_SA
#undef PG8_SB
#undef PG8_STAGE
#undef PG8_LDA
#undef PG8_LDB
#undef PG8_MMA
#undef PG8_WAIT_V
#undef PG8_WAIT_L
#undef PG8_BAR
#undef PG8_SCHED
}
}


typedef unsigned short bf16_t;
typedef short bf16x8 __attribute__((ext_vector_type(8)));
typedef float f32x16 __attribute__((ext_vector_type(16)));
typedef pg8::f32x4 f32x4;
typedef unsigned u32x4v __attribute__((ext_vector_type(4)));
using pg8::Unit;

constexpr int NTHR = 512, NWV = 8;
constexpr int NTOK = 16384, NCTX = 8192, DM = 1024, DIN = 2336, DINP = 2560, DFF = 4096;
constexpr int LDS_RED = 131072;
constexpr int LDS_ROPEW = 131072 + 4096, LDS_ROPEM = LDS_ROPEW + 64 * 32 * 4;
constexpr int LDS_BYTES = LDS_ROPEM + 64 * 16 * 4;
constexpr float LOG2E = 1.4426950408889634f;
constexpr float L2_10000 = 13.287712379549449f;

#define AL256(x) (((x) + 255) & ~(size_t)255)
constexpr size_t OFF_mod = 0;
constexpr size_t OFF_ropeW = OFF_mod + AL256((size_t)2 * 9 * 6144 * 4);
constexpr size_t OFF_ropeM = OFF_ropeW + AL256((size_t)64 * 32 * 4);
constexpr size_t OFF_ctl = OFF_ropeM + AL256((size_t)64 * 16 * 4);
constexpr size_t OFF_rssA = OFF_ctl + AL256((size_t)256 * 4);
constexpr size_t OFF_rssB = OFF_rssA + AL256((size_t)NTOK * 16 * 4);
constexpr size_t OFF_sWin = OFF_rssB + AL256((size_t)NTOK * 16 * 4);
constexpr size_t OFF_sWup = OFF_sWin + AL256((size_t)2 * 9 * DINP * 4);
constexpr size_t OFF_WinT = OFF_sWup + AL256((size_t)2 * 9 * DFF * 4);
constexpr size_t OFF_WoutT = OFF_WinT + AL256((size_t)2 * DINP * DM * 2);
constexpr size_t OFF_WupT = OFF_WoutT + AL256((size_t)2 * DM * DM * 2);
constexpr size_t OFF_WdownT = OFF_WupT + AL256((size_t)2 * DFF * DM * 2);
constexpr size_t OFF_WkvbT = OFF_WdownT + AL256((size_t)2 * DM * DFF * 2);
constexpr size_t OFF_hbuf = OFF_WkvbT + AL256((size_t)2 * 512 * 128 * 2);
constexpr size_t OFF_Kwin_l = OFF_hbuf + AL256((size_t)NTOK * DM * 2);
constexpr size_t OFF_Vtwin_l = OFF_Kwin_l + AL256((size_t)2 * 8 * 1280 * 128 * 2);
constexpr size_t OFF_S0t = OFF_Vtwin_l + AL256((size_t)2 * 8 * 2 * 64 * 1280 * 2);
constexpr size_t OFF_ckvn = OFF_S0t + AL256((size_t)2 * 8 * 2 * 4 * 4096 * 2);
constexpr size_t OFF_Kmla_l = OFF_ckvn + AL256((size_t)2 * 18432 * 128 * 2);
constexpr size_t OFF_Vtmla_l = OFF_Kmla_l + AL256((size_t)2 * 8 * 4 * 1280 * 96 * 2);
constexpr size_t OFF_ubuf = OFF_Vtmla_l + AL256((size_t)2 * 8 * 4 * 64 * 1280 * 2);
constexpr size_t WS_END = OFF_ubuf + AL256((size_t)NTOK * DFF * 2);
constexpr size_t OFF_mix = OFF_ubuf + (size_t)96 * 1024 * 1024;
constexpr size_t OFF_Qwin = OFF_ubuf;
constexpr size_t OFF_Kwin_c = OFF_Qwin + AL256((size_t)NTOK * 512 * 2);
constexpr size_t OFF_Vtwin_c = OFF_Kwin_c + AL256((size_t)NCTX * 128 * 2);
constexpr size_t OFF_Qret = OFF_Vtwin_c + AL256((size_t)32 * 2 * 64 * 256 * 2);
constexpr size_t OFF_Kret = OFF_Qret + AL256((size_t)NTOK * 256 * 2);
constexpr size_t OFF_Gret = OFF_Kret + AL256((size_t)NTOK * 256 * 2);
constexpr size_t OFF_Vtret_c = OFF_Gret + AL256((size_t)NTOK * 256 * 2);
constexpr size_t OFF_Vtret_l = OFF_Vtret_c + AL256((size_t)32 * 4 * 64 * 256 * 2);
constexpr size_t OFF_Qmla = OFF_Vtret_l + AL256((size_t)8 * 4 * 64 * 1024 * 2);
constexpr size_t OFF_Kmla_c = OFF_Qmla + AL256((size_t)NTOK * 384 * 2);
constexpr size_t OFF_Vtmla_c = OFF_Kmla_c + AL256((size_t)32 * 4 * 256 * 96 * 2);
static_assert(OFF_Vtmla_c + (size_t)32 * 4 * 64 * 256 * 2 <= OFF_mix && OFF_mix + (size_t)NTOK * DM * 2 <= WS_END, "attention temporaries + mix must fit in the ubuf region");
static_assert(WS_END <= (size_t)256 * 1024 * 1024, "workspace must fit 256 MiB");

struct P {
  const float *x_prompt, *x_sample, *cache_win_k, *cache_win_v, *cache_mla_ckv, *cache_mla_krope, *state_ret,
      *c, *c_ctx, *w_mod, *b_mod, *norm1, *norm2, *w_in, *win_sink, *ret_decay, *ret_gn, *mla_kv_norm,
      *w_kv_b, *w_out, *w_up, *w_down, *final_norm;
  float* out;
  unsigned char* ws;
#define WSBUF(ty, name) __device__ __forceinline__ ty* name() const { return (ty*)(ws + OFF_##name); }
  WSBUF(unsigned, ctl) WSBUF(float, mod) WSBUF(float, ropeW) WSBUF(float, ropeM) WSBUF(float, rssA) WSBUF(float, rssB) WSBUF(float, sWin) WSBUF(float, sWup) WSBUF(bf16_t, WinT) WSBUF(bf16_t, WoutT) WSBUF(bf16_t, WupT) WSBUF(bf16_t, WdownT) WSBUF(bf16_t, WkvbT)
  WSBUF(bf16_t, hbuf) WSBUF(bf16_t, mix) WSBUF(bf16_t, Qwin) WSBUF(bf16_t, Kwin_c) WSBUF(bf16_t, Vtwin_c) WSBUF(bf16_t, Kwin_l)
  WSBUF(bf16_t, Vtwin_l) WSBUF(bf16_t, Qret) WSBUF(bf16_t, Kret) WSBUF(bf16_t, Gret) WSBUF(bf16_t, Vtret_c) WSBUF(bf16_t, Vtret_l)
  WSBUF(bf16_t, S0t) WSBUF(bf16_t, Qmla) WSBUF(bf16_t, ckvn) WSBUF(bf16_t, Kmla_c) WSBUF(bf16_t, Vtmla_c) WSBUF(bf16_t, Kmla_l)
  WSBUF(bf16_t, Vtmla_l) WSBUF(bf16_t, ubuf)
  __device__ __forceinline__ float* xw() const { return out; }
};

typedef float f32x2_t __attribute__((ext_vector_type(2)));
typedef __bf16 bf16x2_t __attribute__((ext_vector_type(2)));
__device__ __forceinline__ unsigned pk2(float lo, float hi) {
  const f32x2_t v = {lo, hi};
  const bf16x2_t b = __builtin_convertvector(v, bf16x2_t);
  return __builtin_bit_cast(unsigned, b);
}
__device__ __forceinline__ bf16_t f2bf(float f) { return (bf16_t)(pk2(f, 0.f) & 0xffffu); }
__device__ __forceinline__ float bf2f(bf16_t b) { return __uint_as_float(((unsigned)b) << 16); }
__device__ __forceinline__ float shx(float v, int mask, int ln) { return __int_as_float(__builtin_amdgcn_ds_bpermute((ln ^ mask) << 2, __float_as_int(v))); }
__device__ __forceinline__ float wave_sum(float v, int ln) {
#pragma unroll
  for (int o = 1; o < 64; o <<= 1) v += shx(v, o, ln);
  return v;
}
typedef const __attribute__((address_space(4))) unsigned char* kargp_t;
__device__ __forceinline__ P load_params(kargp_t kp) {
  asm volatile("" : "+s"(kp));
  P p;
  __builtin_memcpy(&p, kp, sizeof(P));
  return p;
}
__device__ __forceinline__ int my_tid(int wv) { int w = wv; asm volatile("" : "+s"(w)); int t = w * 64 + lane_id(); asm volatile("" : "+v"(t)); return t; }
__device__ __forceinline__ int my_bid() { int b = blockIdx.x; asm volatile("" : "+s"(b)); return b; }
__device__ __forceinline__ float fexp2(float x) { return __builtin_amdgcn_exp2f(x); }
__device__ __forceinline__ int mod_row(int m) { return m < NCTX ? 0 : 1 + ((m - NCTX) >> 10); }

__device__ __forceinline__ void st_rm_bf16(bf16_t* rp, int h, const f32x16& o) {
#pragma unroll
  for (int g = 0; g < 4; ++g) {
    uint2 u;
    u.x = pk2(o[4 * g], o[4 * g + 1]);
    u.y = pk2(o[4 * g + 2], o[4 * g + 3]);
    *(uint2*)(rp + 8 * g + 4 * h) = u;
  }
}
__device__ __forceinline__ void st_tr_bf16(bf16_t* bp, int stride, int h, const f32x16& o) {
#pragma unroll
  for (int i = 0; i < 16; ++i) bp[(size_t)((i & 3) + 8 * (i >> 2) + 4 * h) * stride] = f2bf(o[i]);
}

__device__ __forceinline__ void st8_bf16(bf16_t* rp, int fq, const f32x4& a, const f32x4& b) {
  *(uint2*)(rp + 4 * fq) = make_uint2(pk2(a[0], a[1]), pk2(a[2], a[3]));
  *(uint2*)(rp + 16 + 4 * fq) = make_uint2(pk2(b[0], b[1]), pk2(b[2], b[3]));
}
__device__ __forceinline__ void st8_f32(float* rp, int fq, const f32x4& a, const f32x4& b) {
  *(f32x4*)(rp + 4 * fq) = a;
  *(f32x4*)(rp + 16 + 4 * fq) = b;
}
__device__ __forceinline__ void st8_tr(bf16_t* bp, int stride, int fq, const f32x4& a, const f32x4& b) {
#pragma unroll
  for (int j = 0; j < 4; ++j) {
    bp[(size_t)(4 * fq + j) * stride] = f2bf(a[j]);
    bp[(size_t)(16 + 4 * fq + j) * stride] = f2bf(b[j]);
  }
}
__device__ __forceinline__ void rope8_win(f32x4& a, f32x4& b, int fq, const float* tab) {
  const f32x4 cs = *(const f32x4*)(tab + 4 * fq), sn = *(const f32x4*)(tab + 16 + 4 * fq);
  const f32x4 x = a, y = b;
  a = x * cs - y * sn;
  b = x * sn + y * cs;
}
__device__ __forceinline__ void rope8_mla(f32x4& a, f32x4& b, int fq, int ln, const float* tabr, const float* tabc) {
  const int fo = 4 * (fq & 1);
  {
    const f32x4 cs = *(const f32x4*)(tabr + fo), sn = *(const f32x4*)(tabr + 8 + fo);
#pragma unroll
    for (int j = 0; j < 4; ++j) { const float pa = shx(a[j], 32, ln); a[j] = fq < 2 ? a[j] * cs[j] - pa * sn[j] : pa * sn[j] + a[j] * cs[j]; }
  }
  asm volatile("" ::: "memory");
  {
    const f32x4 cs = *(const f32x4*)(tabc + fo), sn = *(const f32x4*)(tabc + 8 + fo);
#pragma unroll
    for (int j = 0; j < 4; ++j) { const float pb = shx(b[j], 32, ln); b[j] = fq < 2 ? b[j] * cs[j] - pb * sn[j] : pb * sn[j] + b[j] * cs[j]; }
  }
}


__device__ __forceinline__ void st8p_bf16(bf16_t* rp, int fq, const f32x4& a, const f32x4& b) {
  *(uint4*)(rp + 8 * fq) = make_uint4(pk2(a[0], a[1]), pk2(a[2], a[3]), pk2(b[0], b[1]), pk2(b[2], b[3]));
}
__device__ __forceinline__ void st8p_f32(float* rp, int fq, const f32x4& a, const f32x4& b) {
  __builtin_nontemporal_store(a, (f32x4*)(rp + 8 * fq));
  __builtin_nontemporal_store(b, (f32x4*)(rp + 8 * fq + 4));
}
__device__ __forceinline__ void st8p_tr(bf16_t* bp, int stride, int fq, const f32x4& a, const f32x4& b) {
#pragma unroll
  for (int j = 0; j < 4; ++j) {
    bp[(size_t)(8 * fq + j) * stride] = f2bf(a[j]);
    bp[(size_t)(8 * fq + 4 + j) * stride] = f2bf(b[j]);
  }
}
__device__ __forceinline__ void rope8p_win(f32x4& a, f32x4& b, int fq, int ln, const float* tab) {
  const int f0 = 8 * (fq & 1);
  const f32x4 ca = *(const f32x4*)(tab + f0), cb4 = *(const f32x4*)(tab + f0 + 4), sa = *(const f32x4*)(tab + 16 + f0), sb = *(const f32x4*)(tab + 16 + f0 + 4);
#pragma unroll
  for (int j = 0; j < 4; ++j) {
    const float pa = shx(a[j], 32, ln), pb = shx(b[j], 32, ln);
    a[j] = fq < 2 ? a[j] * ca[j] - pa * sa[j] : pa * sa[j] + a[j] * ca[j];
    b[j] = fq < 2 ? b[j] * cb4[j] - pb * sb[j] : pb * sb[j] + b[j] * cb4[j];
  }
}
__device__ __forceinline__ void rope8p_mla(f32x4& a, f32x4& b, int fq, int ln, const float* tabr, const float* tabc) {
  const float* tab = fq < 2 ? tabr : tabc;
  const f32x4 ca = *(const f32x4*)(tab), cb4 = *(const f32x4*)(tab + 4), sa = *(const f32x4*)(tab + 8), sb = *(const f32x4*)(tab + 12);
#pragma unroll
  for (int j = 0; j < 4; ++j) {
    const float pa = shx(a[j], 16, ln), pb = shx(b[j], 16, ln);
    a[j] = (fq & 1) == 0 ? a[j] * ca[j] - pa * sa[j] : pa * sa[j] + a[j] * ca[j];
    b[j] = (fq & 1) == 0 ? b[j] * cb4[j] - pb * sb[j] : pb * sb[j] + b[j] * cb4[j];
  }
}

__device__ __forceinline__ float row_rstd(const float* rss, int m) {
  const f32x4 a = *(const f32x4*)(rss + (size_t)m * 16), b = *(const f32x4*)(rss + (size_t)m * 16 + 4);
  const f32x4 c = *(const f32x4*)(rss + (size_t)m * 16 + 8), d = *(const f32x4*)(rss + (size_t)m * 16 + 12);
  const f32x4 s = (a + b) + (c + d);
  return rsqrtf(((s[0] + s[1]) + (s[2] + s[3])) * (1.f / 1024.f) + 1e-6f);
}

typedef f32x4 acc_t[2][2][4][2];
template <int V> struct IC { static constexpr int value = V; };
extern __shared__ __attribute__((aligned(16))) unsigned char smem[];
struct EpiIn8 {
  static constexpr bool PERM = true, AFTER_DRAIN = false;
  P p0; int l; kargp_t kp;
  __device__ __forceinline__ void operator()(const acc_t& acc, const Unit& u, int wr, int wc, int fr_in, int fq_in) const {
    int fr = fr_in; asm volatile("" : "+v"(fr));
    int fq = fq_in; asm volatile("" : "+v"(fq));
    const int ln = fq * 16 + fr; (void)ln;
    P p = p0; asm volatile("" : "+s"(p.ws), "+s"(p.out));
    const bool lat = u.pm >= 32;
    const int rbase = u.pm * 256 + wr * 64 + fr;
#define ROWS_BEGIN _Pragma("unroll") for (int ai = 0; ai < 2; ++ai) _Pragma("unroll") for (int mm = 0; mm < 4; ++mm) { \
      int m = rbase + ai * 128 + mm * 16; asm volatile("" : "+v"(m)); int b, s; \
      if (!lat) { b = m >> 8; s = m & 255; } else { b = (m - NCTX) >> 10; s = (m - NCTX) & 1023; } \
      const float rsd = rsdv[ai][mm]; \
      f32x4 v0 = acc[ai][bj][mm][0] * rsd + sw0, v1 = acc[ai][bj][mm][1] * rsd + sw1; (void)b; (void)s;
#define ROWS_END }
    float rsdv[2][4];
    {
      const float* rss = p.rssA();
#pragma unroll
      for (int ai = 0; ai < 2; ++ai)
#pragma unroll
        for (int mm = 0; mm < 4; ++mm) rsdv[ai][mm] = row_rstd(rss, rbase + ai * 128 + mm * 16);
    }
    auto do_half = [&](auto BJ) {
      constexpr int bj = decltype(BJ)::value;
      const int nb = u.pn * 256 + bj * 128 + wc * 32;
      if (nb >= DIN) return;
      const float* swp = p.sWin() + ((size_t)(l * 9 + (lat ? 1 + ((u.pm - 32) >> 2) : 0))) * DINP + nb;
      const f32x4 sw0 = *(const f32x4*)(swp + 8 * fq), sw1 = *(const f32x4*)(swp + 8 * fq + 4);
      if (nb < 512) {
        ROWS_BEGIN
          if (lat) rope8p_win(v0, v1, fq, ln, (const float*)(smem + LDS_ROPEW) + ((nb & 32) ? (s & 63) : (s >> 6)) * 32);
          st8p_bf16(p.Qwin() + (size_t)m * 512 + nb, fq, v0, v1);
        ROWS_END
      } else if (nb < 640) {
        const int c = nb - 512;
        ROWS_BEGIN
          if (!lat) {
            st8p_f32(p.out + 16777216 + ((size_t)((b * 2 + l) * 256 + s)) * 128 + c, fq, v0, v1);
            st8p_bf16(p.Kwin_c() + (size_t)m * 128 + c, fq, v0, v1);
          } else {
            rope8p_win(v0, v1, fq, ln, (const float*)(smem + LDS_ROPEW) + ((nb & 32) ? (s & 63) : (s >> 6)) * 32);
            st8p_bf16(p.Kwin_l() + ((size_t)((l * 8 + b) * 1280 + s)) * 128 + c, fq, v0, v1);
          }
        ROWS_END
      } else if (nb < 768) {
        const int c = nb - 640, kv = c >> 6, d0 = c & 63;
        ROWS_BEGIN
          if (!lat) {
            st8p_f32(p.out + 18874368 + ((size_t)((b * 2 + l) * 256 + s)) * 128 + c, fq, v0, v1);
            st8p_tr(p.Vtwin_c() + ((size_t)((b * 2 + kv) * 64 + d0)) * 256 + s, 256, fq, v0, v1);
          } else {
            st8p_tr(p.Vtwin_l() + ((size_t)(((l * 8 + b) * 2 + kv) * 64 + d0)) * 1280 + s, 1280, fq, v0, v1);
          }
        ROWS_END
      } else if (nb < 1024) {
        ROWS_BEGIN
          st8p_bf16(p.Qret() + (size_t)m * 256 + (nb - 768), fq, v0, v1);
        ROWS_END
      } else if (nb < 1280) {
        ROWS_BEGIN
          st8p_bf16(p.Kret() + (size_t)m * 256 + (nb - 1024), fq, v0, v1);
        ROWS_END
      } else if (nb < 1536) {
        const int c = nb - 1280, hh = c >> 6, d0 = c & 63;
        ROWS_BEGIN
          if (!lat) st8p_tr(p.Vtret_c() + ((size_t)((b * 4 + hh) * 64 + d0)) * 256 + s, 256, fq, v0, v1);
          else st8p_tr(p.Vtret_l() + ((size_t)((b * 4 + hh) * 64 + d0)) * 1024 + s, 1024, fq, v0, v1);
        ROWS_END
      } else if (nb < 1792) {
        ROWS_BEGIN
          st8p_bf16(p.Gret() + (size_t)m * 256 + (nb - 1536), fq, v0, v1);
        ROWS_END
      } else if (nb < 2176) {
        const int c = nb - 1792;
        const bool rp = lat && (c % 96) == 64;
        ROWS_BEGIN
          if (rp) rope8p_mla(v0, v1, fq, ln, (const float*)(smem + LDS_ROPEM) + (s >> 6) * 16, (const float*)(smem + LDS_ROPEM) + (s & 63) * 16);
          st8p_bf16(p.Qmla() + (size_t)m * 384 + c, fq, v0, v1);
        ROWS_END
      } else if (nb < 2304) {
        const int c = nb - 2176;
        float* red = (float*)(smem + LDS_RED);
        kargp_t k2 = kp; asm volatile("" : "+s"(k2));
        const float* g = ((const __attribute__((address_space(4))) P*)k2)->mla_kv_norm + l * 128 + c;
        const f32x4 g0 = *(const f32x4*)(g + 8 * fq), g1 = *(const f32x4*)(g + 8 * fq + 4);
#pragma unroll
        for (int ai = 0; ai < 2; ++ai)
#pragma unroll
          for (int mm = 0; mm < 4; ++mm) {
            const float rsd0 = rsdv[ai][mm];
            const f32x4 a = acc[ai][bj][mm][0] * rsd0 + sw0, b4 = acc[ai][bj][mm][1] * rsd0 + sw1;
            float ss = a[0] * a[0] + a[1] * a[1] + a[2] * a[2] + a[3] * a[3] + b4[0] * b4[0] + b4[1] * b4[1] + b4[2] * b4[2] + b4[3] * b4[3];
            ss += shx(ss, 16, ln);
            ss += shx(ss, 32, ln);
            if (fq == 0) red[wc * 256 + ai * 128 + wr * 64 + mm * 16 + fr] = ss;
          }
        asm volatile("s_waitcnt lgkmcnt(0)" ::: "memory");
        __builtin_amdgcn_s_barrier();
        ROWS_BEGIN
          const int rt = ai * 128 + wr * 64 + mm * 16 + fr;
          const float rsv = rsqrtf((red[rt] + red[256 + rt] + red[512 + rt] + red[768 + rt]) * (1.f / 128.f) + 1e-6f);
          v0 = v0 * rsv * g0;
          v1 = v1 * rsv * g1;
          st8p_bf16(p.ckvn() + ((size_t)l * 18432 + m) * 128 + c, fq, v0, v1);
          if (!lat) st8p_f32(p.out + 20971520 + ((size_t)((b * 2 + l) * 256 + s)) * 128 + c, fq, v0, v1);
        ROWS_END
        asm volatile("s_waitcnt vmcnt(0) lgkmcnt(0)" ::: "memory");
        __builtin_amdgcn_s_barrier();
        if (wr == 0 && wc == 0 && ln == 0) {
          __builtin_amdgcn_fence(__ATOMIC_RELEASE, "agent");
          asm volatile("s_waitcnt vmcnt(0)" ::: "memory");
          __hip_atomic_fetch_add(p.ctl() + 64 * l, 1u, __ATOMIC_RELAXED, __HIP_MEMORY_SCOPE_AGENT);
        }
      } else {
        ROWS_BEGIN
          if (!lat) {
            st8p_f32(p.out + 23068672 + ((size_t)((b * 2 + l) * 256 + s)) * 32, fq, v0, v1);
#pragma unroll
            for (int hh = 0; hh < 4; ++hh) st8p_bf16(p.Kmla_c() + ((size_t)((b * 4 + hh) * 256 + s)) * 96 + 64, fq, v0, v1);
          } else {
            rope8p_mla(v0, v1, fq, ln, (const float*)(smem + LDS_ROPEM) + (s >> 6) * 16, (const float*)(smem + LDS_ROPEM) + (s & 63) * 16);
#pragma unroll
            for (int hh = 0; hh < 4; ++hh) st8p_bf16(p.Kmla_l() + ((size_t)(((l * 8 + b) * 4 + hh) * 1280 + s)) * 96 + 64, fq, v0, v1);
          }
        ROWS_END
      }
    };
    do_half(IC<0>{});
    do_half(IC<1>{});
#undef ROWS_BEGIN
#undef ROWS_END
  }
};

struct EpiOut8 {
  static constexpr bool PERM = true, AFTER_DRAIN = false;
  P p0; int l;
  __device__ __forceinline__ void operator()(const acc_t& acc, const Unit& u, int wr, int wc, int fr_in, int fq_in) const {
    int fr = fr_in; asm volatile("" : "+v"(fr));
    int fq = fq_in; asm volatile("" : "+v"(fq));
    const int ln = fq * 16 + fr; (void)ln;
    P p = p0; asm volatile("" : "+s"(p.ws), "+s"(p.out));
    const int rbase = u.pm * 256 + wr * 64 + fr;
    const int cb = u.pn * 256 + wc * 32 + 8 * fq;
    const float* md = p.mod() + ((size_t)(l * 9 + mod_row(u.pm * 256))) * 6144;
    const float* gate = md + 2 * 1024; const float* sc2 = md + 4 * 1024; const float* g2 = p.norm2 + l * DM;
#pragma unroll
    for (int ap = 0; ap < 4; ++ap) {
      constexpr int dummy = 0; (void)dummy;
      const int ai = ap >> 1, m2 = (ap & 1) * 2;
      int mb = rbase + ai * 128 + m2 * 16; asm volatile("" : "+v"(mb));
      f32x4 xv[2][2][2];
#pragma unroll
      for (int mq = 0; mq < 2; ++mq) {
        const int mm = m2 + mq;
        const int m = mb + mq * 16;
        if (l == 0) {
          const float* xr = m < NCTX ? p.x_prompt + (size_t)m * DM : p.x_sample + (size_t)(m - NCTX) * DM;
#pragma unroll
          for (int bj = 0; bj < 2; ++bj)
#pragma unroll
            for (int n = 0; n < 2; ++n) xv[mq][bj][n] = *(const f32x4*)(xr + cb + bj * 128 + n * 4);
        } else {
          const bf16_t* hr = p.hbuf() + (size_t)m * DM;
#pragma unroll
          for (int bj = 0; bj < 2; ++bj) {
            const uint4 h8 = *(const uint4*)(hr + cb + bj * 128);
#pragma unroll
            for (int n = 0; n < 2; ++n) {
              const int c = cb + bj * 128 + n * 4;
              uint2 hq; hq.x = n ? h8.z : h8.x; hq.y = n ? h8.w : h8.y;
              const f32x4 q1 = *(const f32x4*)(p.norm1 + DM + c) * (*(const f32x4*)(md + 1 * 1024 + c) + 1.f);
              f32x4 xm;
              xm[0] = __uint_as_float(hq.x << 16) * __builtin_amdgcn_rcpf(q1[0]); xm[1] = __uint_as_float(hq.x & 0xffff0000u) * __builtin_amdgcn_rcpf(q1[1]);
              xm[2] = __uint_as_float(hq.y << 16) * __builtin_amdgcn_rcpf(q1[2]); xm[3] = __uint_as_float(hq.y & 0xffff0000u) * __builtin_amdgcn_rcpf(q1[3]);
              xv[mq][bj][n] = xm;
            }
          }
        }
      }
#pragma unroll
      for (int mq = 0; mq < 2; ++mq) {
        const int mm = m2 + mq;
        const int m = mb + mq * 16;
        bf16_t* ho = p.hbuf() + (size_t)m * DM;
        float ss = 0.f;
#pragma unroll
        for (int bj = 0; bj < 2; ++bj) {
          unsigned pw[4];
#pragma unroll
          for (int n = 0; n < 2; ++n) {
            const int c = cb + bj * 128 + n * 4;
            const f32x4 xn = xv[mq][bj][n] + *(const f32x4*)(gate + c) * acc[ai][bj][mm][n];
            const f32x4 hv = xn * (*(const f32x4*)(g2 + c) * (*(const f32x4*)(sc2 + c) + 1.f));
            pw[2 * n] = pk2(hv[0], hv[1]); pw[2 * n + 1] = pk2(hv[2], hv[3]);
            ss += (xn[0] * xn[0] + xn[1] * xn[1]) + (xn[2] * xn[2] + xn[3] * xn[3]);
          }
          *(uint4*)(ho + cb + bj * 128) = make_uint4(pw[0], pw[1], pw[2], pw[3]);
        }
        ss += shx(ss, 16, ln);
        ss += shx(ss, 32, ln);
        if (fq == 0) p.rssB()[(size_t)m * 16 + u.pn * 4 + wc] = ss;
      }
      asm volatile("" ::: "memory");
    }
  }
};
struct EpiUp8 {
  static constexpr bool PERM = true, AFTER_DRAIN = false;
  P p0; int l;
  __device__ __forceinline__ void operator()(const acc_t& acc, const Unit& u, int wr, int wc, int fr_in, int fq_in) const {
    int fr = fr_in; asm volatile("" : "+v"(fr));
    int fq = fq_in; asm volatile("" : "+v"(fq));
    const int ln = fq * 16 + fr; (void)ln;
    P p = p0; asm volatile("" : "+s"(p.ws), "+s"(p.out));
    const int rbase = u.pm * 256 + wr * 64 + fr;
    const int cb = u.pn * 256 + wc * 32 + 8 * fq;
    const float* swp = p.sWup() + ((size_t)(l * 9 + mod_row(u.pm * 256))) * DFF;
    float rsdv[2][4];
#pragma unroll
    for (int ai = 0; ai < 2; ++ai)
#pragma unroll
      for (int mm = 0; mm < 4; ++mm) rsdv[ai][mm] = row_rstd(p.rssB(), rbase + ai * 128 + mm * 16);
    f32x4 swv[2][2];
#pragma unroll
    for (int bj = 0; bj < 2; ++bj)
#pragma unroll
      for (int n = 0; n < 2; ++n) swv[bj][n] = *(const f32x4*)(swp + cb + bj * 128 + n * 4);
#pragma unroll
    for (int ai = 0; ai < 2; ++ai)
#pragma unroll
      for (int mm = 0; mm < 4; ++mm) {
        int m = rbase + ai * 128 + mm * 16; asm volatile("" : "+v"(m));
        bf16_t* uo = p.ubuf() + (size_t)m * DFF;
        const float rsd = rsdv[ai][mm];
#pragma unroll
        for (int bj = 0; bj < 2; ++bj) {
          f32x4 t0 = acc[ai][bj][mm][0] * rsd + swv[bj][0], t1 = acc[ai][bj][mm][1] * rsd + swv[bj][1];
#pragma unroll
          for (int j = 0; j < 4; ++j) { const float a = fmaxf(t0[j], 0.f), b = fmaxf(t1[j], 0.f); t0[j] = a * a; t1[j] = b * b; }
          __builtin_nontemporal_store((u32x4v){pk2(t0[0], t0[1]), pk2(t0[2], t0[3]), pk2(t1[0], t1[1]), pk2(t1[2], t1[3])}, (u32x4v*)(uo + cb + bj * 128));
        }
      }
  }
};
struct EpiDown8 {
  static constexpr bool PERM = true, AFTER_DRAIN = false;
  P p0; int l;
  __device__ __forceinline__ void operator()(const acc_t& acc, const Unit& u, int wr, int wc, int fr_in, int fq_in) const {
    int fr = fr_in; asm volatile("" : "+v"(fr));
    int fq = fq_in; asm volatile("" : "+v"(fq));
    const int ln = fq * 16 + fr; (void)ln;
    P p = p0; asm volatile("" : "+s"(p.ws), "+s"(p.out));
    const int rbase = u.pm * 256 + wr * 64 + fr;
    const int cb = u.pn * 256 + wc * 32 + 8 * fq;
    const int r = mod_row(u.pm * 256);
    const float* md = p.mod() + ((size_t)(l * 9 + r)) * 6144;
    const float* gate = md + 5 * 1024; const float* sc2 = md + 4 * 1024; const float* g2 = p.norm2 + l * DM;
    const float* sc1 = p.mod() + ((size_t)(9 + r)) * 6144 + 1 * 1024;
    const float* g1 = p.norm1 + DM;
    f32x4 riv[2][2];
#pragma unroll
    for (int bj = 0; bj < 2; ++bj)
#pragma unroll
      for (int n = 0; n < 2; ++n) {
        const int c = cb + bj * 128 + n * 4;
        const f32x4 q2 = *(const f32x4*)(g2 + c) * (*(const f32x4*)(sc2 + c) + 1.f);
#pragma unroll
        for (int j = 0; j < 4; ++j) riv[bj][n][j] = __builtin_amdgcn_rcpf(q2[j]);
      }
#pragma unroll
    for (int ap = 0; ap < 4; ++ap) {
      const int ai = ap >> 1, m2 = (ap & 1) * 2;
      int mb = rbase + ai * 128 + m2 * 16; asm volatile("" : "+v"(mb));
      uint4 hvv[2][2];
#pragma unroll
      for (int mq = 0; mq < 2; ++mq) {
        const bf16_t* hr = p.hbuf() + (size_t)(mb + mq * 16) * DM;
#pragma unroll
        for (int bj = 0; bj < 2; ++bj) hvv[mq][bj] = *(const uint4*)(hr + cb + bj * 128);
      }
#pragma unroll
      for (int mq = 0; mq < 2; ++mq) {
        const int mm = m2 + mq;
        const int m = mb + mq * 16;
        float* xo = p.xw() + (size_t)m * DM;
        bf16_t* ho = p.hbuf() + (size_t)m * DM;
        float ss = 0.f;
#pragma unroll
        for (int bj = 0; bj < 2; ++bj) {
          unsigned pw[4] = {0u, 0u, 0u, 0u};
#pragma unroll
          for (int n = 0; n < 2; ++n) {
            const int c = cb + bj * 128 + n * 4;
            uint2 hq; hq.x = n ? hvv[mq][bj].z : hvv[mq][bj].x; hq.y = n ? hvv[mq][bj].w : hvv[mq][bj].y;
            f32x4 xm;
            xm[0] = __uint_as_float(hq.x << 16); xm[1] = __uint_as_float(hq.x & 0xffff0000u);
            xm[2] = __uint_as_float(hq.y << 16); xm[3] = __uint_as_float(hq.y & 0xffff0000u);
            const f32x4 xn = xm * riv[bj][n] + *(const f32x4*)(gate + c) * acc[ai][bj][mm][n];
            if (l != 0) *(f32x4*)(xo + c) = xn;
            if (l == 0) {
              const f32x4 hv = xn * (*(const f32x4*)(g1 + c) * (*(const f32x4*)(sc1 + c) + 1.f));
              pw[2 * n] = pk2(hv[0], hv[1]); pw[2 * n + 1] = pk2(hv[2], hv[3]);
              ss += (xn[0] * xn[0] + xn[1] * xn[1]) + (xn[2] * xn[2] + xn[3] * xn[3]);
            }
          }
          if (l == 0) *(uint4*)(ho + cb + bj * 128) = make_uint4(pw[0], pw[1], pw[2], pw[3]);
        }
        if (l == 0) {
          ss += shx(ss, 16, ln);
          ss += shx(ss, 32, ln);
          if (fq == 0) p.rssA()[(size_t)m * 16 + u.pn * 4 + wc] = ss;
        }
      }
      asm volatile("" ::: "memory");
    }
  }
};

struct EpiKvb {
  P p; int l;
  __device__ __forceinline__ void operator()(int m, int nb, int h, const f32x16& v) const {
    const int hh = nb >> 7, j0 = nb & 127;
    bf16_t* Kb; bf16_t* Vb; int S, key;
    if (m < NCTX) {
      const int b = m >> 8; key = m & 255; S = 256;
      Kb = p.Kmla_c() + ((size_t)((b * 4 + hh) * 256)) * 96;
      Vb = p.Vtmla_c() + ((size_t)((b * 4 + hh) * 64)) * 256;
    } else {
      int b;
      if (m < NTOK) { b = (m - NCTX) >> 10; key = (m - NCTX) & 1023; }
      else { b = (m - NTOK) >> 8; key = 1024 + ((m - NTOK) & 255); }
      S = 1280;
      Kb = p.Kmla_l() + ((size_t)(((l * 8 + b) * 4 + hh) * 1280)) * 96;
      Vb = p.Vtmla_l() + ((size_t)(((l * 8 + b) * 4 + hh) * 64)) * 1280;
    }
    if (j0 < 64) st_rm_bf16(Kb + (size_t)key * 96 + j0, h, v);
    else st_tr_bf16(Vb + (size_t)(j0 - 64) * S + key, S, h, v);
  }
};

template <class Epi>
__device__ __forceinline__ void gemm_small(const bf16_t* __restrict__ A, int lda, const bf16_t* __restrict__ W, int ldw,
                                           int M, int N, int K, unsigned char* smem, const Epi& epi, const int wv, unsigned* ready, unsigned* ticket) {
  constexpr int TA = 256 * 72, TW = 128 * 72;
  bf16_t* sb = (bf16_t*)smem;
  const int tid = my_tid(wv), bid = my_bid(), lane = tid & 63, wave = tid >> 6;
  const int wm = wave >> 1, wn = wave & 1, r = lane & 31, h = lane >> 5;
  const int MT = M >> 8, NT = N >> 7, ntiles = MT * NT, nk = K >> 6;
  const int lc = tid & 7, lr = tid >> 3;
  (void)bid;
  if (tid == 0) {
    unsigned polls = 0;
    while (__hip_atomic_load(ready, __ATOMIC_RELAXED, __HIP_MEMORY_SCOPE_AGENT) < 64u && ++polls < (1u << 22)) __builtin_amdgcn_s_sleep(8);
    __builtin_amdgcn_fence(__ATOMIC_ACQUIRE, "agent");
    asm volatile("s_waitcnt vmcnt(0)" ::: "memory");
  }
  __syncthreads();
  volatile int* tks = (volatile int*)(smem + LDS_RED + 2048);
  for (;;) {
    __syncthreads();
    if (tid == 0) *tks = (int)__hip_atomic_fetch_add(ticket, 1u, __ATOMIC_RELAXED, __HIP_MEMORY_SCOPE_AGENT);
    __syncthreads();
    const int tile = *tks;
    if (tile >= ntiles) break;
    const int m0 = (tile % MT) << 8, n0 = (tile / MT) << 7;
    f32x16 acc[2][2];
#pragma unroll
    for (int a = 0; a < 2; ++a)
#pragma unroll
      for (int b = 0; b < 2; ++b)
#pragma unroll
        for (int i = 0; i < 16; ++i) acc[a][b][i] = 0.f;
    uint4 ra[4], rw[2];
    const bf16_t* Ap = A + (size_t)(m0 + lr) * lda + lc * 8;
    const bf16_t* Wp = W + (size_t)(n0 + lr) * ldw + lc * 8;
    auto gload = [&](int kt) {
#pragma unroll
      for (int i = 0; i < 4; ++i) ra[i] = *(const uint4*)(Ap + (size_t)(64 * i) * lda + kt * 64);
#pragma unroll
      for (int i = 0; i < 2; ++i) rw[i] = *(const uint4*)(Wp + (size_t)(64 * i) * ldw + kt * 64);
    };
    auto swrite = [&](int bsel) {
      bf16_t* sA = sb + bsel * (TA + TW); bf16_t* sW = sA + TA;
#pragma unroll
      for (int i = 0; i < 4; ++i) *(uint4*)(sA + (lr + 64 * i) * 72 + lc * 8) = ra[i];
#pragma unroll
      for (int i = 0; i < 2; ++i) *(uint4*)(sW + (lr + 64 * i) * 72 + lc * 8) = rw[i];
    };
    __syncthreads();
    gload(0); swrite(0);
    __syncthreads();
    for (int kt = 0; kt < nk; ++kt) {
      if (kt + 1 < nk) gload(kt + 1);
      const bf16_t* sA = sb + (kt & 1) * (TA + TW); const bf16_t* sW = sA + TA;
#pragma unroll
      for (int ks = 0; ks < 4; ++ks) {
        bf16x8 wf[2], af[2];
#pragma unroll
        for (int i = 0; i < 2; ++i) {
          wf[i] = *(const bf16x8*)(sW + (wn * 64 + i * 32 + r) * 72 + ks * 16 + h * 8);
          af[i] = *(const bf16x8*)(sA + (wm * 64 + i * 32 + r) * 72 + ks * 16 + h * 8);
        }
#pragma unroll
        for (int a = 0; a < 2; ++a)
#pragma unroll
          for (int b = 0; b < 2; ++b) acc[a][b] = __builtin_amdgcn_mfma_f32_32x32x16_bf16(wf[a], af[b], acc[a][b], 0, 0, 0);
      }
      if (kt + 1 < nk) swrite((kt + 1) & 1);
      __syncthreads();
    }
#pragma unroll
    for (int a = 0; a < 2; ++a)
#pragma unroll
      for (int b = 0; b < 2; ++b) epi(m0 + wm * 64 + b * 32 + r, n0 + wn * 64 + a * 32, h, acc[a][b]);
  }
}

struct AttnItem {
  const bf16_t* Q; int qs;
  const bf16_t* K; int ks;
  const bf16_t* Vt; int vs;
  int t0, t1, t2, t3;
  int qpos0, T;
  float scale, sink_l2; int has_sink;
  float lgf, lgb;
  const bf16_t *S0f, *S0b;
  const bf16_t* G; const float* gn;
  bf16_t* out;
  float* sout;
};

template <int DQK, int MODE>
__device__ __forceinline__ void attn_item(const AttnItem& it, unsigned char* smem, const int wv) {
  constexpr int KSTR = DQK + 8, NKS = DQK / 16, VSTR = 68, KCH = DQK / 8;
  bf16_t* Ks = (bf16_t*)smem;
  bf16_t* Vs = Ks + 64 * KSTR;
  const int tid = my_tid(wv), lane = tid & 63, wave = tid >> 6, r = lane & 31, h = lane >> 5;
  const int qrow = wave * 32 + r;
  bf16x8 qf[NKS];
  if constexpr (MODE == 3) {
    const int dq = (wave & 1) * 32 + r;
#pragma unroll
    for (int ks = 0; ks < NKS; ++ks) {
      const int e = dq - (ks * 16 + h * 8);
      uint4 v;
      v.x = e == 0 ? 0x3F80u : (e == 1 ? 0x3F800000u : 0u);
      v.y = e == 2 ? 0x3F80u : (e == 3 ? 0x3F800000u : 0u);
      v.z = e == 4 ? 0x3F80u : (e == 5 ? 0x3F800000u : 0u);
      v.w = e == 6 ? 0x3F80u : (e == 7 ? 0x3F800000u : 0u);
      qf[ks] = __builtin_bit_cast(bf16x8, v);
    }
  } else {
#pragma unroll
    for (int ks = 0; ks < NKS; ++ks) qf[ks] = *(const bf16x8*)(it.Q + (size_t)qrow * it.qs + ks * 16 + h * 8);
  }
  f32x16 o0, o1;
#pragma unroll
  for (int i = 0; i < 16; ++i) { o0[i] = 0.f; o1[i] = 0.f; }
  float mrun = it.has_sink ? it.sink_l2 : -1e30f, lrun = 0.f;
  const int qp = it.qpos0 + qrow;
  const int n1 = it.t1 - it.t0, ntl = n1 + (it.t3 - it.t2);
  constexpr int BUFE = 64 * KSTR + 64 * VSTR;
  const int krow0 = tid / KCH, kch0 = tid % KCH, krow1 = (tid + NTHR) / KCH, kch1 = (tid + NTHR) % KCH;
  const bool k2 = (KCH == 12) && (tid + NTHR < 64 * KCH);
  const int vrow = tid >> 3, vch = tid & 7;
  uint4 rk0, rk1, rv;
  auto tile_of = [&](int ti) { return ti < n1 ? it.t0 + ti : it.t2 + (ti - n1); };
  auto gload = [&](int t) {
    const bool stt = (MODE == 2) && (t >= 16);
    if (!stt) {
      const int key0 = t * 64;
      rk0 = *(const uint4*)(it.K + (size_t)(key0 + krow0) * it.ks + kch0 * 8);
      if (k2) rk1 = *(const uint4*)(it.K + (size_t)(key0 + krow1) * it.ks + kch1 * 8);
      rv = *(const uint4*)(it.Vt + (size_t)vrow * it.vs + key0 + vch * 8);
    } else {
      const bf16_t* S = (t == 16) ? it.S0f : it.S0b;
      const int e = krow0 - kch0 * 8;
      rk0.x = e == 0 ? 0x3F80u : (e == 1 ? 0x3F800000u : 0u);
      rk0.y = e == 2 ? 0x3F80u : (e == 3 ? 0x3F800000u : 0u);
      rk0.z = e == 4 ? 0x3F80u : (e == 5 ? 0x3F800000u : 0u);
      rk0.w = e == 6 ? 0x3F80u : (e == 7 ? 0x3F800000u : 0u);
      rv = *(const uint4*)(S + (size_t)vrow * 64 + vch * 8);
    }
  };
  auto swrite = [&](int bsel) {
    bf16_t* Kb = Ks + bsel * BUFE; bf16_t* Vb = Kb + 64 * KSTR;
    *(uint4*)(Kb + krow0 * KSTR + kch0 * 8) = rk0;
    if (k2) *(uint4*)(Kb + krow1 * KSTR + kch1 * 8) = rk1;
    uint2* d = (uint2*)(Vb + vrow * VSTR + vch * 8);
    d[0] = make_uint2(rv.x, rv.y); d[1] = make_uint2(rv.z, rv.w);
  };
  __syncthreads();
  gload(tile_of(0)); swrite(0);
  __syncthreads();
  for (int ti = 0; ti < ntl; ++ti) {
    const int t = tile_of(ti);
    const bool st_tile = (MODE == 2) && (t >= 16);
    const int key0 = t * 64;
    const bool more = ti + 1 < ntl;
    if (more) gload(tile_of(ti + 1));
    const bf16_t* Kc = Ks + (ti & 1) * BUFE; const bf16_t* Vc = Kc + 64 * KSTR;
    bool skip = (MODE == 3) && (wave >= 4);
    if (MODE == 1 && t < 16) {
      const int qlo = it.qpos0 + wave * 32;
      skip = (key0 > qlo + 31 + 128 || key0 + 63 < qlo - 128);
    }
    if (!skip) {
    f32x16 s0, s1;
#pragma unroll
    for (int i = 0; i < 16; ++i) { s0[i] = 0.f; s1[i] = 0.f; }
#pragma unroll
    for (int ks = 0; ks < NKS; ++ks) {
      const bf16x8 k0 = *(const bf16x8*)(Kc + r * KSTR + ks * 16 + h * 8);
      const bf16x8 k1 = *(const bf16x8*)(Kc + (32 + r) * KSTR + ks * 16 + h * 8);
      s0 = __builtin_amdgcn_mfma_f32_32x32x16_bf16(k0, qf[ks], s0, 0, 0, 0);
      s1 = __builtin_amdgcn_mfma_f32_32x32x16_bf16(k1, qf[ks], s1, 0, 0, 0);
    }
    if constexpr (MODE == 3) {
      if (wave < 2) {
        const float base = (float)(it.T - 1 - key0 - 4 * h) * it.lgf - 3.f;
#pragma unroll
        for (int i = 0; i < 16; ++i) {
          s0[i] *= fexp2(fmaf(-(float)((i & 3) + 8 * (i >> 2)), it.lgf, base));
          s1[i] *= fexp2(fmaf(-(float)(32 + (i & 3) + 8 * (i >> 2)), it.lgf, base));
        }
      } else {
        const float base = (float)(key0 + 4 * h) * it.lgb - 3.f;
#pragma unroll
        for (int i = 0; i < 16; ++i) {
          s0[i] *= fexp2(fmaf((float)((i & 3) + 8 * (i >> 2)), it.lgb, base));
          s1[i] *= fexp2(fmaf((float)(32 + (i & 3) + 8 * (i >> 2)), it.lgb, base));
        }
      }
    } else if constexpr (MODE == 2) {
      if (!st_tile) {
        const int qlo = it.qpos0 + wave * 32;
        if (key0 + 63 < qlo) {
          const float base = (float)(qp - key0 - 4 * h) * it.lgf - 3.f;
#pragma unroll
          for (int i = 0; i < 16; ++i) {
            s0[i] *= fexp2(fmaf(-(float)((i & 3) + 8 * (i >> 2)), it.lgf, base));
            s1[i] *= fexp2(fmaf(-(float)(32 + (i & 3) + 8 * (i >> 2)), it.lgf, base));
          }
        } else if (key0 > qlo + 31) {
          const float base = (float)(key0 + 4 * h - qp) * it.lgb - 3.f;
#pragma unroll
          for (int i = 0; i < 16; ++i) {
            s0[i] *= fexp2(fmaf((float)((i & 3) + 8 * (i >> 2)), it.lgb, base));
            s1[i] *= fexp2(fmaf((float)(32 + (i & 3) + 8 * (i >> 2)), it.lgb, base));
          }
        } else {
#pragma unroll
        for (int i = 0; i < 16; ++i) {
          const int key = key0 + (i & 3) + 8 * (i >> 2) + 4 * h;
          const int e0 = qp - key, e1 = e0 - 32;
          float d0 = fexp2((float)(e0 < 0 ? -e0 : e0) * (e0 > 0 ? it.lgf : it.lgb));
          float d1 = fexp2((float)(e1 < 0 ? -e1 : e1) * (e1 > 0 ? it.lgf : it.lgb));
          d0 = e0 == 0 ? 2.f : d0;
          d1 = e1 == 0 ? 2.f : d1;
          s0[i] *= it.scale * d0;
          s1[i] *= it.scale * d1;
        }
        }
      } else {
        const float dec = (t == 16) ? fexp2((float)(qp + 1) * it.lgf) : fexp2((float)(it.T - qp) * it.lgb);
#pragma unroll
        for (int i = 0; i < 16; ++i) { s0[i] *= dec; s1[i] *= dec; }
      }
    } else {
      float mx = -INFINITY;
      const int qlo1 = it.qpos0 + wave * 32;
      const bool need_mask = (MODE == 1) && (t < 16) && !(key0 >= qlo1 + 31 - 128 && key0 + 63 <= qlo1 + 128);
#pragma unroll
      for (int i = 0; i < 16; ++i) {
        float a = s0[i] * it.scale, b = s1[i] * it.scale;
        if (MODE == 1 && need_mask) {
          const int key = key0 + (i & 3) + 8 * (i >> 2) + 4 * h;
          const int e0 = key - qp, e1 = e0 + 32;
          if (e0 > 128 || e0 < -128) a = -INFINITY;
          if (e1 > 128 || e1 < -128) b = -INFINITY;
        }
        s0[i] = a; s1[i] = b;
        mx = fmaxf(mx, fmaxf(a, b));
      }
      mx = fmaxf(mx, shx(mx, 32, lane));
      const float mnew = fmaxf(mrun, mx);
      const float alpha = fexp2(mrun - mnew);
      float sum = 0.f;
#pragma unroll
      for (int i = 0; i < 16; ++i) {
        s0[i] = fexp2(s0[i] - mnew);
        s1[i] = fexp2(s1[i] - mnew);
        sum += s0[i] + s1[i];
      }
      lrun = lrun * alpha + sum;
      mrun = mnew;
#pragma unroll
      for (int i = 0; i < 16; ++i) { o0[i] *= alpha; o1[i] *= alpha; }
    }
#pragma unroll
    for (int kt = 0; kt < 2; ++kt) {
#pragma unroll
      for (int sbk = 0; sbk < 2; ++sbk) {
        uint4 pw;
        if (kt == 0) {
          pw.x = pk2(s0[8 * sbk + 0], s0[8 * sbk + 1]); pw.y = pk2(s0[8 * sbk + 2], s0[8 * sbk + 3]);
          pw.z = pk2(s0[8 * sbk + 4], s0[8 * sbk + 5]); pw.w = pk2(s0[8 * sbk + 6], s0[8 * sbk + 7]);
        } else {
          pw.x = pk2(s1[8 * sbk + 0], s1[8 * sbk + 1]); pw.y = pk2(s1[8 * sbk + 2], s1[8 * sbk + 3]);
          pw.z = pk2(s1[8 * sbk + 4], s1[8 * sbk + 5]); pw.w = pk2(s1[8 * sbk + 6], s1[8 * sbk + 7]);
        }
        const bf16x8 pf = __builtin_bit_cast(bf16x8, pw);
        const int koff = kt * 32 + sbk * 16 + 4 * h;
        const uint2 a0 = *(const uint2*)(Vc + r * VSTR + koff), a1 = *(const uint2*)(Vc + r * VSTR + koff + 8);
        const uint2 b0 = *(const uint2*)(Vc + (32 + r) * VSTR + koff), b1 = *(const uint2*)(Vc + (32 + r) * VSTR + koff + 8);
        const bf16x8 v0 = __builtin_bit_cast(bf16x8, make_uint4(a0.x, a0.y, a1.x, a1.y));
        const bf16x8 v1 = __builtin_bit_cast(bf16x8, make_uint4(b0.x, b0.y, b1.x, b1.y));
        o0 = __builtin_amdgcn_mfma_f32_32x32x16_bf16(v0, pf, o0, 0, 0, 0);
        o1 = __builtin_amdgcn_mfma_f32_32x32x16_bf16(v1, pf, o1, 0, 0, 0);
      }
    }
    }
    if (more) swrite((ti + 1) & 1);
    __syncthreads();
  }
  if constexpr (MODE == 3) {
    if (wave < 4) {
      float* rowp = it.sout + (size_t)(wave >> 1) * 16384 + (size_t)((wave & 1) * 32 + r) * 64;
#pragma unroll
      for (int g = 0; g < 4; ++g) {
        *(float4*)(rowp + 8 * g + 4 * h) = make_float4(o0[4 * g], o0[4 * g + 1], o0[4 * g + 2], o0[4 * g + 3]);
        *(float4*)(rowp + 32 + 8 * g + 4 * h) = make_float4(o1[4 * g], o1[4 * g + 1], o1[4 * g + 2], o1[4 * g + 3]);
      }
    }
    return;
  }
  bf16_t* orow = it.out + (size_t)qrow * DM;
  if constexpr (MODE == 2) {
    float sm = 0.f;
#pragma unroll
    for (int i = 0; i < 16; ++i) sm += o0[i] + o1[i];
    sm += shx(sm, 32, lane);
    const float mu = sm * (1.f / 64.f);
    float vr = 0.f;
#pragma unroll
    for (int i = 0; i < 16; ++i) { o0[i] -= mu; o1[i] -= mu; vr += o0[i] * o0[i] + o1[i] * o1[i]; }
    vr += shx(vr, 32, lane);
    const float rstd = rsqrtf(vr * (1.f / 64.f) + 1e-6f);
    const bf16_t* grow = it.G + (size_t)qrow * 256;
#pragma unroll
    for (int g = 0; g < 4; ++g) {
      const int d = 8 * g + 4 * h;
      const uint2 ga = *(const uint2*)(grow + d), gb = *(const uint2*)(grow + 32 + d);
      const float gav[4] = {__uint_as_float(ga.x << 16), __uint_as_float(ga.x & 0xffff0000u), __uint_as_float(ga.y << 16), __uint_as_float(ga.y & 0xffff0000u)};
      const float gbv[4] = {__uint_as_float(gb.x << 16), __uint_as_float(gb.x & 0xffff0000u), __uint_as_float(gb.y << 16), __uint_as_float(gb.y & 0xffff0000u)};
#pragma unroll
      for (int j = 0; j < 4; ++j) {
        const float x0 = gav[j], x1 = gbv[j];
        o0[4 * g + j] = o0[4 * g + j] * rstd * it.gn[d + j] * (x0 / (1.f + __expf(-x0)));
        o1[4 * g + j] = o1[4 * g + j] * rstd * it.gn[32 + d + j] * (x1 / (1.f + __expf(-x1)));
      }
    }
  } else {
    float lt = lrun + shx(lrun, 32, lane);
    if (it.has_sink) lt += fexp2(it.sink_l2 - mrun);
    const float inv = 1.f / lt;
#pragma unroll
    for (int i = 0; i < 16; ++i) { o0[i] *= inv; o1[i] *= inv; }
  }
  st_rm_bf16(orow, h, o0);
  st_rm_bf16(orow + 32, h, o1);
}

__device__ __forceinline__ float log2_sigmoid(float x) { return -log1pf(expf(-x)) * LOG2E; }

__device__ __forceinline__ void state_item(const P& p, int l, int idx, unsigned char* smem, const int wv) {
  const int b = idx >> 3, hh = (idx >> 1) & 3, dir = idx & 1;
  float* Ksm = (float*)smem;
  float* Vsm = Ksm + 4096;
  const int tid = my_tid(wv);
  const float lg = log2_sigmoid(p.ret_decay[(l * 2 + dir) * 4 + hh]);
  float acc[8];
#pragma unroll
  for (int i = 0; i < 8; ++i) acc[i] = 0.f;
  const int d = tid >> 3, e0 = (tid & 7) * 8;
  for (int c = 0; c < 4; ++c) {
    __syncthreads();
    for (int i = tid; i < 4096; i += NTHR) {
      const int j = i >> 6, dd = i & 63, tok = c * 64 + j;
      const float dec = dir == 0 ? fexp2((float)(255 - tok) * lg) : fexp2((float)tok * lg);
      Ksm[j * 64 + dd] = bf2f(p.Kret()[(size_t)(b * 256 + tok) * 256 + hh * 64 + dd]) * 0.125f * dec;
      const int e = i >> 6, jj = i & 63;
      Vsm[e * 65 + jj] = bf2f(p.Vtret_c()[((size_t)((b * 4 + hh) * 64 + e)) * 256 + c * 64 + jj]);
    }
    __syncthreads();
    for (int j = 0; j < 64; ++j) {
      const float kd = Ksm[j * 64 + d];
#pragma unroll
      for (int i = 0; i < 8; ++i) acc[i] += kd * Vsm[(e0 + i) * 65 + j];
    }
  }
  float* op = p.out + 23592960 + ((size_t)((((b * 2 + l) * 2 + dir) * 4 + hh) * 64 + d)) * 64 + e0;
  *(float4*)(op) = make_float4(acc[0], acc[1], acc[2], acc[3]);
  *(float4*)(op + 4) = make_float4(acc[4], acc[5], acc[6], acc[7]);
}

__device__ __forceinline__ void attn_phase(const P& p, int l, unsigned char* smem, const int wv) {
  constexpr int NA = 128, NB = 128, NC = 256, ND = 256, NE = 128, NF = 128, NG = 128;
  constexpr int TOT = NA + NB + NC + ND + NE + NF + NG;
  unsigned* ticket = p.ctl() + 32 + 64 * l;
  volatile int* tks = (volatile int*)(smem + LDS_RED + 2048);
  const int tid0 = my_tid(wv);
  for (;;) {
    __syncthreads();
    if (tid0 == 0) *tks = (int)__hip_atomic_fetch_add(ticket, 1u, __ATOMIC_RELAXED, __HIP_MEMORY_SCOPE_AGENT);
    __syncthreads();
    const int item = *tks;
    if (item >= TOT) break;
    int idx = item;
    AttnItem it;
    it.t2 = 0; it.t3 = 0; it.qpos0 = 0; it.T = 0; it.sink_l2 = 0.f; it.has_sink = 0; it.lgf = 0.f; it.lgb = 0.f;
    it.S0f = nullptr; it.S0b = nullptr; it.G = nullptr; it.gn = nullptr; it.sout = nullptr;
    if (idx < NA) {
      const int b = idx >> 4, hh = (idx >> 2) & 3, qb = idx & 3, row0 = NCTX + b * 1024 + qb * 256;
      it.Q = p.Qmla() + (size_t)row0 * 384 + hh * 96; it.qs = 384;
      it.K = p.Kmla_l() + ((size_t)(((l * 8 + b) * 4 + hh) * 1280)) * 96; it.ks = 96;
      it.Vt = p.Vtmla_l() + ((size_t)(((l * 8 + b) * 4 + hh) * 64)) * 1280; it.vs = 1280;
      it.t0 = 0; it.t1 = 20;
      it.scale = 0.10206207261596575f * LOG2E;
      it.out = p.mix() + (size_t)row0 * DM + 768 + hh * 64;
      attn_item<96, 0>(it, smem, wv);
      continue;
    }
    idx -= NA;
    if (idx < NB) {
      const int b = idx >> 4, hh = (idx >> 2) & 3, qb = idx & 3, row0 = NCTX + b * 1024 + qb * 256;
      it.Q = p.Qret() + (size_t)row0 * 256 + hh * 64; it.qs = 256;
      it.K = p.Kret() + (size_t)(NCTX + b * 1024) * 256 + hh * 64; it.ks = 256;
      it.Vt = p.Vtret_l() + ((size_t)((b * 4 + hh) * 64)) * 1024; it.vs = 1024;
      it.t0 = 0; it.t1 = 16; it.t2 = 16; it.t3 = 18;
      it.qpos0 = qb * 256; it.T = 1024; it.scale = 0.125f;
      it.lgf = log2_sigmoid(p.ret_decay[(l * 2 + 0) * 4 + hh]);
      it.lgb = log2_sigmoid(p.ret_decay[(l * 2 + 1) * 4 + hh]);
      it.S0f = p.S0t() + ((size_t)((((l * 8 + b) * 2 + 0) * 4 + hh))) * 4096;
      it.S0b = p.S0t() + ((size_t)((((l * 8 + b) * 2 + 1) * 4 + hh))) * 4096;
      it.G = p.Gret() + (size_t)row0 * 256 + hh * 64; it.gn = p.ret_gn + l * 256 + hh * 64;
      it.out = p.mix() + (size_t)row0 * DM + 512 + hh * 64;
      attn_item<64, 2>(it, smem, wv);
      continue;
    }
    idx -= NB;
    if (idx < NC) {
      const int b = idx >> 5, head = (idx >> 2) & 7, qb = idx & 3, kv = head >> 2, row0 = NCTX + b * 1024 + qb * 256;
      it.Q = p.Qwin() + (size_t)row0 * 512 + head * 64; it.qs = 512;
      it.K = p.Kwin_l() + ((size_t)((l * 8 + b) * 1280)) * 128 + kv * 64; it.ks = 128;
      it.Vt = p.Vtwin_l() + ((size_t)(((l * 8 + b) * 2 + kv) * 64)) * 1280; it.vs = 1280;
      it.t0 = max(0, qb * 4 - 2); it.t1 = min(16, qb * 4 + 6); it.t2 = 16; it.t3 = 20;
      it.qpos0 = qb * 256;
      it.scale = 0.125f * LOG2E; it.sink_l2 = p.win_sink[l * 8 + head] * LOG2E; it.has_sink = 1;
      it.out = p.mix() + (size_t)row0 * DM + head * 64;
      attn_item<64, 1>(it, smem, wv);
      continue;
    }
    idx -= NC;
    if (idx < ND) {
      const int b = idx >> 3, head = idx & 7, kv = head >> 2, row0 = b * 256;
      it.Q = p.Qwin() + (size_t)row0 * 512 + head * 64; it.qs = 512;
      it.K = p.Kwin_c() + (size_t)(b * 256) * 128 + kv * 64; it.ks = 128;
      it.Vt = p.Vtwin_c() + ((size_t)((b * 2 + kv) * 64)) * 256; it.vs = 256;
      it.t0 = 0; it.t1 = 4;
      it.scale = 0.125f * LOG2E; it.sink_l2 = p.win_sink[l * 8 + head] * LOG2E; it.has_sink = 1;
      it.out = p.mix() + (size_t)row0 * DM + head * 64;
      attn_item<64, 0>(it, smem, wv);
      continue;
    }
    idx -= ND;
    if (idx < NE) {
      const int b = idx >> 2, hh = idx & 3, row0 = b * 256;
      it.Q = p.Qmla() + (size_t)row0 * 384 + hh * 96; it.qs = 384;
      it.K = p.Kmla_c() + ((size_t)((b * 4 + hh) * 256)) * 96; it.ks = 96;
      it.Vt = p.Vtmla_c() + ((size_t)((b * 4 + hh) * 64)) * 256; it.vs = 256;
      it.t0 = 0; it.t1 = 4;
      it.scale = 0.10206207261596575f * LOG2E;
      it.out = p.mix() + (size_t)row0 * DM + 768 + hh * 64;
      attn_item<96, 0>(it, smem, wv);
      continue;
    }
    idx -= NE;
    if (idx < NF) {
      const int b = idx >> 2, hh = idx & 3, row0 = b * 256;
      it.Q = p.Qret() + (size_t)row0 * 256 + hh * 64; it.qs = 256;
      it.K = p.Kret() + (size_t)(b * 256) * 256 + hh * 64; it.ks = 256;
      it.Vt = p.Vtret_c() + ((size_t)((b * 4 + hh) * 64)) * 256; it.vs = 256;
      it.t0 = 0; it.t1 = 4;
      it.qpos0 = 0; it.T = 256; it.scale = 0.125f;
      it.lgf = log2_sigmoid(p.ret_decay[(l * 2 + 0) * 4 + hh]);
      it.lgb = log2_sigmoid(p.ret_decay[(l * 2 + 1) * 4 + hh]);
      it.G = p.Gret() + (size_t)row0 * 256 + hh * 64; it.gn = p.ret_gn + l * 256 + hh * 64;
      it.out = p.mix() + (size_t)row0 * DM + 512 + hh * 64;
      attn_item<64, 2>(it, smem, wv);
      continue;
    }
    idx -= NF;
    {
      const int b = idx >> 2, hh = idx & 3;
      it.Q = nullptr; it.qs = 0;
      it.K = p.Kret() + (size_t)(b * 256) * 256 + hh * 64; it.ks = 256;
      it.Vt = p.Vtret_c() + ((size_t)((b * 4 + hh) * 64)) * 256; it.vs = 256;
      it.t0 = 0; it.t1 = 4;
      it.T = 256; it.scale = 0.125f;
      it.lgf = log2_sigmoid(p.ret_decay[(l * 2 + 0) * 4 + hh]);
      it.lgb = log2_sigmoid(p.ret_decay[(l * 2 + 1) * 4 + hh]);
      it.out = nullptr;
      it.sout = p.out + 23592960 + ((size_t)((b * 2 + l) * 2 * 4 + hh)) * 4096;
      attn_item<64, 3>(it, smem, wv);
    }
  }
}

__device__ __forceinline__ void gemv9_item(const float* sc, float* red, const float* __restrict__ W, int N, int n0, float* outp, int ldo,
                                           const float* bias, const int tid) {
  const int j4 = (tid & 7) * 4, kq = tid >> 3;
  f32x4 acc[9];
#pragma unroll
  for (int r = 0; r < 9; ++r) acc[r] = (f32x4){0.f, 0.f, 0.f, 0.f};
  const float* w = W + (size_t)(kq * 16) * N + n0 + j4;
  const float* s = sc + kq * 16;
#pragma unroll
  for (int kk = 0; kk < 16; ++kk) {
    const f32x4 wv = *(const f32x4*)(w + (size_t)kk * N);
#pragma unroll
    for (int r = 0; r < 9; ++r) acc[r] += wv * s[r * 1024 + kk];
  }
#pragma unroll
  for (int r = 0; r < 9; ++r) *(f32x4*)(red + (kq * 9 + r) * 32 + j4) = acc[r];
  __syncthreads();
  for (int oo = tid; oo < 288; oo += NTHR) {
    const int r = oo >> 5, jj = oo & 31;
    float sum = 0.f;
#pragma unroll 16
    for (int q = 0; q < 64; ++q) sum += red[(q * 9 + r) * 32 + jj];
    outp[(size_t)r * ldo + n0 + jj] = sum + (bias ? bias[n0 + jj] : 0.f);
  }
  __syncthreads();
}

__device__ __forceinline__ void norm0_phase(const P& p, unsigned char* smem, const int wv) {
  const int tid = my_tid(wv), lane = tid & 63, gw = my_bid() * NWV + (tid >> 6), ngw = gridDim.x * NWV;
  const float* gain = p.norm1;
  for (int m0 = gw; m0 < NTOK; m0 += 2 * ngw) {
    float4 v[2][4];
    float ss[2] = {0.f, 0.f};
#pragma unroll
    for (int q = 0; q < 2; ++q) {
      const int m = m0 + q * ngw;
      const float* xr = m < NCTX ? p.x_prompt + (size_t)m * DM : p.x_sample + (size_t)(m - NCTX) * DM;
#pragma unroll
      for (int t = 0; t < 2; ++t) {
        v[q][2 * t] = *(const float4*)(xr + t * 512 + lane * 8);
        v[q][2 * t + 1] = *(const float4*)(xr + t * 512 + lane * 8 + 4);
      }
    }
#pragma unroll
    for (int q = 0; q < 2; ++q) {
#pragma unroll
      for (int j = 0; j < 4; ++j) ss[q] += v[q][j].x * v[q][j].x + v[q][j].y * v[q][j].y + v[q][j].z * v[q][j].z + v[q][j].w * v[q][j].w;
      ss[q] = wave_sum(ss[q], lane);
    }
#pragma unroll
    for (int q = 0; q < 2; ++q) {
      const int m = m0 + q * ngw;
      const float* scale = p.mod() + ((size_t)mod_row(m)) * 6144 + 1 * 1024;
#pragma unroll
      for (int t = 0; t < 2; ++t) {
        const int c = t * 512 + lane * 8;
        const float4 g0 = *(const float4*)(gain + c), g1 = *(const float4*)(gain + c + 4), s0 = *(const float4*)(scale + c), s1 = *(const float4*)(scale + c + 4);
        const float4 a = v[q][2 * t], b = v[q][2 * t + 1];
        uint4 u;
        u.x = pk2(a.x * g0.x * (1.f + s0.x), a.y * g0.y * (1.f + s0.y));
        u.y = pk2(a.z * g0.z * (1.f + s0.z), a.w * g0.w * (1.f + s0.w));
        u.z = pk2(b.x * g1.x * (1.f + s1.x), b.y * g1.y * (1.f + s1.y));
        u.w = pk2(b.z * g1.z * (1.f + s1.z), b.w * g1.w * (1.f + s1.w));
        *(uint4*)(p.hbuf() + (size_t)m * DM + c) = u;
      }
      if (lane < 16) p.rssA()[(size_t)m * 16 + lane] = lane == 0 ? ss[q] : 0.f;
    }
  }
  float* sc = (float*)smem;
  float* red = sc + 9216;
  constexpr int G_IN = DIN / 32, G_UP = DFF / 32, NIT = 2 * G_IN + 2 * G_UP;
  for (int item = my_bid(); item < NIT; item += gridDim.x) {
    int l, grp; const float* W; int N; float* outp; int ldo; int which;
    if (item < 2 * G_IN) { l = item / G_IN; grp = item % G_IN; W = p.w_in + (size_t)l * DM * DIN; N = DIN; outp = p.sWin() + (size_t)l * 9 * DINP; ldo = DINP; which = 0; }
    else { const int i2 = item - 2 * G_IN; l = i2 / G_UP; grp = i2 % G_UP; W = p.w_up + (size_t)l * DM * DFF; N = DFF; outp = p.sWup() + (size_t)l * 9 * DFF; ldo = DFF; which = 3; }
    __syncthreads();
    for (int i = tid; i < 9216; i += NTHR) sc[i] = p.mod()[((size_t)(l * 9 + (i >> 10))) * 6144 + which * 1024 + (i & 1023)];
    __syncthreads();
    gemv9_item(sc, red, W, N, grp * 32, outp, ldo, nullptr, tid);
  }
}
__device__ __forceinline__ void final_norm_phase(const P& p, const int wv) {
  const int tid = my_tid(wv), lane = tid & 63, gw = my_bid() * NWV + (tid >> 6), ngw = gridDim.x * NWV;
  for (int m = gw; m < NTOK; m += ngw) {
    const float* xr = p.xw() + (size_t)m * DM;
    float4 v[4];
    float ss = 0.f;
#pragma unroll
    for (int j = 0; j < 4; ++j) {
      v[j] = ((const float4*)xr)[lane + 64 * j];
      ss += v[j].x * v[j].x + v[j].y * v[j].y + v[j].z * v[j].z + v[j].w * v[j].w;
    }
    ss = wave_sum(ss, lane);
    const float rstd = rsqrtf(ss * (1.f / 1024.f) + 1e-6f);
#pragma unroll
    for (int j = 0; j < 4; ++j) {
      const int c = (lane + 64 * j) * 4;
      const float4 g = *(const float4*)(p.final_norm + c);
      __builtin_nontemporal_store((f32x4){v[j].x * rstd * g.x, v[j].y * rstd * g.y, v[j].z * rstd * g.z, v[j].w * rstd * g.w}, (f32x4*)(p.out + (size_t)m * DM + c));
    }
  }
}

__device__ __forceinline__ void transpose_tile(const float* __restrict__ W, int K, int N, bf16_t* __restrict__ WT, int item, float* tile, const int tid) {
  const int ntn = (N + 63) >> 6, kt = item / ntn, nt = item % ntn, k0 = kt * 64, n0 = nt * 64;
  const int n4 = (tid & 15) * 4, kr = tid >> 4;
#pragma unroll
  for (int q = 0; q < 2; ++q) {
    const int k = q * 32 + kr;
    f32x4 v = (f32x4){0.f, 0.f, 0.f, 0.f};
    if (n0 + n4 < N) v = __builtin_nontemporal_load((const f32x4*)(W + (size_t)(k0 + k) * N + n0 + n4));
    float* t = tile + k * 65 + n4;
    t[0] = v[0]; t[1] = v[1]; t[2] = v[2]; t[3] = v[3];
  }
  __syncthreads();
  {
    const int n = tid >> 3, kc = (tid & 7) * 8;
    const float* t = tile + kc * 65 + n;
    uint4 o;
    o.x = pk2(t[0 * 65], t[1 * 65]); o.y = pk2(t[2 * 65], t[3 * 65]); o.z = pk2(t[4 * 65], t[5 * 65]); o.w = pk2(t[6 * 65], t[7 * 65]);
    if (n0 + n < N) *(uint4*)(WT + (size_t)(n0 + n) * K + k0 + kc) = o;
  }
  __syncthreads();
}

__device__ __forceinline__ void prep_phase(const P& p, unsigned char* smem, const int wv) {
  const int tid = my_tid(wv);
  {
    float* sc = (float*)smem;
    float* red = sc + 9216;
    for (int i = tid; i < 9216; i += NTHR) {
      const int r = i >> 10, k = i & 1023;
      const float x = r == 0 ? p.c_ctx[k] : p.c[(r - 1) * 1024 + k];
      sc[i] = x / (1.f + expf(-x));
    }
    __syncthreads();
    for (int item = blockIdx.x; item < 384; item += gridDim.x) {
      const int l = item / 192, n0 = (item % 192) * 32;
      gemv9_item(sc, red, p.w_mod + (size_t)l * 1024 * 6144, 6144, n0, p.mod() + (size_t)l * 9 * 6144, 6144, p.b_mod + l * 6144, tid);
    }
  }
  __syncthreads();
  {
    float* tile = (float*)smem;
    constexpr int I_IN = 16 * 37, I_OUT = 16 * 16, I_UP = 16 * 64, I_DN = 64 * 16, I_KV = 2 * 8;
    constexpr int PER = I_IN + I_OUT + I_UP + I_DN + I_KV;
    for (int item = blockIdx.x; item < 2 * PER; item += gridDim.x) {
      const int l = item / PER;
      int r = item % PER;
      if (r < I_IN) { transpose_tile(p.w_in + (size_t)l * DM * DIN, DM, DIN, p.WinT() + (size_t)l * DINP * DM, r, tile, tid); continue; }
      r -= I_IN;
      if (r < I_OUT) { transpose_tile(p.w_out + (size_t)l * DM * DM, DM, DM, p.WoutT() + (size_t)l * DM * DM, r, tile, tid); continue; }
      r -= I_OUT;
      if (r < I_UP) { transpose_tile(p.w_up + (size_t)l * DM * DFF, DM, DFF, p.WupT() + (size_t)l * DFF * DM, r, tile, tid); continue; }
      r -= I_UP;
      if (r < I_DN) { transpose_tile(p.w_down + (size_t)l * DFF * DM, DFF, DM, p.WdownT() + (size_t)l * DM * DFF, r, tile, tid); continue; }
      r -= I_DN;
      transpose_tile(p.w_kv_b + (size_t)l * 128 * 512, 128, 512, p.WkvbT() + (size_t)l * 512 * 128, r, tile, tid);
    }
  }
  const int gt = blockIdx.x * NTHR + tid, gs = gridDim.x * NTHR;
  if (gt < 256) p.ctl()[gt] = 0u;
  for (int i = gt; i < 64 * 16; i += gs) {
    const int pos = i >> 4, f = i & 15;
    const float ang = (float)pos * exp2f(-(float)f * (L2_10000 / 16.f));
    p.ropeW()[pos * 32 + f] = __cosf(ang);
    p.ropeW()[pos * 32 + 16 + f] = __sinf(ang);
  }
  for (int i = gt; i < 64 * 8; i += gs) {
    const int pos = i >> 3, f = i & 7;
    const float ang = (float)pos * exp2f(-(float)f * (L2_10000 / 8.f));
    p.ropeM()[pos * 16 + f] = __cosf(ang);
    p.ropeM()[pos * 16 + 8 + f] = __sinf(ang);
  }
  for (int i = gt; i < 2 * (DINP - DIN) * DM / 8; i += gs) {
    const int l = i / ((DINP - DIN) * DM / 8), o = i % ((DINP - DIN) * DM / 8);
    *(uint4*)(p.WinT() + ((size_t)l * DINP + DIN) * DM + (size_t)o * 8) = make_uint4(0, 0, 0, 0);
  }
  for (int i = gt; i < 524288 / 8; i += gs) {
    const int d8 = i & 7, kv = (i >> 3) & 1, s = (i >> 4) & 255, l = (i >> 12) & 1, b = i >> 13;
    const float4 a = *(const float4*)(p.cache_win_k + (size_t)i * 8), c = *(const float4*)(p.cache_win_k + (size_t)i * 8 + 4);
    *(uint4*)(p.Kwin_l() + ((size_t)((l * 8 + b) * 1280 + 1024 + s)) * 128 + kv * 64 + d8 * 8) = make_uint4(pk2(a.x, a.y), pk2(a.z, a.w), pk2(c.x, c.y), pk2(c.z, c.w));
  }
  for (int i = gt; i < 524288 / 8; i += gs) {
    const int d = i & 63, kv = (i >> 6) & 1, s8 = (i >> 7) & 31, l = (i >> 12) & 1, b = i >> 13;
    const float* src = p.cache_win_v + ((size_t)((b * 2 + l) * 256 + s8 * 8) * 2 + kv) * 64 + d;
    float v[8];
#pragma unroll
    for (int j = 0; j < 8; ++j) v[j] = src[(size_t)j * 128];
    *(uint4*)(p.Vtwin_l() + ((size_t)(((l * 8 + b) * 2 + kv) * 64 + d)) * 1280 + 1024 + s8 * 8) = make_uint4(pk2(v[0], v[1]), pk2(v[2], v[3]), pk2(v[4], v[5]), pk2(v[6], v[7]));
  }
  for (int i = gt; i < 524288 / 8; i += gs) {
    const int j8 = i & 15, s = (i >> 4) & 255, l = (i >> 12) & 1, b = i >> 13;
    const float4 a = *(const float4*)(p.cache_mla_ckv + (size_t)i * 8), c = *(const float4*)(p.cache_mla_ckv + (size_t)i * 8 + 4);
    *(uint4*)(p.ckvn() + ((size_t)l * 18432 + 16384 + b * 256 + s) * 128 + j8 * 8) = make_uint4(pk2(a.x, a.y), pk2(a.z, a.w), pk2(c.x, c.y), pk2(c.z, c.w));
  }
  for (int i = gt; i < 131072 / 8; i += gs) {
    const int j8 = i & 3, s = (i >> 2) & 255, l = (i >> 10) & 1, b = i >> 11;
    const float4 a = *(const float4*)(p.cache_mla_krope + (size_t)i * 8), c = *(const float4*)(p.cache_mla_krope + (size_t)i * 8 + 4);
    const uint4 o = make_uint4(pk2(a.x, a.y), pk2(a.z, a.w), pk2(c.x, c.y), pk2(c.z, c.w));
#pragma unroll
    for (int hh = 0; hh < 4; ++hh) *(uint4*)(p.Kmla_l() + ((size_t)(((l * 8 + b) * 4 + hh) * 1280 + 1024 + s)) * 96 + 64 + j8 * 8) = o;
  }
  for (int i = gt; i < 524288 / 8; i += gs) {
    const int e = i & 63, d8 = (i >> 6) & 7, blk = i >> 9;
    const int hh = blk & 3, dir = (blk >> 2) & 1, l = (blk >> 3) & 1, b = blk >> 4;
    const float* src = p.state_ret + (size_t)blk * 4096 + (size_t)(d8 * 8) * 64 + e;
    float v[8];
#pragma unroll
    for (int j = 0; j < 8; ++j) v[j] = src[(size_t)j * 64];
    *(uint4*)(p.S0t() + ((size_t)((((l * 8 + b) * 2 + dir) * 4 + hh) * 64 + e)) * 64 + d8 * 8) = make_uint4(pk2(v[0], v[1]), pk2(v[2], v[3]), pk2(v[4], v[5]), pk2(v[6], v[7]));
  }
}

struct RotOrder : pg8::StaticOrder {
  int rot;
  __device__ __forceinline__ bool next(int i, Unit& u) const {
    if (!pg8::StaticOrder::next(i, u)) return false;
    u.pn += rot; if (u.pn >= nN) u.pn -= nN;
    return true;
  }
};
template <class Epi>
__device__ __forceinline__ void big_gemm(unsigned char* smem, const bf16_t* A, const bf16_t* Bt, int N, int K, const Epi& E, const int wv, int rot = 0) {
  pg8::Gemm g{A, Bt, NTOK, N, K};
  RotOrder S;
  S.init(NTOK, N, (int)gridDim.x, my_bid());
  S.rot = rot;
  pg8::gemm_phase<Epi, RotOrder, true, true>((PG8_LAS unsigned char*)smem, g, S, E, wv);
}

#define GSYNC() grid.sync()
__global__ void __launch_bounds__(NTHR, 2) hybrid_fwd(P p_arg) {
  cg::grid_group grid = cg::this_grid();
  const kargp_t kp = (kargp_t)__builtin_amdgcn_kernarg_segment_ptr();
  const int wv = __builtin_amdgcn_readfirstlane((int)threadIdx.x >> 6);
  { const P p = load_params(kp); prep_phase(p, smem, wv); }
  GSYNC();
  { const P p = load_params(kp); norm0_phase(p, smem, wv); }
  GSYNC();
#pragma unroll
  for (int l = 0; l < 2; ++l) {
    { const P pc = load_params(kp); const int t0 = my_tid(wv);
      for (int i = t0; i < 64 * 32; i += NTHR) ((float*)(smem + LDS_ROPEW))[i] = pc.ropeW()[i];
      for (int i = t0; i < 64 * 16; i += NTHR) ((float*)(smem + LDS_ROPEM))[i] = pc.ropeM()[i];
      __syncthreads(); }
    { const P p = load_params(kp);
      big_gemm(smem, p.hbuf(), p.WinT() + (size_t)l * DINP * DM, DINP, DM, EpiIn8{p, l, kp}, wv, 8); }
    { const P p = load_params(kp); gemm_small(p.ckvn() + (size_t)l * 18432 * 128, 128, p.WkvbT() + (size_t)l * 512 * 128, 128, 18432, 512, 128, smem, EpiKvb{p, l}, wv, p.ctl() + 64 * l, p.ctl() + 128 + 64 * l); }
    GSYNC();
    { const P p = load_params(kp); attn_phase(p, l, smem, wv); }
    GSYNC();
    { const P p = load_params(kp); big_gemm(smem, p.mix(), p.WoutT() + (size_t)l * DM * DM, DM, DM, EpiOut8{p, l}, wv); }
    GSYNC();
    { const P p = load_params(kp); big_gemm(smem, p.hbuf(), p.WupT() + (size_t)l * DFF * DM, DFF, DM, EpiUp8{p, l}, wv); }
    GSYNC();
    { const P p = load_params(kp); big_gemm(smem, p.ubuf(), p.WdownT() + (size_t)l * DM * DFF, DM, DFF, EpiDown8{p, l}, wv); }
    GSYNC();
  }
  { const P p = load_params(kp); final_norm_phase(p, wv); }
}

extern "C" void kernel_launch(void* const* d_in, const int* in_sizes, int n_in, void* d_out, int out_size, void* d_ws, size_t ws_size,
                              hipStream_t stream) {
  static int grid_blocks = 0;
  if (grid_blocks == 0) {
    int dev = 0, cus = 0, per_cu = 0;
    (void)hipGetDevice(&dev);
    (void)hipDeviceGetAttribute(&cus, hipDeviceAttributeMultiprocessorCount, dev);
    (void)hipFuncSetAttribute((const void*)hybrid_fwd, hipFuncAttributeMaxDynamicSharedMemorySize, LDS_BYTES);
    (void)hipOccupancyMaxActiveBlocksPerMultiprocessor(&per_cu, (const void*)hybrid_fwd, NTHR, LDS_BYTES);
    if (per_cu < 1) { fprintf(stderr, "occupancy query returned %d\n", per_cu); per_cu = 1; }
    per_cu = 1;
    grid_blocks = cus * per_cu;
  }
  P p{};
  const float* const* in = (const float* const*)d_in;
  p.x_prompt = in[0]; p.x_sample = in[1]; p.cache_win_k = in[2]; p.cache_win_v = in[3]; p.cache_mla_ckv = in[4];
  p.cache_mla_krope = in[5]; p.state_ret = in[6]; p.c = in[7]; p.c_ctx = in[8]; p.w_mod = in[9]; p.b_mod = in[10];
  p.norm1 = in[11]; p.norm2 = in[12]; p.w_in = in[13]; p.win_sink = in[14]; p.ret_decay = in[15]; p.ret_gn = in[16];
  p.mla_kv_norm = in[17]; p.w_kv_b = in[18]; p.w_out = in[19]; p.w_up = in[20]; p.w_down = in[21]; p.final_norm = in[22];
  p.out = (float*)d_out;
  p.ws = (unsigned char*)d_ws;
  if (WS_END > ws_size) { fprintf(stderr, "kernel_launch: workspace too small: need %zu, have %zu\n", (size_t)WS_END, ws_size); return; }
  void* args[] = {&p};
  hipError_t e = hipLaunchCooperativeKernel((const void*)hybrid_fwd, dim3(grid_blocks), dim3(NTHR), args, LDS_BYTES, stream);
  if (e != hipSuccess) fprintf(stderr, "cooperative launch failed: %s (grid %d)\n", hipGetErrorString(e), grid_blocks);
}
```

```cpp
#include <hip/hip_runtime.h>
#include <hip/hip_cooperative_groups.h>
#include <cstdio>
#include <cstdint>
namespace cg = cooperative_groups;

__device__ __forceinline__ int lane_id() { return (int)__builtin_amdgcn_mbcnt_hi(~0u, __builtin_amdgcn_mbcnt_lo(~0u, 0u)); }

namespace pg8 {
#define PG8_LAS __attribute__((address_space(3)))
typedef unsigned short bf16_t;
typedef short bf16x8 __attribute__((ext_vector_type(8)));
typedef float f32x4 __attribute__((ext_vector_type(4)));
typedef unsigned u32x4 __attribute__((ext_vector_type(4)));
constexpr int BM = 256, BK = 64, HALF = 128, HTB = HALF * BK * 2  , STAGE_BYTES = 8 * HTB, NXCD = 8, WGM = 8;

__host__ __device__ __forceinline__ int lds_byte(int r, int c) { const int st = (r >> 4) * 2 + (c >> 5), rr = r & 15, cc = c & 31, ob = rr * 64 + cc * 2; return st * 1024 + (ob ^ (((ob >> 9) & 1) << 5)); }
__host__ __device__ __forceinline__ void stage_rc(int b, int& R, int& C) { const int st = b / 1024, sb = b % 1024, swz = sb ^ (((sb >> 9) & 1) << 5); R = (st >> 1) * 16 + swz / 64; C = (st & 1) * 32 + (swz % 64) / 2; }
__host__ __device__ __forceinline__ int perm32(int rho) { const int n = rho >> 4, i = rho & 15; return 8 * (i >> 2) + 4 * n + (i & 3); }

struct Unit { int pm, pn; };
struct Gemm { const bf16_t* A; const bf16_t* Bt; int M, N, K; };

struct StaticOrder {
    int nM, nN, nwg, G, c;
    __host__ __device__ void init(int M, int N, int G_, int c_) { nM = M / BM; nN = N / BM; nwg = nM * nN; G = G_; c = c_; }
    __host__ __device__ bool next(int i, Unit& u) const {
        const long L = (long)i * G + c; if (L >= nwg) return false;
        int wgid = (int)L; { const int q = nwg / NXCD, r = nwg % NXCD, xcd = wgid % NXCD, off = wgid / NXCD; wgid = (xcd < r ? xcd * (q + 1) : r * (q + 1) + (xcd - r) * q) + off; }
        const int nig = WGM * nN, gid = wgid / nig, fm = gid * WGM, gsz = (nM - fm) < WGM ? (nM - fm) : WGM;
        u.pm = fm + ((wgid % nig) % gsz); u.pn = (wgid % nig) / gsz; return true;
    }
    __device__ __forceinline__ void a_ready(const Unit&) const {}
    __device__ __forceinline__ void done(const Unit&) const {}
};
template <class Epi, class Sched, bool ALIGN_EPI = false, bool SP2 = false>
__device__ __forceinline__ void gemm_phase(PG8_LAS unsigned char* lds, const Gemm g, const Sched& S, const Epi& E, const int wvp) {
    const int wid = wvp, lane = lane_id(), tid = wid * 64 + lane, wr = wid >> 2, wc = wid & 3, fr = lane & 15, fq = lane >> 4;
    const int K = g.K, nt = K / BK;
    unsigned voffA[2], voffB[2];
#pragma unroll
    for (int i = 0; i < 2; ++i) { int R, C; stage_rc(tid * 16 + i * 8192, R, C); const int Rb = Epi::PERM ? ((R & ~31) + perm32(R & 31)) : R;
        voffA[i] = (unsigned)(R * K + C) * 2u; voffB[i] = (unsigned)(Rb * K + C) * 2u; }
    const size_t kstep = (size_t)(BK * 2);
    const size_t hstep = (size_t)HALF * K * 2;
    const size_t tstep = 2 * hstep;
    const unsigned ldsw = (unsigned)wid * 1024u;
    const int aoff = lds_byte(wr * 64 + fr, fq * 8), boff = lds_byte(wc * 32 + fr, fq * 8);
#define PG8_SA(b, h) (((b) * 2 + (h)) * HTB)
#define PG8_SB(b, h) ((4 + (b) * 2 + (h)) * HTB)
#define PG8_STAGE(bufoff, gbase, voff) do { _Pragma("unroll") for (int _i = 0; _i < 2; ++_i) \
        __builtin_amdgcn_global_load_lds((const unsigned*)((const char*)(gbase) + (voff)[_i]), (PG8_LAS unsigned*)(lds + (bufoff) + ldsw + _i * 8192), 16, 0, 0); } while (0)
#define PG8_LDA(dst, b, h) do { _Pragma("unroll") for (int m = 0; m < 4; ++m) _Pragma("unroll") for (int k = 0; k < 2; ++k) dst[m][k] = *(const PG8_LAS bf16x8*)(lds + PG8_SA(b, h) + aoff + m * 2048 + k * 1024); } while (0)
#define PG8_LDB(dst, b, h) do { _Pragma("unroll") for (int n = 0; n < 2; ++n) _Pragma("unroll") for (int k = 0; k < 2; ++k) dst[n][k] = *(const PG8_LAS bf16x8*)(lds + PG8_SB(b, h) + boff + n * 2048 + k * 1024); } while (0)
#define PG8_MMA(ai, bj, At, Bt) do { __builtin_amdgcn_s_setprio(1); _Pragma("unroll") for (int m = 0; m < 4; ++m) _Pragma("unroll") for (int n = 0; n < 2; ++n) _Pragma("unroll") for (int k = 0; k < 2; ++k) \
        acc[ai][bj][m][n] = __builtin_amdgcn_mfma_f32_16x16x32_bf16(Bt[n][k], At[m][k], acc[ai][bj][m][n], 0, 0, 0); __builtin_amdgcn_s_setprio(0); } while (0)
#define PG8_WAIT_V(n) asm volatile("s_waitcnt vmcnt(" #n ")" ::: "memory")
#define PG8_WAIT_L(n) asm volatile("s_waitcnt lgkmcnt(" #n ")" ::: "memory")
#define PG8_BAR __builtin_amdgcn_s_barrier()
#define PG8_SCHED __builtin_amdgcn_sched_barrier(0)
    Unit cur, nxt; int ui = 0;
    if (!S.next(0, cur)) return;
    f32x4 acc[2][2][4][2];
#pragma unroll
    for (int a = 0; a < 2; ++a)
#pragma unroll
        for (int b = 0; b < 2; ++b)
#pragma unroll
            for (int m = 0; m < 4; ++m)
#pragma unroll
                for (int n = 0; n < 2; ++n) acc[a][b][m][n] = (f32x4){0.f, 0.f, 0.f, 0.f};
    bf16x8 At[4][2], B0[2][2], B1[2][2];
    const char* cA = (const char*)g.A + (size_t)cur.pm * tstep; const char* cB = (const char*)g.Bt + (size_t)cur.pn * tstep;
    S.a_ready(cur);
    if constexpr (SP2) {
        PG8_STAGE(PG8_SB(0, 0), cB, voffB); PG8_STAGE(PG8_SB(0, 1), cB + hstep, voffB); PG8_STAGE(PG8_SA(0, 0), cA, voffA); PG8_STAGE(PG8_SA(0, 1), cA + hstep, voffA);
        if (wr == 1) PG8_BAR;
        PG8_WAIT_V(2); PG8_BAR;
        PG8_STAGE(PG8_SB(1, 0), cB + kstep, voffB); PG8_STAGE(PG8_SA(1, 0), cA + kstep, voffA); PG8_STAGE(PG8_SB(1, 1), cB + hstep + kstep, voffB);
        PG8_WAIT_V(6); PG8_BAR;
    } else {
        PG8_STAGE(PG8_SB(0, 0), cB, voffB); PG8_STAGE(PG8_SA(0, 0), cA, voffA); PG8_STAGE(PG8_SB(0, 1), cB + hstep, voffB); PG8_STAGE(PG8_SA(0, 1), cA + hstep, voffA);
        if (wr == 1) PG8_BAR;
        PG8_WAIT_V(4); PG8_BAR;
        PG8_STAGE(PG8_SB(1, 0), cB + kstep, voffB); PG8_STAGE(PG8_SA(1, 0), cA + kstep, voffA); PG8_STAGE(PG8_SB(1, 1), cB + hstep + kstep, voffB);
        PG8_WAIT_V(6); PG8_BAR;
    }
    for (;;) {
        const bool has_next = S.next(ui + 1, nxt);
        const char* nA = has_next ? (const char*)g.A + (size_t)nxt.pm * tstep : cA; const char* nB = has_next ? (const char*)g.Bt + (size_t)nxt.pn * tstep : cB;
        for (int t = 0; t < nt; t += 2) {
            const bool last = (t == nt - 2);
            const char* a1 = cA + (size_t)(t + 1) * kstep;
            const char* a2 = last ? nA : cA + (size_t)(t + 2) * kstep; const char* b2 = last ? nB : cB + (size_t)(t + 2) * kstep;
            const char* a3 = a2 + kstep; const char* b3 = b2 + kstep;
            if (last && has_next) S.a_ready(nxt);
            if constexpr (SP2) {
            PG8_LDB(B0, 0, 0); PG8_LDB(B1, 0, 1); PG8_SCHED; PG8_LDA(At, 0, 0); PG8_STAGE(PG8_SA(1, 1), a1 + hstep, voffA);
            PG8_WAIT_V(8); PG8_WAIT_L(0); PG8_BAR; PG8_MMA(0, 0, At, B0); PG8_MMA(0, 1, At, B1); PG8_BAR; PG8_SCHED;
            PG8_LDA(At, 0, 1); PG8_STAGE(PG8_SB(0, 0), b2, voffB); PG8_STAGE(PG8_SB(0, 1), b2 + hstep, voffB); PG8_STAGE(PG8_SA(0, 0), a2, voffA);
            PG8_WAIT_V(8); PG8_WAIT_L(0); PG8_BAR; PG8_MMA(1, 0, At, B0); PG8_MMA(1, 1, At, B1); PG8_BAR; PG8_SCHED;
            PG8_LDB(B0, 1, 0); PG8_LDB(B1, 1, 1); PG8_SCHED; PG8_LDA(At, 1, 0); PG8_STAGE(PG8_SA(0, 1), a2 + hstep, voffA);
            PG8_WAIT_V(8); PG8_WAIT_L(0); PG8_BAR; PG8_MMA(0, 0, At, B0); PG8_MMA(0, 1, At, B1); PG8_BAR; PG8_SCHED;
            PG8_LDA(At, 1, 1); PG8_STAGE(PG8_SB(1, 0), b3, voffB); PG8_STAGE(PG8_SB(1, 1), b3 + hstep, voffB); PG8_STAGE(PG8_SA(1, 0), a3, voffA);
            PG8_WAIT_V(8); PG8_WAIT_L(0); PG8_BAR; PG8_MMA(1, 0, At, B0); PG8_MMA(1, 1, At, B1); PG8_BAR; PG8_SCHED;
            } else {
            PG8_LDB(B0, 0, 0); PG8_SCHED; PG8_LDA(At, 0, 0); PG8_STAGE(PG8_SA(1, 1), a1 + hstep, voffA);
            PG8_WAIT_L(8); PG8_BAR; PG8_WAIT_L(0); PG8_MMA(0, 0, At, B0); PG8_BAR; PG8_SCHED;
            PG8_LDB(B1, 0, 1); PG8_STAGE(PG8_SB(0, 0), b2, voffB);
            PG8_BAR; PG8_WAIT_L(0); PG8_MMA(0, 1, At, B1); PG8_BAR;
            PG8_LDA(At, 0, 1); PG8_STAGE(PG8_SA(0, 0), a2, voffA);
            PG8_BAR; PG8_WAIT_L(0); PG8_MMA(1, 0, At, B0); PG8_BAR; PG8_SCHED;
            PG8_STAGE(PG8_SB(0, 1), b2 + hstep, voffB);
            PG8_WAIT_V(6); PG8_BAR; PG8_MMA(1, 1, At, B1); PG8_BAR;
            PG8_LDB(B0, 1, 0); PG8_SCHED; PG8_LDA(At, 1, 0); PG8_STAGE(PG8_SA(0, 1), a2 + hstep, voffA);
            PG8_WAIT_L(8); PG8_BAR; PG8_WAIT_L(0); PG8_MMA(0, 0, At, B0); PG8_BAR; PG8_SCHED;
            PG8_LDB(B1, 1, 1); PG8_STAGE(PG8_SB(1, 0), b3, voffB);
            PG8_BAR; PG8_WAIT_L(0); PG8_MMA(0, 1, At, B1); PG8_BAR;
            PG8_LDA(At, 1, 1); PG8_STAGE(PG8_SA(1, 0), a3, voffA);
            PG8_BAR; PG8_WAIT_L(0); PG8_MMA(1, 0, At, B0); PG8_BAR; PG8_SCHED;
            PG8_STAGE(PG8_SB(1, 1), b3 + hstep, voffB);
            PG8_WAIT_V(6); PG8_BAR; PG8_MMA(1, 1, At, B1); PG8_BAR;
            }
        }
        if constexpr (ALIGN_EPI) { if (wr == 0) PG8_BAR; }
        if constexpr (!Epi::AFTER_DRAIN) { E(acc, cur, wr, wc, fr, fq); S.done(cur); }
        if (!has_next) break;
#pragma unroll
        for (int a = 0; a < 2; ++a)
#pragma unroll
            for (int b = 0; b < 2; ++b)
#pragma unroll
                for (int m = 0; m < 4; ++m)
#pragma unroll
                    for (int n = 0; n < 2; ++n) acc[a][b][m][n] = (f32x4){0.f, 0.f, 0.f, 0.f};
        cur = nxt; cA = nA; cB = nB; ++ui;
        if constexpr (ALIGN_EPI) { if (wr == 1) PG8_BAR; }
    }
    PG8_WAIT_V(0);
    if constexpr (!ALIGN_EPI) { if (wr == 0) PG8_BAR; }
    PG8_BAR;
    if constexpr (Epi::AFTER_DRAIN) { E.fused(acc, cur, wr, wc, fr, fq, lds, wid, lane); S.done(cur); }
#undef PG8_SA
#undef PG8_SB
#undef PG8_STAGE
#undef PG8_LDA
#undef PG8_LDB
#undef PG8_MMA
#undef PG8_WAIT_V
#undef PG8_WAIT_L
#undef PG8_BAR
#undef PG8_SCHED
}
}


typedef unsigned short bf16_t;
typedef short bf16x8 __attribute__((ext_vector_type(8)));
typedef float f32x16 __attribute__((ext_vector_type(16)));
typedef pg8::f32x4 f32x4;
typedef unsigned u32x4v __attribute__((ext_vector_type(4)));
using pg8::Unit;

constexpr int NTHR = 512, NWV = 8;
constexpr int NTOK = 16384, NCTX = 8192, DM = 1024, DIN = 2336, DINP = 2560, DFF = 4096;
constexpr int LDS_RED = 131072;
constexpr int LDS_ROPEW = 131072 + 4096, LDS_ROPEM = LDS_ROPEW + 64 * 32 * 4;
constexpr int LDS_BYTES = LDS_ROPEM + 64 * 16 * 4;
constexpr float LOG2E = 1.4426950408889634f;
constexpr float L2_10000 = 13.287712379549449f;

#define AL256(x) (((x) + 255) & ~(size_t)255)
constexpr size_t OFF_mod = 0;
constexpr size_t OFF_ropeW = OFF_mod + AL256((size_t)2 * 9 * 6144 * 4);
constexpr size_t OFF_ropeM = OFF_ropeW + AL256((size_t)64 * 32 * 4);
constexpr size_t OFF_ctl = OFF_ropeM + AL256((size_t)64 * 16 * 4);
constexpr size_t OFF_rssA = OFF_ctl + AL256((size_t)256 * 4);
constexpr size_t OFF_rssB = OFF_rssA + AL256((size_t)NTOK * 16 * 4);
constexpr size_t OFF_sWin = OFF_rssB + AL256((size_t)NTOK * 16 * 4);
constexpr size_t OFF_sWup = OFF_sWin + AL256((size_t)2 * 9 * DINP * 4);
constexpr size_t OFF_WinT = OFF_sWup + AL256((size_t)2 * 9 * DFF * 4);
constexpr size_t OFF_WoutT = OFF_WinT + AL256((size_t)2 * DINP * DM * 2);
constexpr size_t OFF_WupT = OFF_WoutT + AL256((size_t)2 * DM * DM * 2);
constexpr size_t OFF_WdownT = OFF_WupT + AL256((size_t)2 * DFF * DM * 2);
constexpr size_t OFF_WkvbT = OFF_WdownT + AL256((size_t)2 * DM * DFF * 2);
constexpr size_t OFF_hbuf = OFF_WkvbT + AL256((size_t)2 * 512 * 128 * 2);
constexpr size_t OFF_Kwin_l = OFF_hbuf + AL256((size_t)NTOK * DM * 2);
constexpr size_t OFF_Vtwin_l = OFF_Kwin_l + AL256((size_t)2 * 8 * 1280 * 128 * 2);
constexpr size_t OFF_S0t = OFF_Vtwin_l + AL256((size_t)2 * 8 * 2 * 64 * 1280 * 2);
constexpr size_t OFF_ckvn = OFF_S0t + AL256((size_t)2 * 8 * 2 * 4 * 4096 * 2);
constexpr size_t OFF_Kmla_l = OFF_ckvn + AL256((size_t)2 * 18432 * 128 * 2);
constexpr size_t OFF_Vtmla_l = OFF_Kmla_l + AL256((size_t)2 * 8 * 4 * 1280 * 96 * 2);
constexpr size_t OFF_ubuf = OFF_Vtmla_l + AL256((size_t)2 * 8 * 4 * 64 * 1280 * 2);
constexpr size_t WS_END = OFF_ubuf + AL256((size_t)NTOK * DFF * 2);
constexpr size_t OFF_mix = OFF_ubuf + (size_t)96 * 1024 * 1024;
constexpr size_t OFF_Qwin = OFF_ubuf;
constexpr size_t OFF_Kwin_c = OFF_Qwin + AL256((size_t)NTOK * 512 * 2);
constexpr size_t OFF_Vtwin_c = OFF_Kwin_c + AL256((size_t)NCTX * 128 * 2);
constexpr size_t OFF_Qret = OFF_Vtwin_c + AL256((size_t)32 * 2 * 64 * 256 * 2);
constexpr size_t OFF_Kret = OFF_Qret + AL256((size_t)NTOK * 256 * 2);
constexpr size_t OFF_Gret = OFF_Kret + AL256((size_t)NTOK * 256 * 2);
constexpr size_t OFF_Vtret_c = OFF_Gret + AL256((size_t)NTOK * 256 * 2);
constexpr size_t OFF_Vtret_l = OFF_Vtret_c + AL256((size_t)32 * 4 * 64 * 256 * 2);
constexpr size_t OFF_Qmla = OFF_Vtret_l + AL256((size_t)8 * 4 * 64 * 1024 * 2);
constexpr size_t OFF_Kmla_c = OFF_Qmla + AL256((size_t)NTOK * 384 * 2);
constexpr size_t OFF_Vtmla_c = OFF_Kmla_c + AL256((size_t)32 * 4 * 256 * 96 * 2);
static_assert(OFF_Vtmla_c + (size_t)32 * 4 * 64 * 256 * 2 <= OFF_mix && OFF_mix + (size_t)NTOK * DM * 2 <= WS_END, "attention temporaries + mix must fit in the ubuf region");
static_assert(WS_END <= (size_t)256 * 1024 * 1024, "workspace must fit 256 MiB");

struct P {
  const float *x_prompt, *x_sample, *cache_win_k, *cache_win_v, *cache_mla_ckv, *cache_mla_krope, *state_ret,
      *c, *c_ctx, *w_mod, *b_mod, *norm1, *norm2, *w_in, *win_sink, *ret_decay, *ret_gn, *mla_kv_norm,
      *w_kv_b, *w_out, *w_up, *w_down, *final_norm;
  float* out;
  unsigned char* ws;
#define WSBUF(ty, name) __device__ __forceinline__ ty* name() const { return (ty*)(ws + OFF_##name); }
  WSBUF(unsigned, ctl) WSBUF(float, mod) WSBUF(float, ropeW) WSBUF(float, ropeM) WSBUF(float, rssA) WSBUF(float, rssB) WSBUF(float, sWin) WSBUF(float, sWup) WSBUF(bf16_t, WinT) WSBUF(bf16_t, WoutT) WSBUF(bf16_t, WupT) WSBUF(bf16_t, WdownT) WSBUF(bf16_t, WkvbT)
  WSBUF(bf16_t, hbuf) WSBUF(bf16_t, mix) WSBUF(bf16_t, Qwin) WSBUF(bf16_t, Kwin_c) WSBUF(bf16_t, Vtwin_c) WSBUF(bf16_t, Kwin_l)
  WSBUF(bf16_t, Vtwin_l) WSBUF(bf16_t, Qret) WSBUF(bf16_t, Kret) WSBUF(bf16_t, Gret) WSBUF(bf16_t, Vtret_c) WSBUF(bf16_t, Vtret_l)
  WSBUF(bf16_t, S0t) WSBUF(bf16_t, Qmla) WSBUF(bf16_t, ckvn) WSBUF(bf16_t, Kmla_c) WSBUF(bf16_t, Vtmla_c) WSBUF(bf16_t, Kmla_l)
  WSBUF(bf16_t, Vtmla_l) WSBUF(bf16_t, ubuf)
  __device__ __forceinline__ float* xw() const { return out; }
};

typedef float f32x2_t __attribute__((ext_vector_type(2)));
typedef __bf16 bf16x2_t __attribute__((ext_vector_type(2)));
__device__ __forceinline__ unsigned pk2(float lo, float hi) {
  const f32x2_t v = {lo, hi};
  const bf16x2_t b = __builtin_convertvector(v, bf16x2_t);
  return __builtin_bit_cast(unsigned, b);
}
__device__ __forceinline__ bf16_t f2bf(float f) { return (bf16_t)(pk2(f, 0.f) & 0xffffu); }
__device__ __forceinline__ float bf2f(bf16_t b) { return __uint_as_float(((unsigned)b) << 16); }
__device__ __forceinline__ float shx(float v, int mask, int ln) { return __int_as_float(__builtin_amdgcn_ds_bpermute((ln ^ mask) << 2, __float_as_int(v))); }
__device__ __forceinline__ float wave_sum(float v, int ln) {
#pragma unroll
  for (int o = 1; o < 64; o <<= 1) v += shx(v, o, ln);
  return v;
}
typedef const __attribute__((address_space(4))) unsigned char* kargp_t;
__device__ __forceinline__ P load_params(kargp_t kp) {
  asm volatile("" : "+s"(kp));
  P p;
  __builtin_memcpy(&p, kp, sizeof(P));
  return p;
}
__device__ __forceinline__ int my_tid(int wv) { int w = wv; asm volatile("" : "+s"(w)); int t = w * 64 + lane_id(); asm volatile("" : "+v"(t)); return t; }
__device__ __forceinline__ int my_bid() { int b = blockIdx.x; asm volatile("" : "+s"(b)); return b; }
__device__ __forceinline__ float fexp2(float x) { return __builtin_amdgcn_exp2f(x); }
__device__ __forceinline__ int mod_row(int m) { return m < NCTX ? 0 : 1 + ((m - NCTX) >> 10); }

__device__ __forceinline__ void st_rm_bf16(bf16_t* rp, int h, const f32x16& o) {
#pragma unroll
  for (int g = 0; g < 4; ++g) {
    uint2 u;
    u.x = pk2(o[4 * g], o[4 * g + 1]);
    u.y = pk2(o[4 * g + 2], o[4 * g + 3]);
    *(uint2*)(rp + 8 * g + 4 * h) = u;
  }
}
__device__ __forceinline__ void st_tr_bf16(bf16_t* bp, int stride, int h, const f32x16& o) {
#pragma unroll
  for (int i = 0; i < 16; ++i) bp[(size_t)((i & 3) + 8 * (i >> 2) + 4 * h) * stride] = f2bf(o[i]);
}

__device__ __forceinline__ void st8_bf16(bf16_t* rp, int fq, const f32x4& a, const f32x4& b) {
  *(uint2*)(rp + 4 * fq) = make_uint2(pk2(a[0], a[1]), pk2(a[2], a[3]));
  *(uint2*)(rp + 16 + 4 * fq) = make_uint2(pk2(b[0], b[1]), pk2(b[2], b[3]));
}
__device__ __forceinline__ void st8_f32(float* rp, int fq, const f32x4& a, const f32x4& b) {
  *(f32x4*)(rp + 4 * fq) = a;
  *(f32x4*)(rp + 16 + 4 * fq) = b;
}
__device__ __forceinline__ void st8_tr(bf16_t* bp, int stride, int fq, const f32x4& a, const f32x4& b) {
#pragma unroll
  for (int j = 0; j < 4; ++j) {
    bp[(size_t)(4 * fq + j) * stride] = f2bf(a[j]);
    bp[(size_t)(16 + 4 * fq + j) * stride] = f2bf(b[j]);
  }
}
__device__ __forceinline__ void rope8_win(f32x4& a, f32x4& b, int fq, const float* tab) {
  const f32x4 cs = *(const f32x4*)(tab + 4 * fq), sn = *(const f32x4*)(tab + 16 + 4 * fq);
  const f32x4 x = a, y = b;
  a = x * cs - y * sn;
  b = x * sn + y * cs;
}
__device__ __forceinline__ void rope8_mla(f32x4& a, f32x4& b, int fq, int ln, const float* tabr, const float* tabc) {
  const int fo = 4 * (fq & 1);
  {
    const f32x4 cs = *(const f32x4*)(tabr + fo), sn = *(const f32x4*)(tabr + 8 + fo);
#pragma unroll
    for (int j = 0; j < 4; ++j) { const float pa = shx(a[j], 32, ln); a[j] = fq < 2 ? a[j] * cs[j] - pa * sn[j] : pa * sn[j] + a[j] * cs[j]; }
  }
  asm volatile("" ::: "memory");
  {
    const f32x4 cs = *(const f32x4*)(tabc + fo), sn = *(const f32x4*)(tabc + 8 + fo);
#pragma unroll
    for (int j = 0; j < 4; ++j) { const float pb = shx(b[j], 32, ln); b[j] = fq < 2 ? b[j] * cs[j] - pb * sn[j] : pb * sn[j] + b[j] * cs[j]; }
  }
}


__device__ __forceinline__ void st8p_bf16(bf16_t* rp, int fq, const f32x4& a, const f32x4& b) {
  *(uint4*)(rp + 8 * fq) = make_uint4(pk2(a[0], a[1]), pk2(a[2], a[3]), pk2(b[0], b[1]), pk2(b[2], b[3]));
}
__device__ __forceinline__ void st8p_f32(float* rp, int fq, const f32x4& a, const f32x4& b) {
  __builtin_nontemporal_store(a, (f32x4*)(rp + 8 * fq));
  __builtin_nontemporal_store(b, (f32x4*)(rp + 8 * fq + 4));
}
__device__ __forceinline__ void st8p_tr(bf16_t* bp, int stride, int fq, const f32x4& a, const f32x4& b) {
#pragma unroll
  for (int j = 0; j < 4; ++j) {
    bp[(size_t)(8 * fq + j) * stride] = f2bf(a[j]);
    bp[(size_t)(8 * fq + 4 + j) * stride] = f2bf(b[j]);
  }
}
__device__ __forceinline__ void rope8p_win(f32x4& a, f32x4& b, int fq, int ln, const float* tab) {
  const int f0 = 8 * (fq & 1);
  const f32x4 ca = *(const f32x4*)(tab + f0), cb4 = *(const f32x4*)(tab + f0 + 4), sa = *(const f32x4*)(tab + 16 + f0), sb = *(const f32x4*)(tab + 16 + f0 + 4);
#pragma unroll
  for (int j = 0; j < 4; ++j) {
    const float pa = shx(a[j], 32, ln), pb = shx(b[j], 32, ln);
    a[j] = fq < 2 ? a[j] * ca[j] - pa * sa[j] : pa * sa[j] + a[j] * ca[j];
    b[j] = fq < 2 ? b[j] * cb4[j] - pb * sb[j] : pb * sb[j] + b[j] * cb4[j];
  }
}
__device__ __forceinline__ void rope8p_mla(f32x4& a, f32x4& b, int fq, int ln, const float* tabr, const float* tabc) {
  const float* tab = fq < 2 ? tabr : tabc;
  const f32x4 ca = *(const f32x4*)(tab), cb4 = *(const f32x4*)(tab + 4), sa = *(const f32x4*)(tab + 8), sb = *(const f32x4*)(tab + 12);
#pragma unroll
  for (int j = 0; j < 4; ++j) {
    const float pa = shx(a[j], 16, ln), pb = shx(b[j], 16, ln);
    a[j] = (fq & 1) == 0 ? a[j] * ca[j] - pa * sa[j] : pa * sa[j] + a[j] * ca[j];
    b[j] = (fq & 1) == 0 ? b[j] * cb4[j] - pb * sb[j] : pb * sb[j] + b[j] * cb4[j];
  }
}

__device__ __forceinline__ float row_rstd(const float* rss, int m) {
  const f32x4 a = *(const f32x4*)(rss + (size_t)m * 16), b = *(const f32x4*)(rss + (size_t)m * 16 + 4);
  const f32x4 c = *(const f32x4*)(rss + (size_t)m * 16 + 8), d = *(const f32x4*)(rss + (size_t)m * 16 + 12);
  const f32x4 s = (a + b) + (c + d);
  return rsqrtf(((s[0] + s[1]) + (s[2] + s[3])) * (1.f / 1024.f) + 1e-6f);
}

typedef f32x4 acc_t[2][2][4][2];
template <int V> struct IC { static constexpr int value = V; };
extern __shared__ __attribute__((aligned(16))) unsigned char smem[];
struct EpiIn8 {
  static constexpr bool PERM = true, AFTER_DRAIN = false;
  P p0; int l; kargp_t kp;
  __device__ __forceinline__ void operator()(const acc_t& acc, const Unit& u, int wr, int wc, int fr_in, int fq_in) const {
    int fr = fr_in; asm volatile("" : "+v"(fr));
    int fq = fq_in; asm volatile("" : "+v"(fq));
    const int ln = fq * 16 + fr; (void)ln;
    P p = p0; asm volatile("" : "+s"(p.ws), "+s"(p.out));
    const bool lat = u.pm >= 32;
    const int rbase = u.pm * 256 + wr * 64 + fr;
#define ROWS_BEGIN _Pragma("unroll") for (int ai = 0; ai < 2; ++ai) _Pragma("unroll") for (int mm = 0; mm < 4; ++mm) { \
      int m = rbase + ai * 128 + mm * 16; asm volatile("" : "+v"(m)); int b, s; \
      if (!lat) { b = m >> 8; s = m & 255; } else { b = (m - NCTX) >> 10; s = (m - NCTX) & 1023; } \
      const float rsd = rsdv[ai][mm]; \
      f32x4 v0 = acc[ai][bj][mm][0] * rsd + sw0, v1 = acc[ai][bj][mm][1] * rsd + sw1; (void)b; (void)s;
#define ROWS_END }
    float rsdv[2][4];
    {
      const float* rss = p.rssA();
#pragma unroll
      for (int ai = 0; ai < 2; ++ai)
#pragma unroll
        for (int mm = 0; mm < 4; ++mm) rsdv[ai][mm] = row_rstd(rss, rbase + ai * 128 + mm * 16);
    }
    auto do_half = [&](auto BJ) {
      constexpr int bj = decltype(BJ)::value;
      const int nb = u.pn * 256 + bj * 128 + wc * 32;
      if (nb >= DIN) return;
      const float* swp = p.sWin() + ((size_t)(l * 9 + (lat ? 1 + ((u.pm - 32) >> 2) : 0))) * DINP + nb;
      const f32x4 sw0 = *(const f32x4*)(swp + 8 * fq), sw1 = *(const f32x4*)(swp + 8 * fq + 4);
      if (nb < 512) {
        ROWS_BEGIN
          if (lat) rope8p_win(v0, v1, fq, ln, (const float*)(smem + LDS_ROPEW) + ((nb & 32) ? (s & 63) : (s >> 6)) * 32);
          st8p_bf16(p.Qwin() + (size_t)m * 512 + nb, fq, v0, v1);
        ROWS_END
      } else if (nb < 640) {
        const int c = nb - 512;
        ROWS_BEGIN
          if (!lat) {
            st8p_f32(p.out + 16777216 + ((size_t)((b * 2 + l) * 256 + s)) * 128 + c, fq, v0, v1);
            st8p_bf16(p.Kwin_c() + (size_t)m * 128 + c, fq, v0, v1);
          } else {
            rope8p_win(v0, v1, fq, ln, (const float*)(smem + LDS_ROPEW) + ((nb & 32) ? (s & 63) : (s >> 6)) * 32);
            st8p_bf16(p.Kwin_l() + ((size_t)((l * 8 + b) * 1280 + s)) * 128 + c, fq, v0, v1);
          }
        ROWS_END
      } else if (nb < 768) {
        const int c = nb - 640, kv = c >> 6, d0 = c & 63;
        ROWS_BEGIN
          if (!lat) {
            st8p_f32(p.out + 18874368 + ((size_t)((b * 2 + l) * 256 + s)) * 128 + c, fq, v0, v1);
            st8p_tr(p.Vtwin_c() + ((size_t)((b * 2 + kv) * 64 + d0)) * 256 + s, 256, fq, v0, v1);
          } else {
            st8p_tr(p.Vtwin_l() + ((size_t)(((l * 8 + b) * 2 + kv) * 64 + d0)) * 1280 + s, 1280, fq, v0, v1);
          }
        ROWS_END
      } else if (nb < 1024) {
        ROWS_BEGIN
          st8p_bf16(p.Qret() + (size_t)m * 256 + (nb - 768), fq, v0, v1);
        ROWS_END
      } else if (nb < 1280) {
        ROWS_BEGIN
          st8p_bf16(p.Kret() + (size_t)m * 256 + (nb - 1024), fq, v0, v1);
        ROWS_END
      } else if (nb < 1536) {
        const int c = nb - 1280, hh = c >> 6, d0 = c & 63;
        ROWS_BEGIN
          if (!lat) st8p_tr(p.Vtret_c() + ((size_t)((b * 4 + hh) * 64 + d0)) * 256 + s, 256, fq, v0, v1);
          else st8p_tr(p.Vtret_l() + ((size_t)((b * 4 + hh) * 64 + d0)) * 1024 + s, 1024, fq, v0, v1);
        ROWS_END
      } else if (nb < 1792) {
        ROWS_BEGIN
          st8p_bf16(p.Gret() + (size_t)m * 256 + (nb - 1536), fq, v0, v1);
        ROWS_END
      } else if (nb < 2176) {
        const int c = nb - 1792;
        const bool rp = lat && (c % 96) == 64;
        ROWS_BEGIN
          if (rp) rope8p_mla(v0, v1, fq, ln, (const float*)(smem + LDS_ROPEM) + (s >> 6) * 16, (const float*)(smem + LDS_ROPEM) + (s & 63) * 16);
          st8p_bf16(p.Qmla() + (size_t)m * 384 + c, fq, v0, v1);
        ROWS_END
      } else if (nb < 2304) {
        const int c = nb - 2176;
        float* red = (float*)(smem + LDS_RED);
        kargp_t k2 = kp; asm volatile("" : "+s"(k2));
        const float* g = ((const __attribute__((address_space(4))) P*)k2)->mla_kv_norm + l * 128 + c;
        const f32x4 g0 = *(const f32x4*)(g + 8 * fq), g1 = *(const f32x4*)(g + 8 * fq + 4);
#pragma unroll
        for (int ai = 0; ai < 2; ++ai)
#pragma unroll
          for (int mm = 0; mm < 4; ++mm) {
            const float rsd0 = rsdv[ai][mm];
            const f32x4 a = acc[ai][bj][mm][0] * rsd0 + sw0, b4 = acc[ai][bj][mm][1] * rsd0 + sw1;
            float ss = a[0] * a[0] + a[1] * a[1] + a[2] * a[2] + a[3] * a[3] + b4[0] * b4[0] + b4[1] * b4[1] + b4[2] * b4[2] + b4[3] * b4[3];
            ss += shx(ss, 16, ln);
            ss += shx(ss, 32, ln);
            if (fq == 0) red[wc * 256 + ai * 128 + wr * 64 + mm * 16 + fr] = ss;
          }
        asm volatile("s_waitcnt lgkmcnt(0)" ::: "memory");
        __builtin_amdgcn_s_barrier();
        ROWS_BEGIN
          const int rt = ai * 128 + wr * 64 + mm * 16 + fr;
          const float rsv = rsqrtf((red[rt] + red[256 + rt] + red[512 + rt] + red[768 + rt]) * (1.f / 128.f) + 1e-6f);
          v0 = v0 * rsv * g0;
          v1 = v1 * rsv * g1;
          st8p_bf16(p.ckvn() + ((size_t)l * 18432 + m) * 128 + c, fq, v0, v1);
          if (!lat) st8p_f32(p.out + 20971520 + ((size_t)((b * 2 + l) * 256 + s)) * 128 + c, fq, v0, v1);
        ROWS_END
        asm volatile("s_waitcnt vmcnt(0) lgkmcnt(0)" ::: "memory");
        __builtin_amdgcn_s_barrier();
        if (wr == 0 && wc == 0 && ln == 0) {
          __builtin_amdgcn_fence(__ATOMIC_RELEASE, "agent");
          asm volatile("s_waitcnt vmcnt(0)" ::: "memory");
          __hip_atomic_fetch_add(p.ctl() + 64 * l, 1u, __ATOMIC_RELAXED, __HIP_MEMORY_SCOPE_AGENT);
        }
      } else {
        ROWS_BEGIN
          if (!lat) {
            st8p_f32(p.out + 23068672 + ((size_t)((b * 2 + l) * 256 + s)) * 32, fq, v0, v1);
#pragma unroll
            for (int hh = 0; hh < 4; ++hh) st8p_bf16(p.Kmla_c() + ((size_t)((b * 4 + hh) * 256 + s)) * 96 + 64, fq, v0, v1);
          } else {
            rope8p_mla(v0, v1, fq, ln, (const float*)(smem + LDS_ROPEM) + (s >> 6) * 16, (const float*)(smem + LDS_ROPEM) + (s & 63) * 16);
#pragma unroll
            for (int hh = 0; hh < 4; ++hh) st8p_bf16(p.Kmla_l() + ((size_t)(((l * 8 + b) * 4 + hh) * 1280 + s)) * 96 + 64, fq, v0, v1);
          }
        ROWS_END
      }
    };
    do_half(IC<0>{});
    do_half(IC<1>{});
#undef ROWS_BEGIN
#undef ROWS_END
  }
};

struct EpiOut8 {
  static constexpr bool PERM = true, AFTER_DRAIN = false;
  P p0; int l;
  __device__ __forceinline__ void operator()(const acc_t& acc, const Unit& u, int wr, int wc, int fr_in, int fq_in) const {
    int fr = fr_in; asm volatile("" : "+v"(fr));
    int fq = fq_in; asm volatile("" : "+v"(fq));
    const int ln = fq * 16 + fr; (void)ln;
    P p = p0; asm volatile("" : "+s"(p.ws), "+s"(p.out));
    const int rbase = u.pm * 256 + wr * 64 + fr;
    const int cb = u.pn * 256 + wc * 32 + 8 * fq;
    const float* md = p.mod() + ((size_t)(l * 9 + mod_row(u.pm * 256))) * 6144;
    const float* gate = md + 2 * 1024; const float* sc2 = md + 4 * 1024; const float* g2 = p.norm2 + l * DM;
#pragma unroll
    for (int ap = 0; ap < 4; ++ap) {
      constexpr int dummy = 0; (void)dummy;
      const int ai = ap >> 1, m2 = (ap & 1) * 2;
      int mb = rbase + ai * 128 + m2 * 16; asm volatile("" : "+v"(mb));
      f32x4 xv[2][2][2];
#pragma unroll
      for (int mq = 0; mq < 2; ++mq) {
        const int mm = m2 + mq;
        const int m = mb + mq * 16;
        if (l == 0) {
          const float* xr = m < NCTX ? p.x_prompt + (size_t)m * DM : p.x_sample + (size_t)(m - NCTX) * DM;
#pragma unroll
          for (int bj = 0; bj < 2; ++bj)
#pragma unroll
            for (int n = 0; n < 2; ++n) xv[mq][bj][n] = *(const f32x4*)(xr + cb + bj * 128 + n * 4);
        } else {
          const bf16_t* hr = p.hbuf() + (size_t)m * DM;
#pragma unroll
          for (int bj = 0; bj < 2; ++bj) {
            const uint4 h8 = *(const uint4*)(hr + cb + bj * 128);
#pragma unroll
            for (int n = 0; n < 2; ++n) {
              const int c = cb + bj * 128 + n * 4;
              uint2 hq; hq.x = n ? h8.z : h8.x; hq.y = n ? h8.w : h8.y;
              const f32x4 q1 = *(const f32x4*)(p.norm1 + DM + c) * (*(const f32x4*)(md + 1 * 1024 + c) + 1.f);
              f32x4 xm;
              xm[0] = __uint_as_float(hq.x << 16) * __builtin_amdgcn_rcpf(q1[0]); xm[1] = __uint_as_float(hq.x & 0xffff0000u) * __builtin_amdgcn_rcpf(q1[1]);
              xm[2] = __uint_as_float(hq.y << 16) * __builtin_amdgcn_rcpf(q1[2]); xm[3] = __uint_as_float(hq.y & 0xffff0000u) * __builtin_amdgcn_rcpf(q1[3]);
              xv[mq][bj][n] = xm;
            }
          }
        }
      }
#pragma unroll
      for (int mq = 0; mq < 2; ++mq) {
        const int mm = m2 + mq;
        const int m = mb + mq * 16;
        bf16_t* ho = p.hbuf() + (size_t)m * DM;
        float ss = 0.f;
#pragma unroll
        for (int bj = 0; bj < 2; ++bj) {
          unsigned pw[4];
#pragma unroll
          for (int n = 0; n < 2; ++n) {
            const int c = cb + bj * 128 + n * 4;
            const f32x4 xn = xv[mq][bj][n] + *(const f32x4*)(gate + c) * acc[ai][bj][mm][n];
            const f32x4 hv = xn * (*(const f32x4*)(g2 + c) * (*(const f32x4*)(sc2 + c) + 1.f));
            pw[2 * n] = pk2(hv[0], hv[1]); pw[2 * n + 1] = pk2(hv[2], hv[3]);
            ss += (xn[0] * xn[0] + xn[1] * xn[1]) + (xn[2] * xn[2] + xn[3] * xn[3]);
          }
          *(uint4*)(ho + cb + bj * 128) = make_uint4(pw[0], pw[1], pw[2], pw[3]);
        }
        ss += shx(ss, 16, ln);
        ss += shx(ss, 32, ln);
        if (fq == 0) p.rssB()[(size_t)m * 16 + u.pn * 4 + wc] = ss;
      }
      asm volatile("" ::: "memory");
    }
  }
};
struct EpiUp8 {
  static constexpr bool PERM = true, AFTER_DRAIN = false;
  P p0; int l;
  __device__ __forceinline__ void operator()(const acc_t& acc, const Unit& u, int wr, int wc, int fr_in, int fq_in) const {
    int fr = fr_in; asm volatile("" : "+v"(fr));
    int fq = fq_in; asm volatile("" : "+v"(fq));
    const int ln = fq * 16 + fr; (void)ln;
    P p = p0; asm volatile("" : "+s"(p.ws), "+s"(p.out));
    const int rbase = u.pm * 256 + wr * 64 + fr;
    const int cb = u.pn * 256 + wc * 32 + 8 * fq;
    const float* swp = p.sWup() + ((size_t)(l * 9 + mod_row(u.pm * 256))) * DFF;
    float rsdv[2][4];
#pragma unroll
    for (int ai = 0; ai < 2; ++ai)
#pragma unroll
      for (int mm = 0; mm < 4; ++mm) rsdv[ai][mm] = row_rstd(p.rssB(), rbase + ai * 128 + mm * 16);
    f32x4 swv[2][2];
#pragma unroll
    for (int bj = 0; bj < 2; ++bj)
#pragma unroll
      for (int n = 0; n < 2; ++n) swv[bj][n] = *(const f32x4*)(swp + cb + bj * 128 + n * 4);
#pragma unroll
    for (int ai = 0; ai < 2; ++ai)
#pragma unroll
      for (int mm = 0; mm < 4; ++mm) {
        int m = rbase + ai * 128 + mm * 16; asm volatile("" : "+v"(m));
        bf16_t* uo = p.ubuf() + (size_t)m * DFF;
        const float rsd = rsdv[ai][mm];
#pragma unroll
        for (int bj = 0; bj < 2; ++bj) {
          f32x4 t0 = acc[ai][bj][mm][0] * rsd + swv[bj][0], t1 = acc[ai][bj][mm][1] * rsd + swv[bj][1];
#pragma unroll
          for (int j = 0; j < 4; ++j) { const float a = fmaxf(t0[j], 0.f), b = fmaxf(t1[j], 0.f); t0[j] = a * a; t1[j] = b * b; }
          __builtin_nontemporal_store((u32x4v){pk2(t0[0], t0[1]), pk2(t0[2], t0[3]), pk2(t1[0], t1[1]), pk2(t1[2], t1[3])}, (u32x4v*)(uo + cb + bj * 128));
        }
      }
  }
};
struct EpiDown8 {
  static constexpr bool PERM = true, AFTER_DRAIN = false;
  P p0; int l;
  __device__ __forceinline__ void operator()(const acc_t& acc, const Unit& u, int wr, int wc, int fr_in, int fq_in) const {
    int fr = fr_in; asm volatile("" : "+v"(fr));
    int fq = fq_in; asm volatile("" : "+v"(fq));
    const int ln = fq * 16 + fr; (void)ln;
    P p = p0; asm volatile("" : "+s"(p.ws), "+s"(p.out));
    const int rbase = u.pm * 256 + wr * 64 + fr;
    const int cb = u.pn * 256 + wc * 32 + 8 * fq;
    const int r = mod_row(u.pm * 256);
    const float* md = p.mod() + ((size_t)(l * 9 + r)) * 6144;
    const float* gate = md + 5 * 1024; const float* sc2 = md + 4 * 1024; const float* g2 = p.norm2 + l * DM;
    const float* sc1 = p.mod() + ((size_t)(9 + r)) * 6144 + 1 * 1024;
    const float* g1 = p.norm1 + DM;
    f32x4 riv[2][2];
#pragma unroll
    for (int bj = 0; bj < 2; ++bj)
#pragma unroll
      for (int n = 0; n < 2; ++n) {
        const int c = cb + bj * 128 + n * 4;
        const f32x4 q2 = *(const f32x4*)(g2 + c) * (*(const f32x4*)(sc2 + c) + 1.f);
#pragma unroll
        for (int j = 0; j < 4; ++j) riv[bj][n][j] = __builtin_amdgcn_rcpf(q2[j]);
      }
#pragma unroll
    for (int ap = 0; ap < 4; ++ap) {
      const int ai = ap >> 1, m2 = (ap & 1) * 2;
      int mb = rbase + ai * 128 + m2 * 16; asm volatile("" : "+v"(mb));
      uint4 hvv[2][2];
#pragma unroll
      for (int mq = 0; mq < 2; ++mq) {
        const bf16_t* hr = p.hbuf() + (size_t)(mb + mq * 16) * DM;
#pragma unroll
        for (int bj = 0; bj < 2; ++bj) hvv[mq][bj] = *(const uint4*)(hr + cb + bj * 128);
      }
#pragma unroll
      for (int mq = 0; mq < 2; ++mq) {
        const int mm = m2 + mq;
        const int m = mb + mq * 16;
        float* xo = p.xw() + (size_t)m * DM;
        bf16_t* ho = p.hbuf() + (size_t)m * DM;
        float ss = 0.f;
#pragma unroll
        for (int bj = 0; bj < 2; ++bj) {
          unsigned pw[4] = {0u, 0u, 0u, 0u};
#pragma unroll
          for (int n = 0; n < 2; ++n) {
            const int c = cb + bj * 128 + n * 4;
            uint2 hq; hq.x = n ? hvv[mq][bj].z : hvv[mq][bj].x; hq.y = n ? hvv[mq][bj].w : hvv[mq][bj].y;
            f32x4 xm;
            xm[0] = __uint_as_float(hq.x << 16); xm[1] = __uint_as_float(hq.x & 0xffff0000u);
            xm[2] = __uint_as_float(hq.y << 16); xm[3] = __uint_as_float(hq.y & 0xffff0000u);
            const f32x4 xn = xm * riv[bj][n] + *(const f32x4*)(gate + c) * acc[ai][bj][mm][n];
            if (l != 0) *(f32x4*)(xo + c) = xn;
            if (l == 0) {
              const f32x4 hv = xn * (*(const f32x4*)(g1 + c) * (*(const f32x4*)(sc1 + c) + 1.f));
              pw[2 * n] = pk2(hv[0], hv[1]); pw[2 * n + 1] = pk2(hv[2], hv[3]);
              ss += (xn[0] * xn[0] + xn[1] * xn[1]) + (xn[2] * xn[2] + xn[3] * xn[3]);
            }
          }
          if (l == 0) *(uint4*)(ho + cb + bj * 128) = make_uint4(pw[0], pw[1], pw[2], pw[3]);
        }
        if (l == 0) {
          ss += shx(ss, 16, ln);
          ss += shx(ss, 32, ln);
          if (fq == 0) p.rssA()[(size_t)m * 16 + u.pn * 4 + wc] = ss;
        }
      }
      asm volatile("" ::: "memory");
    }
  }
};

struct EpiKvb {
  P p; int l;
  __device__ __forceinline__ void operator()(int m, int nb, int h, const f32x16& v) const {
    const int hh = nb >> 7, j0 = nb & 127;
    bf16_t* Kb; bf16_t* Vb; int S, key;
    if (m < NCTX) {
      const int b = m >> 8; key = m & 255; S = 256;
      Kb = p.Kmla_c() + ((size_t)((b * 4 + hh) * 256)) * 96;
      Vb = p.Vtmla_c() + ((size_t)((b * 4 + hh) * 64)) * 256;
    } else {
      int b;
      if (m < NTOK) { b = (m - NCTX) >> 10; key = (m - NCTX) & 1023; }
      else { b = (m - NTOK) >> 8; key = 1024 + ((m - NTOK) & 255); }
      S = 1280;
      Kb = p.Kmla_l() + ((size_t)(((l * 8 + b) * 4 + hh) * 1280)) * 96;
      Vb = p.Vtmla_l() + ((size_t)(((l * 8 + b) * 4 + hh) * 64)) * 1280;
    }
    if (j0 < 64) st_rm_bf16(Kb + (size_t)key * 96 + j0, h, v);
    else st_tr_bf16(Vb + (size_t)(j0 - 64) * S + key, S, h, v);
  }
};

template <class Epi>
__device__ __forceinline__ void gemm_small(const bf16_t* __restrict__ A, int lda, const bf16_t* __restrict__ W, int ldw,
                                           int M, int N, int K, unsigned char* smem, const Epi& epi, const int wv, unsigned* ready, unsigned* ticket) {
  constexpr int TA = 256 * 72, TW = 128 * 72;
  bf16_t* sb = (bf16_t*)smem;
  const int tid = my_tid(wv), bid = my_bid(), lane = tid & 63, wave = tid >> 6;
  const int wm = wave >> 1, wn = wave & 1, r = lane & 31, h = lane >> 5;
  const int MT = M >> 8, NT = N >> 7, ntiles = MT * NT, nk = K >> 6;
  const int lc = tid & 7, lr = tid >> 3;
  (void)bid;
  if (tid == 0) {
    unsigned polls = 0;
    while (__hip_atomic_load(ready, __ATOMIC_RELAXED, __HIP_MEMORY_SCOPE_AGENT) < 64u && ++polls < (1u << 22)) __builtin_amdgcn_s_sleep(8);
    __builtin_amdgcn_fence(__ATOMIC_ACQUIRE, "agent");
    asm volatile("s_waitcnt vmcnt(0)" ::: "memory");
  }
  __syncthreads();
  volatile int* tks = (volatile int*)(smem + LDS_RED + 2048);
  for (;;) {
    __syncthreads();
    if (tid == 0) *tks = (int)__hip_atomic_fetch_add(ticket, 1u, __ATOMIC_RELAXED, __HIP_MEMORY_SCOPE_AGENT);
    __syncthreads();
    const int tile = *tks;
    if (tile >= ntiles) break;
    const int m0 = (tile % MT) << 8, n0 = (tile / MT) << 7;
    f32x16 acc[2][2];
#pragma unroll
    for (int a = 0; a < 2; ++a)
#pragma unroll
      for (int b = 0; b < 2; ++b)
#pragma unroll
        for (int i = 0; i < 16; ++i) acc[a][b][i] = 0.f;
    uint4 ra[4], rw[2];
    const bf16_t* Ap = A + (size_t)(m0 + lr) * lda + lc * 8;
    const bf16_t* Wp = W + (size_t)(n0 + lr) * ldw + lc * 8;
    auto gload = [&](int kt) {
#pragma unroll
      for (int i = 0; i < 4; ++i) ra[i] = *(const uint4*)(Ap + (size_t)(64 * i) * lda + kt * 64);
#pragma unroll
      for (int i = 0; i < 2; ++i) rw[i] = *(const uint4*)(Wp + (size_t)(64 * i) * ldw + kt * 64);
    };
    auto swrite = [&](int bsel) {
      bf16_t* sA = sb + bsel * (TA + TW); bf16_t* sW = sA + TA;
#pragma unroll
      for (int i = 0; i < 4; ++i) *(uint4*)(sA + (lr + 64 * i) * 72 + lc * 8) = ra[i];
#pragma unroll
      for (int i = 0; i < 2; ++i) *(uint4*)(sW + (lr + 64 * i) * 72 + lc * 8) = rw[i];
    };
    __syncthreads();
    gload(0); swrite(0);
    __syncthreads();
    for (int kt = 0; kt < nk; ++kt) {
      if (kt + 1 < nk) gload(kt + 1);
      const bf16_t* sA = sb + (kt & 1) * (TA + TW); const bf16_t* sW = sA + TA;
#pragma unroll
      for (int ks = 0; ks < 4; ++ks) {
        bf16x8 wf[2], af[2];
#pragma unroll
        for (int i = 0; i < 2; ++i) {
          wf[i] = *(const bf16x8*)(sW + (wn * 64 + i * 32 + r) * 72 + ks * 16 + h * 8);
          af[i] = *(const bf16x8*)(sA + (wm * 64 + i * 32 + r) * 72 + ks * 16 + h * 8);
        }
#pragma unroll
        for (int a = 0; a < 2; ++a)
#pragma unroll
          for (int b = 0; b < 2; ++b) acc[a][b] = __builtin_amdgcn_mfma_f32_32x32x16_bf16(wf[a], af[b], acc[a][b], 0, 0, 0);
      }
      if (kt + 1 < nk) swrite((kt + 1) & 1);
      __syncthreads();
    }
#pragma unroll
    for (int a = 0; a < 2; ++a)
#pragma unroll
      for (int b = 0; b < 2; ++b) epi(m0 + wm * 64 + b * 32 + r, n0 + wn * 64 + a * 32, h, acc[a][b]);
  }
}

struct AttnItem {
  const bf16_t* Q; int qs;
  const bf16_t* K; int ks;
  const bf16_t* Vt; int vs;
  int t0, t1, t2, t3;
  int qpos0, T;
  float scale, sink_l2; int has_sink;
  float lgf, lgb;
  const bf16_t *S0f, *S0b;
  const bf16_t* G; const float* gn;
  bf16_t* out;
  float* sout;
};

template <int DQK, int MODE>
__device__ __forceinline__ void attn_item(const AttnItem& it, unsigned char* smem, const int wv) {
  constexpr int KSTR = DQK + 8, NKS = DQK / 16, VSTR = 68, KCH = DQK / 8;
  bf16_t* Ks = (bf16_t*)smem;
  bf16_t* Vs = Ks + 64 * KSTR;
  const int tid = my_tid(wv), lane = tid & 63, wave = tid >> 6, r = lane & 31, h = lane >> 5;
  const int qrow = wave * 32 + r;
  bf16x8 qf[NKS];
  if constexpr (MODE == 3) {
    const int dq = (wave & 1) * 32 + r;
#pragma unroll
    for (int ks = 0; ks < NKS; ++ks) {
      const int e = dq - (ks * 16 + h * 8);
      uint4 v;
      v.x = e == 0 ? 0x3F80u : (e == 1 ? 0x3F800000u : 0u);
      v.y = e == 2 ? 0x3F80u : (e == 3 ? 0x3F800000u : 0u);
      v.z = e == 4 ? 0x3F80u : (e == 5 ? 0x3F800000u : 0u);
      v.w = e == 6 ? 0x3F80u : (e == 7 ? 0x3F800000u : 0u);
      qf[ks] = __builtin_bit_cast(bf16x8, v);
    }
  } else {
#pragma unroll
    for (int ks = 0; ks < NKS; ++ks) qf[ks] = *(const bf16x8*)(it.Q + (size_t)qrow * it.qs + ks * 16 + h * 8);
  }
  f32x16 o0, o1;
#pragma unroll
  for (int i = 0; i < 16; ++i) { o0[i] = 0.f; o1[i] = 0.f; }
  float mrun = it.has_sink ? it.sink_l2 : -1e30f, lrun = 0.f;
  const int qp = it.qpos0 + qrow;
  const int n1 = it.t1 - it.t0, ntl = n1 + (it.t3 - it.t2);
  constexpr int BUFE = 64 * KSTR + 64 * VSTR;
  const int krow0 = tid / KCH, kch0 = tid % KCH, krow1 = (tid + NTHR) / KCH, kch1 = (tid + NTHR) % KCH;
  const bool k2 = (KCH == 12) && (tid + NTHR < 64 * KCH);
  const int vrow = tid >> 3, vch = tid & 7;
  uint4 rk0, rk1, rv;
  auto tile_of = [&](int ti) { return ti < n1 ? it.t0 + ti : it.t2 + (ti - n1); };
  auto gload = [&](int t) {
    const bool stt = (MODE == 2) && (t >= 16);
    if (!stt) {
      const int key0 = t * 64;
      rk0 = *(const uint4*)(it.K + (size_t)(key0 + krow0) * it.ks + kch0 * 8);
      if (k2) rk1 = *(const uint4*)(it.K + (size_t)(key0 + krow1) * it.ks + kch1 * 8);
      rv = *(const uint4*)(it.Vt + (size_t)vrow * it.vs + key0 + vch * 8);
    } else {
      const bf16_t* S = (t == 16) ? it.S0f : it.S0b;
      const int e = krow0 - kch0 * 8;
      rk0.x = e == 0 ? 0x3F80u : (e == 1 ? 0x3F800000u : 0u);
      rk0.y = e == 2 ? 0x3F80u : (e == 3 ? 0x3F800000u : 0u);
      rk0.z = e == 4 ? 0x3F80u : (e == 5 ? 0x3F800000u : 0u);
      rk0.w = e == 6 ? 0x3F80u : (e == 7 ? 0x3F800000u : 0u);
      rv = *(const uint4*)(S + (size_t)vrow * 64 + vch * 8);
    }
  };
  auto swrite = [&](int bsel) {
    bf16_t* Kb = Ks + bsel * BUFE; bf16_t* Vb = Kb + 64 * KSTR;
    *(uint4*)(Kb + krow0 * KSTR + kch0 * 8) = rk0;
    if (k2) *(uint4*)(Kb + krow1 * KSTR + kch1 * 8) = rk1;
    uint2* d = (uint2*)(Vb + vrow * VSTR + vch * 8);
    d[0] = make_uint2(rv.x, rv.y); d[1] = make_uint2(rv.z, rv.w);
  };
  __syncthreads();
  gload(tile_of(0)); swrite(0);
  __syncthreads();
  for (int ti = 0; ti < ntl; ++ti) {
    const int t = tile_of(ti);
    const bool st_tile = (MODE == 2) && (t >= 16);
    const int key0 = t * 64;
    const bool more = ti + 1 < ntl;
    if (more) gload(tile_of(ti + 1));
    const bf16_t* Kc = Ks + (ti & 1) * BUFE; const bf16_t* Vc = Kc + 64 * KSTR;
    bool skip = (MODE == 3) && (wave >= 4);
    if (MODE == 1 && t < 16) {
      const int qlo = it.qpos0 + wave * 32;
      skip = (key0 > qlo + 31 + 128 || key0 + 63 < qlo - 128);
    }
    if (!skip) {
    f32x16 s0, s1;
#pragma unroll
    for (int i = 0; i < 16; ++i) { s0[i] = 0.f; s1[i] = 0.f; }
#pragma unroll
    for (int ks = 0; ks < NKS; ++ks) {
      const bf16x8 k0 = *(const bf16x8*)(Kc + r * KSTR + ks * 16 + h * 8);
      const bf16x8 k1 = *(const bf16x8*)(Kc + (32 + r) * KSTR + ks * 16 + h * 8);
      s0 = __builtin_amdgcn_mfma_f32_32x32x16_bf16(k0, qf[ks], s0, 0, 0, 0);
      s1 = __builtin_amdgcn_mfma_f32_32x32x16_bf16(k1, qf[ks], s1, 0, 0, 0);
    }
    if constexpr (MODE == 3) {
      if (wave < 2) {
        const float base = (float)(it.T - 1 - key0 - 4 * h) * it.lgf - 3.f;
#pragma unroll
        for (int i = 0; i < 16; ++i) {
          s0[i] *= fexp2(fmaf(-(float)((i & 3) + 8 * (i >> 2)), it.lgf, base));
          s1[i] *= fexp2(fmaf(-(float)(32 + (i & 3) + 8 * (i >> 2)), it.lgf, base));
        }
      } else {
        const float base = (float)(key0 + 4 * h) * it.lgb - 3.f;
#pragma unroll
        for (int i = 0; i < 16; ++i) {
          s0[i] *= fexp2(fmaf((float)((i & 3) + 8 * (i >> 2)), it.lgb, base));
          s1[i] *= fexp2(fmaf((float)(32 + (i & 3) + 8 * (i >> 2)), it.lgb, base));
        }
      }
    } else if constexpr (MODE == 2) {
      if (!st_tile) {
        const int qlo = it.qpos0 + wave * 32;
        if (key0 + 63 < qlo) {
          const float base = (float)(qp - key0 - 4 * h) * it.lgf - 3.f;
#pragma unroll
          for (int i = 0; i < 16; ++i) {
            s0[i] *= fexp2(fmaf(-(float)((i & 3) + 8 * (i >> 2)), it.lgf, base));
            s1[i] *= fexp2(fmaf(-(float)(32 + (i & 3) + 8 * (i >> 2)), it.lgf, base));
          }
        } else if (key0 > qlo + 31) {
          const float base = (float)(key0 + 4 * h - qp) * it.lgb - 3.f;
#pragma unroll
          for (int i = 0; i < 16; ++i) {
            s0[i] *= fexp2(fmaf((float)((i & 3) + 8 * (i >> 2)), it.lgb, base));
            s1[i] *= fexp2(fmaf((float)(32 + (i & 3) + 8 * (i >> 2)), it.lgb, base));
          }
        } else {
#pragma unroll
        for (int i = 0; i < 16; ++i) {
          const int key = key0 + (i & 3) + 8 * (i >> 2) + 4 * h;
          const int e0 = qp - key, e1 = e0 - 32;
          float d0 = fexp2((float)(e0 < 0 ? -e0 : e0) * (e0 > 0 ? it.lgf : it.lgb));
          float d1 = fexp2((float)(e1 < 0 ? -e1 : e1) * (e1 > 0 ? it.lgf : it.lgb));
          d0 = e0 == 0 ? 2.f : d0;
          d1 = e1 == 0 ? 2.f : d1;
          s0[i] *= it.scale * d0;
          s1[i] *= it.scale * d1;
        }
        }
      } else {
        const float dec = (t == 16) ? fexp2((float)(qp + 1) * it.lgf) : fexp2((float)(it.T - qp) * it.lgb);
#pragma unroll
        for (int i = 0; i < 16; ++i) { s0[i] *= dec; s1[i] *= dec; }
      }
    } else {
      float mx = -INFINITY;
      const int qlo1 = it.qpos0 + wave * 32;
      const bool need_mask = (MODE == 1) && (t < 16) && !(key0 >= qlo1 + 31 - 128 && key0 + 63 <= qlo1 + 128);
#pragma unroll
      for (int i = 0; i < 16; ++i) {
        float a = s0[i] * it.scale, b = s1[i] * it.scale;
        if (MODE == 1 && need_mask) {
          const int key = key0 + (i & 3) + 8 * (i >> 2) + 4 * h;
          const int e0 = key - qp, e1 = e0 + 32;
          if (e0 > 128 || e0 < -128) a = -INFINITY;
          if (e1 > 128 || e1 < -128) b = -INFINITY;
        }
        s0[i] = a; s1[i] = b;
        mx = fmaxf(mx, fmaxf(a, b));
      }
      mx = fmaxf(mx, shx(mx, 32, lane));
      const float mnew = fmaxf(mrun, mx);
      const float alpha = fexp2(mrun - mnew);
      float sum = 0.f;
#pragma unroll
      for (int i = 0; i < 16; ++i) {
        s0[i] = fexp2(s0[i] - mnew);
        s1[i] = fexp2(s1[i] - mnew);
        sum += s0[i] + s1[i];
      }
      lrun = lrun * alpha + sum;
      mrun = mnew;
#pragma unroll
      for (int i = 0; i < 16; ++i) { o0[i] *= alpha; o1[i] *= alpha; }
    }
#pragma unroll
    for (int kt = 0; kt < 2; ++kt) {
#pragma unroll
      for (int sbk = 0; sbk < 2; ++sbk) {
        uint4 pw;
        if (kt == 0) {
          pw.x = pk2(s0[8 * sbk + 0], s0[8 * sbk + 1]); pw.y = pk2(s0[8 * sbk + 2], s0[8 * sbk + 3]);
          pw.z = pk2(s0[8 * sbk + 4], s0[8 * sbk + 5]); pw.w = pk2(s0[8 * sbk + 6], s0[8 * sbk + 7]);
        } else {
          pw.x = pk2(s1[8 * sbk + 0], s1[8 * sbk + 1]); pw.y = pk2(s1[8 * sbk + 2], s1[8 * sbk + 3]);
          pw.z = pk2(s1[8 * sbk + 4], s1[8 * sbk + 5]); pw.w = pk2(s1[8 * sbk + 6], s1[8 * sbk + 7]);
        }
        const bf16x8 pf = __builtin_bit_cast(bf16x8, pw);
        const int koff = kt * 32 + sbk * 16 + 4 * h;
        const uint2 a0 = *(const uint2*)(Vc + r * VSTR + koff), a1 = *(const uint2*)(Vc + r * VSTR + koff + 8);
        const uint2 b0 = *(const uint2*)(Vc + (32 + r) * VSTR + koff), b1 = *(const uint2*)(Vc + (32 + r) * VSTR + koff + 8);
        const bf16x8 v0 = __builtin_bit_cast(bf16x8, make_uint4(a0.x, a0.y, a1.x, a1.y));
        const bf16x8 v1 = __builtin_bit_cast(bf16x8, make_uint4(b0.x, b0.y, b1.x, b1.y));
        o0 = __builtin_amdgcn_mfma_f32_32x32x16_bf16(v0, pf, o0, 0, 0, 0);
        o1 = __builtin_amdgcn_mfma_f32_32x32x16_bf16(v1, pf, o1, 0, 0, 0);
      }
    }
    }
    if (more) swrite((ti + 1) & 1);
    __syncthreads();
  }
  if constexpr (MODE == 3) {
    if (wave < 4) {
      float* rowp = it.sout + (size_t)(wave >> 1) * 16384 + (size_t)((wave & 1) * 32 + r) * 64;
#pragma unroll
      for (int g = 0; g < 4; ++g) {
        *(float4*)(rowp + 8 * g + 4 * h) = make_float4(o0[4 * g], o0[4 * g + 1], o0[4 * g + 2], o0[4 * g + 3]);
        *(float4*)(rowp + 32 + 8 * g + 4 * h) = make_float4(o1[4 * g], o1[4 * g + 1], o1[4 * g + 2], o1[4 * g + 3]);
      }
    }
    return;
  }
  bf16_t* orow = it.out + (size_t)qrow * DM;
  if constexpr (MODE == 2) {
    float sm = 0.f;
#pragma unroll
    for (int i = 0; i < 16; ++i) sm += o0[i] + o1[i];
    sm += shx(sm, 32, lane);
    const float mu = sm * (1.f / 64.f);
    float vr = 0.f;
#pragma unroll
    for (int i = 0; i < 16; ++i) { o0[i] -= mu; o1[i] -= mu; vr += o0[i] * o0[i] + o1[i] * o1[i]; }
    vr += shx(vr, 32, lane);
    const float rstd = rsqrtf(vr * (1.f / 64.f) + 1e-6f);
    const bf16_t* grow = it.G + (size_t)qrow * 256;
#pragma unroll
    for (int g = 0; g < 4; ++g) {
      const int d = 8 * g + 4 * h;
      const uint2 ga = *(const uint2*)(grow + d), gb = *(const uint2*)(grow + 32 + d);
      const float gav[4] = {__uint_as_float(ga.x << 16), __uint_as_float(ga.x & 0xffff0000u), __uint_as_float(ga.y << 16), __uint_as_float(ga.y & 0xffff0000u)};
      const float gbv[4] = {__uint_as_float(gb.x << 16), __uint_as_float(gb.x & 0xffff0000u), __uint_as_float(gb.y << 16), __uint_as_float(gb.y & 0xffff0000u)};
#pragma unroll
      for (int j = 0; j < 4; ++j) {
        const float x0 = gav[j], x1 = gbv[j];
        o0[4 * g + j] = o0[4 * g + j] * rstd * it.gn[d + j] * (x0 / (1.f + __expf(-x0)));
        o1[4 * g + j] = o1[4 * g + j] * rstd * it.gn[32 + d + j] * (x1 / (1.f + __expf(-x1)));
      }
    }
  } else {
    float lt = lrun + shx(lrun, 32, lane);
    if (it.has_sink) lt += fexp2(it.sink_l2 - mrun);
    const float inv = 1.f / lt;
#pragma unroll
    for (int i = 0; i < 16; ++i) { o0[i] *= inv; o1[i] *= inv; }
  }
  st_rm_bf16(orow, h, o0);
  st_rm_bf16(orow + 32, h, o1);
}

__device__ __forceinline__ float log2_sigmoid(float x) { return -log1pf(expf(-x)) * LOG2E; }

__device__ __forceinline__ void state_item(const P& p, int l, int idx, unsigned char* smem, const int wv) {
  const int b = idx >> 3, hh = (idx >> 1) & 3, dir = idx & 1;
  float* Ksm = (float*)smem;
  float* Vsm = Ksm + 4096;
  const int tid = my_tid(wv);
  const float lg = log2_sigmoid(p.ret_decay[(l * 2 + dir) * 4 + hh]);
  float acc[8];
#pragma unroll
  for (int i = 0; i < 8; ++i) acc[i] = 0.f;
  const int d = tid >> 3, e0 = (tid & 7) * 8;
  for (int c = 0; c < 4; ++c) {
    __syncthreads();
    for (int i = tid; i < 4096; i += NTHR) {
      const int j = i >> 6, dd = i & 63, tok = c * 64 + j;
      const float dec = dir == 0 ? fexp2((float)(255 - tok) * lg) : fexp2((float)tok * lg);
      Ksm[j * 64 + dd] = bf2f(p.Kret()[(size_t)(b * 256 + tok) * 256 + hh * 64 + dd]) * 0.125f * dec;
      const int e = i >> 6, jj = i & 63;
      Vsm[e * 65 + jj] = bf2f(p.Vtret_c()[((size_t)((b * 4 + hh) * 64 + e)) * 256 + c * 64 + jj]);
    }
    __syncthreads();
    for (int j = 0; j < 64; ++j) {
      const float kd = Ksm[j * 64 + d];
#pragma unroll
      for (int i = 0; i < 8; ++i) acc[i] += kd * Vsm[(e0 + i) * 65 + j];
    }
  }
  float* op = p.out + 23592960 + ((size_t)((((b * 2 + l) * 2 + dir) * 4 + hh) * 64 + d)) * 64 + e0;
  *(float4*)(op) = make_float4(acc[0], acc[1], acc[2], acc[3]);
  *(float4*)(op + 4) = make_float4(acc[4], acc[5], acc[6], acc[7]);
}

__device__ __forceinline__ void attn_phase(const P& p, int l, unsigned char* smem, const int wv) {
  constexpr int NA = 128, NB = 128, NC = 256, ND = 256, NE = 128, NF = 128, NG = 128;
  constexpr int TOT = NA + NB + NC + ND + NE + NF + NG;
  unsigned* ticket = p.ctl() + 32 + 64 * l;
  volatile int* tks = (volatile int*)(smem + LDS_RED + 2048);
  const int tid0 = my_tid(wv);
  for (;;) {
    __syncthreads();
    if (tid0 == 0) *tks = (int)__hip_atomic_fetch_add(ticket, 1u, __ATOMIC_RELAXED, __HIP_MEMORY_SCOPE_AGENT);
    __syncthreads();
    const int item = *tks;
    if (item >= TOT) break;
    int idx = item;
    AttnItem it;
    it.t2 = 0; it.t3 = 0; it.qpos0 = 0; it.T = 0; it.sink_l2 = 0.f; it.has_sink = 0; it.lgf = 0.f; it.lgb = 0.f;
    it.S0f = nullptr; it.S0b = nullptr; it.G = nullptr; it.gn = nullptr; it.sout = nullptr;
    if (idx < NA) {
      const int b = idx >> 4, hh = (idx >> 2) & 3, qb = idx & 3, row0 = NCTX + b * 1024 + qb * 256;
      it.Q = p.Qmla() + (size_t)row0 * 384 + hh * 96; it.qs = 384;
      it.K = p.Kmla_l() + ((size_t)(((l * 8 + b) * 4 + hh) * 1280)) * 96; it.ks = 96;
      it.Vt = p.Vtmla_l() + ((size_t)(((l * 8 + b) * 4 + hh) * 64)) * 1280; it.vs = 1280;
      it.t0 = 0; it.t1 = 20;
      it.scale = 0.10206207261596575f * LOG2E;
      it.out = p.mix() + (size_t)row0 * DM + 768 + hh * 64;
      attn_item<96, 0>(it, smem, wv);
      continue;
    }
    idx -= NA;
    if (idx < NB) {
      const int b = idx >> 4, hh = (idx >> 2) & 3, qb = idx & 3, row0 = NCTX + b * 1024 + qb * 256;
      it.Q = p.Qret() + (size_t)row0 * 256 + hh * 64; it.qs = 256;
      it.K = p.Kret() + (size_t)(NCTX + b * 1024) * 256 + hh * 64; it.ks = 256;
      it.Vt = p.Vtret_l() + ((size_t)((b * 4 + hh) * 64)) * 1024; it.vs = 1024;
      it.t0 = 0; it.t1 = 16; it.t2 = 16; it.t3 = 18;
      it.qpos0 = qb * 256; it.T = 1024; it.scale = 0.125f;
      it.lgf = log2_sigmoid(p.ret_decay[(l * 2 + 0) * 4 + hh]);
      it.lgb = log2_sigmoid(p.ret_decay[(l * 2 + 1) * 4 + hh]);
      it.S0f = p.S0t() + ((size_t)((((l * 8 + b) * 2 + 0) * 4 + hh))) * 4096;
      it.S0b = p.S0t() + ((size_t)((((l * 8 + b) * 2 + 1) * 4 + hh))) * 4096;
      it.G = p.Gret() + (size_t)row0 * 256 + hh * 64; it.gn = p.ret_gn + l * 256 + hh * 64;
      it.out = p.mix() + (size_t)row0 * DM + 512 + hh * 64;
      attn_item<64, 2>(it, smem, wv);
      continue;
    }
    idx -= NB;
    if (idx < NC) {
      const int b = idx >> 5, head = (idx >> 2) & 7, qb = idx & 3, kv = head >> 2, row0 = NCTX + b * 1024 + qb * 256;
      it.Q = p.Qwin() + (size_t)row0 * 512 + head * 64; it.qs = 512;
      it.K = p.Kwin_l() + ((size_t)((l * 8 + b) * 1280)) * 128 + kv * 64; it.ks = 128;
      it.Vt = p.Vtwin_l() + ((size_t)(((l * 8 + b) * 2 + kv) * 64)) * 1280; it.vs = 1280;
      it.t0 = max(0, qb * 4 - 2); it.t1 = min(16, qb * 4 + 6); it.t2 = 16; it.t3 = 20;
      it.qpos0 = qb * 256;
      it.scale = 0.125f * LOG2E; it.sink_l2 = p.win_sink[l * 8 + head] * LOG2E; it.has_sink = 1;
      it.out = p.mix() + (size_t)row0 * DM + head * 64;
      attn_item<64, 1>(it, smem, wv);
      continue;
    }
    idx -= NC;
    if (idx < ND) {
      const int b = idx >> 3, head = idx & 7, kv = head >> 2, row0 = b * 256;
      it.Q = p.Qwin() + (size_t)row0 * 512 + head * 64; it.qs = 512;
      it.K = p.Kwin_c() + (size_t)(b * 256) * 128 + kv * 64; it.ks = 128;
      it.Vt = p.Vtwin_c() + ((size_t)((b * 2 + kv) * 64)) * 256; it.vs = 256;
      it.t0 = 0; it.t1 = 4;
      it.scale = 0.125f * LOG2E; it.sink_l2 = p.win_sink[l * 8 + head] * LOG2E; it.has_sink = 1;
      it.out = p.mix() + (size_t)row0 * DM + head * 64;
      attn_item<64, 0>(it, smem, wv);
      continue;
    }
    idx -= ND;
    if (idx < NE) {
      const int b = idx >> 2, hh = idx & 3, row0 = b * 256;
      it.Q = p.Qmla() + (size_t)row0 * 384 + hh * 96; it.qs = 384;
      it.K = p.Kmla_c() + ((size_t)((b * 4 + hh) * 256)) * 96; it.ks = 96;
      it.Vt = p.Vtmla_c() + ((size_t)((b * 4 + hh) * 64)) * 256; it.vs = 256;
      it.t0 = 0; it.t1 = 4;
      it.scale = 0.10206207261596575f * LOG2E;
      it.out = p.mix() + (size_t)row0 * DM + 768 + hh * 64;
      attn_item<96, 0>(it, smem, wv);
      continue;
    }
    idx -= NE;
    if (idx < NF) {
      const int b = idx >> 2, hh = idx & 3, row0 = b * 256;
      it.Q = p.Qret() + (size_t)row0 * 256 + hh * 64; it.qs = 256;
      it.K = p.Kret() + (size_t)(b * 256) * 256 + hh * 64; it.ks = 256;
      it.Vt = p.Vtret_c() + ((size_t)((b * 4 + hh) * 64)) * 256; it.vs = 256;
      it.t0 = 0; it.t1 = 4;
      it.qpos0 = 0; it.T = 256; it.scale = 0.125f;
      it.lgf = log2_sigmoid(p.ret_decay[(l * 2 + 0) * 4 + hh]);
      it.lgb = log2_sigmoid(p.ret_decay[(l * 2 + 1) * 4 + hh]);
      it.G = p.Gret() + (size_t)row0 * 256 + hh * 64; it.gn = p.ret_gn + l * 256 + hh * 64;
      it.out = p.mix() + (size_t)row0 * DM + 512 + hh * 64;
      attn_item<64, 2>(it, smem, wv);
      continue;
    }
    idx -= NF;
    {
      const int b = idx >> 2, hh = idx & 3;
      it.Q = nullptr; it.qs = 0;
      it.K = p.Kret() + (size_t)(b * 256) * 256 + hh * 64; it.ks = 256;
      it.Vt = p.Vtret_c() + ((size_t)((b * 4 + hh) * 64)) * 256; it.vs = 256;
      it.t0 = 0; it.t1 = 4;
      it.T = 256; it.scale = 0.125f;
      it.lgf = log2_sigmoid(p.ret_decay[(l * 2 + 0) * 4 + hh]);
      it.lgb = log2_sigmoid(p.ret_decay[(l * 2 + 1) * 4 + hh]);
      it.out = nullptr;
      it.sout = p.out + 23592960 + ((size_t)((b * 2 + l) * 2 * 4 + hh)) * 4096;
      attn_item<64, 3>(it, smem, wv);
    }
  }
}

__device__ __forceinline__ void gemv9_item(const float* sc, float* red, const float* __restrict__ W, int N, int n0, float* outp, int ldo,
                                           const float* bias, const int tid) {
  const int j4 = (tid & 7) * 4, kq = tid >> 3;
  f32x4 acc[9];
#pragma unroll
  for (int r = 0; r < 9; ++r) acc[r] = (f32x4){0.f, 0.f, 0.f, 0.f};
  const float* w = W + (size_t)(kq * 16) * N + n0 + j4;
  const float* s = sc + kq * 16;
#pragma unroll
  for (int kk = 0; kk < 16; ++kk) {
    const f32x4 wv = __builtin_nontemporal_load((const f32x4*)(w + (size_t)kk * N));
#pragma unroll
    for (int r = 0; r < 9; ++r) acc[r] += wv * s[r * 1024 + kk];
  }
#pragma unroll
  for (int r = 0; r < 9; ++r) *(f32x4*)(red + (kq * 9 + r) * 32 + j4) = acc[r];
  __syncthreads();
  for (int oo = tid; oo < 288; oo += NTHR) {
    const int r = oo >> 5, jj = oo & 31;
    float sum = 0.f;
#pragma unroll 16
    for (int q = 0; q < 64; ++q) sum += red[(q * 9 + r) * 32 + jj];
    outp[(size_t)r * ldo + n0 + jj] = sum + (bias ? bias[n0 + jj] : 0.f);
  }
  __syncthreads();
}

__device__ __forceinline__ void norm0_phase(const P& p, unsigned char* smem, const int wv) {
  const int tid = my_tid(wv), lane = tid & 63, gw = my_bid() * NWV + (tid >> 6), ngw = gridDim.x * NWV;
  const float* gain = p.norm1;
  for (int m0 = gw; m0 < NTOK; m0 += 2 * ngw) {
    float4 v[2][4];
    float ss[2] = {0.f, 0.f};
#pragma unroll
    for (int q = 0; q < 2; ++q) {
      const int m = m0 + q * ngw;
      const float* xr = m < NCTX ? p.x_prompt + (size_t)m * DM : p.x_sample + (size_t)(m - NCTX) * DM;
#pragma unroll
      for (int t = 0; t < 2; ++t) {
        v[q][2 * t] = *(const float4*)(xr + t * 512 + lane * 8);
        v[q][2 * t + 1] = *(const float4*)(xr + t * 512 + lane * 8 + 4);
      }
    }
#pragma unroll
    for (int q = 0; q < 2; ++q) {
#pragma unroll
      for (int j = 0; j < 4; ++j) ss[q] += v[q][j].x * v[q][j].x + v[q][j].y * v[q][j].y + v[q][j].z * v[q][j].z + v[q][j].w * v[q][j].w;
      ss[q] = wave_sum(ss[q], lane);
    }
#pragma unroll
    for (int q = 0; q < 2; ++q) {
      const int m = m0 + q * ngw;
      const float* scale = p.mod() + ((size_t)mod_row(m)) * 6144 + 1 * 1024;
#pragma unroll
      for (int t = 0; t < 2; ++t) {
        const int c = t * 512 + lane * 8;
        const float4 g0 = *(const float4*)(gain + c), g1 = *(const float4*)(gain + c + 4), s0 = *(const float4*)(scale + c), s1 = *(const float4*)(scale + c + 4);
        const float4 a = v[q][2 * t], b = v[q][2 * t + 1];
        uint4 u;
        u.x = pk2(a.x * g0.x * (1.f + s0.x), a.y * g0.y * (1.f + s0.y));
        u.y = pk2(a.z * g0.z * (1.f + s0.z), a.w * g0.w * (1.f + s0.w));
        u.z = pk2(b.x * g1.x * (1.f + s1.x), b.y * g1.y * (1.f + s1.y));
        u.w = pk2(b.z * g1.z * (1.f + s1.z), b.w * g1.w * (1.f + s1.w));
        *(uint4*)(p.hbuf() + (size_t)m * DM + c) = u;
      }
      if (lane < 16) p.rssA()[(size_t)m * 16 + lane] = lane == 0 ? ss[q] : 0.f;
    }
  }
  float* sc = (float*)smem;
  float* red = sc + 9216;
  constexpr int G_IN = DIN / 32, G_UP = DFF / 32, NIT = 2 * G_IN + 2 * G_UP;
  for (int item = my_bid(); item < NIT; item += gridDim.x) {
    int l, grp; const float* W; int N; float* outp; int ldo; int which;
    if (item < 2 * G_IN) { l = item / G_IN; grp = item % G_IN; W = p.w_in + (size_t)l * DM * DIN; N = DIN; outp = p.sWin() + (size_t)l * 9 * DINP; ldo = DINP; which = 0; }
    else { const int i2 = item - 2 * G_IN; l = i2 / G_UP; grp = i2 % G_UP; W = p.w_up + (size_t)l * DM * DFF; N = DFF; outp = p.sWup() + (size_t)l * 9 * DFF; ldo = DFF; which = 3; }
    __syncthreads();
    for (int i = tid; i < 9216; i += NTHR) sc[i] = p.mod()[((size_t)(l * 9 + (i >> 10))) * 6144 + which * 1024 + (i & 1023)];
    __syncthreads();
    gemv9_item(sc, red, W, N, grp * 32, outp, ldo, nullptr, tid);
  }
}
__device__ __forceinline__ void final_norm_phase(const P& p, const int wv) {
  const int tid = my_tid(wv), lane = tid & 63, gw = my_bid() * NWV + (tid >> 6), ngw = gridDim.x * NWV;
  for (int m = gw; m < NTOK; m += ngw) {
    const float* xr = p.xw() + (size_t)m * DM;
    float4 v[4];
    float ss = 0.f;
#pragma unroll
    for (int j = 0; j < 4; ++j) {
      v[j] = ((const float4*)xr)[lane + 64 * j];
      ss += v[j].x * v[j].x + v[j].y * v[j].y + v[j].z * v[j].z + v[j].w * v[j].w;
    }
    ss = wave_sum(ss, lane);
    const float rstd = rsqrtf(ss * (1.f / 1024.f) + 1e-6f);
#pragma unroll
    for (int j = 0; j < 4; ++j) {
      const int c = (lane + 64 * j) * 4;
      const float4 g = *(const float4*)(p.final_norm + c);
      __builtin_nontemporal_store((f32x4){v[j].x * rstd * g.x, v[j].y * rstd * g.y, v[j].z * rstd * g.z, v[j].w * rstd * g.w}, (f32x4*)(p.out + (size_t)m * DM + c));
    }
  }
}

__device__ __forceinline__ void transpose_tile(const float* __restrict__ W, int K, int N, bf16_t* __restrict__ WT, int item, float* tile, const int tid) {
  const int ntn = (N + 63) >> 6, kt = item / ntn, nt = item % ntn, k0 = kt * 64, n0 = nt * 64;
  const int n4 = (tid & 15) * 4, kr = tid >> 4;
#pragma unroll
  for (int q = 0; q < 2; ++q) {
    const int k = q * 32 + kr;
    f32x4 v = (f32x4){0.f, 0.f, 0.f, 0.f};
    if (n0 + n4 < N) v = __builtin_nontemporal_load((const f32x4*)(W + (size_t)(k0 + k) * N + n0 + n4));
    float* t = tile + k * 65 + n4;
    t[0] = v[0]; t[1] = v[1]; t[2] = v[2]; t[3] = v[3];
  }
  __syncthreads();
  {
    const int n = tid >> 3, kc = (tid & 7) * 8;
    const float* t = tile + kc * 65 + n;
    uint4 o;
    o.x = pk2(t[0 * 65], t[1 * 65]); o.y = pk2(t[2 * 65], t[3 * 65]); o.z = pk2(t[4 * 65], t[5 * 65]); o.w = pk2(t[6 * 65], t[7 * 65]);
    if (n0 + n < N) *(uint4*)(WT + (size_t)(n0 + n) * K + k0 + kc) = o;
  }
  __syncthreads();
}

__device__ __forceinline__ void prep_phase(const P& p, unsigned char* smem, const int wv) {
  const int tid = my_tid(wv);
  {
    float* sc = (float*)smem;
    float* red = sc + 9216;
    for (int i = tid; i < 9216; i += NTHR) {
      const int r = i >> 10, k = i & 1023;
      const float x = r == 0 ? p.c_ctx[k] : p.c[(r - 1) * 1024 + k];
      sc[i] = x / (1.f + expf(-x));
    }
    __syncthreads();
    for (int item = blockIdx.x; item < 384; item += gridDim.x) {
      const int l = item / 192, n0 = (item % 192) * 32;
      gemv9_item(sc, red, p.w_mod + (size_t)l * 1024 * 6144, 6144, n0, p.mod() + (size_t)l * 9 * 6144, 6144, p.b_mod + l * 6144, tid);
    }
  }
  __syncthreads();
  {
    float* tile = (float*)smem;
    constexpr int I_IN = 16 * 37, I_OUT = 16 * 16, I_UP = 16 * 64, I_DN = 64 * 16, I_KV = 2 * 8;
    constexpr int PER = I_IN + I_OUT + I_UP + I_DN + I_KV;
    for (int item = blockIdx.x; item < 2 * PER; item += gridDim.x) {
      const int l = item / PER;
      int r = item % PER;
      if (r < I_IN) { transpose_tile(p.w_in + (size_t)l * DM * DIN, DM, DIN, p.WinT() + (size_t)l * DINP * DM, r, tile, tid); continue; }
      r -= I_IN;
      if (r < I_OUT) { transpose_tile(p.w_out + (size_t)l * DM * DM, DM, DM, p.WoutT() + (size_t)l * DM * DM, r, tile, tid); continue; }
      r -= I_OUT;
      if (r < I_UP) { transpose_tile(p.w_up + (size_t)l * DM * DFF, DM, DFF, p.WupT() + (size_t)l * DFF * DM, r, tile, tid); continue; }
      r -= I_UP;
      if (r < I_DN) { transpose_tile(p.w_down + (size_t)l * DFF * DM, DFF, DM, p.WdownT() + (size_t)l * DM * DFF, r, tile, tid); continue; }
      r -= I_DN;
      transpose_tile(p.w_kv_b + (size_t)l * 128 * 512, 128, 512, p.WkvbT() + (size_t)l * 512 * 128, r, tile, tid);
    }
  }
  const int gt = blockIdx.x * NTHR + tid, gs = gridDim.x * NTHR;
  if (gt < 256) p.ctl()[gt] = 0u;
  for (int i = gt; i < 64 * 16; i += gs) {
    const int pos = i >> 4, f = i & 15;
    const float ang = (float)pos * exp2f(-(float)f * (L2_10000 / 16.f));
    p.ropeW()[pos * 32 + f] = __cosf(ang);
    p.ropeW()[pos * 32 + 16 + f] = __sinf(ang);
  }
  for (int i = gt; i < 64 * 8; i += gs) {
    const int pos = i >> 3, f = i & 7;
    const float ang = (float)pos * exp2f(-(float)f * (L2_10000 / 8.f));
    p.ropeM()[pos * 16 + f] = __cosf(ang);
    p.ropeM()[pos * 16 + 8 + f] = __sinf(ang);
  }
  for (int i = gt; i < 2 * (DINP - DIN) * DM / 8; i += gs) {
    const int l = i / ((DINP - DIN) * DM / 8), o = i % ((DINP - DIN) * DM / 8);
    *(uint4*)(p.WinT() + ((size_t)l * DINP + DIN) * DM + (size_t)o * 8) = make_uint4(0, 0, 0, 0);
  }
  for (int i = gt; i < 524288 / 8; i += gs) {
    const int d8 = i & 7, kv = (i >> 3) & 1, s = (i >> 4) & 255, l = (i >> 12) & 1, b = i >> 13;
    const float4 a = *(const float4*)(p.cache_win_k + (size_t)i * 8), c = *(const float4*)(p.cache_win_k + (size_t)i * 8 + 4);
    *(uint4*)(p.Kwin_l() + ((size_t)((l * 8 + b) * 1280 + 1024 + s)) * 128 + kv * 64 + d8 * 8) = make_uint4(pk2(a.x, a.y), pk2(a.z, a.w), pk2(c.x, c.y), pk2(c.z, c.w));
  }
  for (int i = gt; i < 524288 / 8; i += gs) {
    const int d = i & 63, kv = (i >> 6) & 1, s8 = (i >> 7) & 31, l = (i >> 12) & 1, b = i >> 13;
    const float* src = p.cache_win_v + ((size_t)((b * 2 + l) * 256 + s8 * 8) * 2 + kv) * 64 + d;
    float v[8];
#pragma unroll
    for (int j = 0; j < 8; ++j) v[j] = src[(size_t)j * 128];
    *(uint4*)(p.Vtwin_l() + ((size_t)(((l * 8 + b) * 2 + kv) * 64 + d)) * 1280 + 1024 + s8 * 8) = make_uint4(pk2(v[0], v[1]), pk2(v[2], v[3]), pk2(v[4], v[5]), pk2(v[6], v[7]));
  }
  for (int i = gt; i < 524288 / 8; i += gs) {
    const int j8 = i & 15, s = (i >> 4) & 255, l = (i >> 12) & 1, b = i >> 13;
    const float4 a = *(const float4*)(p.cache_mla_ckv + (size_t)i * 8), c = *(const float4*)(p.cache_mla_ckv + (size_t)i * 8 + 4);
    *(uint4*)(p.ckvn() + ((size_t)l * 18432 + 16384 + b * 256 + s) * 128 + j8 * 8) = make_uint4(pk2(a.x, a.y), pk2(a.z, a.w), pk2(c.x, c.y), pk2(c.z, c.w));
  }
  for (int i = gt; i < 131072 / 8; i += gs) {
    const int j8 = i & 3, s = (i >> 2) & 255, l = (i >> 10) & 1, b = i >> 11;
    const float4 a = *(const float4*)(p.cache_mla_krope + (size_t)i * 8), c = *(const float4*)(p.cache_mla_krope + (size_t)i * 8 + 4);
    const uint4 o = make_uint4(pk2(a.x, a.y), pk2(a.z, a.w), pk2(c.x, c.y), pk2(c.z, c.w));
#pragma unroll
    for (int hh = 0; hh < 4; ++hh) *(uint4*)(p.Kmla_l() + ((size_t)(((l * 8 + b) * 4 + hh) * 1280 + 1024 + s)) * 96 + 64 + j8 * 8) = o;
  }
  for (int i = gt; i < 524288 / 8; i += gs) {
    const int e = i & 63, d8 = (i >> 6) & 7, blk = i >> 9;
    const int hh = blk & 3, dir = (blk >> 2) & 1, l = (blk >> 3) & 1, b = blk >> 4;
    const float* src = p.state_ret + (size_t)blk * 4096 + (size_t)(d8 * 8) * 64 + e;
    float v[8];
#pragma unroll
    for (int j = 0; j < 8; ++j) v[j] = src[(size_t)j * 64];
    *(uint4*)(p.S0t() + ((size_t)((((l * 8 + b) * 2 + dir) * 4 + hh) * 64 + e)) * 64 + d8 * 8) = make_uint4(pk2(v[0], v[1]), pk2(v[2], v[3]), pk2(v[4], v[5]), pk2(v[6], v[7]));
  }
}

struct RotOrder : pg8::StaticOrder {
  int rot;
  __device__ __forceinline__ bool next(int i, Unit& u) const {
    if (!pg8::StaticOrder::next(i, u)) return false;
    u.pn += rot; if (u.pn >= nN) u.pn -= nN;
    return true;
  }
};
template <class Epi>
__device__ __forceinline__ void big_gemm(unsigned char* smem, const bf16_t* A, const bf16_t* Bt, int N, int K, const Epi& E, const int wv, int rot = 0) {
  pg8::Gemm g{A, Bt, NTOK, N, K};
  RotOrder S;
  S.init(NTOK, N, (int)gridDim.x, my_bid());
  S.rot = rot;
  pg8::gemm_phase<Epi, RotOrder, true, true>((PG8_LAS unsigned char*)smem, g, S, E, wv);
}

#define GSYNC() grid.sync()
__global__ void __launch_bounds__(NTHR, 2) hybrid_fwd(P p_arg) {
  cg::grid_group grid = cg::this_grid();
  const kargp_t kp = (kargp_t)__builtin_amdgcn_kernarg_segment_ptr();
  const int wv = __builtin_amdgcn_readfirstlane((int)threadIdx.x >> 6);
  { const P p = load_params(kp); prep_phase(p, smem, wv); }
  GSYNC();
  { const P p = load_params(kp); norm0_phase(p, smem, wv); }
  GSYNC();
#pragma unroll
  for (int l = 0; l < 2; ++l) {
    { const P pc = load_params(kp); const int t0 = my_tid(wv);
      for (int i = t0; i < 64 * 32; i += NTHR) ((float*)(smem + LDS_ROPEW))[i] = pc.ropeW()[i];
      for (int i = t0; i < 64 * 16; i += NTHR) ((float*)(smem + LDS_ROPEM))[i] = pc.ropeM()[i];
      __syncthreads(); }
    { const P p = load_params(kp);
      big_gemm(smem, p.hbuf(), p.WinT() + (size_t)l * DINP * DM, DINP, DM, EpiIn8{p, l, kp}, wv, 8); }
    { const P p = load_params(kp); gemm_small(p.ckvn() + (size_t)l * 18432 * 128, 128, p.WkvbT() + (size_t)l * 512 * 128, 128, 18432, 512, 128, smem, EpiKvb{p, l}, wv, p.ctl() + 64 * l, p.ctl() + 128 + 64 * l); }
    GSYNC();
    { const P p = load_params(kp); attn_phase(p, l, smem, wv); }
    GSYNC();
    { const P p = load_params(kp); big_gemm(smem, p.mix(), p.WoutT() + (size_t)l * DM * DM, DM, DM, EpiOut8{p, l}, wv); }
    GSYNC();
    { const P p = load_params(kp); big_gemm(smem, p.hbuf(), p.WupT() + (size_t)l * DFF * DM, DFF, DM, EpiUp8{p, l}, wv); }
    GSYNC();
    { const P p = load_params(kp); big_gemm(smem, p.ubuf(), p.WdownT() + (size_t)l * DM * DFF, DM, DFF, EpiDown8{p, l}, wv); }
    GSYNC();
  }
  { const P p = load_params(kp); final_norm_phase(p, wv); }
}

extern "C" void kernel_launch(void* const* d_in, const int* in_sizes, int n_in, void* d_out, int out_size, void* d_ws, size_t ws_size,
                              hipStream_t stream) {
  static int grid_blocks = 0;
  if (grid_blocks == 0) {
    int dev = 0, cus = 0, per_cu = 0;
    (void)hipGetDevice(&dev);
    (void)hipDeviceGetAttribute(&cus, hipDeviceAttributeMultiprocessorCount, dev);
    (void)hipFuncSetAttribute((const void*)hybrid_fwd, hipFuncAttributeMaxDynamicSharedMemorySize, LDS_BYTES);
    (void)hipOccupancyMaxActiveBlocksPerMultiprocessor(&per_cu, (const void*)hybrid_fwd, NTHR, LDS_BYTES);
    if (per_cu < 1) { fprintf(stderr, "occupancy query returned %d\n", per_cu); per_cu = 1; }
    per_cu = 1;
    grid_blocks = cus * per_cu;
  }
  P p{};
  const float* const* in = (const float* const*)d_in;
  p.x_prompt = in[0]; p.x_sample = in[1]; p.cache_win_k = in[2]; p.cache_win_v = in[3]; p.cache_mla_ckv = in[4];
  p.cache_mla_krope = in[5]; p.state_ret = in[6]; p.c = in[7]; p.c_ctx = in[8]; p.w_mod = in[9]; p.b_mod = in[10];
  p.norm1 = in[11]; p.norm2 = in[12]; p.w_in = in[13]; p.win_sink = in[14]; p.ret_decay = in[15]; p.ret_gn = in[16];
  p.mla_kv_norm = in[17]; p.w_kv_b = in[18]; p.w_out = in[19]; p.w_up = in[20]; p.w_down = in[21]; p.final_norm = in[22];
  p.out = (float*)d_out;
  p.ws = (unsigned char*)d_ws;
  if (WS_END > ws_size) { fprintf(stderr, "kernel_launch: workspace too small: need %zu, have %zu\n", (size_t)WS_END, ws_size); return; }
  void* args[] = {&p};
  hipError_t e = hipLaunchCooperativeKernel((const void*)hybrid_fwd, dim3(grid_blocks), dim3(NTHR), args, LDS_BYTES, stream);
  if (e != hipSuccess) fprintf(stderr, "cooperative launch failed: %s (grid %d)\n", hipGetErrorString(e), grid_blocks);
}
```

```cpp
#include <hip/hip_runtime.h>
#include <hip/hip_cooperative_groups.h>
#include <cstdio>
#include <cstdint>
namespace cg = cooperative_groups;

__device__ __forceinline__ int lane_id() { return (int)__builtin_amdgcn_mbcnt_hi(~0u, __builtin_amdgcn_mbcnt_lo(~0u, 0u)); }

namespace pg8 {
#define PG8_LAS __attribute__((address_space(3)))
typedef unsigned short bf16_t;
typedef short bf16x8 __attribute__((ext_vector_type(8)));
typedef float f32x4 __attribute__((ext_vector_type(4)));
typedef unsigned u32x4 __attribute__((ext_vector_type(4)));
constexpr int BM = 256, BK = 64, HALF = 128, HTB = HALF * BK * 2  , STAGE_BYTES = 8 * HTB, NXCD = 8, WGM = 8;

__host__ __device__ __forceinline__ int lds_byte(int r, int c) { const int st = (r >> 4) * 2 + (c >> 5), rr = r & 15, cc = c & 31, ob = rr * 64 + cc * 2; return st * 1024 + (ob ^ (((ob >> 9) & 1) << 5)); }
__host__ __device__ __forceinline__ void stage_rc(int b, int& R, int& C) { const int st = b / 1024, sb = b % 1024, swz = sb ^ (((sb >> 9) & 1) << 5); R = (st >> 1) * 16 + swz / 64; C = (st & 1) * 32 + (swz % 64) / 2; }
__host__ __device__ __forceinline__ int perm32(int rho) { const int n = rho >> 4, i = rho & 15; return 8 * (i >> 2) + 4 * n + (i & 3); }

struct Unit { int pm, pn; };
struct Gemm { const bf16_t* A; const bf16_t* Bt; int M, N, K; };

struct StaticOrder {
    int nM, nN, nwg, G, c;
    __host__ __device__ void init(int M, int N, int G_, int c_) { nM = M / BM; nN = N / BM; nwg = nM * nN; G = G_; c = c_; }
    __host__ __device__ bool next(int i, Unit& u) const {
        const long L = (long)i * G + c; if (L >= nwg) return false;
        int wgid = (int)L; { const int q = nwg / NXCD, r = nwg % NXCD, xcd = wgid % NXCD, off = wgid / NXCD; wgid = (xcd < r ? xcd * (q + 1) : r * (q + 1) + (xcd - r) * q) + off; }
        const int nig = WGM * nN, gid = wgid / nig, fm = gid * WGM, gsz = (nM - fm) < WGM ? (nM - fm) : WGM;
        u.pm = fm + ((wgid % nig) % gsz); u.pn = (wgid % nig) / gsz; return true;
    }
    __device__ __forceinline__ void a_ready(const Unit&) const {}
    __device__ __forceinline__ void done(const Unit&) const {}
};
template <class Epi, class Sched, bool ALIGN_EPI = false, bool SP2 = false>
__device__ __forceinline__ void gemm_phase(PG8_LAS unsigned char* lds, const Gemm g, const Sched& S, const Epi& E, const int wvp) {
    const int wid = wvp, lane = lane_id(), tid = wid * 64 + lane, wr = wid >> 2, wc = wid & 3, fr = lane & 15, fq = lane >> 4;
    const int K = g.K, nt = K / BK;
    unsigned voffA[2], voffB[2];
#pragma unroll
    for (int i = 0; i < 2; ++i) { int R, C; stage_rc(tid * 16 + i * 8192, R, C); const int Rb = Epi::PERM ? ((R & ~31) + perm32(R & 31)) : R;
        voffA[i] = (unsigned)(R * K + C) * 2u; voffB[i] = (unsigned)(Rb * K + C) * 2u; }
    const size_t kstep = (size_t)(BK * 2);
    const size_t hstep = (size_t)HALF * K * 2;
    const size_t tstep = 2 * hstep;
    const unsigned ldsw = (unsigned)wid * 1024u;
    const int aoff = lds_byte(wr * 64 + fr, fq * 8), boff = lds_byte(wc * 32 + fr, fq * 8);
#define PG8_SA(b, h) (((b) * 2 + (h)) * HTB)
#define PG8_SB(b, h) ((4 + (b) * 2 + (h)) * HTB)
#define PG8_STAGE(bufoff, gbase, voff) do { _Pragma("unroll") for (int _i = 0; _i < 2; ++_i) \
        __builtin_amdgcn_global_load_lds((const unsigned*)((const char*)(gbase) + (voff)[_i]), (PG8_LAS unsigned*)(lds + (bufoff) + ldsw + _i * 8192), 16, 0, 0); } while (0)
#define PG8_LDA(dst, b, h) do { _Pragma("unroll") for (int m = 0; m < 4; ++m) _Pragma("unroll") for (int k = 0; k < 2; ++k) dst[m][k] = *(const PG8_LAS bf16x8*)(lds + PG8_SA(b, h) + aoff + m * 2048 + k * 1024); } while (0)
#define PG8_LDB(dst, b, h) do { _Pragma("unroll") for (int n = 0; n < 2; ++n) _Pragma("unroll") for (int k = 0; k < 2; ++k) dst[n][k] = *(const PG8_LAS bf16x8*)(lds + PG8_SB(b, h) + boff + n * 2048 + k * 1024); } while (0)
#define PG8_MMA(ai, bj, At, Bt) do { __builtin_amdgcn_s_setprio(1); _Pragma("unroll") for (int m = 0; m < 4; ++m) _Pragma("unroll") for (int n = 0; n < 2; ++n) _Pragma("unroll") for (int k = 0; k < 2; ++k) \
        acc[ai][bj][m][n] = __builtin_amdgcn_mfma_f32_16x16x32_bf16(Bt[n][k], At[m][k], acc[ai][bj][m][n], 0, 0, 0); __builtin_amdgcn_s_setprio(0); } while (0)
#define PG8_WAIT_V(n) asm volatile("s_waitcnt vmcnt(" #n ")" ::: "memory")
#define PG8_WAIT_L(n) asm volatile("s_waitcnt lgkmcnt(" #n ")" ::: "memory")
#define PG8_BAR __builtin_amdgcn_s_barrier()
#define PG8_SCHED __builtin_amdgcn_sched_barrier(0)
    Unit cur, nxt; int ui = 0;
    if (!S.next(0, cur)) return;
    f32x4 acc[2][2][4][2];
#pragma unroll
    for (int a = 0; a < 2; ++a)
#pragma unroll
        for (int b = 0; b < 2; ++b)
#pragma unroll
            for (int m = 0; m < 4; ++m)
#pragma unroll
                for (int n = 0; n < 2; ++n) acc[a][b][m][n] = (f32x4){0.f, 0.f, 0.f, 0.f};
    bf16x8 At[4][2], B0[2][2], B1[2][2];
    const char* cA = (const char*)g.A + (size_t)cur.pm * tstep; const char* cB = (const char*)g.Bt + (size_t)cur.pn * tstep;
    S.a_ready(cur);
    if constexpr (SP2) {
        PG8_STAGE(PG8_SB(0, 0), cB, voffB); PG8_STAGE(PG8_SB(0, 1), cB + hstep, voffB); PG8_STAGE(PG8_SA(0, 0), cA, voffA); PG8_STAGE(PG8_SA(0, 1), cA + hstep, voffA);
        if (wr == 1) PG8_BAR;
        PG8_WAIT_V(2); PG8_BAR;
        PG8_STAGE(PG8_SB(1, 0), cB + kstep, voffB); PG8_STAGE(PG8_SA(1, 0), cA + kstep, voffA); PG8_STAGE(PG8_SB(1, 1), cB + hstep + kstep, voffB);
        PG8_WAIT_V(6); PG8_BAR;
    } else {
        PG8_STAGE(PG8_SB(0, 0), cB, voffB); PG8_STAGE(PG8_SA(0, 0), cA, voffA); PG8_STAGE(PG8_SB(0, 1), cB + hstep, voffB); PG8_STAGE(PG8_SA(0, 1), cA + hstep, voffA);
        if (wr == 1) PG8_BAR;
        PG8_WAIT_V(4); PG8_BAR;
        PG8_STAGE(PG8_SB(1, 0), cB + kstep, voffB); PG8_STAGE(PG8_SA(1, 0), cA + kstep, voffA); PG8_STAGE(PG8_SB(1, 1), cB + hstep + kstep, voffB);
        PG8_WAIT_V(6); PG8_BAR;
    }
    for (;;) {
        const bool has_next = S.next(ui + 1, nxt);
        const char* nA = has_next ? (const char*)g.A + (size_t)nxt.pm * tstep : cA; const char* nB = has_next ? (const char*)g.Bt + (size_t)nxt.pn * tstep : cB;
        for (int t = 0; t < nt; t += 2) {
            const bool last = (t == nt - 2);
            const char* a1 = cA + (size_t)(t + 1) * kstep;
            const char* a2 = last ? nA : cA + (size_t)(t + 2) * kstep; const char* b2 = last ? nB : cB + (size_t)(t + 2) * kstep;
            const char* a3 = a2 + kstep; const char* b3 = b2 + kstep;
            if (last && has_next) S.a_ready(nxt);
            if constexpr (SP2) {
            PG8_LDB(B0, 0, 0); PG8_LDB(B1, 0, 1); PG8_SCHED; PG8_LDA(At, 0, 0); PG8_STAGE(PG8_SA(1, 1), a1 + hstep, voffA);
            PG8_WAIT_V(8); PG8_WAIT_L(0); PG8_BAR; PG8_MMA(0, 0, At, B0); PG8_MMA(0, 1, At, B1); PG8_BAR; PG8_SCHED;
            PG8_LDA(At, 0, 1); PG8_STAGE(PG8_SB(0, 0), b2, voffB); PG8_STAGE(PG8_SB(0, 1), b2 + hstep, voffB); PG8_STAGE(PG8_SA(0, 0), a2, voffA);
            PG8_WAIT_V(8); PG8_WAIT_L(0); PG8_BAR; PG8_MMA(1, 0, At, B0); PG8_MMA(1, 1, At, B1); PG8_BAR; PG8_SCHED;
            PG8_LDB(B0, 1, 0); PG8_LDB(B1, 1, 1); PG8_SCHED; PG8_LDA(At, 1, 0); PG8_STAGE(PG8_SA(0, 1), a2 + hstep, voffA);
            PG8_WAIT_V(8); PG8_WAIT_L(0); PG8_BAR; PG8_MMA(0, 0, At, B0); PG8_MMA(0, 1, At, B1); PG8_BAR; PG8_SCHED;
            PG8_LDA(At, 1, 1); PG8_STAGE(PG8_SB(1, 0), b3, voffB); PG8_STAGE(PG8_SB(1, 1), b3 + hstep, voffB); PG8_STAGE(PG8_SA(1, 0), a3, voffA);
            PG8_WAIT_V(8); PG8_WAIT_L(0); PG8_BAR; PG8_MMA(1, 0, At, B0); PG8_MMA(1, 1, At, B1); PG8_BAR; PG8_SCHED;
            } else {
            PG8_LDB(B0, 0, 0); PG8_SCHED; PG8_LDA(At, 0, 0); PG8_STAGE(PG8_SA(1, 1), a1 + hstep, voffA);
            PG8_WAIT_L(8); PG8_BAR; PG8_WAIT_L(0); PG8_MMA(0, 0, At, B0); PG8_BAR; PG8_SCHED;
            PG8_LDB(B1, 0, 1); PG8_STAGE(PG8_SB(0, 0), b2, voffB);
            PG8_BAR; PG8_WAIT_L(0); PG8_MMA(0, 1, At, B1); PG8_BAR;
            PG8_LDA(At, 0, 1); PG8_STAGE(PG8_SA(0, 0), a2, voffA);
            PG8_BAR; PG8_WAIT_L(0); PG8_MMA(1, 0, At, B0); PG8_BAR; PG8_SCHED;
            PG8_STAGE(PG8_SB(0, 1), b2 + hstep, voffB);
            PG8_WAIT_V(6); PG8_BAR; PG8_MMA(1, 1, At, B1); PG8_BAR;
            PG8_LDB(B0, 1, 0); PG8_SCHED; PG8_LDA(At, 1, 0); PG8_STAGE(PG8_SA(0, 1), a2 + hstep, voffA);
            PG8_WAIT_L(8); PG8_BAR; PG8_WAIT_L(0); PG8_MMA(0, 0, At, B0); PG8_BAR; PG8_SCHED;
            PG8_LDB(B1, 1, 1); PG8_STAGE(PG8_SB(1, 0), b3, voffB);
            PG8_BAR; PG8_WAIT_L(0); PG8_MMA(0, 1, At, B1); PG8_BAR;
            PG8_LDA(At, 1, 1); PG8_STAGE(PG8_SA(1, 0), a3, voffA);
            PG8_BAR; PG8_WAIT_L(0); PG8_MMA(1, 0, At, B0); PG8_BAR; PG8_SCHED;
            PG8_STAGE(PG8_SB(1, 1), b3 + hstep, voffB);
            PG8_WAIT_V(6); PG8_BAR; PG8_MMA(1, 1, At, B1); PG8_BAR;
            }
        }
        if constexpr (ALIGN_EPI) { if (wr == 0) PG8_BAR; }
        if constexpr (!Epi::AFTER_DRAIN) { E(acc, cur, wr, wc, fr, fq); S.done(cur); }
        if (!has_next) break;
#pragma unroll
        for (int a = 0; a < 2; ++a)
#pragma unroll
            for (int b = 0; b < 2; ++b)
#pragma unroll
                for (int m = 0; m < 4; ++m)
#pragma unroll
                    for (int n = 0; n < 2; ++n) acc[a][b][m][n] = (f32x4){0.f, 0.f, 0.f, 0.f};
        cur = nxt; cA = nA; cB = nB; ++ui;
        if constexpr (ALIGN_EPI) { if (wr == 1) PG8_BAR; }
    }
    PG8_WAIT_V(0);
    if constexpr (!ALIGN_EPI) { if (wr == 0) PG8_BAR; }
    PG8_BAR;
    if constexpr (Epi::AFTER_DRAIN) { E.fused(acc, cur, wr, wc, fr, fq, lds, wid, lane); S.done(cur); }
#undef PG8_SA
#undef PG8_SB
#undef PG8_STAGE
#undef PG8_LDA
#undef PG8_LDB
#undef PG8_MMA
#undef PG8_WAIT_V
#undef PG8_WAIT_L
#undef PG8_BAR
#undef PG8_SCHED
}
}


typedef unsigned short bf16_t;
typedef short bf16x8 __attribute__((ext_vector_type(8)));
typedef float f32x16 __attribute__((ext_vector_type(16)));
typedef pg8::f32x4 f32x4;
typedef unsigned u32x4v __attribute__((ext_vector_type(4)));
using pg8::Unit;

constexpr int NTHR = 512, NWV = 8;
constexpr int NTOK = 16384, NCTX = 8192, DM = 1024, DIN = 2336, DINP = 2560, DFF = 4096;
constexpr int LDS_RED = 131072;
constexpr int LDS_ROPEW = 131072 + 4096, LDS_ROPEM = LDS_ROPEW + 64 * 32 * 4;
constexpr int LDS_BYTES = LDS_ROPEM + 64 * 16 * 4;
constexpr float LOG2E = 1.4426950408889634f;
constexpr float L2_10000 = 13.287712379549449f;

#define AL256(x) (((x) + 255) & ~(size_t)255)
constexpr size_t OFF_mod = 0;
constexpr size_t OFF_ropeW = OFF_mod + AL256((size_t)2 * 9 * 6144 * 4);
constexpr size_t OFF_ropeM = OFF_ropeW + AL256((size_t)64 * 32 * 4);
constexpr size_t OFF_ctl = OFF_ropeM + AL256((size_t)64 * 16 * 4);
constexpr size_t OFF_rssA = OFF_ctl + AL256((size_t)256 * 4);
constexpr size_t OFF_rssB = OFF_rssA + AL256((size_t)NTOK * 16 * 4);
constexpr size_t OFF_sWin = OFF_rssB + AL256((size_t)NTOK * 16 * 4);
constexpr size_t OFF_sWup = OFF_sWin + AL256((size_t)2 * 9 * DINP * 4);
constexpr size_t OFF_WinT = OFF_sWup + AL256((size_t)2 * 9 * DFF * 4);
constexpr size_t OFF_WoutT = OFF_WinT + AL256((size_t)2 * DINP * DM * 2);
constexpr size_t OFF_WupT = OFF_WoutT + AL256((size_t)2 * DM * DM * 2);
constexpr size_t OFF_WdownT = OFF_WupT + AL256((size_t)2 * DFF * DM * 2);
constexpr size_t OFF_WkvbT = OFF_WdownT + AL256((size_t)2 * DM * DFF * 2);
constexpr size_t OFF_hbuf = OFF_WkvbT + AL256((size_t)2 * 512 * 128 * 2);
constexpr size_t OFF_Kwin_l = OFF_hbuf + AL256((size_t)NTOK * DM * 2);
constexpr size_t OFF_Vtwin_l = OFF_Kwin_l + AL256((size_t)2 * 8 * 1280 * 128 * 2);
constexpr size_t OFF_S0t = OFF_Vtwin_l + AL256((size_t)2 * 8 * 2 * 64 * 1280 * 2);
constexpr size_t OFF_ckvn = OFF_S0t + AL256((size_t)2 * 8 * 2 * 4 * 4096 * 2);
constexpr size_t OFF_Kmla_l = OFF_ckvn + AL256((size_t)2 * 18432 * 128 * 2);
constexpr size_t OFF_Vtmla_l = OFF_Kmla_l + AL256((size_t)2 * 8 * 4 * 1280 * 96 * 2);
constexpr size_t OFF_ubuf = OFF_Vtmla_l + AL256((size_t)2 * 8 * 4 * 64 * 1280 * 2);
constexpr size_t WS_END = OFF_ubuf + AL256((size_t)NTOK * DFF * 2);
constexpr size_t OFF_mix = OFF_ubuf + (size_t)96 * 1024 * 1024;
constexpr size_t OFF_Qwin = OFF_ubuf;
constexpr size_t OFF_Kwin_c = OFF_Qwin + AL256((size_t)NTOK * 512 * 2);
constexpr size_t OFF_Vtwin_c = OFF_Kwin_c + AL256((size_t)NCTX * 128 * 2);
constexpr size_t OFF_Qret = OFF_Vtwin_c + AL256((size_t)32 * 2 * 64 * 256 * 2);
constexpr size_t OFF_Kret = OFF_Qret + AL256((size_t)NTOK * 256 * 2);
constexpr size_t OFF_Gret = OFF_Kret + AL256((size_t)NTOK * 256 * 2);
constexpr size_t OFF_Vtret_c = OFF_Gret + AL256((size_t)NTOK * 256 * 2);
constexpr size_t OFF_Vtret_l = OFF_Vtret_c + AL256((size_t)32 * 4 * 64 * 256 * 2);
constexpr size_t OFF_Qmla = OFF_Vtret_l + AL256((size_t)8 * 4 * 64 * 1024 * 2);
constexpr size_t OFF_Kmla_c = OFF_Qmla + AL256((size_t)NTOK * 384 * 2);
constexpr size_t OFF_Vtmla_c = OFF_Kmla_c + AL256((size_t)32 * 4 * 256 * 96 * 2);
static_assert(OFF_Vtmla_c + (size_t)32 * 4 * 64 * 256 * 2 <= OFF_mix && OFF_mix + (size_t)NTOK * DM * 2 <= WS_END, "attention temporaries + mix must fit in the ubuf region");
static_assert(WS_END <= (size_t)256 * 1024 * 1024, "workspace must fit 256 MiB");

struct P {
  const float *x_prompt, *x_sample, *cache_win_k, *cache_win_v, *cache_mla_ckv, *cache_mla_krope, *state_ret,
      *c, *c_ctx, *w_mod, *b_mod, *norm1, *norm2, *w_in, *win_sink, *ret_decay, *ret_gn, *mla_kv_norm,
      *w_kv_b, *w_out, *w_up, *w_down, *final_norm;
  float* out;
  unsigned char* ws;
#define WSBUF(ty, name) __device__ __forceinline__ ty* name() const { return (ty*)(ws + OFF_##name); }
  WSBUF(unsigned, ctl) WSBUF(float, mod) WSBUF(float, ropeW) WSBUF(float, ropeM) WSBUF(float, rssA) WSBUF(float, rssB) WSBUF(float, sWin) WSBUF(float, sWup) WSBUF(bf16_t, WinT) WSBUF(bf16_t, WoutT) WSBUF(bf16_t, WupT) WSBUF(bf16_t, WdownT) WSBUF(bf16_t, WkvbT)
  WSBUF(bf16_t, hbuf) WSBUF(bf16_t, mix) WSBUF(bf16_t, Qwin) WSBUF(bf16_t, Kwin_c) WSBUF(bf16_t, Vtwin_c) WSBUF(bf16_t, Kwin_l)
  WSBUF(bf16_t, Vtwin_l) WSBUF(bf16_t, Qret) WSBUF(bf16_t, Kret) WSBUF(bf16_t, Gret) WSBUF(bf16_t, Vtret_c) WSBUF(bf16_t, Vtret_l)
  WSBUF(bf16_t, S0t) WSBUF(bf16_t, Qmla) WSBUF(bf16_t, ckvn) WSBUF(bf16_t, Kmla_c) WSBUF(bf16_t, Vtmla_c) WSBUF(bf16_t, Kmla_l)
  WSBUF(bf16_t, Vtmla_l) WSBUF(bf16_t, ubuf)
  __device__ __forceinline__ float* xw() const { return out; }
};

typedef float f32x2_t __attribute__((ext_vector_type(2)));
typedef __bf16 bf16x2_t __attribute__((ext_vector_type(2)));
__device__ __forceinline__ unsigned pk2(float lo, float hi) {
  const f32x2_t v = {lo, hi};
  const bf16x2_t b = __builtin_convertvector(v, bf16x2_t);
  return __builtin_bit_cast(unsigned, b);
}
__device__ __forceinline__ bf16_t f2bf(float f) { return (bf16_t)(pk2(f, 0.f) & 0xffffu); }
__device__ __forceinline__ float bf2f(bf16_t b) { return __uint_as_float(((unsigned)b) << 16); }
__device__ __forceinline__ float shx(float v, int mask, int ln) { return __int_as_float(__builtin_amdgcn_ds_bpermute((ln ^ mask) << 2, __float_as_int(v))); }
__device__ __forceinline__ float wave_sum(float v, int ln) {
#pragma unroll
  for (int o = 1; o < 64; o <<= 1) v += shx(v, o, ln);
  return v;
}
typedef const __attribute__((address_space(4))) unsigned char* kargp_t;
__device__ __forceinline__ P load_params(kargp_t kp) {
  asm volatile("" : "+s"(kp));
  P p;
  __builtin_memcpy(&p, kp, sizeof(P));
  return p;
}
__device__ __forceinline__ int my_tid(int wv) { int w = wv; asm volatile("" : "+s"(w)); int t = w * 64 + lane_id(); asm volatile("" : "+v"(t)); return t; }
__device__ __forceinline__ int my_bid() { int b = blockIdx.x; asm volatile("" : "+s"(b)); return b; }
__device__ __forceinline__ float fexp2(float x) { return __builtin_amdgcn_exp2f(x); }
__device__ __forceinline__ int mod_row(int m) { return m < NCTX ? 0 : 1 + ((m - NCTX) >> 10); }

__device__ __forceinline__ void st_rm_bf16(bf16_t* rp, int h, const f32x16& o) {
#pragma unroll
  for (int g = 0; g < 4; ++g) {
    uint2 u;
    u.x = pk2(o[4 * g], o[4 * g + 1]);
    u.y = pk2(o[4 * g + 2], o[4 * g + 3]);
    *(uint2*)(rp + 8 * g + 4 * h) = u;
  }
}
__device__ __forceinline__ void st_tr_bf16(bf16_t* bp, int stride, int h, const f32x16& o) {
#pragma unroll
  for (int i = 0; i < 16; ++i) bp[(size_t)((i & 3) + 8 * (i >> 2) + 4 * h) * stride] = f2bf(o[i]);
}

__device__ __forceinline__ void st8_bf16(bf16_t* rp, int fq, const f32x4& a, const f32x4& b) {
  *(uint2*)(rp + 4 * fq) = make_uint2(pk2(a[0], a[1]), pk2(a[2], a[3]));
  *(uint2*)(rp + 16 + 4 * fq) = make_uint2(pk2(b[0], b[1]), pk2(b[2], b[3]));
}
__device__ __forceinline__ void st8_f32(float* rp, int fq, const f32x4& a, const f32x4& b) {
  *(f32x4*)(rp + 4 * fq) = a;
  *(f32x4*)(rp + 16 + 4 * fq) = b;
}
__device__ __forceinline__ void st8_tr(bf16_t* bp, int stride, int fq, const f32x4& a, const f32x4& b) {
#pragma unroll
  for (int j = 0; j < 4; ++j) {
    bp[(size_t)(4 * fq + j) * stride] = f2bf(a[j]);
    bp[(size_t)(16 + 4 * fq + j) * stride] = f2bf(b[j]);
  }
}
__device__ __forceinline__ void rope8_win(f32x4& a, f32x4& b, int fq, const float* tab) {
  const f32x4 cs = *(const f32x4*)(tab + 4 * fq), sn = *(const f32x4*)(tab + 16 + 4 * fq);
  const f32x4 x = a, y = b;
  a = x * cs - y * sn;
  b = x * sn + y * cs;
}
__device__ __forceinline__ void rope8_mla(f32x4& a, f32x4& b, int fq, int ln, const float* tabr, const float* tabc) {
  const int fo = 4 * (fq & 1);
  {
    const f32x4 cs = *(const f32x4*)(tabr + fo), sn = *(const f32x4*)(tabr + 8 + fo);
#pragma unroll
    for (int j = 0; j < 4; ++j) { const float pa = shx(a[j], 32, ln); a[j] = fq < 2 ? a[j] * cs[j] - pa * sn[j] : pa * sn[j] + a[j] * cs[j]; }
  }
  asm volatile("" ::: "memory");
  {
    const f32x4 cs = *(const f32x4*)(tabc + fo), sn = *(const f32x4*)(tabc + 8 + fo);
#pragma unroll
    for (int j = 0; j < 4; ++j) { const float pb = shx(b[j], 32, ln); b[j] = fq < 2 ? b[j] * cs[j] - pb * sn[j] : pb * sn[j] + b[j] * cs[j]; }
  }
}


__device__ __forceinline__ void st8p_bf16(bf16_t* rp, int fq, const f32x4& a, const f32x4& b) {
  *(uint4*)(rp + 8 * fq) = make_uint4(pk2(a[0], a[1]), pk2(a[2], a[3]), pk2(b[0], b[1]), pk2(b[2], b[3]));
}
__device__ __forceinline__ void st8p_f32(float* rp, int fq, const f32x4& a, const f32x4& b) {
  __builtin_nontemporal_store(a, (f32x4*)(rp + 8 * fq));
  __builtin_nontemporal_store(b, (f32x4*)(rp + 8 * fq + 4));
}
__device__ __forceinline__ void st8p_tr(bf16_t* bp, int stride, int fq, const f32x4& a, const f32x4& b) {
#pragma unroll
  for (int j = 0; j < 4; ++j) {
    bp[(size_t)(8 * fq + j) * stride] = f2bf(a[j]);
    bp[(size_t)(8 * fq + 4 + j) * stride] = f2bf(b[j]);
  }
}
__device__ __forceinline__ void rope8p_win(f32x4& a, f32x4& b, int fq, int ln, const float* tab) {
  const int f0 = 8 * (fq & 1);
  const f32x4 ca = *(const f32x4*)(tab + f0), cb4 = *(const f32x4*)(tab + f0 + 4), sa = *(const f32x4*)(tab + 16 + f0), sb = *(const f32x4*)(tab + 16 + f0 + 4);
#pragma unroll
  for (int j = 0; j < 4; ++j) {
    const float pa = shx(a[j], 32, ln), pb = shx(b[j], 32, ln);
    a[j] = fq < 2 ? a[j] * ca[j] - pa * sa[j] : pa * sa[j] + a[j] * ca[j];
    b[j] = fq < 2 ? b[j] * cb4[j] - pb * sb[j] : pb * sb[j] + b[j] * cb4[j];
  }
}
__device__ __forceinline__ void rope8p_mla(f32x4& a, f32x4& b, int fq, int ln, const float* tabr, const float* tabc) {
  const float* tab = fq < 2 ? tabr : tabc;
  const f32x4 ca = *(const f32x4*)(tab), cb4 = *(const f32x4*)(tab + 4), sa = *(const f32x4*)(tab + 8), sb = *(const f32x4*)(tab + 12);
#pragma unroll
  for (int j = 0; j < 4; ++j) {
    const float pa = shx(a[j], 16, ln), pb = shx(b[j], 16, ln);
    a[j] = (fq & 1) == 0 ? a[j] * ca[j] - pa * sa[j] : pa * sa[j] + a[j] * ca[j];
    b[j] = (fq & 1) == 0 ? b[j] * cb4[j] - pb * sb[j] : pb * sb[j] + b[j] * cb4[j];
  }
}

__device__ __forceinline__ float row_rstd(const float* rss, int m) {
  const f32x4 a = *(const f32x4*)(rss + (size_t)m * 16), b = *(const f32x4*)(rss + (size_t)m * 16 + 4);
  const f32x4 c = *(const f32x4*)(rss + (size_t)m * 16 + 8), d = *(const f32x4*)(rss + (size_t)m * 16 + 12);
  const f32x4 s = (a + b) + (c + d);
  return rsqrtf(((s[0] + s[1]) + (s[2] + s[3])) * (1.f / 1024.f) + 1e-6f);
}

typedef f32x4 acc_t[2][2][4][2];
template <int V> struct IC { static constexpr int value = V; };
extern __shared__ __attribute__((aligned(16))) unsigned char smem[];
struct EpiIn8 {
  static constexpr bool PERM = true, AFTER_DRAIN = false;
  P p0; int l; kargp_t kp;
  __device__ __forceinline__ void operator()(const acc_t& acc, const Unit& u, int wr, int wc, int fr_in, int fq_in) const {
    int fr = fr_in; asm volatile("" : "+v"(fr));
    int fq = fq_in; asm volatile("" : "+v"(fq));
    const int ln = fq * 16 + fr; (void)ln;
    P p = p0; asm volatile("" : "+s"(p.ws), "+s"(p.out));
    const bool lat = u.pm >= 32;
    const int rbase = u.pm * 256 + wr * 64 + fr;
#define ROWS_BEGIN _Pragma("unroll") for (int ai = 0; ai < 2; ++ai) _Pragma("unroll") for (int mm = 0; mm < 4; ++mm) { \
      int m = rbase + ai * 128 + mm * 16; asm volatile("" : "+v"(m)); int b, s; \
      if (!lat) { b = m >> 8; s = m & 255; } else { b = (m - NCTX) >> 10; s = (m - NCTX) & 1023; } \
      const float rsd = rsdv[ai][mm]; \
      f32x4 v0 = acc[ai][bj][mm][0] * rsd + sw0, v1 = acc[ai][bj][mm][1] * rsd + sw1; (void)b; (void)s;
#define ROWS_END }
    float rsdv[2][4];
    {
      const float* rss = p.rssA();
#pragma unroll
      for (int ai = 0; ai < 2; ++ai)
#pragma unroll
        for (int mm = 0; mm < 4; ++mm) rsdv[ai][mm] = row_rstd(rss, rbase + ai * 128 + mm * 16);
    }
    auto do_half = [&](auto BJ) {
      constexpr int bj = decltype(BJ)::value;
      const int nb = u.pn * 256 + bj * 128 + wc * 32;
      if (nb >= DIN) return;
      const float* swp = p.sWin() + ((size_t)(l * 9 + (lat ? 1 + ((u.pm - 32) >> 2) : 0))) * DINP + nb;
      const f32x4 sw0 = *(const f32x4*)(swp + 8 * fq), sw1 = *(const f32x4*)(swp + 8 * fq + 4);
      if (nb < 512) {
        ROWS_BEGIN
          if (lat) rope8p_win(v0, v1, fq, ln, (const float*)(smem + LDS_ROPEW) + ((nb & 32) ? (s & 63) : (s >> 6)) * 32);
          st8p_bf16(p.Qwin() + (size_t)m * 512 + nb, fq, v0, v1);
        ROWS_END
      } else if (nb < 640) {
        const int c = nb - 512;
        ROWS_BEGIN
          if (!lat) {
            st8p_f32(p.out + 16777216 + ((size_t)((b * 2 + l) * 256 + s)) * 128 + c, fq, v0, v1);
            st8p_bf16(p.Kwin_c() + (size_t)m * 128 + c, fq, v0, v1);
          } else {
            rope8p_win(v0, v1, fq, ln, (const float*)(smem + LDS_ROPEW) + ((nb & 32) ? (s & 63) : (s >> 6)) * 32);
            st8p_bf16(p.Kwin_l() + ((size_t)((l * 8 + b) * 1280 + s)) * 128 + c, fq, v0, v1);
          }
        ROWS_END
      } else if (nb < 768) {
        const int c = nb - 640, kv = c >> 6, d0 = c & 63;
        ROWS_BEGIN
          if (!lat) {
            st8p_f32(p.out + 18874368 + ((size_t)((b * 2 + l) * 256 + s)) * 128 + c, fq, v0, v1);
            st8p_tr(p.Vtwin_c() + ((size_t)((b * 2 + kv) * 64 + d0)) * 256 + s, 256, fq, v0, v1);
          } else {
            st8p_tr(p.Vtwin_l() + ((size_t)(((l * 8 + b) * 2 + kv) * 64 + d0)) * 1280 + s, 1280, fq, v0, v1);
          }
        ROWS_END
      } else if (nb < 1024) {
        ROWS_BEGIN
          st8p_bf16(p.Qret() + (size_t)m * 256 + (nb - 768), fq, v0, v1);
        ROWS_END
      } else if (nb < 1280) {
        ROWS_BEGIN
          st8p_bf16(p.Kret() + (size_t)m * 256 + (nb - 1024), fq, v0, v1);
        ROWS_END
      } else if (nb < 1536) {
        const int c = nb - 1280, hh = c >> 6, d0 = c & 63;
        ROWS_BEGIN
          if (!lat) st8p_tr(p.Vtret_c() + ((size_t)((b * 4 + hh) * 64 + d0)) * 256 + s, 256, fq, v0, v1);
          else st8p_tr(p.Vtret_l() + ((size_t)((b * 4 + hh) * 64 + d0)) * 1024 + s, 1024, fq, v0, v1);
        ROWS_END
      } else if (nb < 1792) {
        ROWS_BEGIN
          st8p_bf16(p.Gret() + (size_t)m * 256 + (nb - 1536), fq, v0, v1);
        ROWS_END
      } else if (nb < 2176) {
        const int c = nb - 1792;
        const bool rp = lat && (c % 96) == 64;
        ROWS_BEGIN
          if (rp) rope8p_mla(v0, v1, fq, ln, (const float*)(smem + LDS_ROPEM) + (s >> 6) * 16, (const float*)(smem + LDS_ROPEM) + (s & 63) * 16);
          st8p_bf16(p.Qmla() + (size_t)m * 384 + c, fq, v0, v1);
        ROWS_END
      } else if (nb < 2304) {
        const int c = nb - 2176;
        float* red = (float*)(smem + LDS_RED);
        kargp_t k2 = kp; asm volatile("" : "+s"(k2));
        const float* g = ((const __attribute__((address_space(4))) P*)k2)->mla_kv_norm + l * 128 + c;
        const f32x4 g0 = *(const f32x4*)(g + 8 * fq), g1 = *(const f32x4*)(g + 8 * fq + 4);
#pragma unroll
        for (int ai = 0; ai < 2; ++ai)
#pragma unroll
          for (int mm = 0; mm < 4; ++mm) {
            const float rsd0 = rsdv[ai][mm];
            const f32x4 a = acc[ai][bj][mm][0] * rsd0 + sw0, b4 = acc[ai][bj][mm][1] * rsd0 + sw1;
            float ss = a[0] * a[0] + a[1] * a[1] + a[2] * a[2] + a[3] * a[3] + b4[0] * b4[0] + b4[1] * b4[1] + b4[2] * b4[2] + b4[3] * b4[3];
            ss += shx(ss, 16, ln);
            ss += shx(ss, 32, ln);
            if (fq == 0) red[wc * 256 + ai * 128 + wr * 64 + mm * 16 + fr] = ss;
          }
        asm volatile("s_waitcnt lgkmcnt(0)" ::: "memory");
        __builtin_amdgcn_s_barrier();
        ROWS_BEGIN
          const int rt = ai * 128 + wr * 64 + mm * 16 + fr;
          const float rsv = rsqrtf((red[rt] + red[256 + rt] + red[512 + rt] + red[768 + rt]) * (1.f / 128.f) + 1e-6f);
          v0 = v0 * rsv * g0;
          v1 = v1 * rsv * g1;
          st8p_bf16(p.ckvn() + ((size_t)l * 18432 + m) * 128 + c, fq, v0, v1);
          if (!lat) st8p_f32(p.out + 20971520 + ((size_t)((b * 2 + l) * 256 + s)) * 128 + c, fq, v0, v1);
        ROWS_END
        asm volatile("s_waitcnt vmcnt(0) lgkmcnt(0)" ::: "memory");
        __builtin_amdgcn_s_barrier();
        if (wr == 0 && wc == 0 && ln == 0) {
          __builtin_amdgcn_fence(__ATOMIC_RELEASE, "agent");
          asm volatile("s_waitcnt vmcnt(0)" ::: "memory");
          __hip_atomic_fetch_add(p.ctl() + 64 * l, 1u, __ATOMIC_RELAXED, __HIP_MEMORY_SCOPE_AGENT);
        }
      } else {
        ROWS_BEGIN
          if (!lat) {
            st8p_f32(p.out + 23068672 + ((size_t)((b * 2 + l) * 256 + s)) * 32, fq, v0, v1);
#pragma unroll
            for (int hh = 0; hh < 4; ++hh) st8p_bf16(p.Kmla_c() + ((size_t)((b * 4 + hh) * 256 + s)) * 96 + 64, fq, v0, v1);
          } else {
            rope8p_mla(v0, v1, fq, ln, (const float*)(smem + LDS_ROPEM) + (s >> 6) * 16, (const float*)(smem + LDS_ROPEM) + (s & 63) * 16);
#pragma unroll
            for (int hh = 0; hh < 4; ++hh) st8p_bf16(p.Kmla_l() + ((size_t)(((l * 8 + b) * 4 + hh) * 1280 + s)) * 96 + 64, fq, v0, v1);
          }
        ROWS_END
      }
    };
    do_half(IC<0>{});
    do_half(IC<1>{});
#undef ROWS_BEGIN
#undef ROWS_END
  }
};

struct EpiOut8 {
  static constexpr bool PERM = true, AFTER_DRAIN = false;
  P p0; int l;
  __device__ __forceinline__ void operator()(const acc_t& acc, const Unit& u, int wr, int wc, int fr_in, int fq_in) const {
    int fr = fr_in; asm volatile("" : "+v"(fr));
    int fq = fq_in; asm volatile("" : "+v"(fq));
    const int ln = fq * 16 + fr; (void)ln;
    P p = p0; asm volatile("" : "+s"(p.ws), "+s"(p.out));
    const int rbase = u.pm * 256 + wr * 64 + fr;
    const int cb = u.pn * 256 + wc * 32 + 8 * fq;
    const float* md = p.mod() + ((size_t)(l * 9 + mod_row(u.pm * 256))) * 6144;
    const float* gate = md + 2 * 1024; const float* sc2 = md + 4 * 1024; const float* g2 = p.norm2 + l * DM;
#pragma unroll
    for (int ap = 0; ap < 4; ++ap) {
      constexpr int dummy = 0; (void)dummy;
      const int ai = ap >> 1, m2 = (ap & 1) * 2;
      int mb = rbase + ai * 128 + m2 * 16; asm volatile("" : "+v"(mb));
      f32x4 xv[2][2][2];
#pragma unroll
      for (int mq = 0; mq < 2; ++mq) {
        const int mm = m2 + mq;
        const int m = mb + mq * 16;
        if (l == 0) {
          const float* xr = m < NCTX ? p.x_prompt + (size_t)m * DM : p.x_sample + (size_t)(m - NCTX) * DM;
#pragma unroll
          for (int bj = 0; bj < 2; ++bj)
#pragma unroll
            for (int n = 0; n < 2; ++n) xv[mq][bj][n] = *(const f32x4*)(xr + cb + bj * 128 + n * 4);
        } else {
          const bf16_t* hr = p.hbuf() + (size_t)m * DM;
#pragma unroll
          for (int bj = 0; bj < 2; ++bj) {
            const uint4 h8 = *(const uint4*)(hr + cb + bj * 128);
#pragma unroll
            for (int n = 0; n < 2; ++n) {
              const int c = cb + bj * 128 + n * 4;
              uint2 hq; hq.x = n ? h8.z : h8.x; hq.y = n ? h8.w : h8.y;
              const f32x4 q1 = *(const f32x4*)(p.norm1 + DM + c) * (*(const f32x4*)(md + 1 * 1024 + c) + 1.f);
              f32x4 xm;
              xm[0] = __uint_as_float(hq.x << 16) * __builtin_amdgcn_rcpf(q1[0]); xm[1] = __uint_as_float(hq.x & 0xffff0000u) * __builtin_amdgcn_rcpf(q1[1]);
              xm[2] = __uint_as_float(hq.y << 16) * __builtin_amdgcn_rcpf(q1[2]); xm[3] = __uint_as_float(hq.y & 0xffff0000u) * __builtin_amdgcn_rcpf(q1[3]);
              xv[mq][bj][n] = xm;
            }
          }
        }
      }
#pragma unroll
      for (int mq = 0; mq < 2; ++mq) {
        const int mm = m2 + mq;
        const int m = mb + mq * 16;
        bf16_t* ho = p.hbuf() + (size_t)m * DM;
        float ss = 0.f;
#pragma unroll
        for (int bj = 0; bj < 2; ++bj) {
          unsigned pw[4];
#pragma unroll
          for (int n = 0; n < 2; ++n) {
            const int c = cb + bj * 128 + n * 4;
            const f32x4 xn = xv[mq][bj][n] + *(const f32x4*)(gate + c) * acc[ai][bj][mm][n];
            const f32x4 hv = xn * (*(const f32x4*)(g2 + c) * (*(const f32x4*)(sc2 + c) + 1.f));
            pw[2 * n] = pk2(hv[0], hv[1]); pw[2 * n + 1] = pk2(hv[2], hv[3]);
            ss += (xn[0] * xn[0] + xn[1] * xn[1]) + (xn[2] * xn[2] + xn[3] * xn[3]);
          }
          *(uint4*)(ho + cb + bj * 128) = make_uint4(pw[0], pw[1], pw[2], pw[3]);
        }
        ss += shx(ss, 16, ln);
        ss += shx(ss, 32, ln);
        if (fq == 0) p.rssB()[(size_t)m * 16 + u.pn * 4 + wc] = ss;
      }
      asm volatile("" ::: "memory");
    }
  }
};
struct EpiUp8 {
  static constexpr bool PERM = true, AFTER_DRAIN = false;
  P p0; int l;
  __device__ __forceinline__ void operator()(const acc_t& acc, const Unit& u, int wr, int wc, int fr_in, int fq_in) const {
    int fr = fr_in; asm volatile("" : "+v"(fr));
    int fq = fq_in; asm volatile("" : "+v"(fq));
    const int ln = fq * 16 + fr; (void)ln;
    P p = p0; asm volatile("" : "+s"(p.ws), "+s"(p.out));
    const int rbase = u.pm * 256 + wr * 64 + fr;
    const int cb = u.pn * 256 + wc * 32 + 8 * fq;
    const float* swp = p.sWup() + ((size_t)(l * 9 + mod_row(u.pm * 256))) * DFF;
    float rsdv[2][4];
#pragma unroll
    for (int ai = 0; ai < 2; ++ai)
#pragma unroll
      for (int mm = 0; mm < 4; ++mm) rsdv[ai][mm] = row_rstd(p.rssB(), rbase + ai * 128 + mm * 16);
    f32x4 swv[2][2];
#pragma unroll
    for (int bj = 0; bj < 2; ++bj)
#pragma unroll
      for (int n = 0; n < 2; ++n) swv[bj][n] = *(const f32x4*)(swp + cb + bj * 128 + n * 4);
#pragma unroll
    for (int ai = 0; ai < 2; ++ai)
#pragma unroll
      for (int mm = 0; mm < 4; ++mm) {
        int m = rbase + ai * 128 + mm * 16; asm volatile("" : "+v"(m));
        bf16_t* uo = p.ubuf() + (size_t)m * DFF;
        const float rsd = rsdv[ai][mm];
#pragma unroll
        for (int bj = 0; bj < 2; ++bj) {
          f32x4 t0 = acc[ai][bj][mm][0] * rsd + swv[bj][0], t1 = acc[ai][bj][mm][1] * rsd + swv[bj][1];
#pragma unroll
          for (int j = 0; j < 4; ++j) { const float a = fmaxf(t0[j], 0.f), b = fmaxf(t1[j], 0.f); t0[j] = a * a; t1[j] = b * b; }
          __builtin_nontemporal_store((u32x4v){pk2(t0[0], t0[1]), pk2(t0[2], t0[3]), pk2(t1[0], t1[1]), pk2(t1[2], t1[3])}, (u32x4v*)(uo + cb + bj * 128));
        }
      }
  }
};
struct EpiDown8 {
  static constexpr bool PERM = true, AFTER_DRAIN = false;
  P p0; int l;
  __device__ __forceinline__ void operator()(const acc_t& acc, const Unit& u, int wr, int wc, int fr_in, int fq_in) const {
    int fr = fr_in; asm volatile("" : "+v"(fr));
    int fq = fq_in; asm volatile("" : "+v"(fq));
    const int ln = fq * 16 + fr; (void)ln;
    P p = p0; asm volatile("" : "+s"(p.ws), "+s"(p.out));
    const int rbase = u.pm * 256 + wr * 64 + fr;
    const int cb = u.pn * 256 + wc * 32 + 8 * fq;
    const int r = mod_row(u.pm * 256);
    const float* md = p.mod() + ((size_t)(l * 9 + r)) * 6144;
    const float* gate = md + 5 * 1024; const float* sc2 = md + 4 * 1024; const float* g2 = p.norm2 + l * DM;
    const float* sc1 = p.mod() + ((size_t)(9 + r)) * 6144 + 1 * 1024;
    const float* g1 = p.norm1 + DM;
    f32x4 riv[2][2];
#pragma unroll
    for (int bj = 0; bj < 2; ++bj)
#pragma unroll
      for (int n = 0; n < 2; ++n) {
        const int c = cb + bj * 128 + n * 4;
        const f32x4 q2 = *(const f32x4*)(g2 + c) * (*(const f32x4*)(sc2 + c) + 1.f);
#pragma unroll
        for (int j = 0; j < 4; ++j) riv[bj][n][j] = __builtin_amdgcn_rcpf(q2[j]);
      }
#pragma unroll
    for (int ap = 0; ap < 4; ++ap) {
      const int ai = ap >> 1, m2 = (ap & 1) * 2;
      int mb = rbase + ai * 128 + m2 * 16; asm volatile("" : "+v"(mb));
      uint4 hvv[2][2];
#pragma unroll
      for (int mq = 0; mq < 2; ++mq) {
        const bf16_t* hr = p.hbuf() + (size_t)(mb + mq * 16) * DM;
#pragma unroll
        for (int bj = 0; bj < 2; ++bj) hvv[mq][bj] = *(const uint4*)(hr + cb + bj * 128);
      }
#pragma unroll
      for (int mq = 0; mq < 2; ++mq) {
        const int mm = m2 + mq;
        const int m = mb + mq * 16;
        float* xo = p.xw() + (size_t)m * DM;
        bf16_t* ho = p.hbuf() + (size_t)m * DM;
        float ss = 0.f;
#pragma unroll
        for (int bj = 0; bj < 2; ++bj) {
          unsigned pw[4] = {0u, 0u, 0u, 0u};
#pragma unroll
          for (int n = 0; n < 2; ++n) {
            const int c = cb + bj * 128 + n * 4;
            uint2 hq; hq.x = n ? hvv[mq][bj].z : hvv[mq][bj].x; hq.y = n ? hvv[mq][bj].w : hvv[mq][bj].y;
            f32x4 xm;
            xm[0] = __uint_as_float(hq.x << 16); xm[1] = __uint_as_float(hq.x & 0xffff0000u);
            xm[2] = __uint_as_float(hq.y << 16); xm[3] = __uint_as_float(hq.y & 0xffff0000u);
            const f32x4 xn = xm * riv[bj][n] + *(const f32x4*)(gate + c) * acc[ai][bj][mm][n];
            if (l != 0) *(f32x4*)(xo + c) = xn;
            if (l == 0) {
              const f32x4 hv = xn * (*(const f32x4*)(g1 + c) * (*(const f32x4*)(sc1 + c) + 1.f));
              pw[2 * n] = pk2(hv[0], hv[1]); pw[2 * n + 1] = pk2(hv[2], hv[3]);
              ss += (xn[0] * xn[0] + xn[1] * xn[1]) + (xn[2] * xn[2] + xn[3] * xn[3]);
            }
          }
          if (l == 0) *(uint4*)(ho + cb + bj * 128) = make_uint4(pw[0], pw[1], pw[2], pw[3]);
        }
        if (l == 0) {
          ss += shx(ss, 16, ln);
          ss += shx(ss, 32, ln);
          if (fq == 0) p.rssA()[(size_t)m * 16 + u.pn * 4 + wc] = ss;
        }
      }
      asm volatile("" ::: "memory");
    }
  }
};

struct EpiKvb {
  P p; int l;
  __device__ __forceinline__ void operator()(int m, int nb, int h, const f32x16& v) const {
    const int hh = nb >> 7, j0 = nb & 127;
    bf16_t* Kb; bf16_t* Vb; int S, key;
    if (m < NCTX) {
      const int b = m >> 8; key = m & 255; S = 256;
      Kb = p.Kmla_c() + ((size_t)((b * 4 + hh) * 256)) * 96;
      Vb = p.Vtmla_c() + ((size_t)((b * 4 + hh) * 64)) * 256;
    } else {
      int b;
      if (m < NTOK) { b = (m - NCTX) >> 10; key = (m - NCTX) & 1023; }
      else { b = (m - NTOK) >> 8; key = 1024 + ((m - NTOK) & 255); }
      S = 1280;
      Kb = p.Kmla_l() + ((size_t)(((l * 8 + b) * 4 + hh) * 1280)) * 96;
      Vb = p.Vtmla_l() + ((size_t)(((l * 8 + b) * 4 + hh) * 64)) * 1280;
    }
    if (j0 < 64) st_rm_bf16(Kb + (size_t)key * 96 + j0, h, v);
    else st_tr_bf16(Vb + (size_t)(j0 - 64) * S + key, S, h, v);
  }
};

template <class Epi>
__device__ __forceinline__ void gemm_small(const bf16_t* __restrict__ A, int lda, const bf16_t* __restrict__ W, int ldw,
                                           int M, int N, int K, unsigned char* smem, const Epi& epi, const int wv, unsigned* ready, unsigned* ticket) {
  constexpr int TA = 256 * 72, TW = 128 * 72;
  bf16_t* sb = (bf16_t*)smem;
  const int tid = my_tid(wv), bid = my_bid(), lane = tid & 63, wave = tid >> 6;
  const int wm = wave >> 1, wn = wave & 1, r = lane & 31, h = lane >> 5;
  const int MT = M >> 8, NT = N >> 7, ntiles = MT * NT, nk = K >> 6;
  const int lc = tid & 7, lr = tid >> 3;
  (void)bid;
  if (tid == 0) {
    unsigned polls = 0;
    while (__hip_atomic_load(ready, __ATOMIC_RELAXED, __HIP_MEMORY_SCOPE_AGENT) < 64u && ++polls < (1u << 22)) __builtin_amdgcn_s_sleep(8);
    __builtin_amdgcn_fence(__ATOMIC_ACQUIRE, "agent");
    asm volatile("s_waitcnt vmcnt(0)" ::: "memory");
  }
  __syncthreads();
  volatile int* tks = (volatile int*)(smem + LDS_RED + 2048);
  for (;;) {
    __syncthreads();
    if (tid == 0) *tks = (int)__hip_atomic_fetch_add(ticket, 1u, __ATOMIC_RELAXED, __HIP_MEMORY_SCOPE_AGENT);
    __syncthreads();
    const int tile = *tks;
    if (tile >= ntiles) break;
    const int m0 = (tile % MT) << 8, n0 = (tile / MT) << 7;
    f32x16 acc[2][2];
#pragma unroll
    for (int a = 0; a < 2; ++a)
#pragma unroll
      for (int b = 0; b < 2; ++b)
#pragma unroll
        for (int i = 0; i < 16; ++i) acc[a][b][i] = 0.f;
    uint4 ra[4], rw[2];
    const bf16_t* Ap = A + (size_t)(m0 + lr) * lda + lc * 8;
    const bf16_t* Wp = W + (size_t)(n0 + lr) * ldw + lc * 8;
    auto gload = [&](int kt) {
#pragma unroll
      for (int i = 0; i < 4; ++i) ra[i] = *(const uint4*)(Ap + (size_t)(64 * i) * lda + kt * 64);
#pragma unroll
      for (int i = 0; i < 2; ++i) rw[i] = *(const uint4*)(Wp + (size_t)(64 * i) * ldw + kt * 64);
    };
    auto swrite = [&](int bsel) {
      bf16_t* sA = sb + bsel * (TA + TW); bf16_t* sW = sA + TA;
#pragma unroll
      for (int i = 0; i < 4; ++i) *(uint4*)(sA + (lr + 64 * i) * 72 + lc * 8) = ra[i];
#pragma unroll
      for (int i = 0; i < 2; ++i) *(uint4*)(sW + (lr + 64 * i) * 72 + lc * 8) = rw[i];
    };
    __syncthreads();
    gload(0); swrite(0);
    __syncthreads();
    for (int kt = 0; kt < nk; ++kt) {
      if (kt + 1 < nk) gload(kt + 1);
      const bf16_t* sA = sb + (kt & 1) * (TA + TW); const bf16_t* sW = sA + TA;
#pragma unroll
      for (int ks = 0; ks < 4; ++ks) {
        bf16x8 wf[2], af[2];
#pragma unroll
        for (int i = 0; i < 2; ++i) {
          wf[i] = *(const bf16x8*)(sW + (wn * 64 + i * 32 + r) * 72 + ks * 16 + h * 8);
          af[i] = *(const bf16x8*)(sA + (wm * 64 + i * 32 + r) * 72 + ks * 16 + h * 8);
        }
#pragma unroll
        for (int a = 0; a < 2; ++a)
#pragma unroll
          for (int b = 0; b < 2; ++b) acc[a][b] = __builtin_amdgcn_mfma_f32_32x32x16_bf16(wf[a], af[b], acc[a][b], 0, 0, 0);
      }
      if (kt + 1 < nk) swrite((kt + 1) & 1);
      __syncthreads();
    }
#pragma unroll
    for (int a = 0; a < 2; ++a)
#pragma unroll
      for (int b = 0; b < 2; ++b) epi(m0 + wm * 64 + b * 32 + r, n0 + wn * 64 + a * 32, h, acc[a][b]);
  }
}

struct AttnItem {
  const bf16_t* Q; int qs;
  const bf16_t* K; int ks;
  const bf16_t* Vt; int vs;
  int t0, t1, t2, t3;
  int qpos0, T;
  float scale, sink_l2; int has_sink;
  float lgf, lgb;
  const bf16_t *S0f, *S0b;
  const bf16_t* G; const float* gn;
  bf16_t* out;
  float* sout;
};

template <int DQK, int MODE>
__device__ __forceinline__ void attn_item(const AttnItem& it, unsigned char* smem, const int wv) {
  constexpr int KSTR = DQK + 8, NKS = DQK / 16, VSTR = 68, KCH = DQK / 8;
  bf16_t* Ks = (bf16_t*)smem;
  bf16_t* Vs = Ks + 64 * KSTR;
  const int tid = my_tid(wv), lane = tid & 63, wave = tid >> 6, r = lane & 31, h = lane >> 5;
  const int qrow = wave * 32 + r;
  bf16x8 qf[NKS];
  if constexpr (MODE == 3) {
    const int dq = (wave & 1) * 32 + r;
#pragma unroll
    for (int ks = 0; ks < NKS; ++ks) {
      const int e = dq - (ks * 16 + h * 8);
      uint4 v;
      v.x = e == 0 ? 0x3F80u : (e == 1 ? 0x3F800000u : 0u);
      v.y = e == 2 ? 0x3F80u : (e == 3 ? 0x3F800000u : 0u);
      v.z = e == 4 ? 0x3F80u : (e == 5 ? 0x3F800000u : 0u);
      v.w = e == 6 ? 0x3F80u : (e == 7 ? 0x3F800000u : 0u);
      qf[ks] = __builtin_bit_cast(bf16x8, v);
    }
  } else {
#pragma unroll
    for (int ks = 0; ks < NKS; ++ks) qf[ks] = *(const bf16x8*)(it.Q + (size_t)qrow * it.qs + ks * 16 + h * 8);
  }
  f32x16 o0, o1;
#pragma unroll
  for (int i = 0; i < 16; ++i) { o0[i] = 0.f; o1[i] = 0.f; }
  float mrun = it.has_sink ? it.sink_l2 : -1e30f, lrun = 0.f;
  const int qp = it.qpos0 + qrow;
  const int n1 = it.t1 - it.t0, ntl = n1 + (it.t3 - it.t2);
  constexpr int BUFE = 64 * KSTR + 64 * VSTR;
  const int krow0 = tid / KCH, kch0 = tid % KCH, krow1 = (tid + NTHR) / KCH, kch1 = (tid + NTHR) % KCH;
  const bool k2 = (KCH == 12) && (tid + NTHR < 64 * KCH);
  const int vrow = tid >> 3, vch = tid & 7;
  uint4 rk0, rk1, rv;
  auto tile_of = [&](int ti) { return ti < n1 ? it.t0 + ti : it.t2 + (ti - n1); };
  auto gload = [&](int t) {
    const bool stt = (MODE == 2) && (t >= 16);
    if (!stt) {
      const int key0 = t * 64;
      rk0 = *(const uint4*)(it.K + (size_t)(key0 + krow0) * it.ks + kch0 * 8);
      if (k2) rk1 = *(const uint4*)(it.K + (size_t)(key0 + krow1) * it.ks + kch1 * 8);
      rv = *(const uint4*)(it.Vt + (size_t)vrow * it.vs + key0 + vch * 8);
    } else {
      const bf16_t* S = (t == 16) ? it.S0f : it.S0b;
      const int e = krow0 - kch0 * 8;
      rk0.x = e == 0 ? 0x3F80u : (e == 1 ? 0x3F800000u : 0u);
      rk0.y = e == 2 ? 0x3F80u : (e == 3 ? 0x3F800000u : 0u);
      rk0.z = e == 4 ? 0x3F80u : (e == 5 ? 0x3F800000u : 0u);
      rk0.w = e == 6 ? 0x3F80u : (e == 7 ? 0x3F800000u : 0u);
      rv = *(const uint4*)(S + (size_t)vrow * 64 + vch * 8);
    }
  };
  auto swrite = [&](int bsel) {
    bf16_t* Kb = Ks + bsel * BUFE; bf16_t* Vb = Kb + 64 * KSTR;
    *(uint4*)(Kb + krow0 * KSTR + kch0 * 8) = rk0;
    if (k2) *(uint4*)(Kb + krow1 * KSTR + kch1 * 8) = rk1;
    uint2* d = (uint2*)(Vb + vrow * VSTR + vch * 8);
    d[0] = make_uint2(rv.x, rv.y); d[1] = make_uint2(rv.z, rv.w);
  };
  __syncthreads();
  gload(tile_of(0)); swrite(0);
  __syncthreads();
  for (int ti = 0; ti < ntl; ++ti) {
    const int t = tile_of(ti);
    const bool st_tile = (MODE == 2) && (t >= 16);
    const int key0 = t * 64;
    const bool more = ti + 1 < ntl;
    if (more) gload(tile_of(ti + 1));
    const bf16_t* Kc = Ks + (ti & 1) * BUFE; const bf16_t* Vc = Kc + 64 * KSTR;
    bool skip = (MODE == 3) && (wave >= 4);
    if (MODE == 1 && t < 16) {
      const int qlo = it.qpos0 + wave * 32;
      skip = (key0 > qlo + 31 + 128 || key0 + 63 < qlo - 128);
    }
    if (!skip) {
    f32x16 s0, s1;
#pragma unroll
    for (int i = 0; i < 16; ++i) { s0[i] = 0.f; s1[i] = 0.f; }
#pragma unroll
    for (int ks = 0; ks < NKS; ++ks) {
      const bf16x8 k0 = *(const bf16x8*)(Kc + r * KSTR + ks * 16 + h * 8);
      const bf16x8 k1 = *(const bf16x8*)(Kc + (32 + r) * KSTR + ks * 16 + h * 8);
      s0 = __builtin_amdgcn_mfma_f32_32x32x16_bf16(k0, qf[ks], s0, 0, 0, 0);
      s1 = __builtin_amdgcn_mfma_f32_32x32x16_bf16(k1, qf[ks], s1, 0, 0, 0);
    }
    if constexpr (MODE == 3) {
      if (wave < 2) {
        const float base = (float)(it.T - 1 - key0 - 4 * h) * it.lgf - 3.f;
#pragma unroll
        for (int i = 0; i < 16; ++i) {
          s0[i] *= fexp2(fmaf(-(float)((i & 3) + 8 * (i >> 2)), it.lgf, base));
          s1[i] *= fexp2(fmaf(-(float)(32 + (i & 3) + 8 * (i >> 2)), it.lgf, base));
        }
      } else {
        const float base = (float)(key0 + 4 * h) * it.lgb - 3.f;
#pragma unroll
        for (int i = 0; i < 16; ++i) {
          s0[i] *= fexp2(fmaf((float)((i & 3) + 8 * (i >> 2)), it.lgb, base));
          s1[i] *= fexp2(fmaf((float)(32 + (i & 3) + 8 * (i >> 2)), it.lgb, base));
        }
      }
    } else if constexpr (MODE == 2) {
      if (!st_tile) {
        const int qlo = it.qpos0 + wave * 32;
        if (key0 + 63 < qlo) {
          const float base = (float)(qp - key0 - 4 * h) * it.lgf - 3.f;
#pragma unroll
          for (int i = 0; i < 16; ++i) {
            s0[i] *= fexp2(fmaf(-(float)((i & 3) + 8 * (i >> 2)), it.lgf, base));
            s1[i] *= fexp2(fmaf(-(float)(32 + (i & 3) + 8 * (i >> 2)), it.lgf, base));
          }
        } else if (key0 > qlo + 31) {
          const float base = (float)(key0 + 4 * h - qp) * it.lgb - 3.f;
#pragma unroll
          for (int i = 0; i < 16; ++i) {
            s0[i] *= fexp2(fmaf((float)((i & 3) + 8 * (i >> 2)), it.lgb, base));
            s1[i] *= fexp2(fmaf((float)(32 + (i & 3) + 8 * (i >> 2)), it.lgb, base));
          }
        } else {
#pragma unroll
        for (int i = 0; i < 16; ++i) {
          const int key = key0 + (i & 3) + 8 * (i >> 2) + 4 * h;
          const int e0 = qp - key, e1 = e0 - 32;
          float d0 = fexp2((float)(e0 < 0 ? -e0 : e0) * (e0 > 0 ? it.lgf : it.lgb));
          float d1 = fexp2((float)(e1 < 0 ? -e1 : e1) * (e1 > 0 ? it.lgf : it.lgb));
          d0 = e0 == 0 ? 2.f : d0;
          d1 = e1 == 0 ? 2.f : d1;
          s0[i] *= it.scale * d0;
          s1[i] *= it.scale * d1;
        }
        }
      } else {
        const float dec = (t == 16) ? fexp2((float)(qp + 1) * it.lgf) : fexp2((float)(it.T - qp) * it.lgb);
#pragma unroll
        for (int i = 0; i < 16; ++i) { s0[i] *= dec; s1[i] *= dec; }
      }
    } else {
      float mx = -INFINITY;
      const int qlo1 = it.qpos0 + wave * 32;
      const bool need_mask = (MODE == 1) && (t < 16) && !(key0 >= qlo1 + 31 - 128 && key0 + 63 <= qlo1 + 128);
#pragma unroll
      for (int i = 0; i < 16; ++i) {
        float a = s0[i] * it.scale, b = s1[i] * it.scale;
        if (MODE == 1 && need_mask) {
          const int key = key0 + (i & 3) + 8 * (i >> 2) + 4 * h;
          const int e0 = key - qp, e1 = e0 + 32;
          if (e0 > 128 || e0 < -128) a = -INFINITY;
          if (e1 > 128 || e1 < -128) b = -INFINITY;
        }
        s0[i] = a; s1[i] = b;
        mx = fmaxf(mx, fmaxf(a, b));
      }
      mx = fmaxf(mx, shx(mx, 32, lane));
      const float mnew = fmaxf(mrun, mx);
      const float alpha = fexp2(mrun - mnew);
      float sum = 0.f;
#pragma unroll
      for (int i = 0; i < 16; ++i) {
        s0[i] = fexp2(s0[i] - mnew);
        s1[i] = fexp2(s1[i] - mnew);
        sum += s0[i] + s1[i];
      }
      lrun = lrun * alpha + sum;
      mrun = mnew;
#pragma unroll
      for (int i = 0; i < 16; ++i) { o0[i] *= alpha; o1[i] *= alpha; }
    }
#pragma unroll
    for (int kt = 0; kt < 2; ++kt) {
#pragma unroll
      for (int sbk = 0; sbk < 2; ++sbk) {
        uint4 pw;
        if (kt == 0) {
          pw.x = pk2(s0[8 * sbk + 0], s0[8 * sbk + 1]); pw.y = pk2(s0[8 * sbk + 2], s0[8 * sbk + 3]);
          pw.z = pk2(s0[8 * sbk + 4], s0[8 * sbk + 5]); pw.w = pk2(s0[8 * sbk + 6], s0[8 * sbk + 7]);
        } else {
          pw.x = pk2(s1[8 * sbk + 0], s1[8 * sbk + 1]); pw.y = pk2(s1[8 * sbk + 2], s1[8 * sbk + 3]);
          pw.z = pk2(s1[8 * sbk + 4], s1[8 * sbk + 5]); pw.w = pk2(s1[8 * sbk + 6], s1[8 * sbk + 7]);
        }
        const bf16x8 pf = __builtin_bit_cast(bf16x8, pw);
        const int koff = kt * 32 + sbk * 16 + 4 * h;
        const uint2 a0 = *(const uint2*)(Vc + r * VSTR + koff), a1 = *(const uint2*)(Vc + r * VSTR + koff + 8);
        const uint2 b0 = *(const uint2*)(Vc + (32 + r) * VSTR + koff), b1 = *(const uint2*)(Vc + (32 + r) * VSTR + koff + 8);
        const bf16x8 v0 = __builtin_bit_cast(bf16x8, make_uint4(a0.x, a0.y, a1.x, a1.y));
        const bf16x8 v1 = __builtin_bit_cast(bf16x8, make_uint4(b0.x, b0.y, b1.x, b1.y));
        o0 = __builtin_amdgcn_mfma_f32_32x32x16_bf16(v0, pf, o0, 0, 0, 0);
        o1 = __builtin_amdgcn_mfma_f32_32x32x16_bf16(v1, pf, o1, 0, 0, 0);
      }
    }
    }
    if (more) swrite((ti + 1) & 1);
    __syncthreads();
  }
  if constexpr (MODE == 3) {
    if (wave < 4) {
      float* rowp = it.sout + (size_t)(wave >> 1) * 16384 + (size_t)((wave & 1) * 32 + r) * 64;
#pragma unroll
      for (int g = 0; g < 4; ++g) {
        *(float4*)(rowp + 8 * g + 4 * h) = make_float4(o0[4 * g], o0[4 * g + 1], o0[4 * g + 2], o0[4 * g + 3]);
        *(float4*)(rowp + 32 + 8 * g + 4 * h) = make_float4(o1[4 * g], o1[4 * g + 1], o1[4 * g + 2], o1[4 * g + 3]);
      }
    }
    return;
  }
  bf16_t* orow = it.out + (size_t)qrow * DM;
  if constexpr (MODE == 2) {
    float sm = 0.f;
#pragma unroll
    for (int i = 0; i < 16; ++i) sm += o0[i] + o1[i];
    sm += shx(sm, 32, lane);
    const float mu = sm * (1.f / 64.f);
    float vr = 0.f;
#pragma unroll
    for (int i = 0; i < 16; ++i) { o0[i] -= mu; o1[i] -= mu; vr += o0[i] * o0[i] + o1[i] * o1[i]; }
    vr += shx(vr, 32, lane);
    const float rstd = rsqrtf(vr * (1.f / 64.f) + 1e-6f);
    const bf16_t* grow = it.G + (size_t)qrow * 256;
#pragma unroll
    for (int g = 0; g < 4; ++g) {
      const int d = 8 * g + 4 * h;
      const uint2 ga = *(const uint2*)(grow + d), gb = *(const uint2*)(grow + 32 + d);
      const float gav[4] = {__uint_as_float(ga.x << 16), __uint_as_float(ga.x & 0xffff0000u), __uint_as_float(ga.y << 16), __uint_as_float(ga.y & 0xffff0000u)};
      const float gbv[4] = {__uint_as_float(gb.x << 16), __uint_as_float(gb.x & 0xffff0000u), __uint_as_float(gb.y << 16), __uint_as_float(gb.y & 0xffff0000u)};
#pragma unroll
      for (int j = 0; j < 4; ++j) {
        const float x0 = gav[j], x1 = gbv[j];
        o0[4 * g + j] = o0[4 * g + j] * rstd * it.gn[d + j] * (x0 / (1.f + __expf(-x0)));
        o1[4 * g + j] = o1[4 * g + j] * rstd * it.gn[32 + d + j] * (x1 / (1.f + __expf(-x1)));
      }
    }
  } else {
    float lt = lrun + shx(lrun, 32, lane);
    if (it.has_sink) lt += fexp2(it.sink_l2 - mrun);
    const float inv = 1.f / lt;
#pragma unroll
    for (int i = 0; i < 16; ++i) { o0[i] *= inv; o1[i] *= inv; }
  }
  st_rm_bf16(orow, h, o0);
  st_rm_bf16(orow + 32, h, o1);
}

__device__ __forceinline__ float log2_sigmoid(float x) { return -log1pf(expf(-x)) * LOG2E; }

__device__ __forceinline__ void state_item(const P& p, int l, int idx, unsigned char* smem, const int wv) {
  const int b = idx >> 3, hh = (idx >> 1) & 3, dir = idx & 1;
  float* Ksm = (float*)smem;
  float* Vsm = Ksm + 4096;
  const int tid = my_tid(wv);
  const float lg = log2_sigmoid(p.ret_decay[(l * 2 + dir) * 4 + hh]);
  float acc[8];
#pragma unroll
  for (int i = 0; i < 8; ++i) acc[i] = 0.f;
  const int d = tid >> 3, e0 = (tid & 7) * 8;
  for (int c = 0; c < 4; ++c) {
    __syncthreads();
    for (int i = tid; i < 4096; i += NTHR) {
      const int j = i >> 6, dd = i & 63, tok = c * 64 + j;
      const float dec = dir == 0 ? fexp2((float)(255 - tok) * lg) : fexp2((float)tok * lg);
      Ksm[j * 64 + dd] = bf2f(p.Kret()[(size_t)(b * 256 + tok) * 256 + hh * 64 + dd]) * 0.125f * dec;
      const int e = i >> 6, jj = i & 63;
      Vsm[e * 65 + jj] = bf2f(p.Vtret_c()[((size_t)((b * 4 + hh) * 64 + e)) * 256 + c * 64 + jj]);
    }
    __syncthreads();
    for (int j = 0; j < 64; ++j) {
      const float kd = Ksm[j * 64 + d];
#pragma unroll
      for (int i = 0; i < 8; ++i) acc[i] += kd * Vsm[(e0 + i) * 65 + j];
    }
  }
  float* op = p.out + 23592960 + ((size_t)((((b * 2 + l) * 2 + dir) * 4 + hh) * 64 + d)) * 64 + e0;
  *(float4*)(op) = make_float4(acc[0], acc[1], acc[2], acc[3]);
  *(float4*)(op + 4) = make_float4(acc[4], acc[5], acc[6], acc[7]);
}

__device__ __forceinline__ void attn_phase(const P& p, int l, unsigned char* smem, const int wv) {
  constexpr int NA = 128, NB = 128, NC = 256, ND = 256, NE = 128, NF = 128, NG = 128;
  constexpr int TOT = NA + NB + NC + ND + NE + NF + NG;
  unsigned* ticket = p.ctl() + 32 + 64 * l;
  volatile int* tks = (volatile int*)(smem + LDS_RED + 2048);
  const int tid0 = my_tid(wv);
  for (;;) {
    __syncthreads();
    if (tid0 == 0) *tks = (int)__hip_atomic_fetch_add(ticket, 1u, __ATOMIC_RELAXED, __HIP_MEMORY_SCOPE_AGENT);
    __syncthreads();
    const int item = *tks;
    if (item >= TOT) break;
    int idx = item;
    AttnItem it;
    it.t2 = 0; it.t3 = 0; it.qpos0 = 0; it.T = 0; it.sink_l2 = 0.f; it.has_sink = 0; it.lgf = 0.f; it.lgb = 0.f;
    it.S0f = nullptr; it.S0b = nullptr; it.G = nullptr; it.gn = nullptr; it.sout = nullptr;
    if (idx < NA) {
      const int b = idx >> 4, hh = (idx >> 2) & 3, qb = idx & 3, row0 = NCTX + b * 1024 + qb * 256;
      it.Q = p.Qmla() + (size_t)row0 * 384 + hh * 96; it.qs = 384;
      it.K = p.Kmla_l() + ((size_t)(((l * 8 + b) * 4 + hh) * 1280)) * 96; it.ks = 96;
      it.Vt = p.Vtmla_l() + ((size_t)(((l * 8 + b) * 4 + hh) * 64)) * 1280; it.vs = 1280;
      it.t0 = 0; it.t1 = 20;
      it.scale = 0.10206207261596575f * LOG2E;
      it.out = p.mix() + (size_t)row0 * DM + 768 + hh * 64;
      attn_item<96, 0>(it, smem, wv);
      continue;
    }
    idx -= NA;
    if (idx < NB) {
      const int b = idx >> 4, hh = (idx >> 2) & 3, qb = idx & 3, row0 = NCTX + b * 1024 + qb * 256;
      it.Q = p.Qret() + (size_t)row0 * 256 + hh * 64; it.qs = 256;
      it.K = p.Kret() + (size_t)(NCTX + b * 1024) * 256 + hh * 64; it.ks = 256;
      it.Vt = p.Vtret_l() + ((size_t)((b * 4 + hh) * 64)) * 1024; it.vs = 1024;
      it.t0 = 0; it.t1 = 16; it.t2 = 16; it.t3 = 18;
      it.qpos0 = qb * 256; it.T = 1024; it.scale = 0.125f;
      it.lgf = log2_sigmoid(p.ret_decay[(l * 2 + 0) * 4 + hh]);
      it.lgb = log2_sigmoid(p.ret_decay[(l * 2 + 1) * 4 + hh]);
      it.S0f = p.S0t() + ((size_t)((((l * 8 + b) * 2 + 0) * 4 + hh))) * 4096;
      it.S0b = p.S0t() + ((size_t)((((l * 8 + b) * 2 + 1) * 4 + hh))) * 4096;
      it.G = p.Gret() + (size_t)row0 * 256 + hh * 64; it.gn = p.ret_gn + l * 256 + hh * 64;
      it.out = p.mix() + (size_t)row0 * DM + 512 + hh * 64;
      attn_item<64, 2>(it, smem, wv);
      continue;
    }
    idx -= NB;
    if (idx < NC) {
      const int b = idx >> 5, head = (idx >> 2) & 7, qb = idx & 3, kv = head >> 2, row0 = NCTX + b * 1024 + qb * 256;
      it.Q = p.Qwin() + (size_t)row0 * 512 + head * 64; it.qs = 512;
      it.K = p.Kwin_l() + ((size_t)((l * 8 + b) * 1280)) * 128 + kv * 64; it.ks = 128;
      it.Vt = p.Vtwin_l() + ((size_t)(((l * 8 + b) * 2 + kv) * 64)) * 1280; it.vs = 1280;
      it.t0 = max(0, qb * 4 - 2); it.t1 = min(16, qb * 4 + 6); it.t2 = 16; it.t3 = 20;
      it.qpos0 = qb * 256;
      it.scale = 0.125f * LOG2E; it.sink_l2 = p.win_sink[l * 8 + head] * LOG2E; it.has_sink = 1;
      it.out = p.mix() + (size_t)row0 * DM + head * 64;
      attn_item<64, 1>(it, smem, wv);
      continue;
    }
    idx -= NC;
    if (idx < ND) {
      const int b = idx >> 3, head = idx & 7, kv = head >> 2, row0 = b * 256;
      it.Q = p.Qwin() + (size_t)row0 * 512 + head * 64; it.qs = 512;
      it.K = p.Kwin_c() + (size_t)(b * 256) * 128 + kv * 64; it.ks = 128;
      it.Vt = p.Vtwin_c() + ((size_t)((b * 2 + kv) * 64)) * 256; it.vs = 256;
      it.t0 = 0; it.t1 = 4;
      it.scale = 0.125f * LOG2E; it.sink_l2 = p.win_sink[l * 8 + head] * LOG2E; it.has_sink = 1;
      it.out = p.mix() + (size_t)row0 * DM + head * 64;
      attn_item<64, 0>(it, smem, wv);
      continue;
    }
    idx -= ND;
    if (idx < NE) {
      const int b = idx >> 2, hh = idx & 3, row0 = b * 256;
      it.Q = p.Qmla() + (size_t)row0 * 384 + hh * 96; it.qs = 384;
      it.K = p.Kmla_c() + ((size_t)((b * 4 + hh) * 256)) * 96; it.ks = 96;
      it.Vt = p.Vtmla_c() + ((size_t)((b * 4 + hh) * 64)) * 256; it.vs = 256;
      it.t0 = 0; it.t1 = 4;
      it.scale = 0.10206207261596575f * LOG2E;
      it.out = p.mix() + (size_t)row0 * DM + 768 + hh * 64;
      attn_item<96, 0>(it, smem, wv);
      continue;
    }
    idx -= NE;
    if (idx < NF) {
      const int b = idx >> 2, hh = idx & 3, row0 = b * 256;
      it.Q = p.Qret() + (size_t)row0 * 256 + hh * 64; it.qs = 256;
      it.K = p.Kret() + (size_t)(b * 256) * 256 + hh * 64; it.ks = 256;
      it.Vt = p.Vtret_c() + ((size_t)((b * 4 + hh) * 64)) * 256; it.vs = 256;
      it.t0 = 0; it.t1 = 4;
      it.qpos0 = 0; it.T = 256; it.scale = 0.125f;
      it.lgf = log2_sigmoid(p.ret_decay[(l * 2 + 0) * 4 + hh]);
      it.lgb = log2_sigmoid(p.ret_decay[(l * 2 + 1) * 4 + hh]);
      it.G = p.Gret() + (size_t)row0 * 256 + hh * 64; it.gn = p.ret_gn + l * 256 + hh * 64;
      it.out = p.mix() + (size_t)row0 * DM + 512 + hh * 64;
      attn_item<64, 2>(it, smem, wv);
      continue;
    }
    idx -= NF;
    {
      const int b = idx >> 2, hh = idx & 3;
      it.Q = nullptr; it.qs = 0;
      it.K = p.Kret() + (size_t)(b * 256) * 256 + hh * 64; it.ks = 256;
      it.Vt = p.Vtret_c() + ((size_t)((b * 4 + hh) * 64)) * 256; it.vs = 256;
      it.t0 = 0; it.t1 = 4;
      it.T = 256; it.scale = 0.125f;
      it.lgf = log2_sigmoid(p.ret_decay[(l * 2 + 0) * 4 + hh]);
      it.lgb = log2_sigmoid(p.ret_decay[(l * 2 + 1) * 4 + hh]);
      it.out = nullptr;
      it.sout = p.out + 23592960 + ((size_t)((b * 2 + l) * 2 * 4 + hh)) * 4096;
      attn_item<64, 3>(it, smem, wv);
    }
  }
}

__device__ __forceinline__ void gemv9_item(const float* sc, float* red, const float* __restrict__ W, int N, int n0, float* outp, int ldo,
                                           const float* bias, const int tid) {
  const int j4 = (tid & 7) * 4, kq = tid >> 3;
  f32x4 acc[9];
#pragma unroll
  for (int r = 0; r < 9; ++r) acc[r] = (f32x4){0.f, 0.f, 0.f, 0.f};
  const float* w = W + (size_t)(kq * 16) * N + n0 + j4;
  const float* s = sc + kq * 16;
#pragma unroll
  for (int kk = 0; kk < 16; ++kk) {
    const f32x4 wv = __builtin_nontemporal_load((const f32x4*)(w + (size_t)kk * N));
#pragma unroll
    for (int r = 0; r < 9; ++r) acc[r] += wv * s[r * 1024 + kk];
  }
#pragma unroll
  for (int r = 0; r < 9; ++r) *(f32x4*)(red + (kq * 9 + r) * 32 + j4) = acc[r];
  __syncthreads();
  for (int oo = tid; oo < 288; oo += NTHR) {
    const int r = oo >> 5, jj = oo & 31;
    float sum = 0.f;
#pragma unroll 16
    for (int q = 0; q < 64; ++q) sum += red[(q * 9 + r) * 32 + jj];
    outp[(size_t)r * ldo + n0 + jj] = sum + (bias ? bias[n0 + jj] : 0.f);
  }
  __syncthreads();
}

__device__ __forceinline__ void norm0_phase(const P& p, unsigned char* smem, const int wv) {
  const int tid = my_tid(wv), lane = tid & 63, gw = my_bid() * NWV + (tid >> 6), ngw = gridDim.x * NWV;
  const float* gain = p.norm1;
  for (int m0 = gw; m0 < NTOK; m0 += 2 * ngw) {
    float4 v[2][4];
    float ss[2] = {0.f, 0.f};
#pragma unroll
    for (int q = 0; q < 2; ++q) {
      const int m = m0 + q * ngw;
      const float* xr = m < NCTX ? p.x_prompt + (size_t)m * DM : p.x_sample + (size_t)(m - NCTX) * DM;
#pragma unroll
      for (int t = 0; t < 2; ++t) {
        { const f32x4 a = __builtin_nontemporal_load((const f32x4*)(xr + t * 512 + lane * 8)), b = __builtin_nontemporal_load((const f32x4*)(xr + t * 512 + lane * 8 + 4));
          v[q][2 * t] = make_float4(a[0], a[1], a[2], a[3]); v[q][2 * t + 1] = make_float4(b[0], b[1], b[2], b[3]); }
      }
    }
#pragma unroll
    for (int q = 0; q < 2; ++q) {
#pragma unroll
      for (int j = 0; j < 4; ++j) ss[q] += v[q][j].x * v[q][j].x + v[q][j].y * v[q][j].y + v[q][j].z * v[q][j].z + v[q][j].w * v[q][j].w;
      ss[q] = wave_sum(ss[q], lane);
    }
#pragma unroll
    for (int q = 0; q < 2; ++q) {
      const int m = m0 + q * ngw;
      const float* scale = p.mod() + ((size_t)mod_row(m)) * 6144 + 1 * 1024;
#pragma unroll
      for (int t = 0; t < 2; ++t) {
        const int c = t * 512 + lane * 8;
        const float4 g0 = *(const float4*)(gain + c), g1 = *(const float4*)(gain + c + 4), s0 = *(const float4*)(scale + c), s1 = *(const float4*)(scale + c + 4);
        const float4 a = v[q][2 * t], b = v[q][2 * t + 1];
        uint4 u;
        u.x = pk2(a.x * g0.x * (1.f + s0.x), a.y * g0.y * (1.f + s0.y));
        u.y = pk2(a.z * g0.z * (1.f + s0.z), a.w * g0.w * (1.f + s0.w));
        u.z = pk2(b.x * g1.x * (1.f + s1.x), b.y * g1.y * (1.f + s1.y));
        u.w = pk2(b.z * g1.z * (1.f + s1.z), b.w * g1.w * (1.f + s1.w));
        *(uint4*)(p.hbuf() + (size_t)m * DM + c) = u;
      }
      if (lane < 16) p.rssA()[(size_t)m * 16 + lane] = lane == 0 ? ss[q] : 0.f;
    }
  }
  float* sc = (float*)smem;
  float* red = sc + 9216;
  constexpr int G_IN = DIN / 32, G_UP = DFF / 32, NIT = 2 * G_IN + 2 * G_UP;
  for (int item = my_bid(); item < NIT; item += gridDim.x) {
    int l, grp; const float* W; int N; float* outp; int ldo; int which;
    if (item < 2 * G_IN) { l = item / G_IN; grp = item % G_IN; W = p.w_in + (size_t)l * DM * DIN; N = DIN; outp = p.sWin() + (size_t)l * 9 * DINP; ldo = DINP; which = 0; }
    else { const int i2 = item - 2 * G_IN; l = i2 / G_UP; grp = i2 % G_UP; W = p.w_up + (size_t)l * DM * DFF; N = DFF; outp = p.sWup() + (size_t)l * 9 * DFF; ldo = DFF; which = 3; }
    __syncthreads();
    for (int i = tid; i < 9216; i += NTHR) sc[i] = p.mod()[((size_t)(l * 9 + (i >> 10))) * 6144 + which * 1024 + (i & 1023)];
    __syncthreads();
    gemv9_item(sc, red, W, N, grp * 32, outp, ldo, nullptr, tid);
  }
}
__device__ __forceinline__ void final_norm_phase(const P& p, const int wv) {
  const int tid = my_tid(wv), lane = tid & 63, gw = my_bid() * NWV + (tid >> 6), ngw = gridDim.x * NWV;
  for (int m = gw; m < NTOK; m += ngw) {
    const float* xr = p.xw() + (size_t)m * DM;
    float4 v[4];
    float ss = 0.f;
#pragma unroll
    for (int j = 0; j < 4; ++j) {
      { const f32x4 a = __builtin_nontemporal_load((const f32x4*)xr + lane + 64 * j); v[j] = make_float4(a[0], a[1], a[2], a[3]); }
      ss += v[j].x * v[j].x + v[j].y * v[j].y + v[j].z * v[j].z + v[j].w * v[j].w;
    }
    ss = wave_sum(ss, lane);
    const float rstd = rsqrtf(ss * (1.f / 1024.f) + 1e-6f);
#pragma unroll
    for (int j = 0; j < 4; ++j) {
      const int c = (lane + 64 * j) * 4;
      const float4 g = *(const float4*)(p.final_norm + c);
      __builtin_nontemporal_store((f32x4){v[j].x * rstd * g.x, v[j].y * rstd * g.y, v[j].z * rstd * g.z, v[j].w * rstd * g.w}, (f32x4*)(p.out + (size_t)m * DM + c));
    }
  }
}

__device__ __forceinline__ void transpose_tile(const float* __restrict__ W, int K, int N, bf16_t* __restrict__ WT, int item, float* tile, const int tid) {
  const int ntn = (N + 63) >> 6, kt = item / ntn, nt = item % ntn, k0 = kt * 64, n0 = nt * 64;
  const int n4 = (tid & 15) * 4, kr = tid >> 4;
#pragma unroll
  for (int q = 0; q < 2; ++q) {
    const int k = q * 32 + kr;
    f32x4 v = (f32x4){0.f, 0.f, 0.f, 0.f};
    if (n0 + n4 < N) v = __builtin_nontemporal_load((const f32x4*)(W + (size_t)(k0 + k) * N + n0 + n4));
    float* t = tile + k * 65 + n4;
    t[0] = v[0]; t[1] = v[1]; t[2] = v[2]; t[3] = v[3];
  }
  __syncthreads();
  {
    const int n = tid >> 3, kc = (tid & 7) * 8;
    const float* t = tile + kc * 65 + n;
    uint4 o;
    o.x = pk2(t[0 * 65], t[1 * 65]); o.y = pk2(t[2 * 65], t[3 * 65]); o.z = pk2(t[4 * 65], t[5 * 65]); o.w = pk2(t[6 * 65], t[7 * 65]);
    if (n0 + n < N) *(uint4*)(WT + (size_t)(n0 + n) * K + k0 + kc) = o;
  }
  __syncthreads();
}

__device__ __forceinline__ void prep_phase(const P& p, unsigned char* smem, const int wv) {
  const int tid = my_tid(wv);
  {
    float* sc = (float*)smem;
    float* red = sc + 9216;
    for (int i = tid; i < 9216; i += NTHR) {
      const int r = i >> 10, k = i & 1023;
      const float x = r == 0 ? p.c_ctx[k] : p.c[(r - 1) * 1024 + k];
      sc[i] = x / (1.f + expf(-x));
    }
    __syncthreads();
    for (int item = blockIdx.x; item < 384; item += gridDim.x) {
      const int l = item / 192, n0 = (item % 192) * 32;
      gemv9_item(sc, red, p.w_mod + (size_t)l * 1024 * 6144, 6144, n0, p.mod() + (size_t)l * 9 * 6144, 6144, p.b_mod + l * 6144, tid);
    }
  }
  __syncthreads();
  {
    float* tile = (float*)smem;
    constexpr int I_IN = 16 * 37, I_OUT = 16 * 16, I_UP = 16 * 64, I_DN = 64 * 16, I_KV = 2 * 8;
    constexpr int PER = I_IN + I_OUT + I_UP + I_DN + I_KV;
    for (int item = blockIdx.x; item < 2 * PER; item += gridDim.x) {
      const int l = item / PER;
      int r = item % PER;
      if (r < I_IN) { transpose_tile(p.w_in + (size_t)l * DM * DIN, DM, DIN, p.WinT() + (size_t)l * DINP * DM, r, tile, tid); continue; }
      r -= I_IN;
      if (r < I_OUT) { transpose_tile(p.w_out + (size_t)l * DM * DM, DM, DM, p.WoutT() + (size_t)l * DM * DM, r, tile, tid); continue; }
      r -= I_OUT;
      if (r < I_UP) { transpose_tile(p.w_up + (size_t)l * DM * DFF, DM, DFF, p.WupT() + (size_t)l * DFF * DM, r, tile, tid); continue; }
      r -= I_UP;
      if (r < I_DN) { transpose_tile(p.w_down + (size_t)l * DFF * DM, DFF, DM, p.WdownT() + (size_t)l * DM * DFF, r, tile, tid); continue; }
      r -= I_DN;
      transpose_tile(p.w_kv_b + (size_t)l * 128 * 512, 128, 512, p.WkvbT() + (size_t)l * 512 * 128, r, tile, tid);
    }
  }
  const int gt = blockIdx.x * NTHR + tid, gs = gridDim.x * NTHR;
  if (gt < 256) p.ctl()[gt] = 0u;
  for (int i = gt; i < 64 * 16; i += gs) {
    const int pos = i >> 4, f = i & 15;
    const float ang = (float)pos * exp2f(-(float)f * (L2_10000 / 16.f));
    p.ropeW()[pos * 32 + f] = __cosf(ang);
    p.ropeW()[pos * 32 + 16 + f] = __sinf(ang);
  }
  for (int i = gt; i < 64 * 8; i += gs) {
    const int pos = i >> 3, f = i & 7;
    const float ang = (float)pos * exp2f(-(float)f * (L2_10000 / 8.f));
    p.ropeM()[pos * 16 + f] = __cosf(ang);
    p.ropeM()[pos * 16 + 8 + f] = __sinf(ang);
  }
  for (int i = gt; i < 2 * (DINP - DIN) * DM / 8; i += gs) {
    const int l = i / ((DINP - DIN) * DM / 8), o = i % ((DINP - DIN) * DM / 8);
    *(uint4*)(p.WinT() + ((size_t)l * DINP + DIN) * DM + (size_t)o * 8) = make_uint4(0, 0, 0, 0);
  }
  for (int i = gt; i < 524288 / 8; i += gs) {
    const int d8 = i & 7, kv = (i >> 3) & 1, s = (i >> 4) & 255, l = (i >> 12) & 1, b = i >> 13;
    const float4 a = *(const float4*)(p.cache_win_k + (size_t)i * 8), c = *(const float4*)(p.cache_win_k + (size_t)i * 8 + 4);
    *(uint4*)(p.Kwin_l() + ((size_t)((l * 8 + b) * 1280 + 1024 + s)) * 128 + kv * 64 + d8 * 8) = make_uint4(pk2(a.x, a.y), pk2(a.z, a.w), pk2(c.x, c.y), pk2(c.z, c.w));
  }
  for (int i = gt; i < 524288 / 8; i += gs) {
    const int d = i & 63, kv = (i >> 6) & 1, s8 = (i >> 7) & 31, l = (i >> 12) & 1, b = i >> 13;
    const float* src = p.cache_win_v + ((size_t)((b * 2 + l) * 256 + s8 * 8) * 2 + kv) * 64 + d;
    float v[8];
#pragma unroll
    for (int j = 0; j < 8; ++j) v[j] = src[(size_t)j * 128];
    *(uint4*)(p.Vtwin_l() + ((size_t)(((l * 8 + b) * 2 + kv) * 64 + d)) * 1280 + 1024 + s8 * 8) = make_uint4(pk2(v[0], v[1]), pk2(v[2], v[3]), pk2(v[4], v[5]), pk2(v[6], v[7]));
  }
  for (int i = gt; i < 524288 / 8; i += gs) {
    const int j8 = i & 15, s = (i >> 4) & 255, l = (i >> 12) & 1, b = i >> 13;
    const float4 a = *(const float4*)(p.cache_mla_ckv + (size_t)i * 8), c = *(const float4*)(p.cache_mla_ckv + (size_t)i * 8 + 4);
    *(uint4*)(p.ckvn() + ((size_t)l * 18432 + 16384 + b * 256 + s) * 128 + j8 * 8) = make_uint4(pk2(a.x, a.y), pk2(a.z, a.w), pk2(c.x, c.y), pk2(c.z, c.w));
  }
  for (int i = gt; i < 131072 / 8; i += gs) {
    const int j8 = i & 3, s = (i >> 2) & 255, l = (i >> 10) & 1, b = i >> 11;
    const float4 a = *(const float4*)(p.cache_mla_krope + (size_t)i * 8), c = *(const float4*)(p.cache_mla_krope + (size_t)i * 8 + 4);
    const uint4 o = make_uint4(pk2(a.x, a.y), pk2(a.z, a.w), pk2(c.x, c.y), pk2(c.z, c.w));
#pragma unroll
    for (int hh = 0; hh < 4; ++hh) *(uint4*)(p.Kmla_l() + ((size_t)(((l * 8 + b) * 4 + hh) * 1280 + 1024 + s)) * 96 + 64 + j8 * 8) = o;
  }
  for (int i = gt; i < 524288 / 8; i += gs) {
    const int e = i & 63, d8 = (i >> 6) & 7, blk = i >> 9;
    const int hh = blk & 3, dir = (blk >> 2) & 1, l = (blk >> 3) & 1, b = blk >> 4;
    const float* src = p.state_ret + (size_t)blk * 4096 + (size_t)(d8 * 8) * 64 + e;
    float v[8];
#pragma unroll
    for (int j = 0; j < 8; ++j) v[j] = src[(size_t)j * 64];
    *(uint4*)(p.S0t() + ((size_t)((((l * 8 + b) * 2 + dir) * 4 + hh) * 64 + e)) * 64 + d8 * 8) = make_uint4(pk2(v[0], v[1]), pk2(v[2], v[3]), pk2(v[4], v[5]), pk2(v[6], v[7]));
  }
}

struct RotOrder : pg8::StaticOrder {
  int rot;
  __device__ __forceinline__ bool next(int i, Unit& u) const {
    if (!pg8::StaticOrder::next(i, u)) return false;
    u.pn += rot; if (u.pn >= nN) u.pn -= nN;
    return true;
  }
};
template <class Epi>
__device__ __forceinline__ void big_gemm(unsigned char* smem, const bf16_t* A, const bf16_t* Bt, int N, int K, const Epi& E, const int wv, int rot = 0) {
  pg8::Gemm g{A, Bt, NTOK, N, K};
  RotOrder S;
  S.init(NTOK, N, (int)gridDim.x, my_bid());
  S.rot = rot;
  pg8::gemm_phase<Epi, RotOrder, true, true>((PG8_LAS unsigned char*)smem, g, S, E, wv);
}

#define GSYNC() grid.sync()
__global__ void __launch_bounds__(NTHR, 2) hybrid_fwd(P p_arg) {
  cg::grid_group grid = cg::this_grid();
  const kargp_t kp = (kargp_t)__builtin_amdgcn_kernarg_segment_ptr();
  const int wv = __builtin_amdgcn_readfirstlane((int)threadIdx.x >> 6);
  { const P p = load_params(kp); prep_phase(p, smem, wv); }
  GSYNC();
  { const P p = load_params(kp); norm0_phase(p, smem, wv); }
  GSYNC();
#pragma unroll
  for (int l = 0; l < 2; ++l) {
    { const P pc = load_params(kp); const int t0 = my_tid(wv);
      for (int i = t0; i < 64 * 32; i += NTHR) ((float*)(smem + LDS_ROPEW))[i] = pc.ropeW()[i];
      for (int i = t0; i < 64 * 16; i += NTHR) ((float*)(smem + LDS_ROPEM))[i] = pc.ropeM()[i];
      __syncthreads(); }
    { const P p = load_params(kp);
      big_gemm(smem, p.hbuf(), p.WinT() + (size_t)l * DINP * DM, DINP, DM, EpiIn8{p, l, kp}, wv, 8); }
    { const P p = load_params(kp); gemm_small(p.ckvn() + (size_t)l * 18432 * 128, 128, p.WkvbT() + (size_t)l * 512 * 128, 128, 18432, 512, 128, smem, EpiKvb{p, l}, wv, p.ctl() + 64 * l, p.ctl() + 128 + 64 * l); }
    GSYNC();
    { const P p = load_params(kp); attn_phase(p, l, smem, wv); }
    GSYNC();
    { const P p = load_params(kp); big_gemm(smem, p.mix(), p.WoutT() + (size_t)l * DM * DM, DM, DM, EpiOut8{p, l}, wv); }
    GSYNC();
    { const P p = load_params(kp); big_gemm(smem, p.hbuf(), p.WupT() + (size_t)l * DFF * DM, DFF, DM, EpiUp8{p, l}, wv); }
    GSYNC();
    { const P p = load_params(kp); big_gemm(smem, p.ubuf(), p.WdownT() + (size_t)l * DM * DFF, DM, DFF, EpiDown8{p, l}, wv); }
    GSYNC();
  }
  { const P p = load_params(kp); final_norm_phase(p, wv); }
}

extern "C" void kernel_launch(void* const* d_in, const int* in_sizes, int n_in, void* d_out, int out_size, void* d_ws, size_t ws_size,
                              hipStream_t stream) {
  static int grid_blocks = 0;
  if (grid_blocks == 0) {
    int dev = 0, cus = 0, per_cu = 0;
    (void)hipGetDevice(&dev);
    (void)hipDeviceGetAttribute(&cus, hipDeviceAttributeMultiprocessorCount, dev);
    (void)hipFuncSetAttribute((const void*)hybrid_fwd, hipFuncAttributeMaxDynamicSharedMemorySize, LDS_BYTES);
    (void)hipOccupancyMaxActiveBlocksPerMultiprocessor(&per_cu, (const void*)hybrid_fwd, NTHR, LDS_BYTES);
    if (per_cu < 1) { fprintf(stderr, "occupancy query returned %d\n", per_cu); per_cu = 1; }
    per_cu = 1;
    grid_blocks = cus * per_cu;
  }
  P p{};
  const float* const* in = (const float* const*)d_in;
  p.x_prompt = in[0]; p.x_sample = in[1]; p.cache_win_k = in[2]; p.cache_win_v = in[3]; p.cache_mla_ckv = in[4];
  p.cache_mla_krope = in[5]; p.state_ret = in[6]; p.c = in[7]; p.c_ctx = in[8]; p.w_mod = in[9]; p.b_mod = in[10];
  p.norm1 = in[11]; p.norm2 = in[12]; p.w_in = in[13]; p.win_sink = in[14]; p.ret_decay = in[15]; p.ret_gn = in[16];
  p.mla_kv_norm = in[17]; p.w_kv_b = in[18]; p.w_out = in[19]; p.w_up = in[20]; p.w_down = in[21]; p.final_norm = in[22];
  p.out = (float*)d_out;
  p.ws = (unsigned char*)d_ws;
  if (WS_END > ws_size) { fprintf(stderr, "kernel_launch: workspace too small: need %zu, have %zu\n", (size_t)WS_END, ws_size); return; }
  void* args[] = {&p};
  hipError_t e = hipLaunchCooperativeKernel((const void*)hybrid_fwd, dim3(grid_blocks), dim3(NTHR), args, LDS_BYTES, stream);
  if (e != hipSuccess) fprintf(stderr, "cooperative launch failed: %s (grid %d)\n", hipGetErrorString(e), grid_blocks);
}
```
